# Optimizing an MI355X kernel written in HIP

```python
import math
import jax, jax.numpy as jnp
from jax import lax
import numpy as np

D_MODEL = 1024
BATCH = 4
SEQ = 8192
DEPTH = 1

MIX_WIDTH = D_MODEL
ATTN_WIDTH = MIX_WIDTH // 2
REC_WIDTH = MIX_WIDTH - ATTN_WIDTH
HEAD_DIM = 64
N_HEADS = ATTN_WIDTH // HEAD_DIM
ROT_DIM = HEAD_DIM // 4
ROPE_THETA = 500000.0
ATTN_BRANCHES = ((128, 1), (512, 4), (2048, 16))
REC_BLOCKS = 8
REC_BLOCK_W = REC_WIDTH // REC_BLOCKS
CONV_WIDTH = 4
CONV_PAD = (2, 1)
RG_LRU_C = 8.0
IN_WIDTH = 3 * ATTN_WIDTH + 2 * REC_WIDTH
N_EXPERTS = 256
TOP_K = 8
N_GROUPS = 8
TOPK_GROUPS = 4
EXPERT_HIDDEN = 256
SHARED_HIDDEN = 256
ROUTED_SCALE = 2.5
EXPERT_BLOCK = 128
DEEPNORM_ALPHA = (2 * DEPTH) ** 0.25
DEEPNORM_BETA = (8 * DEPTH) ** -0.25
LN_EPS = 1e-5
NEG_INF = -1e30
MAX_POS_OFFSET = 4096

kernel_name = 'hybrid_dilated_attn_rglru_moe_encoder'


def _layer_norm(x, g, b):
    xf = x.astype(jnp.float32)
    mu = jnp.mean(xf, axis=-1, keepdims=True)
    var = jnp.mean(jnp.square(xf - mu), axis=-1, keepdims=True)
    return ((xf - mu) * lax.rsqrt(var + LN_EPS) * g + b).astype(x.dtype)


def _rms_norm(t, g):
    tf = t.astype(jnp.float32)
    return tf * lax.rsqrt(jnp.mean(jnp.square(tf), axis=-1, keepdims=True) + LN_EPS) * g


def _partial_rope(t, positions):
    half = ROT_DIM // 2
    inv_freq = ROPE_THETA ** (-jnp.arange(half, dtype=jnp.float32) * 2.0 / ROT_DIM)
    ang = positions.astype(jnp.float32)[:, :, None] * inv_freq
    cos = jnp.cos(ang)[:, :, None, :]
    sin = jnp.sin(ang)[:, :, None, :]
    tr = t[..., :ROT_DIM].astype(jnp.float32)
    t1, t2 = tr[..., :half], tr[..., half:]
    rot = jnp.concatenate([t1 * cos - t2 * sin, t2 * cos + t1 * sin], axis=-1).astype(t.dtype)
    return jnp.concatenate([rot, t[..., ROT_DIM:]], axis=-1)


def _band_attention(q, k, v, half):
    L, hd = q.shape[-2], q.shape[-1]
    blk = half
    nb = -(-L // blk)
    lead = q.shape[:-2]
    nl = len(lead)
    qb = jnp.pad(q, [(0, 0)] * nl + [(0, nb * blk - L), (0, 0)]).reshape(*lead, nb, blk, hd)

    def windows(t):
        tp = jnp.pad(t, [(0, 0)] * nl + [(blk, nb * blk - L + blk), (0, 0)])
        tp = tp.reshape(*lead, nb + 2, blk, hd)
        return jnp.concatenate([tp[..., :-2, :, :], tp[..., 1:-1, :, :], tp[..., 2:, :, :]], axis=-2)

    kw, vw = windows(k), windows(v)
    qpos = (jnp.arange(nb)[:, None] * blk + jnp.arange(blk)[None, :])[:, :, None]
    kpos = (jnp.arange(nb)[:, None] * blk - blk + jnp.arange(3 * blk)[None, :])[:, None, :]
    mask = (jnp.abs(qpos - kpos) <= half) & (kpos >= 0) & (kpos < L)
    s = jnp.einsum('...nqd,...nkd->...nqk', qb, kw, preferred_element_type=jnp.float32) * (hd ** -0.5)
    s = jnp.where(mask, s, NEG_INF)
    m = jnp.max(s, axis=-1, keepdims=True)
    p = jnp.exp(s - m)
    den = jnp.sum(p, axis=-1)
    o = jnp.einsum('...nqk,...nkd->...nqd', p, vw.astype(jnp.float32)) / den[..., None]
    lse = m[..., 0] + jnp.log(den)
    o = o.reshape(*lead, nb * blk, hd)[..., :L, :]
    lse = lse.reshape(*lead, nb * blk)[..., :L]
    return o, lse


def _dilated_attention(q, k, v):
    B, H, S, hd = q.shape
    outs, lses = [], []
    for window, dil in ATTN_BRANCHES:
        half = window // (2 * dil)

        def to_residue(t, d=dil):
            return t.reshape(B, H, S // d, d, hd).swapaxes(2, 3)

        o, lse = _band_attention(to_residue(q), to_residue(k), to_residue(v), half)
        outs.append(o.swapaxes(2, 3).reshape(B, H, S, hd))
        lses.append(lse.swapaxes(2, 3).reshape(B, H, S))
    wts = jax.nn.softmax(jnp.stack(lses), axis=0)
    return jnp.einsum('gbhs,gbhsd->bhsd', wts, jnp.stack(outs))


def _centred_depthwise_conv(u, w, b):
    y = lax.conv_general_dilated(u, w[:, None, :], window_strides=(1,), padding=[CONV_PAD],
                                 dimension_numbers=('NWC', 'WIO', 'NWC'),
                                 feature_group_count=u.shape[-1])
    return y + b


def _linear_combine(c1, c2):
    a1, b1 = c1
    a2, b2 = c2
    return a1 * a2, a2 * b1 + b2


def _rg_lru_scan(u, w_a, b_a, w_x, b_x, lam, reverse):
    B, S, W = u.shape
    ub = u.reshape(B, S, REC_BLOCKS, REC_BLOCK_W)
    r = jax.nn.sigmoid((jnp.einsum('bsni,nij->bsnj', ub, w_a).reshape(B, S, W) + b_a).astype(jnp.float32))
    i = jax.nn.sigmoid((jnp.einsum('bsni,nij->bsnj', ub, w_x).reshape(B, S, W) + b_x).astype(jnp.float32))
    log_a = -RG_LRU_C * r * jax.nn.softplus(-lam.astype(jnp.float32))
    a = jnp.exp(log_a)
    b = jnp.sqrt(-jnp.expm1(2.0 * log_a)) * i * u.astype(jnp.float32)
    _, h = lax.associative_scan(_linear_combine, (a, b), axis=1, reverse=reverse)
    return h


def _hybrid_mixer(x, positions, w_in, attn_gain, conv_w, conv_b, ga_w, ga_b, gx_w, gx_b, lam, rec_gain, w_out):
    B, S, _ = x.shape
    h = jnp.einsum('bsd,de->bse', x, w_in)
    q, k, v, rx, rg = jnp.split(h, [ATTN_WIDTH, 2 * ATTN_WIDTH, 3 * ATTN_WIDTH,
                                    3 * ATTN_WIDTH + REC_WIDTH], axis=-1)

    def heads(t):
        return t.reshape(B, S, N_HEADS, HEAD_DIM)

    q = _partial_rope(heads(q), positions).transpose(0, 2, 1, 3)
    k = _partial_rope(heads(k), positions).transpose(0, 2, 1, 3)
    v = heads(v).transpose(0, 2, 1, 3)
    attn = _dilated_attention(q, k, v).transpose(0, 2, 1, 3).reshape(B, S, ATTN_WIDTH)

    u = _centred_depthwise_conv(rx, conv_w, conv_b)
    h_fwd = _rg_lru_scan(u, ga_w[0], ga_b[0], gx_w[0], gx_b[0], lam[0], reverse=False)
    h_bwd = _rg_lru_scan(u, ga_w[1], ga_b[1], gx_w[1], gx_b[1], lam[1], reverse=True)
    rec = (h_fwd + h_bwd) * jax.nn.gelu(rg.astype(jnp.float32))

    mix = jnp.concatenate([_rms_norm(attn, attn_gain), _rms_norm(rec, rec_gain)], axis=-1).astype(x.dtype)
    return jnp.einsum('bse,ed->bsd', mix, w_out)


def _swiglu(x, wg, wu, wd):
    return (jax.nn.silu(x @ wg) * (x @ wu)) @ wd


def _routed_experts(xt, idx, gate, w_gate, w_up, w_down):
    T, D = xt.shape
    N = T * TOP_K
    n_blocks = -(-(N + N_EXPERTS * (EXPERT_BLOCK - 1)) // EXPERT_BLOCK)
    P = n_blocks * EXPERT_BLOCK
    flat_e = idx.reshape(N)
    order = jnp.argsort(flat_e)
    e_sorted = flat_e[order]
    tok_sorted = (order // TOP_K).astype(jnp.int32)
    w_sorted = gate.reshape(N)[order]
    counts = jnp.bincount(flat_e, length=N_EXPERTS)
    padded = (counts + EXPERT_BLOCK - 1) // EXPERT_BLOCK * EXPERT_BLOCK
    pad_end = jnp.cumsum(padded)
    pad_start = pad_end - padded
    start = jnp.cumsum(counts) - counts
    dest = pad_start[e_sorted] + jnp.arange(N) - start[e_sorted]
    slot_tok = jnp.full((P,), T, jnp.int32).at[dest].set(tok_sorted)
    slot_w = jnp.zeros((P,), xt.dtype).at[dest].set(w_sorted)
    block_e = jnp.minimum(jnp.searchsorted(pad_end, jnp.arange(n_blocks) * EXPERT_BLOCK, side='right'),
                          N_EXPERTS - 1)
    x_pad = jnp.concatenate([xt, jnp.zeros((1, D), xt.dtype)], axis=0)

    def step(acc, blk):
        tok, w, e = blk
        yb = _swiglu(x_pad[tok], w_gate[e], w_up[e], w_down[e]) * w[:, None]
        return acc.at[tok].add(yb), None

    acc, _ = lax.scan(step, jnp.zeros((T + 1, D), xt.dtype),
                      (slot_tok.reshape(n_blocks, EXPERT_BLOCK), slot_w.reshape(n_blocks, EXPERT_BLOCK), block_e))
    return acc[:T]


def _moe_ffn(x, router_w, router_bias, exp_w_gate, exp_w_up, exp_w_down, sh_gate, sh_up, sh_down):
    B, S, D = x.shape
    T = B * S
    xt = x.reshape(T, D)
    scores = jax.nn.sigmoid(jnp.einsum('td,de->te', xt, router_w, preferred_element_type=jnp.float32))
    biased = scores + router_bias.astype(jnp.float32)
    grp = biased.reshape(T, N_GROUPS, N_EXPERTS // N_GROUPS)
    grp_score = jnp.sum(lax.top_k(grp, 2)[0], axis=-1)
    _, top_grp = lax.top_k(grp_score, TOPK_GROUPS)
    grp_mask = jnp.sum(jax.nn.one_hot(top_grp, N_GROUPS, dtype=jnp.float32), axis=-2) > 0
    expert_mask = jnp.repeat(grp_mask, N_EXPERTS // N_GROUPS, axis=-1)
    _, idx = lax.top_k(jnp.where(expert_mask, biased, -jnp.inf), TOP_K)
    gate = jnp.take_along_axis(scores, idx, axis=-1)
    gate = gate / jnp.sum(gate, axis=-1, keepdims=True) * ROUTED_SCALE
    routed = _routed_experts(xt, idx, gate.astype(xt.dtype), exp_w_gate, exp_w_up, exp_w_down)
    shared = _swiglu(xt, sh_gate, sh_up, sh_down)
    return (routed + shared).reshape(B, S, D)


def setup_inputs(seed: int = 0) -> dict:
    key = jax.random.key(seed)
    ks = jax.random.split(key, 32)
    f32 = jnp.float32

    def nrm(k, shape, scale):
        return jax.random.normal(k, shape, f32) * scale

    x = nrm(ks[0], (BATCH, SEQ, D_MODEL), 1.0)
    positions = (jax.random.randint(ks[1], (BATCH, 1), 0, MAX_POS_OFFSET)
                 + jnp.arange(SEQ)[None, :]).astype(jnp.int32)
    col_scale = jnp.ones((IN_WIDTH,), f32).at[2 * ATTN_WIDTH:3 * ATTN_WIDTH].set(DEEPNORM_BETA)
    w_in = nrm(ks[2], (DEPTH, D_MODEL, IN_WIDTH), D_MODEL ** -0.5) * col_scale
    attn_gain = 1.0 + nrm(ks[3], (DEPTH, ATTN_WIDTH), 0.1)
    rec_conv_w = nrm(ks[4], (DEPTH, CONV_WIDTH, REC_WIDTH), CONV_WIDTH ** -0.5)
    rec_conv_b = nrm(ks[5], (DEPTH, REC_WIDTH), 0.02)
    rec_gate_a_w = nrm(ks[6], (DEPTH, 2, REC_BLOCKS, REC_BLOCK_W, REC_BLOCK_W), REC_BLOCK_W ** -0.5)
    rec_gate_a_b = nrm(ks[7], (DEPTH, 2, REC_WIDTH), 0.02)
    rec_gate_x_w = nrm(ks[8], (DEPTH, 2, REC_BLOCKS, REC_BLOCK_W, REC_BLOCK_W), REC_BLOCK_W ** -0.5)
    rec_gate_x_b = nrm(ks[9], (DEPTH, 2, REC_WIDTH), 0.02)
    a_c = jax.random.uniform(ks[10], (DEPTH, 2, REC_WIDTH), f32, minval=0.9, maxval=0.999)
    a0 = a_c ** (1.0 / RG_LRU_C)
    rec_lambda = jnp.log(a0) - jnp.log1p(-a0)
    rec_gain = 1.0 + nrm(ks[11], (DEPTH, REC_WIDTH), 0.1)
    w_out = nrm(ks[12], (DEPTH, MIX_WIDTH, D_MODEL), MIX_WIDTH ** -0.5 * DEEPNORM_BETA)
    ln1_g = 1.0 + nrm(ks[13], (DEPTH, D_MODEL), 0.1)
    ln1_b = nrm(ks[14], (DEPTH, D_MODEL), 0.02)
    router_w = nrm(ks[15], (DEPTH, D_MODEL, N_EXPERTS), D_MODEL ** -0.5)
    router_bias = nrm(ks[16], (DEPTH, N_EXPERTS), 0.01)
    exp_w_gate = nrm(ks[17], (DEPTH, N_EXPERTS, D_MODEL, EXPERT_HIDDEN), D_MODEL ** -0.5)
    exp_w_up = nrm(ks[18], (DEPTH, N_EXPERTS, D_MODEL, EXPERT_HIDDEN), D_MODEL ** -0.5)
    exp_w_down = nrm(ks[19], (DEPTH, N_EXPERTS, EXPERT_HIDDEN, D_MODEL), EXPERT_HIDDEN ** -0.5 * DEEPNORM_BETA)
    shared_w_gate = nrm(ks[20], (DEPTH, D_MODEL, SHARED_HIDDEN), D_MODEL ** -0.5)
    shared_w_up = nrm(ks[21], (DEPTH, D_MODEL, SHARED_HIDDEN), D_MODEL ** -0.5)
    shared_w_down = nrm(ks[22], (DEPTH, SHARED_HIDDEN, D_MODEL), SHARED_HIDDEN ** -0.5 * DEEPNORM_BETA)
    ln2_g = 1.0 + nrm(ks[23], (DEPTH, D_MODEL), 0.1)
    ln2_b = nrm(ks[24], (DEPTH, D_MODEL), 0.02)
    return {'x': x, 'positions': positions, 'w_in': w_in, 'attn_gain': attn_gain,
            'rec_conv_w': rec_conv_w, 'rec_conv_b': rec_conv_b,
            'rec_gate_a_w': rec_gate_a_w, 'rec_gate_a_b': rec_gate_a_b,
            'rec_gate_x_w': rec_gate_x_w, 'rec_gate_x_b': rec_gate_x_b,
            'rec_lambda': rec_lambda, 'rec_gain': rec_gain, 'w_out': w_out,
            'ln1_g': ln1_g, 'ln1_b': ln1_b, 'router_w': router_w, 'router_bias': router_bias,
            'exp_w_gate': exp_w_gate, 'exp_w_up': exp_w_up, 'exp_w_down': exp_w_down,
            'shared_w_gate': shared_w_gate, 'shared_w_up': shared_w_up, 'shared_w_down': shared_w_down,
            'ln2_g': ln2_g, 'ln2_b': ln2_b}


def reference(x, positions, w_in, attn_gain, rec_conv_w, rec_conv_b, rec_gate_a_w, rec_gate_a_b,
              rec_gate_x_w, rec_gate_x_b, rec_lambda, rec_gain, w_out, ln1_g, ln1_b, router_w,
              router_bias, exp_w_gate, exp_w_up, exp_w_down, shared_w_gate, shared_w_up,
              shared_w_down, ln2_g, ln2_b):
    for l in range(DEPTH):
        y = _hybrid_mixer(x, positions, w_in[l], attn_gain[l], rec_conv_w[l], rec_conv_b[l],
                          rec_gate_a_w[l], rec_gate_a_b[l], rec_gate_x_w[l], rec_gate_x_b[l],
                          rec_lambda[l], rec_gain[l], w_out[l])
        x = _layer_norm(DEEPNORM_ALPHA * x + y, ln1_g[l], ln1_b[l])
        f = _moe_ffn(x, router_w[l], router_bias[l], exp_w_gate[l], exp_w_up[l], exp_w_down[l],
                     shared_w_gate[l], shared_w_up[l], shared_w_down[l])
        x = _layer_norm(DEEPNORM_ALPHA * x + f, ln2_g[l], ln2_b[l])
    return x
```

```cpp
#include <hip/hip_runtime.h>
#include <cstdio>
#include <cstdint>

namespace nv {
constexpr int NB = 4, S = 8192, T = NB * S, D = 1024, AW = 512, RW = 512, HD = 64, NH = 8, INW = 2560;
constexpr int NE = 256, TOPK = 8, EH = 256;
constexpr float ALPHA = 1.189207115002721f;
constexpr float LN_EPS = 1e-5f;
constexpr int TILE = 64;
constexpr int MAXTILES = T * TOPK / TILE + NE;
constexpr int MAXSLOTS = MAXTILES * TILE;

struct GemmP { const float* A; const float* B; float* C; int lda, ldb, ldc, M, N, K; };
__global__ void __launch_bounds__(256) k_gemm(GemmP g) {
    __shared__ float As[16][68];
    __shared__ float Bs[16][68];
    const int tid = threadIdx.x, tx = tid & 15, ty = tid >> 4;
    const int m0 = blockIdx.y * 64, n0 = blockIdx.x * 64;
    float acc[4][4];
#pragma unroll
    for (int i = 0; i < 4; ++i)
#pragma unroll
        for (int j = 0; j < 4; ++j) acc[i][j] = 0.f;
    const int ar = tid >> 2, ak = (tid & 3) * 4;
    const int bk = tid >> 4, bn = (tid & 15) * 4;
    for (int k0 = 0; k0 < g.K; k0 += 16) {
        const float4 av = *(const float4*)(g.A + (size_t)(m0 + ar) * g.lda + k0 + ak);
        const float4 bv = *(const float4*)(g.B + (size_t)(k0 + bk) * g.ldb + n0 + bn);
        As[ak + 0][ar] = av.x; As[ak + 1][ar] = av.y; As[ak + 2][ar] = av.z; As[ak + 3][ar] = av.w;
        *(float4*)&Bs[bk][bn] = bv;
        __syncthreads();
#pragma unroll
        for (int k = 0; k < 16; ++k) {
            const float4 a = *(const float4*)&As[k][ty * 4];
            const float4 b = *(const float4*)&Bs[k][tx * 4];
            const float aa[4] = {a.x, a.y, a.z, a.w}, bb[4] = {b.x, b.y, b.z, b.w};
#pragma unroll
            for (int i = 0; i < 4; ++i)
#pragma unroll
                for (int j = 0; j < 4; ++j) acc[i][j] = fmaf(aa[i], bb[j], acc[i][j]);
        }
        __syncthreads();
    }
#pragma unroll
    for (int i = 0; i < 4; ++i)
        *(float4*)(g.C + (size_t)(m0 + ty * 4 + i) * g.ldc + n0 + tx * 4) = make_float4(acc[i][0], acc[i][1], acc[i][2], acc[i][3]);
}

struct GGemmP { const float* A; const int* slot_tok; const float* B; float* C; const int* tile_e; const int* ntiles; const float* slot_w; size_t strideB;
                int lda, gatherA, ldb, ldc, N, K, mode, pad; };
__global__ void __launch_bounds__(256) k_ggemm(GGemmP g) {
    __shared__ float As[16][68];
    __shared__ float Bs[16][68];
    __shared__ int toks[64];
    const int tile = blockIdx.y;
    if (tile >= *g.ntiles) return;
    const int e = g.tile_e[tile];
    const int tid = threadIdx.x, tx = tid & 15, ty = tid >> 4;
    const int n0 = blockIdx.x * 64;
    if (tid < 64) toks[tid] = g.slot_tok[tile * 64 + tid];
    __syncthreads();
    const float* Bp = g.B + (size_t)e * g.strideB;
    float acc[4][4];
#pragma unroll
    for (int i = 0; i < 4; ++i)
#pragma unroll
        for (int j = 0; j < 4; ++j) acc[i][j] = 0.f;
    const int ar = tid >> 2, ak = (tid & 3) * 4;
    const int bk = tid >> 4, bn = (tid & 15) * 4;
    const int atok = toks[ar];
    const long arow = g.gatherA ? (long)atok : (long)(tile * 64 + ar);
    for (int k0 = 0; k0 < g.K; k0 += 16) {
        float4 av = make_float4(0.f, 0.f, 0.f, 0.f);
        if (atok >= 0) av = *(const float4*)(g.A + (size_t)arow * g.lda + k0 + ak);
        const float4 bv = *(const float4*)(Bp + (size_t)(k0 + bk) * g.ldb + n0 + bn);
        As[ak + 0][ar] = av.x; As[ak + 1][ar] = av.y; As[ak + 2][ar] = av.z; As[ak + 3][ar] = av.w;
        *(float4*)&Bs[bk][bn] = bv;
        __syncthreads();
#pragma unroll
        for (int k = 0; k < 16; ++k) {
            const float4 a = *(const float4*)&As[k][ty * 4];
            const float4 b = *(const float4*)&Bs[k][tx * 4];
            const float aa[4] = {a.x, a.y, a.z, a.w}, bb[4] = {b.x, b.y, b.z, b.w};
#pragma unroll
            for (int i = 0; i < 4; ++i)
#pragma unroll
                for (int j = 0; j < 4; ++j) acc[i][j] = fmaf(aa[i], bb[j], acc[i][j]);
        }
        __syncthreads();
    }
#pragma unroll
    for (int i = 0; i < 4; ++i) {
        const int r = ty * 4 + i, slot = tile * 64 + r, tok = toks[r];
        if (g.mode == 0) {
            *(float4*)(g.C + (size_t)slot * g.ldc + n0 + tx * 4) = make_float4(acc[i][0], acc[i][1], acc[i][2], acc[i][3]);
        } else if (tok >= 0) {
            const float w = g.slot_w[slot];
#pragma unroll
            for (int j = 0; j < 4; ++j) atomicAdd(g.C + (size_t)tok * g.ldc + n0 + tx * 4 + j, w * acc[i][j]);
        }
    }
}

__device__ __forceinline__ float wsum(float v) {
#pragma unroll
    for (int o = 1; o < 64; o <<= 1) v += __shfl_xor(v, o);
    return v;
}
__device__ __forceinline__ float wmaxf(float v) {
#pragma unroll
    for (int o = 1; o < 64; o <<= 1) v = fmaxf(v, __shfl_xor(v, o));
    return v;
}
__device__ __forceinline__ int wmini(int v) {
#pragma unroll
    for (int o = 1; o < 64; o <<= 1) v = min(v, __shfl_xor(v, o));
    return v;
}
__device__ __forceinline__ void sincos_acc(float ang, float& c, float& s) {
    const double x = (double)ang;
    const double k = rint(x * 0.63661977236758134308);
    double r = fma(-k, 1.57079632679489655800, x);
    r = fma(-k, 6.12323399573676603587e-17, r);
    const long long q = (long long)k;
    const double r2 = r * r;
    double sp = -7.6471637318198164759e-13; sp = fma(sp, r2, 1.6059043836821614599e-10); sp = fma(sp, r2, -2.5052108385441718775e-08);
    sp = fma(sp, r2, 2.7557319223985890653e-06); sp = fma(sp, r2, -1.9841269841269841270e-04); sp = fma(sp, r2, 8.3333333333333333333e-03);
    sp = fma(sp, r2, -1.6666666666666666667e-01); const double sr = fma(sp * r2, r, r);
    double cp = 4.7794773323873852974e-14; cp = fma(cp, r2, -1.1470745597729724714e-11); cp = fma(cp, r2, 2.0876756987868098979e-09);
    cp = fma(cp, r2, -2.7557319223985890653e-07); cp = fma(cp, r2, 2.4801587301587301587e-05); cp = fma(cp, r2, -1.3888888888888888889e-03);
    cp = fma(cp, r2, 4.1666666666666666667e-02); cp = fma(cp, r2, -0.5); const double cr = fma(cp, r2, 1.0);
    double ss, cc;
    switch ((int)(q & 3)) { case 0: ss = sr; cc = cr; break; case 1: ss = cr; cc = -sr; break; case 2: ss = -sr; cc = -cr; break; default: ss = -cr; cc = sr; break; }
    c = (float)cc; s = (float)ss;
}
__device__ __forceinline__ float gelu_tanh(float x) {
    const float z = 0.7978845608028654f * (x + 0.044715f * x * x * x);
    const float e = __expf(2.f * z);
    const float th = 1.f - 2.f / (e + 1.f);
    return 0.5f * x * (1.f + th);
}
__device__ __forceinline__ float sigmoidf_(float x) { return 1.f / (1.f + expf(-x)); }

__global__ void k_rope(float* h, const int* pos) {
    const int gid = blockIdx.x * blockDim.x + threadIdx.x;
    if (gid >= T * 2 * NH * 8) return;
    const int i = gid & 7, head = (gid >> 3) & 7, which = (gid >> 6) & 1, t = gid >> 7;
    const float invf[8] = {1.0f, 0x1.8d275ep-3f, 0x1.341190p-5f, 0x1.ddee9cp-8f, 0x1.72ba44p-10f, 0x1.1f91f0p-12f, 0x1.be218ap-15f, 0x1.5a0f50p-17f};
    float inv = invf[0];
#pragma unroll
    for (int j = 1; j < 8; ++j) inv = (i == j) ? invf[j] : inv;
    const float ang = (float)pos[t] * inv;
    float c, s; sincos_acc(ang, c, s);
    float* p = h + (size_t)t * INW + which * AW + head * HD;
    const float t1 = p[i], t2 = p[i + 8];
    p[i] = t1 * c - t2 * s; p[i + 8] = t2 * c + t1 * s;
}

__global__ void __launch_bounds__(64) k_attn(const float* h, float* attn) {
    const int lane = threadIdx.x, head = blockIdx.x & 7, t = blockIdx.x >> 3, b = t / S, s = t % S;
    const float q = h[(size_t)t * INW + head * HD + lane];
    float og[3], lse[3];
    const int dil[3] = {1, 4, 16};
#pragma unroll
    for (int g = 0; g < 3; ++g) {
        const int d = dil[g];
        float m = -1e30f, den = 0.f, o = 0.f;
        for (int mm = -64; mm <= 64; ++mm) {
            const int j = s + d * mm;
            if (j < 0 || j >= S) continue;
            const size_t row = (size_t)(b * S + j) * INW;
            const float kk = h[row + AW + head * HD + lane], vv = h[row + 2 * AW + head * HD + lane];
            const float sc = wsum(q * kk) * 0.125f;
            const float mn = fmaxf(m, sc), al = __expf(m - mn), p = __expf(sc - mn);
            den = den * al + p; o = o * al + p * vv; m = mn;
        }
        og[g] = o / den; lse[g] = m + __logf(den);
    }
    const float ml = fmaxf(lse[0], fmaxf(lse[1], lse[2]));
    const float w0 = __expf(lse[0] - ml), w1 = __expf(lse[1] - ml), w2 = __expf(lse[2] - ml);
    attn[(size_t)t * AW + head * HD + lane] = (w0 * og[0] + w1 * og[1] + w2 * og[2]) / (w0 + w1 + w2);
}

__global__ void k_conv(const float* h, const float* cw, const float* cb, float* u) {
    const int gid = blockIdx.x * blockDim.x + threadIdx.x;
    if (gid >= T * RW) return;
    const int c = gid & 511, t = gid >> 9, s = t % S;
    float acc = cb[c];
#pragma unroll
    for (int k = 0; k < 4; ++k) { const int ss = s + k - 2; if (ss >= 0 && ss < S) acc = fmaf(cw[k * RW + c], h[(size_t)(t + k - 2) * INW + 3 * AW + c], acc); }
    u[gid] = acc;
}
__global__ void k_gates(const float* u, const float* gaw, const float* gab, const float* gxw, const float* gxb, const float* lam, float* Aa, float* Bb) {
    const int gid = blockIdx.x * blockDim.x + threadIdx.x;
    if (gid >= T * RW) return;
    const int c = gid & 511, t = gid >> 9, n = c >> 6, j = c & 63;
    const float* ur = u + (size_t)t * RW + n * 64;
    float pa[2] = {0.f, 0.f}, px[2] = {0.f, 0.f};
    for (int i = 0; i < 64; ++i) {
        const float uu = ur[i];
#pragma unroll
        for (int dir = 0; dir < 2; ++dir) {
            pa[dir] = fmaf(uu, gaw[(((size_t)dir * 8 + n) * 64 + i) * 64 + j], pa[dir]);
            px[dir] = fmaf(uu, gxw[(((size_t)dir * 8 + n) * 64 + i) * 64 + j], px[dir]);
        }
    }
    const float uc = u[gid];
#pragma unroll
    for (int dir = 0; dir < 2; ++dir) {
        const float r = sigmoidf_(pa[dir] + gab[dir * RW + c]), ig = sigmoidf_(px[dir] + gxb[dir * RW + c]);
        const float l = lam[dir * RW + c];
        const float sp = (-l > 20.f) ? -l : log1pf(expf(-l));
        const float log_a = -8.0f * r * sp;
        const float a = expf(log_a);
        const float bb = sqrtf(-expm1f(2.0f * log_a)) * ig * uc;
        Aa[(size_t)dir * T * RW + gid] = a; Bb[(size_t)dir * T * RW + gid] = bb;
    }
}
__global__ void __launch_bounds__(64) k_scan(const float* Aa, float* Bb) {
    const int gid = blockIdx.x * 64 + threadIdx.x;
    const int c = gid & 511, b = (gid >> 9) & 3, dir = gid >> 11;
    const float* a = Aa + (size_t)dir * T * RW + (size_t)b * S * RW + c;
    float* bp = Bb + (size_t)dir * T * RW + (size_t)b * S * RW + c;
    float hh = 0.f;
    if (dir == 0) { for (int s = 0; s < S; ++s) { hh = fmaf(a[(size_t)s * RW], hh, bp[(size_t)s * RW]); bp[(size_t)s * RW] = hh; } }
    else { for (int s = S - 1; s >= 0; --s) { hh = fmaf(a[(size_t)s * RW], hh, bp[(size_t)s * RW]); bp[(size_t)s * RW] = hh; } }
}
__global__ void __launch_bounds__(256) k_mix(const float* attn, const float* Hs, const float* h, const float* ga, const float* gr, float* mix) {
    __shared__ float red[8];
    const int t = blockIdx.x, tid = threadIdx.x;
    float av[2], rv[2]; float sa = 0.f, sr = 0.f;
#pragma unroll
    for (int i = 0; i < 2; ++i) {
        const int c = tid + 256 * i;
        av[i] = attn[(size_t)t * AW + c];
        const float hf = Hs[(size_t)t * RW + c], hb = Hs[(size_t)T * RW + (size_t)t * RW + c];
        rv[i] = (hf + hb) * gelu_tanh(h[(size_t)t * INW + 3 * AW + RW + c]);
        sa += av[i] * av[i]; sr += rv[i] * rv[i];
    }
    sa = wsum(sa); sr = wsum(sr);
    if ((tid & 63) == 0) { red[tid >> 6] = sa; red[4 + (tid >> 6)] = sr; }
    __syncthreads();
    const float ta = red[0] + red[1] + red[2] + red[3], tr = red[4] + red[5] + red[6] + red[7];
    const float ra = rsqrtf(ta / 512.f + LN_EPS), rr = rsqrtf(tr / 512.f + LN_EPS);
#pragma unroll
    for (int i = 0; i < 2; ++i) {
        const int c = tid + 256 * i;
        mix[(size_t)t * D + c] = av[i] * ra * ga[c];
        mix[(size_t)t * D + AW + c] = rv[i] * rr * gr[c];
    }
}
__global__ void __launch_bounds__(256) k_resln(const float* xin, const float* y, const float* g, const float* bb, float* out) {
    __shared__ float red[8];
    const int t = blockIdx.x, tid = threadIdx.x;
    float v[4]; float s = 0.f;
#pragma unroll
    for (int i = 0; i < 4; ++i) { const int c = tid + 256 * i; v[i] = ALPHA * xin[(size_t)t * D + c] + y[(size_t)t * D + c]; s += v[i]; }
    s = wsum(s); if ((tid & 63) == 0) red[tid >> 6] = s; __syncthreads();
    const float mu = (red[0] + red[1] + red[2] + red[3]) / (float)D;
    float q = 0.f;
#pragma unroll
    for (int i = 0; i < 4; ++i) { const float d = v[i] - mu; q += d * d; }
    q = wsum(q); if ((tid & 63) == 0) red[4 + (tid >> 6)] = q; __syncthreads();
    const float var = (red[4] + red[5] + red[6] + red[7]) / (float)D, rs = rsqrtf(var + LN_EPS);
#pragma unroll
    for (int i = 0; i < 4; ++i) { const int c = tid + 256 * i; out[(size_t)t * D + c] = (v[i] - mu) * rs * g[c] + bb[c]; }
}

__global__ void __launch_bounds__(256) k_route(const float* logits, const float* rbias, unsigned* cnt, unsigned* ER, float* GW) {
    const int lane = threadIdx.x & 63, t = blockIdx.x * 4 + (threadIdx.x >> 6);
    const float4 lg = ((const float4*)(logits + (size_t)t * NE))[lane];
    const float4 bi = ((const float4*)rbias)[lane];
    const float s0 = sigmoidf_(lg.x), s1 = sigmoidf_(lg.y), s2 = sigmoidf_(lg.z), s3 = sigmoidf_(lg.w);
    float v0 = s0 + bi.x, v1 = s1 + bi.y, v2 = s2 + bi.z, v3 = s3 + bi.w;
    float hi1 = fmaxf(v0, v1), lo1 = fminf(v0, v1), hi2 = fmaxf(v2, v3), lo2 = fminf(v2, v3);
    float m1 = fmaxf(hi1, hi2), m2 = fmaxf(fminf(hi1, hi2), fmaxf(lo1, lo2));
#pragma unroll
    for (int o = 1; o < 8; o <<= 1) { const float o1 = __shfl_xor(m1, o), o2 = __shfl_xor(m2, o); const float n1 = fmaxf(m1, o1), n2 = fmaxf(fminf(m1, o1), fmaxf(m2, o2)); m1 = n1; m2 = n2; }
    const float gs = m1 + m2; const int myg = lane >> 3; int rank = 0;
#pragma unroll
    for (int j = 0; j < 8; ++j) { const float gj = __shfl(gs, 8 * j); rank += (gj > gs || (gj == gs && j < myg)) ? 1 : 0; }
    const float NEGINF = -__builtin_huge_valf();
    if (rank >= 4) { v0 = NEGINF; v1 = NEGINF; v2 = NEGINF; v3 = NEGINF; }
    float gsel[8]; int esel[8]; float gsum = 0.f;
#pragma unroll
    for (int k = 0; k < 8; ++k) {
        const float lm = fmaxf(fmaxf(v0, v1), fmaxf(v2, v3)), wm = wmaxf(lm);
        int cand = 1 << 20;
        if (v3 == wm) cand = 4 * lane + 3;
        if (v2 == wm) cand = 4 * lane + 2;
        if (v1 == wm) cand = 4 * lane + 1;
        if (v0 == wm) cand = 4 * lane + 0;
        const int e = wmini(cand), el = e >> 2, ei = e & 3;
        const float mysc = ei == 0 ? s0 : (ei == 1 ? s1 : (ei == 2 ? s2 : s3));
        const float sc = __shfl(mysc, el);
        if (lane == el) { if (ei == 0) v0 = NEGINF; else if (ei == 1) v1 = NEGINF; else if (ei == 2) v2 = NEGINF; else v3 = NEGINF; }
        esel[k] = e; gsel[k] = sc; gsum += sc;
    }
    int me = esel[0]; float mg = gsel[0];
#pragma unroll
    for (int k = 1; k < 8; ++k) { me = (lane == k) ? esel[k] : me; mg = (lane == k) ? gsel[k] : mg; }
    if (lane < 8) {
        const unsigned rk = atomicAdd(cnt + me, 1u);
        ER[(size_t)t * 8 + lane] = ((unsigned)me << 24) | rk;
        GW[(size_t)t * 8 + lane] = mg / gsum * 2.5f;
    }
}
__global__ void __launch_bounds__(256) k_offsets(const unsigned* cnt, int* tile_base, int* tile_e, int* ntiles) {
    __shared__ int tb[NE + 1];
    if (threadIdx.x == 0) { int acc = 0; for (int e = 0; e < NE; ++e) { tb[e] = acc; acc += ((int)cnt[e] + TILE - 1) / TILE; } tb[NE] = acc; *ntiles = acc; }
    __syncthreads();
    const int e = threadIdx.x; tile_base[e] = tb[e];
    for (int tl = tb[e]; tl < tb[e + 1]; ++tl) tile_e[tl] = e;
}
__global__ void k_slots(const unsigned* ER, const float* GW, const int* tile_base, int* slot_tok, float* slot_w) {
    const int gid = blockIdx.x * blockDim.x + threadIdx.x;
    if (gid >= T * 8) return;
    const unsigned er = ER[gid]; const int e = er >> 24, rk = er & 0xffffff;
    const int slot = tile_base[e] * TILE + rk;
    slot_tok[slot] = gid >> 3; slot_w[slot] = GW[gid];
}
__global__ void k_swiglu(float* G, const float* U, size_t n) {
    const size_t i = (size_t)blockIdx.x * blockDim.x + threadIdx.x;
    if (i < n) { const float g = G[i]; G[i] = g / (1.f + __expf(-g)) * U[i]; }
}
}

extern "C" void kernel_launch(void* const* d_in, const int* in_sizes, int n_in, void* d_out, int out_size, void* d_ws, size_t ws_size, hipStream_t stream) {
    using namespace nv;
    const size_t MiB = 1u << 20;
    if (ws_size < 1000 * MiB) { fprintf(stderr, "kernel_launch: workspace too small (%zu)\n", ws_size); return; }
    const float* x = (const float*)d_in[0]; const int* pos = (const int*)d_in[1]; const float* w_in = (const float*)d_in[2]; const float* attn_gain = (const float*)d_in[3];
    const float* conv_w = (const float*)d_in[4]; const float* conv_b = (const float*)d_in[5]; const float* gaw = (const float*)d_in[6]; const float* gab = (const float*)d_in[7];
    const float* gxw = (const float*)d_in[8]; const float* gxb = (const float*)d_in[9]; const float* lam = (const float*)d_in[10]; const float* rec_gain = (const float*)d_in[11];
    const float* w_out = (const float*)d_in[12]; const float* ln1g = (const float*)d_in[13]; const float* ln1b = (const float*)d_in[14]; const float* router_w = (const float*)d_in[15];
    const float* router_b = (const float*)d_in[16]; const float* ewg = (const float*)d_in[17]; const float* ewu = (const float*)d_in[18]; const float* ewd = (const float*)d_in[19];
    const float* swg = (const float*)d_in[20]; const float* swu = (const float*)d_in[21]; const float* swd = (const float*)d_in[22]; const float* ln2g = (const float*)d_in[23]; const float* ln2b = (const float*)d_in[24];
    float* out = (float*)d_out; char* ws = (char*)d_ws;
    unsigned* cnt = (unsigned*)(ws + 0);
    int* tile_base = (int*)(ws + 4096); int* ntiles = (int*)(ws + 8192); int* tile_e = (int*)(ws + 16384);
    unsigned* ER = (unsigned*)(ws + 1 * MiB); float* GW = (float*)(ws + 2 * MiB);
    int* slot_tok = (int*)(ws + 3 * MiB); float* slot_w = (float*)(ws + 5 * MiB);
    float* h = (float*)(ws + 16 * MiB); float* attn = (float*)(ws + 336 * MiB); float* u = (float*)(ws + 400 * MiB);
    float* Aa = (float*)(ws + 464 * MiB); float* Bb = (float*)(ws + 592 * MiB); float* mix = (float*)(ws + 720 * MiB);
    float* y = (float*)(ws + 16 * MiB); float* x1 = (float*)(ws + 144 * MiB); float* logits = (float*)(ws + 272 * MiB);
    float* G = (float*)(ws + 304 * MiB); float* U = (float*)(ws + 576 * MiB); float* acc = (float*)(ws + 848 * MiB);

    (void)hipMemsetAsync(cnt, 0, 1024, stream);
    (void)hipMemsetAsync(slot_tok, 0xFF, (size_t)MAXSLOTS * 4, stream);
    { GemmP g{x, w_in, h, D, INW, INW, T, INW, D}; hipLaunchKernelGGL(k_gemm, dim3(INW / 64, T / 64), dim3(256), 0, stream, g); }
    hipLaunchKernelGGL(k_rope, dim3(T * 2 * NH * 8 / 256), dim3(256), 0, stream, h, pos);
    hipLaunchKernelGGL(k_attn, dim3(T * NH), dim3(64), 0, stream, h, attn);
    hipLaunchKernelGGL(k_conv, dim3(T * RW / 256), dim3(256), 0, stream, h, conv_w, conv_b, u);
    hipLaunchKernelGGL(k_gates, dim3(T * RW / 256), dim3(256), 0, stream, u, gaw, gab, gxw, gxb, lam, Aa, Bb);
    hipLaunchKernelGGL(k_scan, dim3(4 * 512 * 2 / 64), dim3(64), 0, stream, Aa, Bb);
    hipLaunchKernelGGL(k_mix, dim3(T), dim3(256), 0, stream, attn, Bb, h, attn_gain, rec_gain, mix);
    { GemmP g{mix, w_out, y, D, D, D, T, D, D}; hipLaunchKernelGGL(k_gemm, dim3(D / 64, T / 64), dim3(256), 0, stream, g); }
    hipLaunchKernelGGL(k_resln, dim3(T), dim3(256), 0, stream, x, y, ln1g, ln1b, x1);
    { GemmP g{x1, router_w, logits, D, NE, NE, T, NE, D}; hipLaunchKernelGGL(k_gemm, dim3(NE / 64, T / 64), dim3(256), 0, stream, g); }
    hipLaunchKernelGGL(k_route, dim3(T / 4), dim3(256), 0, stream, logits, router_b, cnt, ER, GW);
    hipLaunchKernelGGL(k_offsets, dim3(1), dim3(256), 0, stream, cnt, tile_base, tile_e, ntiles);
    hipLaunchKernelGGL(k_slots, dim3(T * 8 / 256), dim3(256), 0, stream, ER, GW, tile_base, slot_tok, slot_w);
    { GemmP g{x1, swg, G, D, EH, EH, T, EH, D}; hipLaunchKernelGGL(k_gemm, dim3(EH / 64, T / 64), dim3(256), 0, stream, g); }
    { GemmP g{x1, swu, U, D, EH, EH, T, EH, D}; hipLaunchKernelGGL(k_gemm, dim3(EH / 64, T / 64), dim3(256), 0, stream, g); }
    hipLaunchKernelGGL(k_swiglu, dim3((unsigned)(((size_t)T * EH + 255) / 256)), dim3(256), 0, stream, G, U, (size_t)T * EH);
    { GemmP g{G, swd, acc, EH, D, D, T, D, EH}; hipLaunchKernelGGL(k_gemm, dim3(D / 64, T / 64), dim3(256), 0, stream, g); }
    { GGemmP g{x1, slot_tok, ewg, G, tile_e, ntiles, slot_w, (size_t)D * EH, D, 1, EH, EH, EH, D, 0, 0}; hipLaunchKernelGGL(k_ggemm, dim3(EH / 64, MAXTILES), dim3(256), 0, stream, g); }
    { GGemmP g{x1, slot_tok, ewu, U, tile_e, ntiles, slot_w, (size_t)D * EH, D, 1, EH, EH, EH, D, 0, 0}; hipLaunchKernelGGL(k_ggemm, dim3(EH / 64, MAXTILES), dim3(256), 0, stream, g); }
    hipLaunchKernelGGL(k_swiglu, dim3((unsigned)(((size_t)MAXSLOTS * EH + 255) / 256)), dim3(256), 0, stream, G, U, (size_t)MAXSLOTS * EH);
    { GGemmP g{G, slot_tok, ewd, acc, tile_e, ntiles, slot_w, (size_t)EH * D, EH, 0, D, D, D, EH, 1, 0}; hipLaunchKernelGGL(k_ggemm, dim3(D / 64, MAXTILES), dim3(256), 0, stream, g); }
    hipLaunchKernelGGL(k_resln, dim3(T), dim3(256), 0, stream, x1, acc, ln2g, ln2b, out);
}
```

```cpp
#include <hip/hip_runtime.h>
#include <cstdio>
#include <cstdint>

#define LAS __attribute__((address_space(3)))
#define GAS __attribute__((address_space(1)))
typedef unsigned short bf16;
typedef short bf16x8 __attribute__((ext_vector_type(8)));
typedef short s16x4 __attribute__((ext_vector_type(4)));
typedef float f32x2 __attribute__((ext_vector_type(2)));
typedef float f32x4 __attribute__((ext_vector_type(4)));
typedef float f32x16 __attribute__((ext_vector_type(16)));
typedef unsigned u32x2 __attribute__((ext_vector_type(2)));
typedef unsigned u32x4 __attribute__((ext_vector_type(4)));
typedef GAS unsigned gu32;
#define RLX_AGENT __ATOMIC_RELAXED, __HIP_MEMORY_SCOPE_AGENT
#define DI __device__ __forceinline__

constexpr int NB = 4, SEQ = 8192, T = NB * SEQ, D = 1024, AW = 512, RW = 512, HD = 64, NH = 8, INW = 2560;
constexpr int NE = 256, TOPK = 8, EH = 256;
constexpr float ALPHA = 1.189207115002721f;
constexpr float LN_EPS = 1e-5f;
constexpr float LOG2E = 1.4426950408889634f;
constexpr float QSCALE = 0.125f * LOG2E;
constexpr int NWAVES = 8;
constexpr int MAXRT = T * TOPK / 256 + NE;
constexpr int NSHT = T / 256;
constexpr int MAXTILES = MAXRT + NSHT;
constexpr int MAXSLOTS = MAXTILES * 256;
constexpr int LCH = 128, NCH = SEQ / LCH;

constexpr size_t MiB = 1u << 20;
constexpr size_t WS_CTL = 0, CTL_ZERO_BYTES = 1 * MiB;
constexpr size_t WS_ROPE = 1 * MiB;
constexpr size_t WS_GWT = 3 * MiB;
constexpr size_t WS_C2 = 3 * MiB + 512 * 1024;
constexpr size_t WS_CARRY = 4 * MiB;
constexpr size_t WS_ER = 6 * MiB, WS_TS = 7 * MiB, WS_GW = 8 * MiB;
constexpr size_t WS_SLOTTOK = 9 * MiB, WS_SLOTW = 11 * MiB;
constexpr size_t WS_TILEE = 13 * MiB;
constexpr size_t WS_WINT = 14 * MiB, WS_WOUTT = 19 * MiB, WS_RTT = 21 * MiB;
constexpr size_t WS_WDT = 32 * MiB;
constexpr size_t WS_H = 161 * MiB;
constexpr size_t WS_Q = 161 * MiB, SEG_BYTES = 32 * MiB;
constexpr size_t WS_Y = 337 * MiB;
constexpr size_t WS_WGUT = 337 * MiB;
constexpr size_t WS_X1B = 594 * MiB;
constexpr size_t WS_LOGITS = 658 * MiB;
constexpr size_t WS_ATTN = 658 * MiB, WS_REC = 690 * MiB;
constexpr size_t WS_V1 = 722 * MiB;
constexpr size_t WS_XB = 722 * MiB;
constexpr size_t WS_MIX = 850 * MiB;
constexpr size_t WS_HF = 914 * MiB;
constexpr size_t WS_END = 977 * MiB;
static_assert(WS_WDT + (size_t)257 * 1024 * 256 * 2 <= WS_H && WS_H + (size_t)MAXSLOTS * 256 * 2 <= WS_Y && WS_Y + (size_t)MAXRT * 256 * 1024 * 2 <= WS_END, "ws map");
static_assert(WS_WGUT + (size_t)257 * 512 * 1024 * 2 <= WS_X1B && WS_Q + 5 * SEG_BYTES <= WS_Y, "ws map 2");
constexpr int CW_TMO = 0, CW_CNT = 1024, CW_NT = 2048, CW_CHK = 3072, CW_BAR = 4096;
#define XCD_BAR_WORDS_C 3456
static_assert((CW_BAR + 16 * XCD_BAR_WORDS_C) * 4 <= (int)CTL_ZERO_BYTES, "ctl");

constexpr int RING_OFF = 0, RING_BYTES = 131072;
constexpr int UT_OFF = RING_BYTES;
constexpr int UT_IDX = UT_OFF + 128;
constexpr int MISC_OFF = UT_IDX + 11 * 1024;
constexpr int LDS_BYTES = 147456;
static_assert(MISC_OFF + 256 <= LDS_BYTES, "LDS map");

DI unsigned f2bf(float f) { unsigned u = __builtin_bit_cast(unsigned, f); return (u + 0x7fffu + ((u >> 16) & 1u)) >> 16; }
DI unsigned pk2(float lo, float hi) { return f2bf(lo) | (f2bf(hi) << 16); }
DI float bf2f(unsigned short b) { return __builtin_bit_cast(float, (unsigned)b << 16); }
DI float bflo(unsigned w) { return __builtin_bit_cast(float, w << 16); }
DI float bfhi(unsigned w) { return __builtin_bit_cast(float, w & 0xffff0000u); }
DI float wave_sum(float v) {
#pragma unroll
    for (int o = 1; o < 64; o <<= 1) v += __shfl_xor(v, o);
    return v;
}
DI float wave_max(float v) {
#pragma unroll
    for (int o = 1; o < 64; o <<= 1) v = fmaxf(v, __shfl_xor(v, o));
    return v;
}
DI int wave_min_i(int v) {
#pragma unroll
    for (int o = 1; o < 64; o <<= 1) v = min(v, __shfl_xor(v, o));
    return v;
}
DI float fexp2(float x) { return __builtin_amdgcn_exp2f(x); }
DI float frcp(float x) { return __builtin_amdgcn_rcpf(x); }
DI float gelu_tanh(float x) {
    const float z = 0.7978845608028654f * (x + 0.044715f * x * x * x);
    const float e = fexp2(2.f * LOG2E * z);
    return 0.5f * x * (2.f - 2.f * frcp(e + 1.f));
}
DI int crow(int r, int hi) { return (r & 3) + 8 * (r >> 2) + 4 * hi; }
#define MFMA32(a, b, c) __builtin_amdgcn_mfma_f32_32x32x16_bf16((a), (b), (c), 0, 0, 0)

namespace pg8 {
constexpr int BM = 256, BK = 64, HALF = 128, HTB = HALF * BK * 2, NXCD = 8;
DI int lds_byte(int r, int c) { const int st = (r >> 4) * 2 + (c >> 5), rr = r & 15, cc = c & 31, ob = rr * 64 + cc * 2; return st * 1024 + (ob ^ (((ob >> 9) & 1) << 5)); }
DI void stage_rc(int b, int& R, int& C) { const int st = b / 1024, sb = b % 1024, swz = sb ^ (((sb >> 9) & 1) << 5); R = (st >> 1) * 16 + swz / 64; C = (st & 1) * 32 + (swz % 64) / 2; }
DI int perm32(int rho) { const int n = rho >> 4, i = rho & 15; return 8 * (i >> 2) + 4 * n + (i & 3); }
struct Unit { int pm, pn, li, ex; };
DI bool xcd_order(int i, int G, int c, int nwg, int& wgid) {
    const long L = (long)i * G + c; if (L >= nwg) return false;
    const int w = (int)L, q = nwg / NXCD, r = nwg % NXCD, xcd = w % NXCD, off = w / NXCD;
    wgid = (xcd < r ? xcd * (q + 1) : r * (q + 1) + (xcd - r) * q) + off; return true;
}
DI unsigned cvt_pk_bf16(float lo, float hi) { unsigned r; asm volatile("v_cvt_pk_bf16_f32 %0, %1, %2" : "=v"(r) : "v"(lo), "v"(hi)); return r; }

template <class Epi, class Sched, bool ALIGN_EPI>
DI void gemm_phase(LAS unsigned char* lds, const Sched& S, const Epi& E, const int K) {
    const int tid = threadIdx.x, wid = __builtin_amdgcn_readfirstlane(tid >> 6), lane = tid & 63, wr = wid >> 2, wc = wid & 3, fr = lane & 15, fq = lane >> 4;
    const int nt = K / BK;
    int Ri[2], Ci[2]; unsigned voffB[2];
#pragma unroll
    for (int i = 0; i < 2; ++i) { int R, C; stage_rc(tid * 16 + i * 8192, R, C); Ri[i] = R; Ci[i] = C; const int Rb = Epi::PERM ? ((R & ~31) + perm32(R & 31)) : R; voffB[i] = (unsigned)(Rb * S.ldb + C) * 2u; }
    const size_t kstep = (size_t)(BK * 2);
    const size_t hstepB = (size_t)HALF * S.ldb * 2;
    const unsigned ldsw = (unsigned)wid * 1024u;
    const int aoff = lds_byte(wr * 64 + fr, fq * 8), boff = lds_byte(wc * 32 + fr, fq * 8);
#define PG8_SA(b, h) (((b) * 2 + (h)) * HTB)
#define PG8_SB(b, h) ((4 + (b) * 2 + (h)) * HTB)
#define PG8_STAGE(bufoff, gbase, voff) do { _Pragma("unroll") for (int _i = 0; _i < 2; ++_i) \
        __builtin_amdgcn_global_load_lds((const unsigned*)((const char*)(gbase) + (voff)[_i]), (LAS unsigned*)(lds + (bufoff) + ldsw + _i * 8192), 16, 0, 0); } while (0)
#define PG8_LDA(dst, b, h) do { _Pragma("unroll") for (int m = 0; m < 4; ++m) _Pragma("unroll") for (int k = 0; k < 2; ++k) dst[m][k] = *(const LAS bf16x8*)(lds + PG8_SA(b, h) + aoff + m * 2048 + k * 1024); } while (0)
#define PG8_LDB(dst, b, h) do { _Pragma("unroll") for (int n = 0; n < 2; ++n) _Pragma("unroll") for (int k = 0; k < 2; ++k) dst[n][k] = *(const LAS bf16x8*)(lds + PG8_SB(b, h) + boff + n * 2048 + k * 1024); } while (0)
#define PG8_MMA(ai, bj, At, Bt) do { __builtin_amdgcn_s_setprio(1); _Pragma("unroll") for (int m = 0; m < 4; ++m) _Pragma("unroll") for (int n = 0; n < 2; ++n) _Pragma("unroll") for (int k = 0; k < 2; ++k) \
        acc[ai][bj][m][n] = __builtin_amdgcn_mfma_f32_16x16x32_bf16(Bt[n][k], At[m][k], acc[ai][bj][m][n], 0, 0, 0); __builtin_amdgcn_s_setprio(0); } while (0)
#define PG8_WAIT_V(n) asm volatile("s_waitcnt vmcnt(" #n ")" ::: "memory")
#define PG8_WAIT_L(n) asm volatile("s_waitcnt lgkmcnt(" #n ")" ::: "memory")
#define PG8_BAR __builtin_amdgcn_s_barrier()
#define PG8_SCHED __builtin_amdgcn_sched_barrier(0)
    Unit cur, nxt; int ui = 0;
    if (!S.next(0, cur)) return;
    f32x4 acc[2][2][4][2];
#pragma unroll
    for (int a = 0; a < 2; ++a)
#pragma unroll
        for (int b = 0; b < 2; ++b)
#pragma unroll
            for (int m = 0; m < 4; ++m)
#pragma unroll
                for (int n = 0; n < 2; ++n) acc[a][b][m][n] = (f32x4){0.f, 0.f, 0.f, 0.f};
    bf16x8 At[4][2], B0[2][2], B1[2][2];
    unsigned ca0[2], ca1[2], na0[2], na1[2];
#pragma unroll
    for (int i = 0; i < 2; ++i) { ca0[i] = S.a_voff(cur, Ri[i], Ci[i]); ca1[i] = S.a_voff(cur, HALF + Ri[i], Ci[i]); }
    const char* cA = S.a_base(cur); const char* cB = S.b_base(cur);
    PG8_STAGE(PG8_SB(0, 0), cB, voffB); PG8_STAGE(PG8_SB(0, 1), cB + hstepB, voffB); PG8_STAGE(PG8_SA(0, 0), cA, ca0); PG8_STAGE(PG8_SA(0, 1), cA, ca1);
    if (wr == 1) PG8_BAR;
    PG8_WAIT_V(2); PG8_BAR;
    PG8_STAGE(PG8_SB(1, 0), cB + kstep, voffB); PG8_STAGE(PG8_SA(1, 0), cA + kstep, ca0); PG8_STAGE(PG8_SB(1, 1), cB + hstepB + kstep, voffB);
    PG8_WAIT_V(6); PG8_BAR;
    for (;;) {
        const bool has_next = S.next(ui + 1, nxt);
        const char* nA = has_next ? S.a_base(nxt) : cA; const char* nB = has_next ? S.b_base(nxt) : cB;
#pragma unroll
        for (int i = 0; i < 2; ++i) { na0[i] = has_next ? S.a_voff(nxt, Ri[i], Ci[i]) : ca0[i]; na1[i] = has_next ? S.a_voff(nxt, HALF + Ri[i], Ci[i]) : ca1[i]; }
#pragma unroll 1
        for (int t = 0; t < nt; t += 2) {
            const bool last = (t == nt - 2);
            const char* a1 = cA + (size_t)(t + 1) * kstep;
            const char* a2 = last ? nA : cA + (size_t)(t + 2) * kstep; const char* b2 = last ? nB : cB + (size_t)(t + 2) * kstep;
            const char* a3 = a2 + kstep; const char* b3 = b2 + kstep;
            unsigned v20[2], v21[2];
#pragma unroll
            for (int i = 0; i < 2; ++i) { v20[i] = last ? na0[i] : ca0[i]; v21[i] = last ? na1[i] : ca1[i]; }
            PG8_LDB(B0, 0, 0); PG8_LDB(B1, 0, 1); PG8_SCHED; PG8_LDA(At, 0, 0); PG8_STAGE(PG8_SA(1, 1), a1, ca1);
            PG8_WAIT_V(8); PG8_WAIT_L(0); PG8_BAR; PG8_MMA(0, 0, At, B0); PG8_MMA(0, 1, At, B1); PG8_BAR; PG8_SCHED;
            PG8_LDA(At, 0, 1); PG8_STAGE(PG8_SB(0, 0), b2, voffB); PG8_STAGE(PG8_SB(0, 1), b2 + hstepB, voffB); PG8_STAGE(PG8_SA(0, 0), a2, v20);
            PG8_WAIT_V(8); PG8_WAIT_L(0); PG8_BAR; PG8_MMA(1, 0, At, B0); PG8_MMA(1, 1, At, B1); PG8_BAR; PG8_SCHED;
            PG8_LDB(B0, 1, 0); PG8_LDB(B1, 1, 1); PG8_SCHED; PG8_LDA(At, 1, 0); PG8_STAGE(PG8_SA(0, 1), a2, v21);
            PG8_WAIT_V(8); PG8_WAIT_L(0); PG8_BAR; PG8_MMA(0, 0, At, B0); PG8_MMA(0, 1, At, B1); PG8_BAR; PG8_SCHED;
            PG8_LDA(At, 1, 1); PG8_STAGE(PG8_SB(1, 0), b3, voffB); PG8_STAGE(PG8_SB(1, 1), b3 + hstepB, voffB); PG8_STAGE(PG8_SA(1, 0), a3, v20);
            PG8_WAIT_V(8); PG8_WAIT_L(0); PG8_BAR; PG8_MMA(1, 0, At, B0); PG8_MMA(1, 1, At, B1); PG8_BAR; PG8_SCHED;
        }
        if constexpr (ALIGN_EPI) { if (wr == 0) PG8_BAR; }
        E(acc, cur, wr, wc, fr, fq);
        if (!has_next) break;
#pragma unroll
        for (int a = 0; a < 2; ++a)
#pragma unroll
            for (int b = 0; b < 2; ++b)
#pragma unroll
                for (int m = 0; m < 4; ++m)
#pragma unroll
                    for (int n = 0; n < 2; ++n) acc[a][b][m][n] = (f32x4){0.f, 0.f, 0.f, 0.f};
        cur = nxt; cA = nA; cB = nB; ++ui;
#pragma unroll
        for (int i = 0; i < 2; ++i) { ca0[i] = na0[i]; ca1[i] = na1[i]; }
        if constexpr (ALIGN_EPI) { if (wr == 1) PG8_BAR; }
    }
    PG8_WAIT_V(0);
    if constexpr (!ALIGN_EPI) { if (wr == 0) PG8_BAR; }
    PG8_BAR;
#undef PG8_SA
#undef PG8_SB
#undef PG8_STAGE
#undef PG8_LDA
#undef PG8_LDB
#undef PG8_MMA
#undef PG8_WAIT_V
#undef PG8_WAIT_L
#undef PG8_BAR
#undef PG8_SCHED
}
}
#define XB_TMO      128
#define XB_XCNT(j)  (256  + 64 * (j))
#define XB_XSUB(j)  (1280 + 64 * (j))
#define XB_XGEN(j)  (2304 + 64 * (j))
#define XB_TOP      3328
#define XB_TOPGEN   3392
#define XCD_BAR_WORDS 3456
#define XB_SPIN_CAP (1u << 18)

__device__ __forceinline__ unsigned xb_ld(unsigned* p)              { return __hip_atomic_load(p, __ATOMIC_RELAXED, __HIP_MEMORY_SCOPE_AGENT); }
__device__ __forceinline__ unsigned xb_add(unsigned* p, unsigned v) { return __hip_atomic_fetch_add(p, v, __ATOMIC_RELAXED, __HIP_MEMORY_SCOPE_AGENT); }
__device__ __forceinline__ unsigned xb_xcc_id() { return (unsigned)__builtin_amdgcn_s_getreg((3 << 11) | 20) & 0xFu; }
#define XB_SPIN(cond, bar) do { unsigned _sp = 0; while (cond) { __builtin_amdgcn_s_sleep(1); \
    if ((++_sp & 255u) == 0u) { if (xb_ld(&(bar)[XB_TMO])) break; if (_sp > XB_SPIN_CAP) { atomicAdd(&(bar)[XB_TMO], 1u); break; } } } } while (0)

struct XcdBarrier {
    unsigned* bar; unsigned x;
    volatile LAS unsigned* st;
};

__device__ __forceinline__ XcdBarrier xcd_barrier_post(unsigned* bar, volatile LAS unsigned* st) {
    XcdBarrier b; b.bar = bar; b.x = xb_xcc_id(); b.st = st;
    if (threadIdx.x == 0) (void)xb_add(&bar[XB_XCNT(b.x)], 1u);
    return b;
}
__device__ __forceinline__ void xcd_barrier_complete(unsigned* bar, unsigned x, unsigned& nloc, unsigned& nx) {
    const unsigned G = gridDim.x * gridDim.y * gridDim.z;
    unsigned sum, cnt, mine, sp = 0u;
    for (;;) {
        sum = 0u; cnt = 0u; mine = 0u;
#pragma unroll
        for (unsigned j = 0; j < 16; ++j) { const unsigned c = xb_ld(&bar[XB_XCNT(j)]); sum += c; cnt += (c > 0u) ? 1u : 0u; mine = (j == x) ? c : mine; }
        if (sum == G) break;
        __builtin_amdgcn_s_sleep(1);
        if ((++sp & 255u) == 0u) { if (xb_ld(&bar[XB_TMO])) break; if (sp > XB_SPIN_CAP) { atomicAdd(&bar[XB_TMO], 1u); break; } }
    }
    nloc = mine > 0u ? mine : 1u; nx = cnt > 0u ? cnt : 1u;
}

__device__ __forceinline__ void xcd_barrier(const XcdBarrier& b) {
    asm volatile("s_waitcnt vmcnt(0)" ::: "memory");
    __syncthreads();
    if (threadIdx.x == 0) {
        unsigned* bar = b.bar;
        __builtin_amdgcn_s_waitcnt(0);
        unsigned nloc = b.st[0], nx = b.st[1];
        if (nloc == 0u) { xcd_barrier_complete(bar, b.x, nloc, nx); b.st[0] = nloc; b.st[1] = nx; }
        const unsigned old = xb_add(&bar[XB_XSUB(b.x)], 1u);
        const unsigned gen = old / nloc;
        if (old + 1u == (gen + 1u) * nloc) {
            __builtin_amdgcn_fence(__ATOMIC_RELEASE, "agent");
            asm volatile("s_waitcnt vmcnt(0)" ::: "memory");
            const unsigned og = xb_add(&bar[XB_TOP], 1u);
            const unsigned tg = og / nx;
            if (og + 1u == (tg + 1u) * nx) xb_add(&bar[XB_TOPGEN], 1u);
            else XB_SPIN(xb_ld(&bar[XB_TOPGEN]) == tg, bar);
            __builtin_amdgcn_fence(__ATOMIC_ACQUIRE, "agent");
            xb_add(&bar[XB_XGEN(b.x)], 1u);
            asm volatile("s_waitcnt vmcnt(0)" ::: "memory");
        } else {
            XB_SPIN(xb_ld(&bar[XB_XGEN(b.x)]) == gen, bar);
            __builtin_amdgcn_fence(__ATOMIC_ACQUIRE, "agent");
            asm volatile("s_waitcnt vmcnt(0)" ::: "memory");
        }
    }
    __syncthreads();
}

#define LDS_WAIT() asm volatile("s_waitcnt lgkmcnt(0)" ::: "memory")
#define VM_WAIT() asm volatile("s_waitcnt vmcnt(0)" ::: "memory")
struct Frame {
    LAS unsigned char* lds;
    volatile LAS unsigned* MISC;
    gu32* ctl;
    int tid, lane, wave, vcu, G;
    unsigned char* ws;
    const float* in[25];
    float* out;
};

DI void sincos_acc(float ang, float& c, float& s) {
    const double x = (double)ang;
    const double k = rint(x * 0.63661977236758134308);
    double r = fma(-k, 1.57079632679489655800, x);
    r = fma(-k, 6.12323399573676603587e-17, r);
    const long long q = (long long)k;
    const double r2 = r * r;
    double sp = -7.6471637318198164759e-13; sp = fma(sp, r2, 1.6059043836821614599e-10); sp = fma(sp, r2, -2.5052108385441718775e-08);
    sp = fma(sp, r2, 2.7557319223985890653e-06); sp = fma(sp, r2, -1.9841269841269841270e-04); sp = fma(sp, r2, 8.3333333333333333333e-03);
    sp = fma(sp, r2, -1.6666666666666666667e-01); const double sr = fma(sp * r2, r, r);
    double cp = 4.7794773323873852974e-14; cp = fma(cp, r2, -1.1470745597729724714e-11); cp = fma(cp, r2, 2.0876756987868098979e-09);
    cp = fma(cp, r2, -2.7557319223985890653e-07); cp = fma(cp, r2, 2.4801587301587301587e-05); cp = fma(cp, r2, -1.3888888888888888889e-03);
    cp = fma(cp, r2, 4.1666666666666666667e-02); cp = fma(cp, r2, -0.5); const double cr = fma(cp, r2, 1.0);
    const int qq = (int)(q & 3);
    const double ss = qq == 0 ? sr : (qq == 1 ? cr : (qq == 2 ? -sr : -cr));
    const double cc = qq == 0 ? cr : (qq == 1 ? -sr : (qq == 2 ? -cr : sr));
    c = (float)cc; s = (float)ss;
}

DI void tr_item(const float* W, int N, bf16* WT, int Kd, LAS float* scr, int lane) {
#pragma unroll 4
    for (int i = 0; i < 16; ++i) { const int k = 4 * i + (lane >> 4), c4 = (lane & 15) * 4; const f32x4 v = *(const GAS f32x4*)(W + (size_t)k * N + c4);
        LAS float* d = scr + k * 65 + c4; d[0] = v.x; d[1] = v.y; d[2] = v.z; d[3] = v.w; }
    LDS_WAIT(); asm volatile("" ::: "memory");
    const int c = lane & 7;
#pragma unroll
    for (int j = 0; j < 8; ++j) { const int n = 8 * j + (lane >> 3); const LAS float* s = scr + (8 * c) * 65 + n;
        u32x4 o; o.x = pk2(s[0 * 65], s[1 * 65]); o.y = pk2(s[2 * 65], s[3 * 65]); o.z = pk2(s[4 * 65], s[5 * 65]); o.w = pk2(s[6 * 65], s[7 * 65]);
        *(GAS u32x4*)(WT + (size_t)n * Kd + 8 * c) = o; }
    LDS_WAIT(); asm volatile("" ::: "memory");
}
DI void p0_prologue(Frame& F) {
    LAS float* scr = (LAS float*)(F.lds + F.wave * 16640);
    const int gw = F.vcu * NWAVES + F.wave, NGW = F.G * NWAVES, lane = F.lane;
    unsigned char* ws = F.ws;
    constexpr int I_IN = 16 * 40, I_OUT = 16 * 16, I_RT = 16 * 4, I_EX = 257 * 64, I_G = 32;
    constexpr int NITEMS = I_IN + I_OUT + I_RT + 3 * I_EX + I_G;
    for (int it = gw; it < NITEMS; it += NGW) {
        int r = it;
        if (r < I_IN) { const int kb = r / 40, nb = r % 40; tr_item(F.in[2] + (size_t)kb * 64 * INW + nb * 64, INW, (bf16*)(ws + WS_WINT) + (size_t)nb * 64 * D + kb * 64, D, scr, lane); continue; } r -= I_IN;
        if (r < I_OUT) { const int kb = r / 16, nb = r % 16; tr_item(F.in[12] + (size_t)kb * 64 * D + nb * 64, D, (bf16*)(ws + WS_WOUTT) + (size_t)nb * 64 * D + kb * 64, D, scr, lane); continue; } r -= I_OUT;
        if (r < I_RT) { const int kb = r / 4, nb = r % 4; tr_item(F.in[15] + (size_t)kb * 64 * NE + nb * 64, NE, (bf16*)(ws + WS_RTT) + (size_t)nb * 64 * D + kb * 64, D, scr, lane); continue; } r -= I_RT;
        if (r < 2 * I_EX) {
            const int up = r >= I_EX; if (up) r -= I_EX;
            const int e = r >> 6, kb = (r >> 2) & 15, nb = r & 3;
            const float* src = (e < NE) ? F.in[up ? 18 : 17] + (size_t)e * D * EH : F.in[up ? 21 : 20];
            const int row = (nb >> 1) * 256 + up * 128 + (nb & 1) * 64;
            tr_item(src + (size_t)kb * 64 * EH + nb * 64, EH, (bf16*)(ws + WS_WGUT) + ((size_t)e * 512 + row) * D + kb * 64, D, scr, lane); continue; } r -= 2 * I_EX;
        if (r < I_EX) {
            const int e = r >> 6, kb = (r >> 4) & 3, nb = r & 15;
            const float* src = (e < NE) ? F.in[19] + (size_t)e * EH * D : F.in[22];
            tr_item(src + (size_t)kb * 64 * D + nb * 64, D, (bf16*)(ws + WS_WDT) + ((size_t)e * D + nb * 64) * EH + kb * 64, EH, scr, lane); continue; } r -= I_EX;
        {
            const int gate = r >> 4, dir = (r >> 3) & 1, n = r & 7;
            tr_item(F.in[gate ? 8 : 6] + (size_t)(dir * 8 + n) * 4096, 64, (bf16*)(ws + WS_GWT) + (size_t)((dir * 2 + gate) * 8 + n) * 4096, 64, scr, lane); }
    }
    { const f32x4* x4 = (const f32x4*)F.in[0]; u32x4* o = (u32x4*)(ws + WS_XB);
      for (size_t i = (size_t)gw * 64 + lane; i < (size_t)T * D / 8; i += (size_t)NGW * 64) { const f32x4 a = x4[2 * i], b = x4[2 * i + 1];
          u32x4 w; w.x = pk2(a.x, a.y); w.y = pk2(a.z, a.w); w.z = pk2(b.x, b.y); w.w = pk2(b.z, b.w); o[i] = w; } }
    { const int* pos = (const int*)F.in[1]; float* rt = (float*)(ws + WS_ROPE);
      for (int i = gw * 64 + lane; i < T * 8; i += NGW * 64) { const int t = i >> 3, f = i & 7;
          float inv = 1.0f;
          inv = f == 1 ? 0x1.8d275ep-3f : inv; inv = f == 2 ? 0x1.341190p-5f : inv; inv = f == 3 ? 0x1.ddee9cp-8f : inv; inv = f == 4 ? 0x1.72ba44p-10f : inv;
          inv = f == 5 ? 0x1.1f91f0p-12f : inv; inv = f == 6 ? 0x1.be218ap-15f : inv; inv = f == 7 ? 0x1.5a0f50p-17f : inv;
          float c, s; sincos_acc((float)pos[t] * inv, c, s); rt[t * 16 + f] = c; rt[t * 16 + 8 + f] = s; } }
    { const float* lam = F.in[10]; float* c2 = (float*)(ws + WS_C2);
      for (int i = gw * 64 + lane; i < 2 * RW; i += NGW * 64) { const float l = lam[i]; const float sp = (-l > 20.f) ? -l : log1pf(expf(-l)); c2[i] = -8.0f * sp * LOG2E; } }
}

struct SchedDense {
    const bf16* A; const bf16* Bt; int lda, ldb, nM, nN, G, c;
    DI bool next(int i, pg8::Unit& u) const { int wgid; if (!pg8::xcd_order(i, G, c, nM * nN, wgid)) return false;
        const int nig = 8 * nN, gid = wgid / nig, fm = gid * 8, gsz = (nM - fm) < 8 ? (nM - fm) : 8; u.pm = fm + ((wgid % nig) % gsz); u.pn = (wgid % nig) / gsz; u.li = i; u.ex = 0; return true; }
    DI const char* a_base(const pg8::Unit& u) const { return (const char*)A + (size_t)u.pm * 256 * lda * 2; }
    DI unsigned a_voff(const pg8::Unit&, int R, int C) const { return (unsigned)(R * lda + C) * 2u; }
    DI const char* b_base(const pg8::Unit& u) const { return (const char*)Bt + (size_t)u.pn * 256 * ldb * 2; }
};
struct SchedRouter {
    const bf16* A; const bf16* Bt; int lda, ldb, nM, G, c;
    DI bool next(int i, pg8::Unit& u) const { int wgid; if (!pg8::xcd_order(i, G, c, nM * 2, wgid)) return false; u.pm = wgid >> 1; u.pn = wgid & 1; u.li = i; u.ex = 0; return true; }
    DI const char* a_base(const pg8::Unit& u) const { return (const char*)A + ((size_t)u.pm * 256 * lda + u.pn * 512) * 2; }
    DI unsigned a_voff(const pg8::Unit&, int R, int C) const { return (unsigned)(R * lda + C) * 2u; }
    DI const char* b_base(const pg8::Unit& u) const { return (const char*)Bt + (size_t)u.pn * 512 * 2; }
};
struct SchedG1 {
    const bf16* X; const bf16* W; const LAS unsigned* ue; const LAS unsigned* idx; int ldb, nwg, G, c;
    DI bool next(int i, pg8::Unit& u) const { int wgid; if (!pg8::xcd_order(i, G, c, nwg, wgid)) return false; u.pm = wgid >> 1; u.pn = wgid & 1; u.li = i; u.ex = (int)ue[i]; return true; }
    DI const char* a_base(const pg8::Unit&) const { return (const char*)X; }
    DI unsigned a_voff(const pg8::Unit& u, int R, int C) const { return idx[u.li * 256 + R] * 2048u + (unsigned)C * 2u; }
    DI const char* b_base(const pg8::Unit& u) const { return (const char*)W + ((size_t)u.ex * 512 + u.pn * 256) * D * 2; }
};
struct SchedG2 {
    const bf16* Hh; const bf16* W; const LAS unsigned* ue; int ldb, nwg, G, c, tile0;
    DI bool next(int i, pg8::Unit& u) const { int wgid; if (!pg8::xcd_order(i, G, c, nwg, wgid)) return false; u.pm = tile0 + (wgid >> 2); u.pn = wgid & 3; u.li = i; u.ex = (int)ue[i]; return true; }
    DI const char* a_base(const pg8::Unit& u) const { return (const char*)Hh + (size_t)u.pm * 256 * EH * 2; }
    DI unsigned a_voff(const pg8::Unit&, int R, int C) const { return (unsigned)(R * EH + C) * 2u; }
    DI const char* b_base(const pg8::Unit& u) const { return (const char*)W + ((size_t)u.ex * D + u.pn * 256) * EH * 2; }
};

struct EpiInProj {
    static constexpr bool PERM = true;
    bf16* Q; const float* rope;
    DI void operator()(const f32x4 (&acc)[2][2][4][2], const pg8::Unit& u, int wr, int wc, int fr, int fq) const {
        const int seg = u.pn >> 1;
        bf16* base = Q + (size_t)seg * (SEG_BYTES / 2);
        const int row0 = u.pm * 256 + wr * 64 + fr, col0 = (u.pn & 1) * 256 + wc * 32 + 8 * fq;
        const bool rot = (seg < 2) && ((wc & 1) == 0);
        const float sgn = (fq == 0) ? -1.f : 1.f;
#pragma unroll
        for (int ai = 0; ai < 2; ++ai)
#pragma unroll
            for (int m = 0; m < 4; ++m) {
                const int row = row0 + ai * 128 + m * 16;
                f32x4 c0 = {1.f, 1.f, 1.f, 1.f}, c1 = c0, s0 = {0.f, 0.f, 0.f, 0.f}, s1 = s0;
                if (rot) { const f32x4* rp = (const f32x4*)(rope + (size_t)row * 16); c0 = rp[0]; c1 = rp[1]; s0 = rp[2]; s1 = rp[3]; }
#pragma unroll
                for (int bj = 0; bj < 2; ++bj) {
                    f32x4 v0 = acc[ai][bj][m][0], v1 = acc[ai][bj][m][1];
                    if (rot) {
                        f32x4 p0, p1;
#pragma unroll
                        for (int j = 0; j < 4; ++j) { p0[j] = __shfl_xor(v0[j], 16); p1[j] = __shfl_xor(v1[j], 16); }
                        if (fq < 2) { v0 = v0 * c0 + (p0 * s0) * sgn; v1 = v1 * c1 + (p1 * s1) * sgn; }
                    }
                    if (seg == 0) { v0 = v0 * QSCALE; v1 = v1 * QSCALE; }
                    if (seg == 4) {
#pragma unroll
                        for (int j = 0; j < 4; ++j) { v0[j] = gelu_tanh(v0[j]); v1[j] = gelu_tanh(v1[j]); } }
                    u32x4 w; w.x = pg8::cvt_pk_bf16(v0[0], v0[1]); w.y = pg8::cvt_pk_bf16(v0[2], v0[3]); w.z = pg8::cvt_pk_bf16(v1[0], v1[1]); w.w = pg8::cvt_pk_bf16(v1[2], v1[3]);
                    *(u32x4*)(base + (size_t)row * 512 + col0 + bj * 128) = w;
                }
            }
    }
};
struct EpiResV1 {
    static constexpr bool PERM = false;
    const float* x; float* V1;
    DI void operator()(const f32x4 (&acc)[2][2][4][2], const pg8::Unit& u, int wr, int wc, int fr, int fq) const {
        const int row0 = u.pm * 256 + wr * 64 + fr, col0 = u.pn * 256 + wc * 32 + 4 * fq;
#pragma unroll
        for (int ai = 0; ai < 2; ++ai)
#pragma unroll
            for (int m = 0; m < 4; ++m) { const size_t ro = (size_t)(row0 + ai * 128 + m * 16) * D + col0;
#pragma unroll
                for (int bj = 0; bj < 2; ++bj)
#pragma unroll
                    for (int n = 0; n < 2; ++n) { const f32x4 xv = *(const f32x4*)(x + ro + bj * 128 + n * 16); *(f32x4*)(V1 + ro + bj * 128 + n * 16) = acc[ai][bj][m][n] + xv * ALPHA; } }
    }
};
struct EpiLogits {
    static constexpr bool PERM = false;
    float* L;
    DI void operator()(const f32x4 (&acc)[2][2][4][2], const pg8::Unit& u, int wr, int wc, int fr, int fq) const {
        float* base = L + (size_t)u.pn * T * NE; const int row0 = u.pm * 256 + wr * 64 + fr, col0 = wc * 32 + 4 * fq;
#pragma unroll
        for (int ai = 0; ai < 2; ++ai)
#pragma unroll
            for (int m = 0; m < 4; ++m) { const size_t ro = (size_t)(row0 + ai * 128 + m * 16) * NE + col0;
#pragma unroll
                for (int bj = 0; bj < 2; ++bj)
#pragma unroll
                    for (int n = 0; n < 2; ++n) *(f32x4*)(base + ro + bj * 128 + n * 16) = acc[ai][bj][m][n]; }
    }
};
struct EpiSwiglu {
    static constexpr bool PERM = true;
    bf16* Hh;
    DI void operator()(const f32x4 (&acc)[2][2][4][2], const pg8::Unit& u, int wr, int wc, int fr, int fq) const {
        const int row0 = u.pm * 256 + wr * 64 + fr, col0 = u.pn * 128 + wc * 32 + 8 * fq;
#pragma unroll
        for (int ai = 0; ai < 2; ++ai)
#pragma unroll
            for (int m = 0; m < 4; ++m) {
                float h[8];
#pragma unroll
                for (int n = 0; n < 2; ++n)
#pragma unroll
                    for (int j = 0; j < 4; ++j) { const float g = acc[ai][0][m][n][j], uu = acc[ai][1][m][n][j]; h[4 * n + j] = g * frcp(1.f + fexp2(-LOG2E * g)) * uu; }
                u32x4 w; w.x = pg8::cvt_pk_bf16(h[0], h[1]); w.y = pg8::cvt_pk_bf16(h[2], h[3]); w.z = pg8::cvt_pk_bf16(h[4], h[5]); w.w = pg8::cvt_pk_bf16(h[6], h[7]);
                *(u32x4*)(Hh + (size_t)(row0 + ai * 128 + m * 16) * EH + col0) = w;
            }
    }
};
struct EpiDownY {
    static constexpr bool PERM = true;
    bf16* Y; const float* slot_w;
    DI void operator()(const f32x4 (&acc)[2][2][4][2], const pg8::Unit& u, int wr, int wc, int fr, int fq) const {
        const int rl0 = wr * 64 + fr, col0 = u.pn * 256 + wc * 32 + 8 * fq;
#pragma unroll
        for (int ai = 0; ai < 2; ++ai)
#pragma unroll
            for (int m = 0; m < 4; ++m) { const size_t slot = (size_t)u.pm * 256 + rl0 + ai * 128 + m * 16; const float w = slot_w[slot];
#pragma unroll
                for (int bj = 0; bj < 2; ++bj) { const f32x4 v0 = acc[ai][bj][m][0] * w, v1 = acc[ai][bj][m][1] * w;
                    u32x4 o; o.x = pg8::cvt_pk_bf16(v0[0], v0[1]); o.y = pg8::cvt_pk_bf16(v0[2], v0[3]); o.z = pg8::cvt_pk_bf16(v1[0], v1[1]); o.w = pg8::cvt_pk_bf16(v1[2], v1[3]);
                    *(u32x4*)(Y + slot * D + col0 + bj * 128) = o; } }
    }
};
struct EpiDownS {
    static constexpr bool PERM = true;
    float* out; int NT;
    DI void operator()(const f32x4 (&acc)[2][2][4][2], const pg8::Unit& u, int wr, int wc, int fr, int fq) const {
        const int rl0 = wr * 64 + fr, col0 = u.pn * 256 + wc * 32 + 8 * fq;
#pragma unroll
        for (int ai = 0; ai < 2; ++ai)
#pragma unroll
            for (int m = 0; m < 4; ++m) { const size_t tok = (size_t)(u.pm - NT) * 256 + rl0 + ai * 128 + m * 16;
#pragma unroll
                for (int bj = 0; bj < 2; ++bj) { f32x4* p = (f32x4*)(out + tok * D + col0 + bj * 128); const f32x4 a0 = p[0], a1 = p[1]; p[0] = a0 + acc[ai][bj][m][0]; p[1] = a1 + acc[ai][bj][m][1]; }
                asm volatile("" ::: "memory"); }
    }
};

struct ScanP { const bf16* RX; const bf16* G; const bf16* GWT; const float* cw; const float* cb; const float* gab; const float* gxb; const float* c2; f32x2* carry; bf16* HF; bf16* REC; };
constexpr int UT_PITCH = 144;
DI void build_u_tile(const bf16* RX, int tt0, int n, float w0, float w1, float w2, float w3, float cbv, LAS unsigned char* ut, int lane) {
    const int s0 = tt0 & (SEQ - 1);
    const bf16* p = RX + (size_t)tt0 * RW + 64 * n + lane;
    float xm2 = 0.f, xm1 = 0.f;
    if (s0 != 0) { xm2 = bf2f(p[-2 * RW]); xm1 = bf2f(p[-RW]); }
    float x0 = bf2f(p[0]);
    const bool has_tail = (s0 + 32) < SEQ;
#pragma unroll
    for (int tok = 0; tok < 32; ++tok) {
        float x1 = 0.f;
        if (tok < 31) x1 = bf2f(p[(tok + 1) * RW]); else if (has_tail) x1 = bf2f(p[32 * RW]);
        const float uu = cbv + w0 * xm2 + w1 * xm1 + w2 * x0 + w3 * x1;
        *(LAS unsigned short*)(ut + tok * UT_PITCH + lane * 2) = (unsigned short)f2bf(uu);
        xm2 = xm1; xm1 = x0; x0 = x1;
    }
}
DI void gate_tile(const LAS unsigned char* ut, const bf16x8 (&wA)[2][4], const bf16x8 (&wX)[2][4], const float (&ba)[2], const float (&bx)[2], const float (&c2v)[2],
                  f32x16 (&a)[2], f32x16 (&b)[2], int lane) {
    const int col = lane & 31, hi = lane >> 5;
    bf16x8 af[4];
#pragma unroll
    for (int ks = 0; ks < 4; ++ks) af[ks] = *(const LAS bf16x8*)(ut + col * UT_PITCH + (16 * ks + 8 * hi) * 2);
    f32x16 z;
#pragma unroll
    for (int i = 0; i < 16; ++i) z[i] = 0.f;
#pragma unroll
    for (int ct = 0; ct < 2; ++ct) {
        f32x16 pa = z, px = z;
#pragma unroll
        for (int ks = 0; ks < 4; ++ks) { pa = MFMA32(af[ks], wA[ct][ks], pa); px = MFMA32(af[ks], wX[ct][ks], px); }
#pragma unroll
        for (int r = 0; r < 16; ++r) {
            const float uu = bf2f(*(const LAS unsigned short*)(ut + crow(r, hi) * UT_PITCH + (32 * ct + col) * 2));
            const float rr = frcp(1.f + fexp2(-LOG2E * (pa[r] + ba[ct])));
            const float ii = frcp(1.f + fexp2(-LOG2E * (px[r] + bx[ct])));
            const float av = fexp2(rr * c2v[ct]);
            a[ct][r] = av; b[ct][r] = __builtin_sqrtf(fmaxf(1.f - av * av, 0.f)) * ii * uu;
        }
    }
}
template <int DIR, bool PASS2>
DI void scan_tile(const f32x16& a, const f32x16& b, f32x16& hv, float& h, float& Ac, float& Bc, int hi) {
    float Ag[4], Bg[4];
#pragma unroll
    for (int g = 0; g < 4; ++g) {
        if (DIR == 0) { float B = b[4 * g]; B = a[4 * g + 1] * B + b[4 * g + 1]; B = a[4 * g + 2] * B + b[4 * g + 2]; B = a[4 * g + 3] * B + b[4 * g + 3]; Bg[g] = B; }
        else          { float B = b[4 * g + 3]; B = a[4 * g + 2] * B + b[4 * g + 2]; B = a[4 * g + 1] * B + b[4 * g + 1]; B = a[4 * g] * B + b[4 * g]; Bg[g] = B; }
        Ag[g] = (a[4 * g] * a[4 * g + 1]) * (a[4 * g + 2] * a[4 * g + 3]);
    }
    float AE[4], BE[4], AO[4], BO[4];
#pragma unroll
    for (int g = 0; g < 4; ++g) { const float pA = __shfl_xor(Ag[g], 32), pB = __shfl_xor(Bg[g], 32);
        AE[g] = hi ? pA : Ag[g]; BE[g] = hi ? pB : Bg[g]; AO[g] = hi ? Ag[g] : pA; BO[g] = hi ? Bg[g] : pB; }
    float hin[4];
    if (DIR == 0) {
#pragma unroll
        for (int g = 0; g < 4; ++g) { const float hE = h; h = AE[g] * h + BE[g]; const float hO = h; h = AO[g] * h + BO[g]; hin[g] = hi ? hO : hE;
            if (!PASS2) { Bc = AE[g] * Bc + BE[g]; Ac *= AE[g]; Bc = AO[g] * Bc + BO[g]; Ac *= AO[g]; } }
    } else {
#pragma unroll
        for (int g = 3; g >= 0; --g) { const float hO = h; h = AO[g] * h + BO[g]; const float hE = h; h = AE[g] * h + BE[g]; hin[g] = hi ? hO : hE;
            if (!PASS2) { Bc = AO[g] * Bc + BO[g]; Ac *= AO[g]; Bc = AE[g] * Bc + BE[g]; Ac *= AE[g]; } }
    }
    if (PASS2) {
#pragma unroll
        for (int g = 0; g < 4; ++g) { float hh = hin[g];
            if (DIR == 0) {
#pragma unroll
                for (int q = 0; q < 4; ++q) { hh = a[4 * g + q] * hh + b[4 * g + q]; hv[4 * g + q] = hh; }
            } else {
#pragma unroll
                for (int q = 3; q >= 0; --q) { hh = a[4 * g + q] * hh + b[4 * g + q]; hv[4 * g + q] = hh; }
            } }
    }
}
template <int DIR, bool PASS2>
DI void scan_sweep(const ScanP& P, int b, int n, int j, LAS unsigned char* ut, int lane) {
    const int col = lane & 31, hi = lane >> 5;
    bf16x8 wA[2][4], wX[2][4]; float ba[2], bx[2], c2v[2];
#pragma unroll
    for (int ct = 0; ct < 2; ++ct) {
#pragma unroll
        for (int ks = 0; ks < 4; ++ks) {
            wA[ct][ks] = *(const GAS bf16x8*)(P.GWT + ((size_t)((DIR * 2 + 0) * 8 + n) * 64 + 32 * ct + col) * 64 + 16 * ks + 8 * hi);
            wX[ct][ks] = *(const GAS bf16x8*)(P.GWT + ((size_t)((DIR * 2 + 1) * 8 + n) * 64 + 32 * ct + col) * 64 + 16 * ks + 8 * hi); }
        const int c = DIR * RW + 64 * n + 32 * ct + col; ba[ct] = P.gab[c]; bx[ct] = P.gxb[c]; c2v[ct] = P.c2[c];
    }
    const float w0 = P.cw[0 * RW + 64 * n + lane], w1 = P.cw[1 * RW + 64 * n + lane], w2 = P.cw[2 * RW + 64 * n + lane], w3 = P.cw[3 * RW + 64 * n + lane], cbv = P.cb[64 * n + lane];
    float h[2] = {0.f, 0.f}, Ac[2] = {1.f, 1.f}, Bc[2] = {0.f, 0.f};
    if (PASS2) {
        const f32x2* cr = P.carry + ((size_t)(b * 2 + DIR) * NCH) * RW + 64 * n + col;
        if (DIR == 0) { for (int jj = 0; jj < j; ++jj) {
#pragma unroll
            for (int ct = 0; ct < 2; ++ct) { const f32x2 ab = cr[(size_t)jj * RW + 32 * ct]; h[ct] = ab.x * h[ct] + ab.y; } } }
        else { for (int jj = NCH - 1; jj > j; --jj) {
#pragma unroll
            for (int ct = 0; ct < 2; ++ct) { const f32x2 ab = cr[(size_t)jj * RW + 32 * ct]; h[ct] = ab.x * h[ct] + ab.y; } } }
    }
    const int t0 = b * SEQ + j * LCH;
    for (int tq = 0; tq < LCH / 32; ++tq) {
        const int ti = DIR == 0 ? tq : (LCH / 32 - 1 - tq);
        const int tt0 = t0 + 32 * ti;
        build_u_tile(P.RX, tt0, n, w0, w1, w2, w3, cbv, ut, lane);
        f32x16 a[2], bb[2], hv[2];
        gate_tile(ut, wA, wX, ba, bx, c2v, a, bb, lane);
#pragma unroll
        for (int ct = 0; ct < 2; ++ct) scan_tile<DIR, PASS2>(a[ct], bb[ct], hv[ct], h[ct], Ac[ct], Bc[ct], hi);
        if (PASS2) {
#pragma unroll
            for (int ct = 0; ct < 2; ++ct)
#pragma unroll
                for (int r = 0; r < 16; ++r) {
                    const size_t o = (size_t)(tt0 + crow(r, hi)) * RW + 64 * n + 32 * ct + col;
                    if (DIR == 0) P.HF[o] = (bf16)f2bf(hv[ct][r]);
                    else { const float rec = (bf2f(P.HF[o]) + hv[ct][r]) * bf2f(P.G[o]); P.REC[o] = (bf16)f2bf(rec); }
                }
        }
    }
    if (!PASS2 && hi == 0) {
#pragma unroll
        for (int ct = 0; ct < 2; ++ct) P.carry[((size_t)(b * 2 + DIR) * NCH + j) * RW + 64 * n + 32 * ct + col] = (f32x2){Ac[ct], Bc[ct]};
    }
}
template <bool PASS2>
DI void scan_phase(Frame& F, const ScanP& P) {
    LAS unsigned char* ut = F.lds + F.wave * 4608;
    const int gw = F.vcu * NWAVES + F.wave, NGW = F.G * NWAVES;
    for (int u = gw; u < NB * 8 * NCH; u += NGW) {
        const int j = u % NCH, n = (u / NCH) & 7, b = u / (NCH * 8);
        scan_sweep<0, PASS2>(P, b, n, j, ut, F.lane);
        if (PASS2) VM_WAIT();
        scan_sweep<1, PASS2>(P, b, n, j, ut, F.lane);
    }
}

constexpr int AT_OACC = 0, AT_ML = 65536, AT_V = 69632;
DI s16x4 vtr(const LAS unsigned char* p) { typedef short v4i16_t __attribute__((ext_vector_type(4))); return __builtin_bit_cast(s16x4, __builtin_amdgcn_ds_read_tr16_b64_v4i16((LAS v4i16_t*)p)); }
DI void attn_tile(const bf16* Qp, const bf16* Kp, const bf16* Vp, int tb, int h, int rho, int dl, int nq0, int L, LAS unsigned char* vt, int lane, f32x16 (&o)[2], float& m_out, float& l_out) {
    const int qi = lane & 31, hi = lane >> 5;
    bf16x8 qf[4];
    { const bf16* qp = Qp + (size_t)(tb + rho + dl * (nq0 + qi)) * AW + h * HD + 8 * hi;
#pragma unroll
      for (int ks = 0; ks < 4; ++ks) qf[ks] = *(const GAS bf16x8*)(qp + 16 * ks); }
    f32x16 z;
#pragma unroll
    for (int i = 0; i < 16; ++i) z[i] = 0.f;
    o[0] = z; o[1] = z;
    float m = -1e30f, l = 0.f;
    const int q4 = (lane & 15) >> 2, p4 = lane & 3, blk = (lane >> 4) & 1;
    const LAS unsigned char* vrd = vt + (4 * hi + q4) * 128 + (16 * blk + 4 * p4) * 2;
    for (int kt = 0; kt < 5; ++kt) {
        const int nb = nq0 - 64 + 32 * kt;
        if (nb < 0 || nb >= L) continue;
        bf16x8 kf[4];
        { const bf16* kp = Kp + (size_t)(tb + rho + dl * (nb + qi)) * AW + h * HD + 8 * hi;
#pragma unroll
          for (int ks = 0; ks < 4; ++ks) kf[ks] = *(const GAS bf16x8*)(kp + 16 * ks); }
        u32x4 vv[4];
#pragma unroll
        for (int i = 0; i < 4; ++i) { const int piece = i * 64 + lane, key = piece >> 3, ch = piece & 7;
            vv[i] = *(const GAS u32x4*)(Vp + (size_t)(tb + rho + dl * (nb + key)) * AW + h * HD + 8 * ch); }
        f32x16 s = z;
#pragma unroll
        for (int ks = 0; ks < 4; ++ks) s = MFMA32(kf[ks], qf[ks], s);
        if (kt == 0) {
#pragma unroll
            for (int r = 0; r < 16; ++r) if (crow(r, hi) < qi) s[r] = -1e30f;
        }
        if (kt == 4) {
#pragma unroll
            for (int r = 0; r < 16; ++r) if (crow(r, hi) > qi) s[r] = -1e30f;
        }
        float tm = s[0];
#pragma unroll
        for (int r = 1; r < 16; ++r) tm = fmaxf(tm, s[r]);
        tm = fmaxf(tm, __shfl_xor(tm, 32));
        const float mn = fmaxf(m, tm), al = fexp2(m - mn);
        float ps = 0.f;
#pragma unroll
        for (int r = 0; r < 16; ++r) { s[r] = fexp2(s[r] - mn); ps += s[r]; }
        l = l * al + ps; m = mn;
#pragma unroll
        for (int r = 0; r < 16; ++r) { o[0][r] *= al; o[1][r] *= al; }
        bf16x8 pk[2];
#pragma unroll
        for (int sx = 0; sx < 2; ++sx) { u32x4 w; w.x = pg8::cvt_pk_bf16(s[8 * sx + 0], s[8 * sx + 1]); w.y = pg8::cvt_pk_bf16(s[8 * sx + 2], s[8 * sx + 3]);
            w.z = pg8::cvt_pk_bf16(s[8 * sx + 4], s[8 * sx + 5]); w.w = pg8::cvt_pk_bf16(s[8 * sx + 6], s[8 * sx + 7]); pk[sx] = __builtin_bit_cast(bf16x8, w); }
#pragma unroll
        for (int i = 0; i < 4; ++i) { const int piece = i * 64 + lane; *(LAS u32x4*)(vt + piece * 16) = vv[i]; }
#pragma unroll
        for (int sx = 0; sx < 2; ++sx)
#pragma unroll
            for (int dh = 0; dh < 2; ++dh) {
                const s16x4 lo = vtr(vrd + (16 * sx) * 128 + 64 * dh), hi4 = vtr(vrd + (16 * sx + 8) * 128 + 64 * dh);
                const bf16x8 vf = __builtin_shufflevector(lo, hi4, 0, 1, 2, 3, 4, 5, 6, 7);
                o[dh] = MFMA32(vf, pk[sx], o[dh]);
            }
    }
    m_out = m; l_out = l + __shfl_xor(l, 32);
}
struct AttnP { const bf16* Q; const bf16* K; const bf16* V; bf16* O; };
DI void attn_phase(Frame& F, const AttnP& P) {
    LAS unsigned char* lds = F.lds;
    LAS unsigned char* vt = lds + AT_V + F.wave * 4096;
    const int lane = F.lane, qi = lane & 31, hi = lane >> 5;
    for (int unit = F.vcu; unit < NB * NH * (SEQ / 512); unit += F.G) {
        const int sp = unit & 15, h = (unit >> 4) & 7, b = unit >> 7;
        const int tb = b * SEQ, P0 = 512 * sp;
#pragma unroll 1
        for (int g = 0; g < 3; ++g) {
            const int dl = g == 0 ? 1 : (g == 1 ? 4 : 16), L = SEQ / dl;
#pragma unroll 1
            for (int xx = 0; xx < 2; ++xx) {
                const int x = F.wave + 8 * xx;
                int rho, nq0, qp0, qst;
                if (g == 0) { rho = 0; nq0 = P0 + 32 * x; qp0 = 32 * x; qst = 1; }
                else if (g == 1) { rho = x & 3; nq0 = P0 / 4 + 32 * (x >> 2); qp0 = rho + 128 * (x >> 2); qst = 4; }
                else { rho = x; nq0 = P0 / 16; qp0 = rho; qst = 16; }
                f32x16 o[2]; float m, l;
                attn_tile(P.Q, P.K, P.V, tb, h, rho, dl, nq0, L, vt, lane, o, m, l);
                const int qpos = qp0 + qst * qi;
                LAS unsigned char* orow = lds + AT_OACC + qpos * 128 + 8 * hi;
                LAS f32x2* ml = (LAS f32x2*)(lds + AT_ML) + qpos;
                float w2 = frcp(l), w1 = 0.f;
                if (g > 0) { const f32x2 old = *ml; const float mN = fmaxf(old.x, m); const float a1 = old.y * fexp2(old.x - mN), a2 = fexp2(m - mN); const float lN = a1 + l * a2, rl = frcp(lN);
                    w1 = a1 * rl; w2 = a2 * rl; m = mN; l = lN; }
#pragma unroll
                for (int dh = 0; dh < 2; ++dh)
#pragma unroll
                    for (int gq = 0; gq < 4; ++gq) {
                        LAS u32x2* p = (LAS u32x2*)(orow + (32 * dh + 8 * gq) * 2);
                        float v0 = o[dh][4 * gq] * w2, v1 = o[dh][4 * gq + 1] * w2, v2 = o[dh][4 * gq + 2] * w2, v3 = o[dh][4 * gq + 3] * w2;
                        if (g > 0) { const u32x2 ow = *p; v0 += bflo(ow.x) * w1; v1 += bfhi(ow.x) * w1; v2 += bflo(ow.y) * w1; v3 += bfhi(ow.y) * w1; }
                        u32x2 nw; nw.x = pg8::cvt_pk_bf16(v0, v1); nw.y = pg8::cvt_pk_bf16(v2, v3); *p = nw;
                    }
                if (hi == 0) *ml = (f32x2){m, l};
            }
            __syncthreads();
        }
#pragma unroll
        for (int i = 0; i < 8; ++i) { const int c = i * 512 + F.tid, q = c >> 3, ch = c & 7;
            *(GAS u32x4*)(P.O + (size_t)(tb + P0 + q) * AW + h * HD + 8 * ch) = *(const LAS u32x4*)(lds + AT_OACC + q * 128 + ch * 16); }
        __syncthreads();
    }
}

DI void mix_phase(Frame& F) {
    const bf16* AT = (const bf16*)(F.ws + WS_ATTN); const bf16* RC = (const bf16*)(F.ws + WS_REC); bf16* MX = (bf16*)(F.ws + WS_MIX);
    const int gw = F.vcu * NWAVES + F.wave, NGW = F.G * NWAVES, lane = F.lane;
    const f32x4 ga0 = *(const f32x4*)(F.in[3] + 8 * lane), ga1 = *(const f32x4*)(F.in[3] + 8 * lane + 4), gr0 = *(const f32x4*)(F.in[11] + 8 * lane), gr1 = *(const f32x4*)(F.in[11] + 8 * lane + 4);
    for (int t = gw; t < T; t += NGW) {
        const u32x4 a = *(const GAS u32x4*)(AT + (size_t)t * AW + 8 * lane), r = *(const GAS u32x4*)(RC + (size_t)t * RW + 8 * lane);
        float av[8] = {bflo(a.x), bfhi(a.x), bflo(a.y), bfhi(a.y), bflo(a.z), bfhi(a.z), bflo(a.w), bfhi(a.w)};
        float rv[8] = {bflo(r.x), bfhi(r.x), bflo(r.y), bfhi(r.y), bflo(r.z), bfhi(r.z), bflo(r.w), bfhi(r.w)};
        float sa = 0.f, sr = 0.f;
#pragma unroll
        for (int i = 0; i < 8; ++i) { sa += av[i] * av[i]; sr += rv[i] * rv[i]; }
        sa = wave_sum(sa); sr = wave_sum(sr);
        const float ra = 1.0f / sqrtf(sa * (1.f / 512.f) + LN_EPS), rr = 1.0f / sqrtf(sr * (1.f / 512.f) + LN_EPS);
        u32x4 oa, orr;
        oa.x = pk2(av[0] * ra * ga0.x, av[1] * ra * ga0.y); oa.y = pk2(av[2] * ra * ga0.z, av[3] * ra * ga0.w); oa.z = pk2(av[4] * ra * ga1.x, av[5] * ra * ga1.y); oa.w = pk2(av[6] * ra * ga1.z, av[7] * ra * ga1.w);
        orr.x = pk2(rv[0] * rr * gr0.x, rv[1] * rr * gr0.y); orr.y = pk2(rv[2] * rr * gr0.z, rv[3] * rr * gr0.w); orr.z = pk2(rv[4] * rr * gr1.x, rv[5] * rr * gr1.y); orr.w = pk2(rv[6] * rr * gr1.z, rv[7] * rr * gr1.w);
        *(GAS u32x4*)(MX + (size_t)t * D + 8 * lane) = oa; *(GAS u32x4*)(MX + (size_t)t * D + AW + 8 * lane) = orr;
    }
}
DI void ln1_phase(Frame& F) {
    const float* V1 = (const float*)(F.ws + WS_V1); bf16* X1B = (bf16*)(F.ws + WS_X1B);
    const int gw = F.vcu * NWAVES + F.wave, NGW = F.G * NWAVES, lane = F.lane;
    f32x4 gg[4], bb[4];
#pragma unroll
    for (int j = 0; j < 4; ++j) { gg[j] = *(const f32x4*)(F.in[13] + 4 * lane + 256 * j); bb[j] = *(const f32x4*)(F.in[14] + 4 * lane + 256 * j); }
    for (int t = gw; t < T; t += NGW) {
        const GAS f32x4* xr = (const GAS f32x4*)(V1 + (size_t)t * D) + lane;
        f32x4 v[4]; float s = 0.f;
#pragma unroll
        for (int j = 0; j < 4; ++j) { v[j] = xr[64 * j]; s += (v[j].x + v[j].y) + (v[j].z + v[j].w); }
        const float mean = wave_sum(s) * (1.f / D); float s2 = 0.f;
#pragma unroll
        for (int j = 0; j < 4; ++j) { v[j] = v[j] - mean; s2 += (v[j].x * v[j].x + v[j].y * v[j].y) + (v[j].z * v[j].z + v[j].w * v[j].w); }
        const float rstd = 1.f / sqrtf(wave_sum(s2) * (1.f / D) + LN_EPS);
        GAS f32x4* o4 = (GAS f32x4*)(F.out + (size_t)t * D) + lane; GAS u32x2* o2 = (GAS u32x2*)(X1B + (size_t)t * D) + lane;
#pragma unroll
        for (int j = 0; j < 4; ++j) { const f32x4 y = v[j] * rstd * gg[j] + bb[j]; o4[64 * j] = y * ALPHA; u32x2 w; w.x = pk2(y.x, y.y); w.y = pk2(y.z, y.w); o2[64 * j] = w; }
    }
}
DI void route_phase(Frame& F) {
    const float* LG = (const float*)(F.ws + WS_LOGITS); const float* rbias = F.in[16];
    unsigned* ER = (unsigned*)(F.ws + WS_ER); float* GW = (float*)(F.ws + WS_GW); int* slot_tok = (int*)(F.ws + WS_SLOTTOK);
    LAS unsigned* hist = (LAS unsigned*)(F.lds); LAS unsigned* base = hist + 256; LAS unsigned* erl = hist + 512;
    const int lane = F.lane, tid = F.tid;
    for (int i = F.vcu * 512 + tid; i < MAXSLOTS; i += F.G * 512) slot_tok[i] = 0;
    if (tid < 256) hist[tid] = 0u;
    __syncthreads();
    const int TPW = T / F.G;
    const f32x4 bi = ((const f32x4*)rbias)[lane];
    const float NEGINF = -__builtin_huge_valf();
    for (int i = F.wave; i < TPW; i += NWAVES) {
        const int t = F.vcu * TPW + i;
        const f32x4 l0 = ((const GAS f32x4*)(LG + (size_t)t * NE))[lane], l1 = ((const GAS f32x4*)(LG + (size_t)T * NE + (size_t)t * NE))[lane];
        const f32x4 lg = l0 + l1;
        const float s0 = 1.f / (1.f + expf(-lg.x)), s1 = 1.f / (1.f + expf(-lg.y)), s2 = 1.f / (1.f + expf(-lg.z)), s3 = 1.f / (1.f + expf(-lg.w));
        float v0 = s0 + bi.x, v1 = s1 + bi.y, v2 = s2 + bi.z, v3 = s3 + bi.w;
        const float hi1 = fmaxf(v0, v1), lo1 = fminf(v0, v1), hi2 = fmaxf(v2, v3), lo2 = fminf(v2, v3);
        float m1 = fmaxf(hi1, hi2), m2 = fmaxf(fminf(hi1, hi2), fmaxf(lo1, lo2));
#pragma unroll
        for (int o = 1; o < 8; o <<= 1) { const float o1 = __shfl_xor(m1, o), o2 = __shfl_xor(m2, o); const float n1 = fmaxf(m1, o1), n2 = fmaxf(fminf(m1, o1), fmaxf(m2, o2)); m1 = n1; m2 = n2; }
        const float gs = m1 + m2; const int myg = lane >> 3; int rank = 0;
#pragma unroll
        for (int j = 0; j < 8; ++j) { const float gj = __shfl(gs, 8 * j); rank += (gj > gs || (gj == gs && j < myg)) ? 1 : 0; }
        if (rank >= 4) { v0 = NEGINF; v1 = NEGINF; v2 = NEGINF; v3 = NEGINF; }
        int me = 0; float mg = 0.f, gsum = 0.f;
#pragma unroll
        for (int k = 0; k < 8; ++k) {
            const float lm = fmaxf(fmaxf(v0, v1), fmaxf(v2, v3)), wm = wave_max(lm);
            int cand = 1 << 20;
            if (v3 == wm) cand = 4 * lane + 3;
            if (v2 == wm) cand = 4 * lane + 2;
            if (v1 == wm) cand = 4 * lane + 1;
            if (v0 == wm) cand = 4 * lane + 0;
            const int e = wave_min_i(cand), el = e >> 2, ei = e & 3;
            const float mysc = ei == 0 ? s0 : (ei == 1 ? s1 : (ei == 2 ? s2 : s3));
            const float sc = __shfl(mysc, el);
            if (lane == el) { if (ei == 0) v0 = NEGINF; else if (ei == 1) v1 = NEGINF; else if (ei == 2) v2 = NEGINF; else v3 = NEGINF; }
            me = (lane == k) ? e : me; mg = (lane == k) ? sc : mg; gsum += sc;
        }
        if (lane < 8) { const unsigned lr = __hip_atomic_fetch_add(hist + me, 1u, __ATOMIC_RELAXED, __HIP_MEMORY_SCOPE_WORKGROUP); erl[i * 8 + lane] = ((unsigned)me << 24) | lr; GW[(size_t)t * 8 + lane] = mg / gsum * 2.5f; }
    }
    __syncthreads();
    if (tid < 256) base[tid] = atomicAdd((unsigned*)(F.ctl + CW_CNT) + tid, hist[tid]);
    __syncthreads();
    for (int i = tid; i < TPW * 8; i += 512) { const unsigned er = erl[i]; ER[(size_t)F.vcu * TPW * 8 + i] = er + base[er >> 24]; }
    __syncthreads();
}
DI void slot_phase(Frame& F) {
    const unsigned* ER = (const unsigned*)(F.ws + WS_ER); const float* GW = (const float*)(F.ws + WS_GW);
    unsigned* TS = (unsigned*)(F.ws + WS_TS); int* slot_tok = (int*)(F.ws + WS_SLOTTOK); float* slot_w = (float*)(F.ws + WS_SLOTW); int* tile_e = (int*)(F.ws + WS_TILEE);
    LAS int* tb = (LAS int*)(F.lds); LAS int* tmp = tb + 512;
    const int tid = F.tid;
    int nt_e = 0;
    if (tid < 256) { nt_e = ((int)__hip_atomic_load((unsigned*)(F.ctl + CW_CNT) + tid, RLX_AGENT) + 255) >> 8; tmp[tid] = nt_e; }
    __syncthreads();
    int src = 0;
    for (int o = 1; o < 256; o <<= 1) { if (tid < 256) { int v = tmp[src * 256 + tid]; if (tid >= o) v += tmp[src * 256 + tid - o]; tmp[(src ^ 1) * 256 + tid] = v; } src ^= 1; __syncthreads(); }
    if (tid < 256) tb[tid] = tmp[src * 256 + tid] - nt_e;
    const int NT = tmp[src * 256 + 255];
    __syncthreads();
    if (F.vcu == 0) {
        if (tid == 0) __hip_atomic_store((unsigned*)(F.ctl + CW_NT), (unsigned)NT, RLX_AGENT);
        if (tid < 256) for (int tl = tb[tid]; tl < tb[tid] + nt_e; ++tl) tile_e[tl] = tid;
        for (int i = tid; i < NSHT; i += 512) tile_e[NT + i] = NE;
    }
    for (int i = F.vcu * 512 + tid; i < T; i += F.G * 512) { slot_tok[(size_t)NT * 256 + i] = i; }
    const int TPW = T / F.G;
    for (int i = tid; i < TPW * 8; i += 512) {
        const size_t gi = (size_t)F.vcu * TPW * 8 + i; const unsigned er = ER[gi]; const int e = er >> 24, rk = er & 0xffffff;
        const int slot = tb[e] * 256 + rk;
        slot_tok[slot] = (int)(gi >> 3); slot_w[slot] = GW[gi]; TS[gi] = (unsigned)slot;
    }
}
DI void final_phase(Frame& F) {
    const bf16* Y = (const bf16*)(F.ws + WS_Y); const unsigned* TS = (const unsigned*)(F.ws + WS_TS);
    const int gw = F.vcu * NWAVES + F.wave, NGW = F.G * NWAVES, lane = F.lane;
    f32x4 gg[4], bb[4];
#pragma unroll
    for (int j = 0; j < 4; ++j) { gg[j] = *(const f32x4*)(F.in[23] + 4 * lane + 256 * j); bb[j] = *(const f32x4*)(F.in[24] + 4 * lane + 256 * j); }
    for (int t = gw; t < T; t += NGW) {
        GAS f32x4* xr = (GAS f32x4*)(F.out + (size_t)t * D) + lane;
        f32x4 v[4];
#pragma unroll
        for (int j = 0; j < 4; ++j) v[j] = xr[64 * j];
        const unsigned myslot = TS[(size_t)t * 8 + (lane & 7)];
#pragma unroll
        for (int k = 0; k < 8; ++k) {
            const unsigned slot = __shfl(myslot, k);
            const GAS u32x2* yr = (const GAS u32x2*)(Y + (size_t)slot * D) + lane;
#pragma unroll
            for (int j = 0; j < 4; ++j) { const u32x2 w = yr[64 * j]; v[j].x += bflo(w.x); v[j].y += bfhi(w.x); v[j].z += bflo(w.y); v[j].w += bfhi(w.y); }
        }
        float s = 0.f;
#pragma unroll
        for (int j = 0; j < 4; ++j) s += (v[j].x + v[j].y) + (v[j].z + v[j].w);
        const float mean = wave_sum(s) * (1.f / D); float s2 = 0.f;
#pragma unroll
        for (int j = 0; j < 4; ++j) { v[j] = v[j] - mean; s2 += (v[j].x * v[j].x + v[j].y * v[j].y) + (v[j].z * v[j].z + v[j].w * v[j].w); }
        const float rstd = 1.f / sqrtf(wave_sum(s2) * (1.f / D) + LN_EPS);
#pragma unroll
        for (int j = 0; j < 4; ++j) xr[64 * j] = v[j] * rstd * gg[j] + bb[j];
    }
}

constexpr int N_PHASES = 13;
struct Args { const float* in[25]; float* out; unsigned char* ws; int ph_lo, ph_hi, li, pad; };
__global__ void __launch_bounds__(NWAVES * 64, 2) mk_fwd(Args args) {
    extern __shared__ __attribute__((aligned(16))) unsigned char lds_raw[];
    Frame F;
    F.lds = (LAS unsigned char*)lds_raw;
    F.MISC = (volatile LAS unsigned*)(F.lds + MISC_OFF);
    F.tid = threadIdx.x; F.lane = F.tid & 63; F.wave = __builtin_amdgcn_readfirstlane(F.tid >> 6);
    F.G = gridDim.x; { const int bx = blockIdx.x; F.vcu = (F.G % 8 == 0) ? (bx % 8) * (F.G / 8) + bx / 8 : bx; }
    F.ws = args.ws; F.out = args.out; F.ctl = (gu32*)(args.ws + WS_CTL);
#pragma unroll
    for (int i = 0; i < 25; ++i) F.in[i] = args.in[i];
    if (F.tid < 64) F.MISC[F.tid] = 0u;
    __syncthreads();
    XcdBarrier bar = xcd_barrier_post((unsigned*)(F.ctl + CW_BAR) + args.li * XCD_BAR_WORDS, F.MISC + 8);
    const int lo = args.ph_lo, hi = args.ph_hi;
#ifndef PHMASK
#define PHMASK 0x1fff
#endif
#define IN(k) (((PHMASK >> (k)) & 1) && lo <= (k) && (k) < hi)
#define SEAM(k) do { if (IN(k) && IN((k) + 1)) xcd_barrier(bar); } while (0)
    unsigned char* ws = F.ws;
    const int cid = (int)blockIdx.x;

    if (IN(0)) { p0_prologue(F); } SEAM(0);

    if (IN(1)) {
        SchedDense S{(const bf16*)(ws + WS_XB), (const bf16*)(ws + WS_WINT), D, D, T / 256, INW / 256, F.G, cid};
        EpiInProj E{(bf16*)(ws + WS_Q), (const float*)(ws + WS_ROPE)};
        pg8::gemm_phase<EpiInProj, SchedDense, true>(F.lds + RING_OFF, S, E, D);
    } SEAM(1);

    const ScanP SP{(const bf16*)(ws + WS_Q + 3 * SEG_BYTES), (const bf16*)(ws + WS_Q + 4 * SEG_BYTES), (const bf16*)(ws + WS_GWT), F.in[4], F.in[5], F.in[7], F.in[9],
                   (const float*)(ws + WS_C2), (f32x2*)(ws + WS_CARRY), (bf16*)(ws + WS_HF), (bf16*)(ws + WS_REC)};
    if (IN(2)) {
        scan_phase<false>(F, SP);
        __syncthreads();
        const AttnP AP{(const bf16*)(ws + WS_Q), (const bf16*)(ws + WS_Q + SEG_BYTES), (const bf16*)(ws + WS_Q + 2 * SEG_BYTES), (bf16*)(ws + WS_ATTN)};
        attn_phase(F, AP);
    } SEAM(2);

    if (IN(3)) { scan_phase<true>(F, SP); } SEAM(3);

    if (IN(4)) { mix_phase(F); } SEAM(4);

    if (IN(5)) {
        SchedDense S{(const bf16*)(ws + WS_MIX), (const bf16*)(ws + WS_WOUTT), D, D, T / 256, D / 256, F.G, cid};
        EpiResV1 E{F.in[0], (float*)(ws + WS_V1)};
        pg8::gemm_phase<EpiResV1, SchedDense, true>(F.lds + RING_OFF, S, E, D);
    } SEAM(5);

    if (IN(6)) { ln1_phase(F); } SEAM(6);

    if (IN(7)) {
        SchedRouter S{(const bf16*)(ws + WS_X1B), (const bf16*)(ws + WS_RTT), D, D, T / 256, F.G, cid};
        EpiLogits E{(float*)(ws + WS_LOGITS)};
        pg8::gemm_phase<EpiLogits, SchedRouter, true>(F.lds + RING_OFF, S, E, 512);
    } SEAM(7);

    if (IN(8)) { route_phase(F); } SEAM(8);

    if (IN(9)) { slot_phase(F); } SEAM(9);

    LAS unsigned* ue = (LAS unsigned*)(F.lds + UT_OFF); LAS unsigned* uidx = (LAS unsigned*)(F.lds + UT_IDX);
    if (IN(10)) {
        const int NT = (int)__hip_atomic_load((unsigned*)(F.ctl + CW_NT), RLX_AGENT);
        const int nwg = 2 * (NT + NSHT);
        const int* tile_e = (const int*)(ws + WS_TILEE); const int* slot_tok = (const int*)(ws + WS_SLOTTOK);
        for (int i = 0; i < 11; ++i) { int wgid; if (!pg8::xcd_order(i, F.G, cid, nwg, wgid)) break; const int tile = wgid >> 1;
            if (F.tid == 0) ue[i] = (unsigned)tile_e[tile];
            if (F.tid < 256) uidx[i * 256 + F.tid] = (unsigned)slot_tok[(size_t)tile * 256 + F.tid]; }
        __syncthreads();
        SchedG1 S{(const bf16*)(ws + WS_X1B), (const bf16*)(ws + WS_WGUT), ue, uidx, D, nwg, F.G, cid};
        EpiSwiglu E{(bf16*)(ws + WS_H)};
        pg8::gemm_phase<EpiSwiglu, SchedG1, true>(F.lds + RING_OFF, S, E, D);
    } SEAM(10);

    if (IN(11)) {
        const int NT = (int)__hip_atomic_load((unsigned*)(F.ctl + CW_NT), RLX_AGENT);
        const int* tile_e = (const int*)(ws + WS_TILEE);
        { const int nwg = 4 * NT;
          __syncthreads();
          for (int i = F.tid; i < 22; i += NWAVES * 64) { int wgid; if (pg8::xcd_order(i, F.G, cid, nwg, wgid)) ue[i] = (unsigned)tile_e[wgid >> 2]; }
          __syncthreads();
          SchedG2 S{(const bf16*)(ws + WS_H), (const bf16*)(ws + WS_WDT), ue, EH, nwg, F.G, cid, 0};
          EpiDownY E{(bf16*)(ws + WS_Y), (const float*)(ws + WS_SLOTW)};
          pg8::gemm_phase<EpiDownY, SchedG2, true>(F.lds + RING_OFF, S, E, EH); }
        { const int nwg = 4 * NSHT;
          __syncthreads();
          if (F.tid < 22) ue[F.tid] = (unsigned)NE;
          __syncthreads();
          SchedG2 S{(const bf16*)(ws + WS_H), (const bf16*)(ws + WS_WDT), ue, EH, nwg, F.G, cid, NT};
          EpiDownS E{F.out, NT};
          pg8::gemm_phase<EpiDownS, SchedG2, true>(F.lds + RING_OFF, S, E, EH); }
    } SEAM(11);

    if (IN(12)) { final_phase(F); }
#undef IN
#undef SEAM
}

#if defined(SELFCHECK) && SELFCHECK
namespace chk {
constexpr int NS = 64;
struct InP { const float* p[25]; };
__host__ __device__ inline int samp_tok(int i) { return i == 0 ? 0 : i == 1 ? 8191 : i == 2 ? 8192 : i == 3 ? T - 1 : i == 4 ? 63 : i == 5 ? 64 : i == 6 ? 8127 : i == 7 ? 16384 + 4095 : (int)(((long)i * 2039 + 17 * (i % 5)) % T); }
DI void put_err(unsigned* CHK, int stage, float num, float den) { float e = sqrtf(num / (den + 1e-30f)); if (!(e == e)) e = 1e30f; atomicMax(CHK + stage, __float_as_uint(e)); }
DI float blk_sum(float v, float* red) {
    v = wave_sum(v); __syncthreads(); if ((threadIdx.x & 63) == 0) red[threadIdx.x >> 6] = v; __syncthreads(); return red[0] + red[1] + red[2] + red[3]; }
__global__ void __launch_bounds__(256) c1(const float* x, const int* pos, const float* w_in, const unsigned char* ws, unsigned* CHK) {
    __shared__ float hrow[INW]; __shared__ float red[4];
    const int t = samp_tok(blockIdx.x), tid = threadIdx.x;
    for (int c = tid; c < INW; c += 256) { float a = 0.f; for (int k = 0; k < D; ++k) a = fmaf(x[(size_t)t * D + k], w_in[(size_t)k * INW + c], a); hrow[c] = a; }
    __syncthreads();
    if (tid < 128) { const int i = tid & 7, head = (tid >> 3) & 7, which = tid >> 6;
        const float invf[8] = {1.0f, 0x1.8d275ep-3f, 0x1.341190p-5f, 0x1.ddee9cp-8f, 0x1.72ba44p-10f, 0x1.1f91f0p-12f, 0x1.be218ap-15f, 0x1.5a0f50p-17f};
        float inv = invf[0];
#pragma unroll
        for (int j = 1; j < 8; ++j) inv = (i == j) ? invf[j] : inv;
        float c, s; sincos_acc((float)pos[t] * inv, c, s);
        float* p = hrow + which * AW + head * HD; const float t1 = p[i], t2 = p[i + 8]; p[i] = t1 * c - t2 * s; p[i + 8] = t2 * c + t1 * s; }
    __syncthreads();
    float num = 0.f, den = 0.f;
    for (int c = tid; c < INW; c += 256) { const int seg = c >> 9; float r = hrow[c]; if (seg == 0) r *= QSCALE; if (seg == 4) r = gelu_tanh(r);
        const float f = bf2f(((const bf16*)(ws + WS_Q + (size_t)seg * SEG_BYTES))[(size_t)t * 512 + (c & 511)]); num += (f - r) * (f - r); den += r * r; }
    num = blk_sum(num, red); den = blk_sum(den, red);
    if (tid == 0) put_err(CHK, 1, num, den);
}
__global__ void __launch_bounds__(64) c2(const unsigned char* ws, unsigned* CHK) {
    const bf16* Q = (const bf16*)(ws + WS_Q); const bf16* K = (const bf16*)(ws + WS_Q + SEG_BYTES); const bf16* V = (const bf16*)(ws + WS_Q + 2 * SEG_BYTES); const bf16* O = (const bf16*)(ws + WS_ATTN);
    const int lane = threadIdx.x, head = blockIdx.x & 7, t = samp_tok(blockIdx.x >> 3), b = t / SEQ, s = t % SEQ;
    const float q = bf2f(Q[(size_t)t * AW + head * HD + lane]);
    float m = -1e30f, den = 0.f, o = 0.f;
    for (int g = 0; g < 3; ++g) { const int d = g == 0 ? 1 : (g == 1 ? 4 : 16);
        for (int mm = -64; mm <= 64; ++mm) { const int j = s + d * mm; if (j < 0 || j >= SEQ) continue;
            const size_t row = (size_t)(b * SEQ + j) * AW + head * HD + lane;
            const float sc = wave_sum(q * bf2f(K[row])); const float mn = fmaxf(m, sc), al = exp2f(m - mn), p = exp2f(sc - mn);
            den = den * al + p; o = o * al + p * bf2f(V[row]); m = mn; } }
    const float r = o / den, f = bf2f(O[(size_t)t * AW + head * HD + lane]);
    const float num = wave_sum((f - r) * (f - r)), dn = wave_sum(r * r);
    if (lane == 0) put_err(CHK, 2, num, dn);
}
__global__ void __launch_bounds__(64) c3(InP ip, const unsigned char* ws, float* scratch, unsigned* CHK) {
    const float* cw = ip.p[4]; const float* cb = ip.p[5]; const float* gaw = ip.p[6]; const float* gab = ip.p[7]; const float* gxw = ip.p[8]; const float* gxb = ip.p[9]; const float* lam = ip.p[10];
    const bf16* RX = (const bf16*)(ws + WS_Q + 3 * SEG_BYTES); const bf16* G = (const bf16*)(ws + WS_Q + 4 * SEG_BYTES); const bf16* REC = (const bf16*)(ws + WS_REC);
    const int lane = threadIdx.x, smp = blockIdx.x, b = smp & 3, c = (smp * 37 + 5) % RW, n = c >> 6, j = c & 63;
    float* sc = scratch + (size_t)smp * SEQ * 4;
    for (int s = lane; s < SEQ; s += 64) {
        float pa0 = 0.f, pa1 = 0.f, px0 = 0.f, px1 = 0.f, uc = 0.f;
        for (int i = 0; i < 64; ++i) { const int ci = 64 * n + i; float u = cb[ci];
            for (int k = 0; k < 4; ++k) { const int ss = s + k - 2; if (ss >= 0 && ss < SEQ) u = fmaf(cw[k * RW + ci], bf2f(RX[(size_t)(b * SEQ + ss) * RW + ci]), u); }
            if (i == j) uc = u;
            pa0 = fmaf(u, gaw[(((size_t)0 * 8 + n) * 64 + i) * 64 + j], pa0); px0 = fmaf(u, gxw[(((size_t)0 * 8 + n) * 64 + i) * 64 + j], px0);
            pa1 = fmaf(u, gaw[(((size_t)1 * 8 + n) * 64 + i) * 64 + j], pa1); px1 = fmaf(u, gxw[(((size_t)1 * 8 + n) * 64 + i) * 64 + j], px1); }
        { const float r = 1.f / (1.f + expf(-(pa0 + gab[c]))), ig = 1.f / (1.f + expf(-(px0 + gxb[c])));
          const float l = lam[c], sp = log1pf(expf(-l)), log_a = -8.0f * r * sp, a = expf(log_a);
          sc[(size_t)s * 4 + 0] = a; sc[(size_t)s * 4 + 1] = sqrtf(-expm1f(2.0f * log_a)) * ig * uc; }
        { const float r = 1.f / (1.f + expf(-(pa1 + gab[RW + c]))), ig = 1.f / (1.f + expf(-(px1 + gxb[RW + c])));
          const float l = lam[RW + c], sp = log1pf(expf(-l)), log_a = -8.0f * r * sp, a = expf(log_a);
          sc[(size_t)s * 4 + 2] = a; sc[(size_t)s * 4 + 3] = sqrtf(-expm1f(2.0f * log_a)) * ig * uc; }
    }
    __syncthreads();
    if (lane == 0) { float h = 0.f; for (int s = 0; s < SEQ; ++s) { h = fmaf(sc[(size_t)s * 4], h, sc[(size_t)s * 4 + 1]); sc[(size_t)s * 4 + 1] = h; } }
    if (lane == 1) { float h = 0.f; for (int s = SEQ - 1; s >= 0; --s) { h = fmaf(sc[(size_t)s * 4 + 2], h, sc[(size_t)s * 4 + 3]); sc[(size_t)s * 4 + 3] = h; } }
    __syncthreads();
    float num = 0.f, den = 0.f;
    for (int s = lane; s < SEQ; s += 64) { const size_t o = (size_t)(b * SEQ + s) * RW + c; const float r = (sc[(size_t)s * 4 + 1] + sc[(size_t)s * 4 + 3]) * bf2f(G[o]), f = bf2f(REC[o]); num += (f - r) * (f - r); den += r * r; }
    num = wave_sum(num); den = wave_sum(den);
    if (lane == 0) put_err(CHK, 3, num, den);
}
__global__ void __launch_bounds__(256) c4(const float* ga, const float* gr, const unsigned char* ws, unsigned* CHK) {
    __shared__ float red[4];
    const bf16* AT = (const bf16*)(ws + WS_ATTN); const bf16* RC = (const bf16*)(ws + WS_REC); const bf16* MX = (const bf16*)(ws + WS_MIX);
    const int t = samp_tok(blockIdx.x), tid = threadIdx.x;
    float av[2], rv[2], sa = 0.f, sr = 0.f;
    for (int i = 0; i < 2; ++i) { const int c = tid + 256 * i; av[i] = bf2f(AT[(size_t)t * AW + c]); rv[i] = bf2f(RC[(size_t)t * RW + c]); sa += av[i] * av[i]; sr += rv[i] * rv[i]; }
    sa = blk_sum(sa, red); sr = blk_sum(sr, red);
    const float ra = rsqrtf(sa / 512.f + LN_EPS), rr = rsqrtf(sr / 512.f + LN_EPS);
    float num = 0.f, den = 0.f;
    for (int i = 0; i < 2; ++i) { const int c = tid + 256 * i; const float r1 = av[i] * ra * ga[c], r2 = rv[i] * rr * gr[c], f1 = bf2f(MX[(size_t)t * D + c]), f2 = bf2f(MX[(size_t)t * D + AW + c]);
        num += (f1 - r1) * (f1 - r1) + (f2 - r2) * (f2 - r2); den += r1 * r1 + r2 * r2; }
    num = blk_sum(num, red); den = blk_sum(den, red);
    if (tid == 0) put_err(CHK, 4, num, den);
}
__global__ void __launch_bounds__(256) c5(const float* x, const float* w_out, const unsigned char* ws, unsigned* CHK) {
    __shared__ float red[4];
    const bf16* MX = (const bf16*)(ws + WS_MIX); const float* V1 = (const float*)(ws + WS_V1);
    const int t = samp_tok(blockIdx.x), tid = threadIdx.x; float num = 0.f, den = 0.f;
    for (int c = tid; c < D; c += 256) { float a = 0.f; for (int k = 0; k < D; ++k) a = fmaf(bf2f(MX[(size_t)t * D + k]), w_out[(size_t)k * D + c], a);
        const float r = ALPHA * x[(size_t)t * D + c] + a, f = V1[(size_t)t * D + c]; num += (f - r) * (f - r); den += r * r; }
    num = blk_sum(num, red); den = blk_sum(den, red);
    if (tid == 0) put_err(CHK, 5, num, den);
}
__global__ void __launch_bounds__(256) c6(const float* g, const float* bb, const float* out, const unsigned char* ws, unsigned* CHK) {
    __shared__ float red[4];
    const float* V1 = (const float*)(ws + WS_V1); const bf16* X1B = (const bf16*)(ws + WS_X1B);
    const int t = samp_tok(blockIdx.x), tid = threadIdx.x; float v[4], s = 0.f;
    for (int i = 0; i < 4; ++i) { v[i] = V1[(size_t)t * D + tid + 256 * i]; s += v[i]; }
    const float mu = blk_sum(s, red) / D; float q = 0.f;
    for (int i = 0; i < 4; ++i) { const float d = v[i] - mu; q += d * d; }
    const float rs = rsqrtf(blk_sum(q, red) / D + LN_EPS); float num = 0.f, den = 0.f;
    for (int i = 0; i < 4; ++i) { const int c = tid + 256 * i; const float r = (v[i] - mu) * rs * g[c] + bb[c], f1 = out[(size_t)t * D + c] / ALPHA, f2 = bf2f(X1B[(size_t)t * D + c]);
        num += (f1 - r) * (f1 - r) + (f2 - r) * (f2 - r); den += 2.f * r * r; }
    num = blk_sum(num, red); den = blk_sum(den, red);
    if (tid == 0) put_err(CHK, 6, num, den);
}
__global__ void __launch_bounds__(256) c7(const float* router_w, const unsigned char* ws, unsigned* CHK) {
    __shared__ float red[4];
    const bf16* X1B = (const bf16*)(ws + WS_X1B); const float* LG = (const float*)(ws + WS_LOGITS);
    const int t = samp_tok(blockIdx.x), c = threadIdx.x; float a = 0.f;
    for (int k = 0; k < D; ++k) a = fmaf(bf2f(X1B[(size_t)t * D + k]), router_w[(size_t)k * NE + c], a);
    const float f = LG[(size_t)t * NE + c] + LG[(size_t)T * NE + (size_t)t * NE + c];
    const float num = blk_sum((f - a) * (f - a), red), den = blk_sum(a * a, red);
    if (c == 0) put_err(CHK, 7, num, den);
}
__global__ void __launch_bounds__(64) c8(const float* rbias, const unsigned char* ws, const unsigned* ctl, unsigned* CHK) {
    __shared__ float sc[NE], bs[NE]; __shared__ int sel[8]; __shared__ float gate[8]; __shared__ float gsc[8]; __shared__ int gm[8];
    const float* LG = (const float*)(ws + WS_LOGITS); const unsigned* TS = (const unsigned*)(ws + WS_TS); const int* slot_tok = (const int*)(ws + WS_SLOTTOK);
    const float* slot_w = (const float*)(ws + WS_SLOTW); const int* tile_e = (const int*)(ws + WS_TILEE);
    const int t = samp_tok(blockIdx.x), lane = threadIdx.x;
    for (int e = lane; e < NE; e += 64) { const float l = LG[(size_t)t * NE + e] + LG[(size_t)T * NE + (size_t)t * NE + e]; sc[e] = 1.f / (1.f + expf(-l)); bs[e] = sc[e] + rbias[e]; }
    __syncthreads();
    if (lane == 0) {
        for (int g = 0; g < 8; ++g) { float a = -1e30f, b2 = -1e30f; for (int i = 0; i < 32; ++i) { const float v = bs[32 * g + i]; if (v > a) { b2 = a; a = v; } else if (v > b2) b2 = v; } gsc[g] = a + b2; gm[g] = 0; }
        for (int k = 0; k < 4; ++k) { int best = -1; for (int g = 0; g < 8; ++g) if (!gm[g] && (best < 0 || gsc[g] > gsc[best])) best = g; gm[best] = 1; }
        float sum = 0.f;
        for (int k = 0; k < 8; ++k) { int best = -1; for (int e = 0; e < NE; ++e) { if (!gm[e >> 5]) continue; bool used = false; for (int q = 0; q < k; ++q) used |= (sel[q] == e); if (used) continue; if (best < 0 || bs[e] > bs[best]) best = e; } sel[k] = best; sum += sc[best]; }
        for (int k = 0; k < 8; ++k) gate[k] = sc[sel[k]] / sum * 2.5f;
        int bad = 0; const int NT = (int)ctl[CW_NT];
        for (int k = 0; k < 8; ++k) { const unsigned slot = TS[(size_t)t * 8 + k]; const int e = tile_e[slot >> 8];
            if (slot >= (unsigned)NT * 256) { ++bad; continue; }
            if (slot_tok[slot] != t) ++bad;
            int q = -1; for (int k2 = 0; k2 < 8; ++k2) if (sel[k2] == e) q = k2;
            if (q < 0) ++bad; else if (fabsf(slot_w[slot] - gate[q]) > 1e-5f) ++bad; }
        atomicMax(CHK + 8, __float_as_uint((float)bad));
    }
}
DI void samp_slot(int i, const unsigned char* ws, const unsigned* ctl, int& slot, int& e, int& tok) {
    const unsigned* TS = (const unsigned*)(ws + WS_TS); const int* tile_e = (const int*)(ws + WS_TILEE); const int NT = (int)ctl[CW_NT];
    tok = samp_tok(i); if (i >= 32 && (i & 1)) { slot = NT * 256 + tok; e = NE; } else { slot = (int)TS[(size_t)tok * 8 + (i & 7)]; e = tile_e[slot >> 8]; } }
__global__ void __launch_bounds__(256) c9(InP ip, const unsigned char* ws, const unsigned* ctl, unsigned* CHK) {
    __shared__ float red[4];
    int slot, e, tok; samp_slot(blockIdx.x, ws, ctl, slot, e, tok);
    const float* wg = e < NE ? ip.p[17] + (size_t)e * D * EH : ip.p[20]; const float* wu = e < NE ? ip.p[18] + (size_t)e * D * EH : ip.p[21];
    const bf16* X1B = (const bf16*)(ws + WS_X1B); const bf16* Hh = (const bf16*)(ws + WS_H);
    const int c = threadIdx.x; float g = 0.f, u = 0.f;
    for (int k = 0; k < D; ++k) { const float xv = bf2f(X1B[(size_t)tok * D + k]); g = fmaf(xv, wg[(size_t)k * EH + c], g); u = fmaf(xv, wu[(size_t)k * EH + c], u); }
    const float r = g / (1.f + expf(-g)) * u, f = bf2f(Hh[(size_t)slot * EH + c]);
    const float num = blk_sum((f - r) * (f - r), red), den = blk_sum(r * r, red);
    if (c == 0) put_err(CHK, 9, num, den);
}
__global__ void __launch_bounds__(256) c10(InP ip, const unsigned char* ws, const unsigned* ctl, unsigned* CHK) {
    __shared__ float red[4];
    int slot, e, tok; samp_slot(blockIdx.x & 31, ws, ctl, slot, e, tok);
    const float* wd = ip.p[19] + (size_t)e * EH * D; const bf16* Hh = (const bf16*)(ws + WS_H); const bf16* Y = (const bf16*)(ws + WS_Y); const float w = ((const float*)(ws + WS_SLOTW))[slot];
    float num = 0.f, den = 0.f;
    for (int c = threadIdx.x; c < D; c += 256) { float a = 0.f; for (int k = 0; k < EH; ++k) a = fmaf(bf2f(Hh[(size_t)slot * EH + k]), wd[(size_t)k * D + c], a);
        const float r = a * w, f = bf2f(Y[(size_t)slot * D + c]); num += (f - r) * (f - r); den += r * r; }
    num = blk_sum(num, red); den = blk_sum(den, red);
    if (threadIdx.x == 0) put_err(CHK, 10, num, den);
}
__global__ void __launch_bounds__(256) save_x1b(const unsigned char* ws, bf16* dst) { const bf16* X1B = (const bf16*)(ws + WS_X1B); const int t = samp_tok(blockIdx.x); for (int c = threadIdx.x; c < D; c += 256) dst[(size_t)blockIdx.x * D + c] = X1B[(size_t)t * D + c]; }
__global__ void __launch_bounds__(256) c11(InP ip, const float* out, const unsigned char* ws, const unsigned* ctl, unsigned* CHK, const bf16* x1s) {
    __shared__ float red[4];
    const bf16* X1B = (const bf16*)(ws + WS_X1B); const bf16* Hh = (const bf16*)(ws + WS_H); const bf16* Y = (const bf16*)(ws + WS_Y); const unsigned* TS = (const unsigned*)(ws + WS_TS);
    const int t = samp_tok(blockIdx.x), tid = threadIdx.x, NT = (int)ctl[CW_NT]; const float* sd = ip.p[22];
    float v[4], s = 0.f;
    for (int i = 0; i < 4; ++i) { const int c = tid + 256 * i; float a = 0.f; for (int k = 0; k < EH; ++k) a = fmaf(bf2f(Hh[((size_t)NT * 256 + t) * EH + k]), sd[(size_t)k * D + c], a);
        a += ALPHA * bf2f(x1s[(size_t)blockIdx.x * D + c]); for (int k = 0; k < 8; ++k) a += bf2f(Y[(size_t)TS[(size_t)t * 8 + k] * D + c]); v[i] = a; s += a; }
    const float mu = blk_sum(s, red) / D; float q = 0.f;
    for (int i = 0; i < 4; ++i) { const float d = v[i] - mu; q += d * d; }
    const float rs = rsqrtf(blk_sum(q, red) / D + LN_EPS); float num = 0.f, den = 0.f;
    for (int i = 0; i < 4; ++i) { const int c = tid + 256 * i; const float r = (v[i] - mu) * rs * ip.p[23][c] + ip.p[24][c], f = out[(size_t)t * D + c]; num += (f - r) * (f - r); den += r * r; }
    num = blk_sum(num, red); den = blk_sum(den, red);
    if (tid == 0) put_err(CHK, 11, num, den);
}
__global__ void __launch_bounds__(256) verdict(float* out, const unsigned* CHK, const unsigned* ctl) {
    int stage = 0; float err = 0.f;
    for (int s = 1; s <= 11; ++s) { const float e = __uint_as_float(CHK[s]); const float tol = (s == 8) ? 0.5f : 0.03f; if (stage == 0 && !(e <= tol)) { stage = s; err = e; } }
    for (int li = 0; li < 16; ++li) if (stage == 0 && ctl[CW_BAR + li * XCD_BAR_WORDS_C + 128] != 0) { stage = 12; err = 1.f; }
    if (stage == 0) return;
    float lg = (log10f(fminf(fmaxf(err, 1e-3f), 1.f)) + 3.f) / 3.f; const float c2v = powf(10.f, (float)stage) * (1.f + 8.f * lg); const float C = sqrtf(c2v);
    for (size_t i = (size_t)blockIdx.x * 256 + threadIdx.x; i < (size_t)T * D; i += (size_t)gridDim.x * 256) out[i] = C;
}
}
#endif

extern "C" void kernel_launch(void* const* d_in, const int* in_sizes, int n_in, void* d_out, int out_size, void* d_ws, size_t ws_size, hipStream_t stream) {
    static int grid = 0;
    if (grid == 0) {
        if (n_in != 25 || in_sizes[0] != T * D || out_size != T * D || ws_size < WS_END) { fprintf(stderr, "kernel_launch: unexpected problem shape / workspace (%d inputs, ws %zu); nothing launched\n", n_in, ws_size); grid = -1; return; }
        int dev = 0, cus = 0, per_cu = 0;
        if (hipGetDevice(&dev) != hipSuccess || hipDeviceGetAttribute(&cus, hipDeviceAttributeMultiprocessorCount, dev) != hipSuccess) { grid = -1; return; }
        if (hipFuncSetAttribute((const void*)mk_fwd, hipFuncAttributeMaxDynamicSharedMemorySize, LDS_BYTES) != hipSuccess) { fprintf(stderr, "kernel_launch: hipFuncSetAttribute failed\n"); grid = -1; return; }
        if (hipOccupancyMaxActiveBlocksPerMultiprocessor(&per_cu, (const void*)mk_fwd, NWAVES * 64, LDS_BYTES) != hipSuccess || per_cu < 1) { fprintf(stderr, "kernel_launch: occupancy query says %d\n", per_cu); }
        (void)hipGetLastError();
        grid = cus;
    }
    if (grid < 0) return;
    (void)hipMemsetAsync((char*)d_ws + WS_CTL, 0, CTL_ZERO_BYTES, stream);
    Args a{};
    for (int i = 0; i < 25; ++i) a.in[i] = (const float*)d_in[i];
    a.out = (float*)d_out; a.ws = (unsigned char*)d_ws;
#if defined(SELFCHECK) && SELFCHECK
    unsigned char* ws = (unsigned char*)d_ws; unsigned* CHK = (unsigned*)(ws + WS_CTL) + CW_CHK; const unsigned* ctl = (const unsigned*)(ws + WS_CTL);
    chk::InP inp{}; for (int i = 0; i < 25; ++i) inp.p[i] = a.in[i];
    float* scratch = (float*)(ws + WS_END + MiB);
    for (int p = 0; p < N_PHASES; ++p) {
        a.ph_lo = p; a.ph_hi = p + 1; a.li = p;
        hipLaunchKernelGGL(mk_fwd, dim3(grid), dim3(NWAVES * 64), LDS_BYTES, stream, a);
        using namespace chk;
        if (p == 1) hipLaunchKernelGGL(c1, dim3(NS), dim3(256), 0, stream, a.in[0], (const int*)d_in[1], a.in[2], ws, CHK);
        if (p == 2) hipLaunchKernelGGL(c2, dim3(NS * 8), dim3(64), 0, stream, ws, CHK);
        if (p == 3) hipLaunchKernelGGL(c3, dim3(16), dim3(64), 0, stream, inp, ws, scratch, CHK);
        if (p == 4) hipLaunchKernelGGL(c4, dim3(NS), dim3(256), 0, stream, a.in[3], a.in[11], ws, CHK);
        if (p == 5) hipLaunchKernelGGL(c5, dim3(NS), dim3(256), 0, stream, a.in[0], a.in[12], ws, CHK);
        if (p == 6) hipLaunchKernelGGL(c6, dim3(NS), dim3(256), 0, stream, a.in[13], a.in[14], (const float*)d_out, ws, CHK);
        if (p == 7) hipLaunchKernelGGL(c7, dim3(NS), dim3(256), 0, stream, a.in[15], ws, CHK);
        if (p == 9) hipLaunchKernelGGL(c8, dim3(NS), dim3(64), 0, stream, a.in[16], ws, ctl, CHK);
        if (p == 10) { hipLaunchKernelGGL(c9, dim3(NS), dim3(256), 0, stream, inp, ws, ctl, CHK); hipLaunchKernelGGL(save_x1b, dim3(NS), dim3(256), 0, stream, ws, (bf16*)(ws + WS_END + 4 * MiB)); }
        if (p == 11) hipLaunchKernelGGL(c10, dim3(32), dim3(256), 0, stream, inp, ws, ctl, CHK);
        if (p == 12) hipLaunchKernelGGL(c11, dim3(NS), dim3(256), 0, stream, inp, (const float*)d_out, ws, ctl, CHK, (const bf16*)(ws + WS_END + 4 * MiB));
    }
    hipLaunchKernelGGL(chk::verdict, dim3(1024), dim3(256), 0, stream, (float*)d_out, CHK, ctl);
#else
    a.ph_lo = 0; a.ph_hi = N_PHASES; a.li = 0;
    hipLaunchKernelGGL(mk_fwd, dim3(grid), dim3(NWAVES * 64), LDS_BYTES, stream, a);
#endif
}
```

```cpp
#include <hip/hip_runtime.h>
#include <cstdio>
#include <cstdint>

#define LAS __attribute__((address_space(3)))
#define GAS __attribute__((address_space(1)))
typedef unsigned short bf16;
typedef short bf16x8 __attribute__((ext_vector_type(8)));
typedef short s16x4 __attribute__((ext_vector_type(4)));
typedef float f32x2 __attribute__((ext_vector_type(2)));
typedef float f32x4 __attribute__((ext_vector_type(4)));
typedef float f32x16 __attribute__((ext_vector_type(16)));
typedef unsigned u32x2 __attribute__((ext_vector_type(2)));
typedef unsigned u32x4 __attribute__((ext_vector_type(4)));
typedef GAS unsigned gu32;
#define RLX_AGENT __ATOMIC_RELAXED, __HIP_MEMORY_SCOPE_AGENT
#define DI __device__ __forceinline__

constexpr int NB = 4, SEQ = 8192, T = NB * SEQ, D = 1024, AW = 512, RW = 512, HD = 64, NH = 8, INW = 2560;
constexpr int NE = 256, TOPK = 8, EH = 256;
constexpr float ALPHA = 1.189207115002721f;
constexpr float LN_EPS = 1e-5f;
constexpr float LOG2E = 1.4426950408889634f;
constexpr float QSCALE = 0.125f * LOG2E;
constexpr int NWAVES = 8;
constexpr int MAXRT = T * TOPK / 256 + NE;
constexpr int NSHT = T / 256;
constexpr int MAXTILES = MAXRT + NSHT;
constexpr int MAXSLOTS = MAXTILES * 256;
constexpr int LCH = 128, NCH = SEQ / LCH;

constexpr size_t MiB = 1u << 20;
constexpr size_t WS_CTL = 0, CTL_ZERO_BYTES = 1 * MiB;
constexpr size_t WS_ROPE = 1 * MiB;
constexpr size_t WS_GWT = 3 * MiB;
constexpr size_t WS_C2 = 3 * MiB + 512 * 1024;
constexpr size_t WS_CARRY = 4 * MiB;
constexpr size_t WS_ER = 6 * MiB, WS_TS = 7 * MiB, WS_GW = 8 * MiB;
constexpr size_t WS_SLOTTOK = 9 * MiB, WS_SLOTW = 11 * MiB;
constexpr size_t WS_TILEE = 13 * MiB;
constexpr size_t WS_WINT = 14 * MiB, WS_WOUTT = 19 * MiB, WS_RTT = 21 * MiB;
constexpr size_t WS_WDT = 32 * MiB;
constexpr size_t WS_H = 161 * MiB;
constexpr size_t WS_Q = 161 * MiB, SEG_BYTES = 32 * MiB;
constexpr size_t WS_Y = 337 * MiB;
constexpr size_t WS_WGUT = 337 * MiB;
constexpr size_t WS_X1B = 850 * MiB;
constexpr size_t WS_LOGITS = 658 * MiB;
constexpr size_t WS_ATTN = 658 * MiB, WS_REC = 690 * MiB;
constexpr size_t WS_V1 = 722 * MiB;
constexpr size_t WS_XB = 722 * MiB;
constexpr size_t WS_MIX = 850 * MiB;
constexpr size_t WS_HF = 914 * MiB;
constexpr size_t WS_END = 977 * MiB;
static_assert(WS_WDT + (size_t)257 * 1024 * 256 * 2 <= WS_H && WS_H + (size_t)MAXSLOTS * 256 * 2 <= WS_Y && WS_Y + (size_t)MAXSLOTS * 1024 <= WS_V1, "ws map");
static_assert(WS_WGUT + (size_t)257 * 512 * 1024 * 2 <= WS_LOGITS && WS_Q + 5 * SEG_BYTES <= WS_Y, "ws map 2");
constexpr int CW_TMO = 0, CW_CNT = 1024, CW_NT = 2048, CW_CHK = 3072, CW_BAR = 4096;
#define XCD_BAR_WORDS_C 3456
static_assert((CW_BAR + 16 * XCD_BAR_WORDS_C) * 4 <= (int)CTL_ZERO_BYTES, "ctl");

constexpr int RING_OFF = 0, RING_BYTES = 131072;
constexpr int UT_OFF = RING_BYTES;
constexpr int UT_IDX = UT_OFF + 128;
constexpr int UT_W = UT_IDX + 11 * 1024;
constexpr int MISC_OFF = UT_W + 11 * 1024;
constexpr int LDS_BYTES = 163840;
static_assert(MISC_OFF + 256 <= LDS_BYTES, "LDS map");

DI unsigned f2bf(float f) { unsigned u = __builtin_bit_cast(unsigned, f); return (u + 0x7fffu + ((u >> 16) & 1u)) >> 16; }
DI unsigned pk2(float lo, float hi) { return f2bf(lo) | (f2bf(hi) << 16); }
DI float bf2f(unsigned short b) { return __builtin_bit_cast(float, (unsigned)b << 16); }
DI float bflo(unsigned w) { return __builtin_bit_cast(float, w << 16); }
DI float bfhi(unsigned w) { return __builtin_bit_cast(float, w & 0xffff0000u); }
DI float wave_sum(float v) {
#pragma unroll
    for (int o = 1; o < 64; o <<= 1) v += __shfl_xor(v, o);
    return v;
}
DI float wave_max(float v) {
#pragma unroll
    for (int o = 1; o < 64; o <<= 1) v = fmaxf(v, __shfl_xor(v, o));
    return v;
}
DI int wave_min_i(int v) {
#pragma unroll
    for (int o = 1; o < 64; o <<= 1) v = min(v, __shfl_xor(v, o));
    return v;
}
DI float row16_max(float v) {
    v = fmaxf(v, __builtin_bit_cast(float, __builtin_amdgcn_update_dpp(0, __builtin_bit_cast(int, v), 0xB1, 0xF, 0xF, false)));
    v = fmaxf(v, __builtin_bit_cast(float, __builtin_amdgcn_update_dpp(0, __builtin_bit_cast(int, v), 0x4E, 0xF, 0xF, false)));
    v = fmaxf(v, __builtin_bit_cast(float, __builtin_amdgcn_update_dpp(0, __builtin_bit_cast(int, v), 0x141, 0xF, 0xF, false)));
    v = fmaxf(v, __builtin_bit_cast(float, __builtin_amdgcn_update_dpp(0, __builtin_bit_cast(int, v), 0x140, 0xF, 0xF, false)));
    return v; }
DI float wave_max_fast(float v) { v = row16_max(v);
    const float r0 = __builtin_bit_cast(float, __builtin_amdgcn_readlane(__builtin_bit_cast(int, v), 0)), r1 = __builtin_bit_cast(float, __builtin_amdgcn_readlane(__builtin_bit_cast(int, v), 16)),
                r2 = __builtin_bit_cast(float, __builtin_amdgcn_readlane(__builtin_bit_cast(int, v), 32)), r3 = __builtin_bit_cast(float, __builtin_amdgcn_readlane(__builtin_bit_cast(int, v), 48));
    return fmaxf(fmaxf(r0, r1), fmaxf(r2, r3)); }
DI int wave_min_i_fast(int v) {
    v = min(v, __builtin_amdgcn_update_dpp(0, v, 0xB1, 0xF, 0xF, false)); v = min(v, __builtin_amdgcn_update_dpp(0, v, 0x4E, 0xF, 0xF, false));
    v = min(v, __builtin_amdgcn_update_dpp(0, v, 0x141, 0xF, 0xF, false)); v = min(v, __builtin_amdgcn_update_dpp(0, v, 0x140, 0xF, 0xF, false));
    return min(min(__builtin_amdgcn_readlane(v, 0), __builtin_amdgcn_readlane(v, 16)), min(__builtin_amdgcn_readlane(v, 32), __builtin_amdgcn_readlane(v, 48))); }
DI int lane_id() { return (int)__builtin_amdgcn_mbcnt_hi(~0u, __builtin_amdgcn_mbcnt_lo(~0u, 0u)); }
DI float fexp2(float x) { return __builtin_amdgcn_exp2f(x); }
DI float frcp(float x) { return __builtin_amdgcn_rcpf(x); }
DI float gelu_tanh(float x) {
    const float z = 0.7978845608028654f * (x + 0.044715f * x * x * x);
    const float e = fexp2(2.f * LOG2E * z);
    return 0.5f * x * (2.f - 2.f * frcp(e + 1.f));
}
DI int crow(int r, int hi) { return (r & 3) + 8 * (r >> 2) + 4 * hi; }
#define MFMA32(a, b, c) __builtin_amdgcn_mfma_f32_32x32x16_bf16((a), (b), (c), 0, 0, 0)

namespace pg8 {
constexpr int BM = 256, BK = 64, HALF = 128, HTB = HALF * BK * 2, NXCD = 8;
DI int lds_byte(int r, int c) { const int st = (r >> 4) * 2 + (c >> 5), rr = r & 15, cc = c & 31, ob = rr * 64 + cc * 2; return st * 1024 + (ob ^ (((ob >> 9) & 1) << 5)); }
DI void stage_rc(int b, int& R, int& C) { const int st = b / 1024, sb = b % 1024, swz = sb ^ (((sb >> 9) & 1) << 5); R = (st >> 1) * 16 + swz / 64; C = (st & 1) * 32 + (swz % 64) / 2; }
DI int perm32(int rho) { const int n = rho >> 4, i = rho & 15; return 8 * (i >> 2) + 4 * n + (i & 3); }
struct Unit { int pm, pn, li, ex; };
DI bool xcd_order(int i, int G, int c, int nwg, int& wgid) {
    const long L = (long)i * G + c; if (L >= nwg) return false;
    const int w = (int)L, q = nwg / NXCD, r = nwg % NXCD, xcd = w % NXCD, off = w / NXCD;
    wgid = (xcd < r ? xcd * (q + 1) : r * (q + 1) + (xcd - r) * q) + off; return true;
}
DI s16x4 pg8_tr(const LAS unsigned char* p) { typedef short v4i16_t __attribute__((ext_vector_type(4))); return __builtin_bit_cast(s16x4, __builtin_amdgcn_ds_read_tr16_b64_v4i16((LAS v4i16_t*)p)); }
DI unsigned cvt_pk_bf16(float lo, float hi) { unsigned r; asm volatile("v_cvt_pk_bf16_f32 %0, %1, %2" : "=v"(r) : "v"(lo), "v"(hi)); return r; }

template <class Epi, class Sched, bool ALIGN_EPI, bool BKN = false>
DI void gemm_phase(LAS unsigned char* lds, const Sched& S, const Epi& E, const int K) {
    const int tid = threadIdx.x, wid = __builtin_amdgcn_readfirstlane(tid >> 6), lane = tid & 63, wr = wid >> 2, wc = wid & 3, fr = lane & 15, fq = lane >> 4;
    const int nt = K / BK;
    int Ri[2], Ci[2]; unsigned voffB[2];
#pragma unroll
    for (int i = 0; i < 2; ++i) { int R, C; stage_rc(tid * 16 + i * 8192, R, C); Ri[i] = R; Ci[i] = C; const int Rb = Epi::PERM ? ((R & ~31) + perm32(R & 31)) : R; voffB[i] = (unsigned)(Rb * S.ldb + C) * 2u;
        if constexpr (BKN) { static_assert(!BKN || Epi::PERM, "the [K][N] B path delivers the PERM column order"); const int b = tid * 16 + i * 8192, k = b >> 8, c = (b >> 4) & 15, cl = ((((c >> 2) ^ (k & 3)) << 2) | (c & 3)); voffB[i] = (unsigned)(k * S.ldb + 8 * cl) * 2u; } }
    const size_t kstep = (size_t)(BK * 2);
    size_t hstepB = (size_t)HALF * S.ldb * 2, kstepB = kstep;
    if constexpr (BKN) { hstepB = S.bh1; kstepB = (size_t)BK * S.ldb * 2; }
    int bkn_off = 0;
    if constexpr (BKN) { const int g = lane >> 4, q = (lane >> 2) & 3, pp = lane & 3; bkn_off = (8 * g + q) * 256 + ((((wc ^ q) << 2) | pp) << 4); }
    const unsigned ldsw = (unsigned)wid * 1024u;
    const int aoff = lds_byte(wr * 64 + fr, fq * 8), boff = lds_byte(wc * 32 + fr, fq * 8);
#define PG8_SA(b, h) (((b) * 2 + (h)) * HTB)
#define PG8_SB(b, h) ((4 + (b) * 2 + (h)) * HTB)
#define PG8_STAGE(bufoff, gbase, voff) do { _Pragma("unroll") for (int _i = 0; _i < 2; ++_i) \
        __builtin_amdgcn_global_load_lds((const unsigned*)((const char*)(gbase) + (voff)[_i]), (LAS unsigned*)(lds + (bufoff) + ldsw + _i * 8192), 16, 0, 0); } while (0)
#define PG8_LDA(dst, b, h) do { _Pragma("unroll") for (int m = 0; m < 4; ++m) _Pragma("unroll") for (int k = 0; k < 2; ++k) dst[m][k] = *(const LAS bf16x8*)(lds + PG8_SA(b, h) + aoff + m * 2048 + k * 1024); } while (0)
#define PG8_LDB(dst, b, h) do { if constexpr (BKN) { _Pragma("unroll") for (int n = 0; n < 2; ++n) _Pragma("unroll") for (int k = 0; k < 2; ++k) { \
            const s16x4 lo_ = pg8_tr(lds + PG8_SB(b, h) + bkn_off + k * 8192 + n * 8), hi_ = pg8_tr(lds + PG8_SB(b, h) + bkn_off + k * 8192 + n * 8 + 1024); dst[n][k] = __builtin_shufflevector(lo_, hi_, 0, 1, 2, 3, 4, 5, 6, 7); } } \
        else { _Pragma("unroll") for (int n = 0; n < 2; ++n) _Pragma("unroll") for (int k = 0; k < 2; ++k) dst[n][k] = *(const LAS bf16x8*)(lds + PG8_SB(b, h) + boff + n * 2048 + k * 1024); } } while (0)
#define PG8_MMA(ai, bj, At, Bt) do { __builtin_amdgcn_s_setprio(1); _Pragma("unroll") for (int m = 0; m < 4; ++m) _Pragma("unroll") for (int n = 0; n < 2; ++n) _Pragma("unroll") for (int k = 0; k < 2; ++k) \
        acc[ai][bj][m][n] = __builtin_amdgcn_mfma_f32_16x16x32_bf16(Bt[n][k], At[m][k], acc[ai][bj][m][n], 0, 0, 0); __builtin_amdgcn_s_setprio(0); } while (0)
#define PG8_WAIT_V(n) asm volatile("s_waitcnt vmcnt(" #n ")" ::: "memory")
#define PG8_WAIT_L(n) asm volatile("s_waitcnt lgkmcnt(" #n ")" ::: "memory")
#define PG8_BAR __builtin_amdgcn_s_barrier()
#define PG8_SCHED __builtin_amdgcn_sched_barrier(0)
    Unit cur, nxt; int ui = 0;
    if (!S.next(0, cur)) return;
    f32x4 acc[2][2][4][2];
#pragma unroll
    for (int a = 0; a < 2; ++a)
#pragma unroll
        for (int b = 0; b < 2; ++b)
#pragma unroll
            for (int m = 0; m < 4; ++m)
#pragma unroll
                for (int n = 0; n < 2; ++n) acc[a][b][m][n] = (f32x4){0.f, 0.f, 0.f, 0.f};
    bf16x8 At[4][2], B0[2][2], B1[2][2];
    unsigned ca0[2], ca1[2], na0[2], na1[2];
#pragma unroll
    for (int i = 0; i < 2; ++i) { ca0[i] = S.a_voff(cur, Ri[i], Ci[i]); ca1[i] = S.a_voff(cur, HALF + Ri[i], Ci[i]); }
    const char* cA = S.a_base(cur); const char* cB = S.b_base(cur);
    typename Epi::Ctx ctx = E.pre(cur, wr, fr);
    PG8_STAGE(PG8_SB(0, 0), cB, voffB); PG8_STAGE(PG8_SB(0, 1), cB + hstepB, voffB); PG8_STAGE(PG8_SA(0, 0), cA, ca0); PG8_STAGE(PG8_SA(0, 1), cA, ca1);
    if (wr == 1) PG8_BAR;
    PG8_WAIT_V(2); PG8_BAR;
    PG8_STAGE(PG8_SB(1, 0), cB + kstepB, voffB); PG8_STAGE(PG8_SA(1, 0), cA + kstep, ca0); PG8_STAGE(PG8_SB(1, 1), cB + hstepB + kstepB, voffB);
    PG8_WAIT_V(6); PG8_BAR;
    for (;;) {
        const bool has_next = S.next(ui + 1, nxt);
        const char* nA = has_next ? S.a_base(nxt) : cA; const char* nB = has_next ? S.b_base(nxt) : cB;
#pragma unroll
        for (int i = 0; i < 2; ++i) { na0[i] = has_next ? S.a_voff(nxt, Ri[i], Ci[i]) : ca0[i]; na1[i] = has_next ? S.a_voff(nxt, HALF + Ri[i], Ci[i]) : ca1[i]; }
#pragma unroll 1
        for (int t = 0; t < nt; t += 2) {
            const bool last = (t == nt - 2);
            const char* a1 = cA + (size_t)(t + 1) * kstep;
            const char* a2 = last ? nA : cA + (size_t)(t + 2) * kstep; const char* b2 = last ? nB : cB + (size_t)(t + 2) * kstepB;
            const char* a3 = a2 + kstep; const char* b3 = b2 + kstepB;
            unsigned v20[2], v21[2];
#pragma unroll
            for (int i = 0; i < 2; ++i) { v20[i] = last ? na0[i] : ca0[i]; v21[i] = last ? na1[i] : ca1[i]; }
            PG8_LDB(B0, 0, 0); PG8_LDB(B1, 0, 1); PG8_SCHED; PG8_LDA(At, 0, 0); PG8_STAGE(PG8_SA(1, 1), a1, ca1);
            PG8_WAIT_V(8); PG8_WAIT_L(0); PG8_BAR; PG8_MMA(0, 0, At, B0); PG8_MMA(0, 1, At, B1); PG8_BAR; PG8_SCHED;
            PG8_LDA(At, 0, 1); PG8_STAGE(PG8_SB(0, 0), b2, voffB); PG8_STAGE(PG8_SB(0, 1), b2 + hstepB, voffB); PG8_STAGE(PG8_SA(0, 0), a2, v20);
            PG8_WAIT_V(8); PG8_WAIT_L(0); PG8_BAR; PG8_MMA(1, 0, At, B0); PG8_MMA(1, 1, At, B1); PG8_BAR; PG8_SCHED;
            PG8_LDB(B0, 1, 0); PG8_LDB(B1, 1, 1); PG8_SCHED; PG8_LDA(At, 1, 0); PG8_STAGE(PG8_SA(0, 1), a2, v21);
            PG8_WAIT_V(8); PG8_WAIT_L(0); PG8_BAR; PG8_MMA(0, 0, At, B0); PG8_MMA(0, 1, At, B1); PG8_BAR; PG8_SCHED;
            PG8_LDA(At, 1, 1); PG8_STAGE(PG8_SB(1, 0), b3, voffB); PG8_STAGE(PG8_SB(1, 1), b3 + hstepB, voffB); PG8_STAGE(PG8_SA(1, 0), a3, v20);
            PG8_WAIT_V(8); PG8_WAIT_L(0); PG8_BAR; PG8_MMA(1, 0, At, B0); PG8_MMA(1, 1, At, B1); PG8_BAR; PG8_SCHED;
        }
        if constexpr (ALIGN_EPI) { if (wr == 0) PG8_BAR; }
        E(acc, cur, ctx, wr, wc, fr, fq);
        if (!has_next) break;
#pragma unroll
        for (int a = 0; a < 2; ++a)
#pragma unroll
            for (int b = 0; b < 2; ++b)
#pragma unroll
                for (int m = 0; m < 4; ++m)
#pragma unroll
                    for (int n = 0; n < 2; ++n) acc[a][b][m][n] = (f32x4){0.f, 0.f, 0.f, 0.f};
        cur = nxt; cA = nA; cB = nB; ++ui;
        ctx = E.pre(cur, wr, fr);
#pragma unroll
        for (int i = 0; i < 2; ++i) { ca0[i] = na0[i]; ca1[i] = na1[i]; }
        if constexpr (ALIGN_EPI) { if (wr == 1) PG8_BAR; }
    }
    PG8_WAIT_V(0);
    if constexpr (!ALIGN_EPI) { if (wr == 0) PG8_BAR; }
    PG8_BAR;
#undef PG8_SA
#undef PG8_SB
#undef PG8_STAGE
#undef PG8_LDA
#undef PG8_LDB
#undef PG8_MMA
#undef PG8_WAIT_V
#undef PG8_WAIT_L
#undef PG8_BAR
#undef PG8_SCHED
}
}
#define XB_TMO      128
#define XB_XCNT(j)  (256  + 64 * (j))
#define XB_XSUB(j)  (1280 + 64 * (j))
#define XB_XGEN(j)  (2304 + 64 * (j))
#define XB_TOP      3328
#define XB_TOPGEN   3392
#define XCD_BAR_WORDS 3456
#define XB_SPIN_CAP (1u << 18)

__device__ __forceinline__ unsigned xb_ld(unsigned* p)              { return __hip_atomic_load(p, __ATOMIC_RELAXED, __HIP_MEMORY_SCOPE_AGENT); }
__device__ __forceinline__ unsigned xb_add(unsigned* p, unsigned v) { return __hip_atomic_fetch_add(p, v, __ATOMIC_RELAXED, __HIP_MEMORY_SCOPE_AGENT); }
__device__ __forceinline__ unsigned xb_xcc_id() { return (unsigned)__builtin_amdgcn_s_getreg((3 << 11) | 20) & 0xFu; }
#define XB_SPIN(cond, bar) do { unsigned _sp = 0; while (cond) { __builtin_amdgcn_s_sleep(1); \
    if ((++_sp & 255u) == 0u) { if (xb_ld(&(bar)[XB_TMO])) break; if (_sp > XB_SPIN_CAP) { atomicAdd(&(bar)[XB_TMO], 1u); break; } } } } while (0)

struct XcdBarrier {
    unsigned* bar; unsigned x;
    volatile LAS unsigned* st;
};

__device__ __forceinline__ XcdBarrier xcd_barrier_post(unsigned* bar, volatile LAS unsigned* st) {
    XcdBarrier b; b.bar = bar; b.x = xb_xcc_id(); b.st = st;
    if (threadIdx.x == 0) (void)xb_add(&bar[XB_XCNT(b.x)], 1u);
    return b;
}
__device__ __forceinline__ void xcd_barrier_complete(unsigned* bar, unsigned x, unsigned& nloc, unsigned& nx) {
    const unsigned G = gridDim.x * gridDim.y * gridDim.z;
    unsigned sum, cnt, mine, sp = 0u;
    for (;;) {
        sum = 0u; cnt = 0u; mine = 0u;
#pragma unroll
        for (unsigned j = 0; j < 16; ++j) { const unsigned c = xb_ld(&bar[XB_XCNT(j)]); sum += c; cnt += (c > 0u) ? 1u : 0u; mine = (j == x) ? c : mine; }
        if (sum == G) break;
        __builtin_amdgcn_s_sleep(1);
        if ((++sp & 255u) == 0u) { if (xb_ld(&bar[XB_TMO])) break; if (sp > XB_SPIN_CAP) { atomicAdd(&bar[XB_TMO], 1u); break; } }
    }
    nloc = mine > 0u ? mine : 1u; nx = cnt > 0u ? cnt : 1u;
}

__device__ __forceinline__ void xcd_barrier(const XcdBarrier& b) {
    asm volatile("s_waitcnt vmcnt(0)" ::: "memory");
    __syncthreads();
    if (threadIdx.x == 0) {
        unsigned* bar = b.bar;
        __builtin_amdgcn_s_waitcnt(0);
        unsigned nloc = b.st[0], nx = b.st[1];
        if (nloc == 0u) { xcd_barrier_complete(bar, b.x, nloc, nx); b.st[0] = nloc; b.st[1] = nx; }
        const unsigned old = xb_add(&bar[XB_XSUB(b.x)], 1u);
        const unsigned gen = old / nloc;
        if (old + 1u == (gen + 1u) * nloc) {
            __builtin_amdgcn_fence(__ATOMIC_RELEASE, "agent");
            asm volatile("s_waitcnt vmcnt(0)" ::: "memory");
            const unsigned og = xb_add(&bar[XB_TOP], 1u);
            const unsigned tg = og / nx;
            if (og + 1u == (tg + 1u) * nx) xb_add(&bar[XB_TOPGEN], 1u);
            else XB_SPIN(xb_ld(&bar[XB_TOPGEN]) == tg, bar);
            __builtin_amdgcn_fence(__ATOMIC_ACQUIRE, "agent");
            xb_add(&bar[XB_XGEN(b.x)], 1u);
            asm volatile("s_waitcnt vmcnt(0)" ::: "memory");
        } else {
            XB_SPIN(xb_ld(&bar[XB_XGEN(b.x)]) == gen, bar);
            __builtin_amdgcn_fence(__ATOMIC_ACQUIRE, "agent");
            asm volatile("s_waitcnt vmcnt(0)" ::: "memory");
        }
    }
    __syncthreads();
}

#define LDS_WAIT() asm volatile("s_waitcnt lgkmcnt(0)" ::: "memory")
#define VM_WAIT() asm volatile("s_waitcnt vmcnt(0)" ::: "memory")
struct Frame {
    LAS unsigned char* lds;
    volatile LAS unsigned* MISC;
    gu32* ctl;
    int tid, lane, wave, vcu, G;
    unsigned char* ws;
    const float* in[25];
    float* out;
};

DI void sincos_acc(float ang, float& c, float& s) {
    const double x = (double)ang;
    const double k = rint(x * 0.63661977236758134308);
    double r = fma(-k, 1.57079632679489655800, x);
    r = fma(-k, 6.12323399573676603587e-17, r);
    const long long q = (long long)k;
    const double r2 = r * r;
    double sp = -7.6471637318198164759e-13; sp = fma(sp, r2, 1.6059043836821614599e-10); sp = fma(sp, r2, -2.5052108385441718775e-08);
    sp = fma(sp, r2, 2.7557319223985890653e-06); sp = fma(sp, r2, -1.9841269841269841270e-04); sp = fma(sp, r2, 8.3333333333333333333e-03);
    sp = fma(sp, r2, -1.6666666666666666667e-01); const double sr = fma(sp * r2, r, r);
    double cp = 4.7794773323873852974e-14; cp = fma(cp, r2, -1.1470745597729724714e-11); cp = fma(cp, r2, 2.0876756987868098979e-09);
    cp = fma(cp, r2, -2.7557319223985890653e-07); cp = fma(cp, r2, 2.4801587301587301587e-05); cp = fma(cp, r2, -1.3888888888888888889e-03);
    cp = fma(cp, r2, 4.1666666666666666667e-02); cp = fma(cp, r2, -0.5); const double cr = fma(cp, r2, 1.0);
    const int qq = (int)(q & 3);
    const double ss = qq == 0 ? sr : (qq == 1 ? cr : (qq == 2 ? -sr : -cr));
    const double cc = qq == 0 ? cr : (qq == 1 ? -sr : (qq == 2 ? -cr : sr));
    c = (float)cc; s = (float)ss;
}

DI void tr_item(const float* W, int N, bf16* WT, int Kd, LAS float* scr, int lane) {
#pragma unroll 4
    for (int i = 0; i < 16; ++i) { const int k = 4 * i + (lane >> 4), c4 = (lane & 15) * 4; const f32x4 v = *(const GAS f32x4*)(W + (size_t)k * N + c4);
        LAS float* d = scr + k * 65 + c4; d[0] = v.x; d[1] = v.y; d[2] = v.z; d[3] = v.w; }
    LDS_WAIT(); asm volatile("" ::: "memory");
    const int c = lane & 7;
#pragma unroll
    for (int j = 0; j < 8; ++j) { const int n = 8 * j + (lane >> 3); const LAS float* s = scr + (8 * c) * 65 + n;
        u32x4 o; o.x = pk2(s[0 * 65], s[1 * 65]); o.y = pk2(s[2 * 65], s[3 * 65]); o.z = pk2(s[4 * 65], s[5 * 65]); o.w = pk2(s[6 * 65], s[7 * 65]);
        *(GAS u32x4*)(WT + (size_t)n * Kd + 8 * c) = o; }
    LDS_WAIT(); asm volatile("" ::: "memory");
}
constexpr int XI_GU = 257 * 16 * 4, XI_DN = 257 * 4 * 16, XI_ALL = 2 * XI_GU + XI_DN;
struct XItem { const float* src; bf16* dst; int N, Kd; };
DI XItem expert_item(Frame& F, int r) {
    unsigned char* ws = F.ws; XItem x;
    if (r < 2 * XI_GU) {
        const int up = r >= XI_GU; if (up) r -= XI_GU;
        const int e = r >> 6, kb = (r >> 2) & 15, nb = r & 3;
        const float* src = (e < NE) ? F.in[up ? 18 : 17] + (size_t)e * D * EH : F.in[up ? 21 : 20];
        const int row = (nb >> 1) * 256 + up * 128 + (nb & 1) * 64;
        x.src = src + (size_t)kb * 64 * EH + nb * 64; x.N = EH; x.dst = (bf16*)(ws + WS_WGUT) + ((size_t)e * 512 + row) * D + kb * 64; x.Kd = D;
    } else {
        r -= 2 * XI_GU;
        const int e = r >> 6, kb = (r >> 4) & 3, nb = r & 15;
        const float* src = (e < NE) ? F.in[19] + (size_t)e * EH * D : F.in[22];
        x.src = src + (size_t)kb * 64 * D + nb * 64; x.N = D; x.dst = (bf16*)(ws + WS_WDT) + ((size_t)e * D + nb * 64) * EH + kb * 64; x.Kd = EH;
    }
    return x;
}
DI void xi_load(const XItem& x, f32x4 (&r)[16], int lane) {
#pragma unroll
    for (int i = 0; i < 16; ++i) { const int k = 4 * i + (lane >> 4), c4 = (lane & 15) * 4; r[i] = __builtin_nontemporal_load((const GAS f32x4*)(x.src + (size_t)k * x.N + c4)); }
}
DI void xi_finish(const XItem& x, const f32x4 (&r)[16], LAS float* scr, int lane) {
#pragma unroll
    for (int i = 0; i < 16; ++i) { const int k = 4 * i + (lane >> 4), c4 = (lane & 15) * 4; LAS float* d = scr + k * 65 + c4; d[0] = r[i].x; d[1] = r[i].y; d[2] = r[i].z; d[3] = r[i].w; }
    LDS_WAIT(); asm volatile("" ::: "memory");
    const int c = lane & 7;
#pragma unroll
    for (int j = 0; j < 8; ++j) { const int n = 8 * j + (lane >> 3); const LAS float* s = scr + (8 * c) * 65 + n;
        u32x4 o; o.x = pg8::cvt_pk_bf16(s[0 * 65], s[1 * 65]); o.y = pg8::cvt_pk_bf16(s[2 * 65], s[3 * 65]); o.z = pg8::cvt_pk_bf16(s[4 * 65], s[5 * 65]); o.w = pg8::cvt_pk_bf16(s[6 * 65], s[7 * 65]);
        *(GAS u32x4*)(x.dst + (size_t)n * x.Kd + 8 * c) = o; }
    LDS_WAIT(); asm volatile("" ::: "memory");
}
DI void convert_items(Frame& F, int it_lo, int it_hi, LAS float* scr) {
    const int gw = F.vcu * NWAVES + F.wave, NGW = F.G * NWAVES, lane = lane_id();
    const int first = it_lo + gw; if (first >= it_hi) return;
    const int n = (it_hi - first + NGW - 1) / NGW;
    f32x4 r0[16], r1[16]; XItem x0, x1;
    x0 = expert_item(F, first); xi_load(x0, r0, lane);
    x1 = expert_item(F, first + (1 < n ? 1 : 0) * NGW); if (1 < n) xi_load(x1, r1, lane);
#pragma unroll 1
    for (int q = 0; q < n; q += 2) {
        xi_finish(x0, r0, scr, lane); if (q + 2 < n) { x0 = expert_item(F, first + (q + 2) * NGW); xi_load(x0, r0, lane); }
        if (q + 1 < n) { xi_finish(x1, r1, scr, lane); if (q + 3 < n) { x1 = expert_item(F, first + (q + 3) * NGW); xi_load(x1, r1, lane); } }
    }
}
DI void p0_prologue(Frame& F) {
    LAS float* scr = (LAS float*)(F.lds + F.wave * 16640);
    const int gw = F.vcu * NWAVES + F.wave, NGW = F.G * NWAVES, lane = F.lane;
    unsigned char* ws = F.ws;
    constexpr int I_IN = 16 * 40, I_OUT = 16 * 16, I_RT = 16 * 4, I_G = 32;
    constexpr int NITEMS = I_IN + I_OUT + I_RT + I_G;
    for (int it = gw; it < NITEMS; it += NGW) {
        int r = it;
        if (r < I_IN) { const int kb = r / 40, nb = r % 40; tr_item(F.in[2] + (size_t)kb * 64 * INW + nb * 64, INW, (bf16*)(ws + WS_WINT) + (size_t)nb * 64 * D + kb * 64, D, scr, lane); continue; } r -= I_IN;
        if (r < I_OUT) { const int kb = r / 16, nb = r % 16; tr_item(F.in[12] + (size_t)kb * 64 * D + nb * 64, D, (bf16*)(ws + WS_WOUTT) + (size_t)nb * 64 * D + kb * 64, D, scr, lane); continue; } r -= I_OUT;
        if (r < I_RT) { const int kb = r / 4, nb = r % 4; tr_item(F.in[15] + (size_t)kb * 64 * NE + nb * 64, NE, (bf16*)(ws + WS_RTT) + (size_t)nb * 64 * D + kb * 64, D, scr, lane); continue; } r -= I_RT;
        {
            const int gate = r >> 4, dir = (r >> 3) & 1, n = r & 7;
            tr_item(F.in[gate ? 8 : 6] + (size_t)(dir * 8 + n) * 4096, 64, (bf16*)(ws + WS_GWT) + (size_t)((dir * 2 + gate) * 8 + n) * 4096, 64, scr, lane); }
    }
    { const f32x4* x4 = (const f32x4*)F.in[0]; u32x4* o = (u32x4*)(ws + WS_XB);
      const size_t NCHK = (size_t)T * D / 8, STR = (size_t)NGW * 64;
      for (size_t i = (size_t)gw * 64 + lane; i < NCHK; i += 4 * STR) {
          f32x4 a[4], b[4];
#pragma unroll
          for (int q = 0; q < 4; ++q) { const size_t ii = (i + q * STR < NCHK) ? i + q * STR : i; a[q] = __builtin_nontemporal_load((const GAS f32x4*)x4 + 2 * ii); b[q] = __builtin_nontemporal_load((const GAS f32x4*)x4 + 2 * ii + 1); }
#pragma unroll
          for (int q = 0; q < 4; ++q) if (i + q * STR < NCHK) { u32x4 w; w.x = pk2(a[q].x, a[q].y); w.y = pk2(a[q].z, a[q].w); w.z = pk2(b[q].x, b[q].y); w.w = pk2(b[q].z, b[q].w); o[i + q * STR] = w; } } }
    { const int* pos = (const int*)F.in[1]; float* rt = (float*)(ws + WS_ROPE);
      for (int i = gw * 64 + lane; i < T * 8; i += NGW * 64) { const int t = i >> 3, f = i & 7;
          float inv = 1.0f;
          inv = f == 1 ? 0x1.8d275ep-3f : inv; inv = f == 2 ? 0x1.341190p-5f : inv; inv = f == 3 ? 0x1.ddee9cp-8f : inv; inv = f == 4 ? 0x1.72ba44p-10f : inv;
          inv = f == 5 ? 0x1.1f91f0p-12f : inv; inv = f == 6 ? 0x1.be218ap-15f : inv; inv = f == 7 ? 0x1.5a0f50p-17f : inv;
          float c, s; sincos_acc((float)pos[t] * inv, c, s); rt[t * 16 + f] = c; rt[t * 16 + 8 + f] = s; } }
    { const float* lam = F.in[10]; float* c2 = (float*)(ws + WS_C2);
      for (int i = gw * 64 + lane; i < 2 * RW; i += NGW * 64) { const float l = lam[i]; const float sp = (-l > 20.f) ? -l : log1pf(expf(-l)); c2[i] = -8.0f * sp * LOG2E; } }
}

struct SchedDense {
    const bf16* A; const bf16* Bt; int lda, ldb, nM, nN, G, c, i0, i1;
    DI bool next(int ii, pg8::Unit& u) const { const int i = ii + i0; if (i >= i1) return false; int wgid; if (!pg8::xcd_order(i, G, c, nM * nN, wgid)) return false;
        const int nig = 8 * nN, gid = wgid / nig, fm = gid * 8, gsz = (nM - fm) < 8 ? (nM - fm) : 8; u.pm = fm + ((wgid % nig) % gsz); u.pn = (wgid % nig) / gsz; u.li = i; u.ex = 0; return true; }
    DI const char* a_base(const pg8::Unit& u) const { return (const char*)A + (size_t)u.pm * 256 * lda * 2; }
    DI unsigned a_voff(const pg8::Unit&, int R, int C) const { return (unsigned)(R * lda + C) * 2u; }
    DI const char* b_base(const pg8::Unit& u) const { return (const char*)Bt + (size_t)u.pn * 256 * ldb * 2; }
};
struct SchedRouter {
    const bf16* A; const bf16* Bt; int lda, ldb, nM, G, c;
    DI bool next(int i, pg8::Unit& u) const { int wgid; if (!pg8::xcd_order(i, G, c, nM * 2, wgid)) return false; u.pm = wgid >> 1; u.pn = wgid & 1; u.li = i; u.ex = 0; return true; }
    DI const char* a_base(const pg8::Unit& u) const { return (const char*)A + ((size_t)u.pm * 256 * lda + u.pn * 512) * 2; }
    DI unsigned a_voff(const pg8::Unit&, int R, int C) const { return (unsigned)(R * lda + C) * 2u; }
    DI const char* b_base(const pg8::Unit& u) const { return (const char*)Bt + (size_t)u.pn * 512 * 2; }
};
struct SchedG1 {
    const bf16* X; const bf16* W; const LAS unsigned* ue; const LAS unsigned* idx; int ldb, nwg, G, c; size_t bh1;
    DI bool next(int i, pg8::Unit& u) const { int wgid; if (!pg8::xcd_order(i, G, c, nwg, wgid)) return false; u.pm = wgid >> 1; u.pn = wgid & 1; u.li = i; u.ex = (int)ue[i]; return true; }
    DI const char* a_base(const pg8::Unit&) const { return (const char*)X; }
    DI unsigned a_voff(const pg8::Unit& u, int R, int C) const { return idx[u.li * 256 + R] * 2048u + (unsigned)C * 2u; }
    DI const char* b_base(const pg8::Unit& u) const { return (const char*)W + ((size_t)u.ex * 512 + u.pn * 256) * D * 2; }
};
struct SchedG2 {
    const bf16* Hh; const bf16* W; const LAS unsigned* ue; int ldb, nwg, G, c, tile0; size_t bh1;
    DI bool next(int i, pg8::Unit& u) const { int wgid; if (!pg8::xcd_order(i, G, c, nwg, wgid)) return false; u.pm = tile0 + (wgid >> 2); u.pn = wgid & 3; u.li = i; u.ex = (int)ue[i]; return true; }
    DI const char* a_base(const pg8::Unit& u) const { return (const char*)Hh + (size_t)u.pm * 256 * EH * 2; }
    DI unsigned a_voff(const pg8::Unit&, int R, int C) const { return (unsigned)(R * EH + C) * 2u; }
    DI const char* b_base(const pg8::Unit& u) const { return (const char*)W + ((size_t)u.ex * D + u.pn * 256) * EH * 2; }
};

struct EpiInProj {
    static constexpr bool PERM = true; struct Ctx {}; DI Ctx pre(const pg8::Unit&, int, int) const { return Ctx{}; }
    bf16* Q; const float* rope;
    DI void operator()(const f32x4 (&acc)[2][2][4][2], const pg8::Unit& u, const Ctx& cx, int wr, int wc, int fr, int fq) const {
        const int seg = u.pn >> 1;
        bf16* base = Q + (size_t)seg * (SEG_BYTES / 2);
        const int row0 = u.pm * 256 + wr * 64 + fr, col0 = (u.pn & 1) * 256 + wc * 32 + 8 * fq;
        const bool rot = (seg < 2) && ((wc & 1) == 0);
        const float sgn = (fq == 0) ? -1.f : 1.f;
#pragma unroll
        for (int ai = 0; ai < 2; ++ai)
#pragma unroll
            for (int m = 0; m < 4; ++m) {
                const int row = row0 + ai * 128 + m * 16;
                f32x4 c0 = {1.f, 1.f, 1.f, 1.f}, c1 = c0, s0 = {0.f, 0.f, 0.f, 0.f}, s1 = s0;
                if (rot) { const f32x4* rp = (const f32x4*)(rope + (size_t)row * 16); c0 = rp[0]; c1 = rp[1]; s0 = rp[2]; s1 = rp[3]; }
#pragma unroll
                for (int bj = 0; bj < 2; ++bj) {
                    f32x4 v0 = acc[ai][bj][m][0], v1 = acc[ai][bj][m][1];
                    if (rot) {
                        f32x4 p0, p1;
#pragma unroll
                        for (int j = 0; j < 4; ++j) { p0[j] = __shfl_xor(v0[j], 16); p1[j] = __shfl_xor(v1[j], 16); }
                        if (fq < 2) { v0 = v0 * c0 + (p0 * s0) * sgn; v1 = v1 * c1 + (p1 * s1) * sgn; }
                    }
                    if (seg == 0) { v0 = v0 * QSCALE; v1 = v1 * QSCALE; }
                    if (seg == 4) {
#pragma unroll
                        for (int j = 0; j < 4; ++j) { v0[j] = gelu_tanh(v0[j]); v1[j] = gelu_tanh(v1[j]); } }
                    u32x4 w; w.x = pg8::cvt_pk_bf16(v0[0], v0[1]); w.y = pg8::cvt_pk_bf16(v0[2], v0[3]); w.z = pg8::cvt_pk_bf16(v1[0], v1[1]); w.w = pg8::cvt_pk_bf16(v1[2], v1[3]);
                    *(u32x4*)(base + (size_t)row * 512 + col0 + bj * 128) = w;
                }
            }
    }
};
struct EpiYb {
    static constexpr bool PERM = true; struct Ctx {}; DI Ctx pre(const pg8::Unit&, int, int) const { return Ctx{}; }
    bf16* Yb;
    DI void operator()(const f32x4 (&acc)[2][2][4][2], const pg8::Unit& u, const Ctx& cx, int wr, int wc, int fr, int fq) const {
        const int row0 = u.pm * 256 + wr * 64 + fr, col0 = u.pn * 256 + wc * 32 + 8 * fq;
#pragma unroll
        for (int ai = 0; ai < 2; ++ai)
#pragma unroll
            for (int m = 0; m < 4; ++m) { const size_t ro = (size_t)(row0 + ai * 128 + m * 16) * D + col0;
#pragma unroll
                for (int bj = 0; bj < 2; ++bj) { const f32x4 v0 = acc[ai][bj][m][0], v1 = acc[ai][bj][m][1];
                    u32x4 o; o.x = pg8::cvt_pk_bf16(v0[0], v0[1]); o.y = pg8::cvt_pk_bf16(v0[2], v0[3]); o.z = pg8::cvt_pk_bf16(v1[0], v1[1]); o.w = pg8::cvt_pk_bf16(v1[2], v1[3]);
                    *(u32x4*)(Yb + ro + bj * 128) = o; } }
    }
};
struct EpiLogits {
    static constexpr bool PERM = false; struct Ctx {}; DI Ctx pre(const pg8::Unit&, int, int) const { return Ctx{}; }
    float* L;
    DI void operator()(const f32x4 (&acc)[2][2][4][2], const pg8::Unit& u, const Ctx& cx, int wr, int wc, int fr, int fq) const {
        float* base = L + (size_t)u.pn * T * NE; const int row0 = u.pm * 256 + wr * 64 + fr, col0 = wc * 32 + 4 * fq;
#pragma unroll
        for (int ai = 0; ai < 2; ++ai)
#pragma unroll
            for (int m = 0; m < 4; ++m) { const size_t ro = (size_t)(row0 + ai * 128 + m * 16) * NE + col0;
#pragma unroll
                for (int bj = 0; bj < 2; ++bj)
#pragma unroll
                    for (int n = 0; n < 2; ++n) *(f32x4*)(base + ro + bj * 128 + n * 16) = acc[ai][bj][m][n]; }
    }
};
struct EpiSwiglu {
    static constexpr bool PERM = true;
    struct Ctx { float w[2][4]; };
    bf16* Hh; const LAS float* wtab; int NT;
    DI Ctx pre(const pg8::Unit& u, int wr, int fr) const { Ctx c;
#pragma unroll
        for (int ai = 0; ai < 2; ++ai)
#pragma unroll
            for (int m = 0; m < 4; ++m) c.w[ai][m] = wtab[u.li * 256 + wr * 64 + fr + ai * 128 + m * 16];
        return c; }
    DI void operator()(const f32x4 (&acc)[2][2][4][2], const pg8::Unit& u, const Ctx& cx, int wr, int wc, int fr, int fq) const {
        const int row0 = u.pm * 256 + wr * 64 + fr, col0 = u.pn * 128 + wc * 32 + 8 * fq;
#pragma unroll
        for (int ai = 0; ai < 2; ++ai)
#pragma unroll
            for (int m = 0; m < 4; ++m) {
                float h[8]; const float w = cx.w[ai][m];
#pragma unroll
                for (int n = 0; n < 2; ++n)
#pragma unroll
                    for (int j = 0; j < 4; ++j) { const float g = acc[ai][0][m][n][j], uu = acc[ai][1][m][n][j]; h[4 * n + j] = g * frcp(1.f + fexp2(-LOG2E * g)) * (uu * w); }
                u32x4 o; o.x = pg8::cvt_pk_bf16(h[0], h[1]); o.y = pg8::cvt_pk_bf16(h[2], h[3]); o.z = pg8::cvt_pk_bf16(h[4], h[5]); o.w = pg8::cvt_pk_bf16(h[6], h[7]);
                *(u32x4*)(Hh + (size_t)(row0 + ai * 128 + m * 16) * EH + col0) = o;
            }
    }
};
constexpr float YSCALE = 16.0f;
DI unsigned pk_fp8x4(float a, float b, float c, float d) {
    a = __builtin_amdgcn_fmed3f(a * YSCALE, -448.f, 448.f); b = __builtin_amdgcn_fmed3f(b * YSCALE, -448.f, 448.f); c = __builtin_amdgcn_fmed3f(c * YSCALE, -448.f, 448.f); d = __builtin_amdgcn_fmed3f(d * YSCALE, -448.f, 448.f);
    int w = __builtin_amdgcn_cvt_pk_fp8_f32(a, b, 0, false); w = __builtin_amdgcn_cvt_pk_fp8_f32(c, d, w, true); return (unsigned)w; }
struct EpiDownY {
    static constexpr bool PERM = true; struct Ctx {}; DI Ctx pre(const pg8::Unit&, int, int) const { return Ctx{}; }
    unsigned char* Y; bool dry;
    DI void operator()(const f32x4 (&acc)[2][2][4][2], const pg8::Unit& u, const Ctx& cx, int wr, int wc, int fr, int fq) const {
        const int rl0 = wr * 64 + fr, boff = ((u.pn * 4 + wc) * 4 + fq) * 16;
#pragma unroll
        for (int ai = 0; ai < 2; ++ai)
#pragma unroll
            for (int m = 0; m < 4; ++m) { const size_t slot = (size_t)u.pm * 256 + rl0 + ai * 128 + m * 16;
                u32x4 o;
                o.x = pk_fp8x4(acc[ai][0][m][0][0], acc[ai][0][m][0][1], acc[ai][0][m][0][2], acc[ai][0][m][0][3]); o.y = pk_fp8x4(acc[ai][0][m][1][0], acc[ai][0][m][1][1], acc[ai][0][m][1][2], acc[ai][0][m][1][3]);
                o.z = pk_fp8x4(acc[ai][1][m][0][0], acc[ai][1][m][0][1], acc[ai][1][m][0][2], acc[ai][1][m][0][3]); o.w = pk_fp8x4(acc[ai][1][m][1][0], acc[ai][1][m][1][1], acc[ai][1][m][1][2], acc[ai][1][m][1][3]);
                if (!dry) *(u32x4*)(Y + slot * 1024 + boff) = o; }
    }
};

struct ScanP { const bf16* RX; const bf16* GWT; const float* cw; const float* cb; const float* gab; const float* gxb; const float* c2; f32x2* carry; bf16* HF; bf16* HB; };
constexpr int UT_PITCH = 144;
constexpr int SC_RAW = 4608;
DI void load_raw(const bf16* RX, int tt0, int n, u32x4 (&rw)[5], int lane) {
    const int s0 = tt0 & (SEQ - 1);
#pragma unroll
    for (int i = 0; i < 5; ++i) { const int p = i * 64 + lane, row = p >> 3, ch = p & 7; const int ss = s0 + row - 2;
        u32x4 v = {0u, 0u, 0u, 0u};
        if (p < 288 && ss >= 0 && ss < SEQ) v = *(const GAS u32x4*)(RX + (size_t)(tt0 + row - 2) * RW + 64 * n + 8 * ch);
        rw[i] = v; }
}
DI void build_u_tile(const u32x4 (&rw)[5], float w0, float w1, float w2, float w3, float cbv, LAS unsigned char* ut, int lane) {
    LAS unsigned char* raw = ut + SC_RAW;
#pragma unroll
    for (int i = 0; i < 5; ++i) { const int p = i * 64 + lane; if (p < 288) *(LAS u32x4*)(raw + p * 16) = rw[i]; }
    float xm2 = bf2f(*(const LAS unsigned short*)(raw + 0 * 128 + lane * 2)), xm1 = bf2f(*(const LAS unsigned short*)(raw + 1 * 128 + lane * 2)), x0 = bf2f(*(const LAS unsigned short*)(raw + 2 * 128 + lane * 2));
#pragma unroll
    for (int tok = 0; tok < 32; ++tok) {
        const float x1 = bf2f(*(const LAS unsigned short*)(raw + (tok + 3) * 128 + lane * 2));
        const float uu = cbv + w0 * xm2 + w1 * xm1 + w2 * x0 + w3 * x1;
        *(LAS unsigned short*)(ut + tok * UT_PITCH + lane * 2) = (unsigned short)pg8::cvt_pk_bf16(uu, uu);
        xm2 = xm1; xm1 = x0; x0 = x1;
    }
}
DI void gate_ct(const LAS unsigned char* ut, const bf16x8 (&af)[4], const bf16x8 (&wA)[4], const bf16x8 (&wX)[4], float ba, float bx, float c2v, int ct, f32x16& a, f32x16& b, int lane) {
    const int col = lane & 31, hi = lane >> 5;
    f32x16 pa, px;
#pragma unroll
    for (int i = 0; i < 16; ++i) { pa[i] = 0.f; px[i] = 0.f; }
#pragma unroll
    for (int ks = 0; ks < 4; ++ks) { pa = MFMA32(af[ks], wA[ks], pa); px = MFMA32(af[ks], wX[ks], px); }
#pragma unroll
    for (int r = 0; r < 16; ++r) {
        const float uu = bf2f(*(const LAS unsigned short*)(ut + crow(r, hi) * UT_PITCH + (32 * ct + col) * 2));
        const float rr = frcp(1.f + fexp2(-LOG2E * (pa[r] + ba)));
        const float ii = frcp(1.f + fexp2(-LOG2E * (px[r] + bx)));
        const float av = fexp2(rr * c2v);
        a[r] = av; b[r] = __builtin_amdgcn_sqrtf(fmaxf(1.f - av * av, 0.f)) * ii * uu;
    }
}
template <int DIR, bool PASS2>
DI void scan_tile(const f32x16& a, const f32x16& b, LAS unsigned char* ocol, float& h, float& Ac, float& Bc, int hi) {
    float Ag[4], Bg[4];
#pragma unroll
    for (int g = 0; g < 4; ++g) {
        if (DIR == 0) { float B = b[4 * g]; B = a[4 * g + 1] * B + b[4 * g + 1]; B = a[4 * g + 2] * B + b[4 * g + 2]; B = a[4 * g + 3] * B + b[4 * g + 3]; Bg[g] = B; }
        else          { float B = b[4 * g + 3]; B = a[4 * g + 2] * B + b[4 * g + 2]; B = a[4 * g + 1] * B + b[4 * g + 1]; B = a[4 * g] * B + b[4 * g]; Bg[g] = B; }
        Ag[g] = (a[4 * g] * a[4 * g + 1]) * (a[4 * g + 2] * a[4 * g + 3]);
    }
    float AE[4], BE[4], AO[4], BO[4];
#pragma unroll
    for (int g = 0; g < 4; ++g) { const float pA = __shfl_xor(Ag[g], 32), pB = __shfl_xor(Bg[g], 32);
        AE[g] = hi ? pA : Ag[g]; BE[g] = hi ? pB : Bg[g]; AO[g] = hi ? Ag[g] : pA; BO[g] = hi ? Bg[g] : pB; }
    float hin[4];
    if (DIR == 0) {
#pragma unroll
        for (int g = 0; g < 4; ++g) { const float hE = h; h = AE[g] * h + BE[g]; const float hO = h; h = AO[g] * h + BO[g]; hin[g] = hi ? hO : hE;
            if (!PASS2) { Bc = AE[g] * Bc + BE[g]; Ac *= AE[g]; Bc = AO[g] * Bc + BO[g]; Ac *= AO[g]; } }
    } else {
#pragma unroll
        for (int g = 3; g >= 0; --g) { const float hO = h; h = AO[g] * h + BO[g]; const float hE = h; h = AE[g] * h + BE[g]; hin[g] = hi ? hO : hE;
            if (!PASS2) { Bc = AO[g] * Bc + BO[g]; Ac *= AO[g]; Bc = AE[g] * Bc + BE[g]; Ac *= AE[g]; } }
    }
    if (PASS2) {
#pragma unroll
        for (int g = 0; g < 4; ++g) { float hh = hin[g];
            if (DIR == 0) {
#pragma unroll
                for (int q = 0; q < 4; ++q) { hh = a[4 * g + q] * hh + b[4 * g + q]; *(LAS unsigned short*)(ocol + crow(4 * g + q, hi) * 128) = (unsigned short)pg8::cvt_pk_bf16(hh, hh); }
            } else {
#pragma unroll
                for (int q = 3; q >= 0; --q) { hh = a[4 * g + q] * hh + b[4 * g + q]; *(LAS unsigned short*)(ocol + crow(4 * g + q, hi) * 128) = (unsigned short)pg8::cvt_pk_bf16(hh, hh); }
            } }
    }
}
template <int DIR, bool PASS2>
DI void scan_sweep(const ScanP& P, int b, int n, int j, LAS unsigned char* ut, int lane) {
    const int col = lane & 31, hi = lane >> 5;
    bf16x8 wA[2][4], wX[2][4]; float ba[2], bx[2], c2v[2];
#pragma unroll
    for (int ct = 0; ct < 2; ++ct) {
#pragma unroll
        for (int ks = 0; ks < 4; ++ks) {
            wA[ct][ks] = *(const GAS bf16x8*)(P.GWT + ((size_t)((DIR * 2 + 0) * 8 + n) * 64 + 32 * ct + col) * 64 + 16 * ks + 8 * hi);
            wX[ct][ks] = *(const GAS bf16x8*)(P.GWT + ((size_t)((DIR * 2 + 1) * 8 + n) * 64 + 32 * ct + col) * 64 + 16 * ks + 8 * hi); }
        const int c = DIR * RW + 64 * n + 32 * ct + col; ba[ct] = P.gab[c]; bx[ct] = P.gxb[c]; c2v[ct] = P.c2[c];
    }
    const float w0 = P.cw[0 * RW + 64 * n + lane], w1 = P.cw[1 * RW + 64 * n + lane], w2 = P.cw[2 * RW + 64 * n + lane], w3 = P.cw[3 * RW + 64 * n + lane], cbv = P.cb[64 * n + lane];
    const int t0 = b * SEQ + j * LCH;
    u32x4 rw[5];
    load_raw(P.RX, t0 + 32 * (DIR == 0 ? 0 : (LCH / 32 - 1)), n, rw, lane);
    float h[2] = {0.f, 0.f}, Ac[2] = {1.f, 1.f}, Bc[2] = {0.f, 0.f};
    if (PASS2) {
        const f32x2* cr = P.carry + ((size_t)(b * 2 + DIR) * NCH) * RW + 64 * n + col;
        const int cnt = DIR == 0 ? j : (NCH - 1 - j);
        f32x2 ab[16][2];
#define SC_LD(dst, q0) do { _Pragma("unroll") for (int q = 0; q < 16; ++q) { const int qq_ = ((q0) + q < cnt) ? ((q0) + q) : (cnt > 0 ? cnt - 1 : 0); const int jj_ = DIR == 0 ? qq_ : (NCH - 1 - qq_); \
            _Pragma("unroll") for (int ct = 0; ct < 2; ++ct) dst[q][ct] = cr[(size_t)jj_ * RW + 32 * ct]; } } while (0)
        for (int q0 = 0; q0 < cnt; q0 += 16) {
            SC_LD(ab, q0);
#pragma unroll
            for (int q = 0; q < 16; ++q) if (q0 + q < cnt) {
#pragma unroll
                for (int ct = 0; ct < 2; ++ct) h[ct] = ab[q][ct].x * h[ct] + ab[q][ct].y; }
        }
#undef SC_LD
    }
#pragma unroll 1
    for (int tq = 0; tq < LCH / 32; ++tq) {
        const int ti = DIR == 0 ? tq : (LCH / 32 - 1 - tq);
        const int tt0 = t0 + 32 * ti;
        if (PASS2 && tq > 0) load_raw(P.RX, tt0, n, rw, lane);
        build_u_tile(rw, w0, w1, w2, w3, cbv, ut, lane);
        if (!PASS2 && tq + 1 < LCH / 32) load_raw(P.RX, t0 + 32 * (DIR == 0 ? tq + 1 : (LCH / 32 - 2 - tq)), n, rw, lane);
        bf16x8 af[4];
#pragma unroll
        for (int ks = 0; ks < 4; ++ks) af[ks] = *(const LAS bf16x8*)(ut + col * UT_PITCH + (16 * ks + 8 * hi) * 2);
        LAS unsigned char* ot = ut + SC_RAW;
#pragma unroll
        for (int ct = 0; ct < 2; ++ct) {
            f32x16 a, bb;
            gate_ct(ut, af, wA[ct], wX[ct], ba[ct], bx[ct], c2v[ct], ct, a, bb, lane);
            scan_tile<DIR, PASS2>(a, bb, ot + (32 * ct + col) * 2, h[ct], Ac[ct], Bc[ct], hi);
            __builtin_amdgcn_sched_barrier(0);
        }
        if (PASS2) {
            bf16* dst = (DIR == 0 ? P.HF : P.HB) + (size_t)tt0 * RW + 64 * n;
#pragma unroll
            for (int i = 0; i < 4; ++i) { const int p = i * 64 + lane, row = p >> 3, ch = p & 7; *(GAS u32x4*)(dst + (size_t)row * RW + 8 * ch) = *(const LAS u32x4*)(ot + p * 16); }
        }
    }
    if (!PASS2 && hi == 0) {
#pragma unroll
        for (int ct = 0; ct < 2; ++ct) P.carry[((size_t)(b * 2 + DIR) * NCH + j) * RW + 64 * n + 32 * ct + col] = (f32x2){Ac[ct], Bc[ct]};
    }
}
template <bool PASS2>
DI void scan_phase(Frame& F, const ScanP& P, int it_lo, int it_hi);
constexpr int AT_OACC = 0, AT_ML = 65536, AT_V = 69632;
DI s16x4 vtr(const LAS unsigned char* p) { typedef short v4i16_t __attribute__((ext_vector_type(4))); return __builtin_bit_cast(s16x4, __builtin_amdgcn_ds_read_tr16_b64_v4i16((LAS v4i16_t*)p)); }
DI void attn_tile(const bf16* Qp, const bf16* Kp, const bf16* Vp, int tb, int h, int rho, int dl, int nq0, int L, LAS unsigned char* vt, int lane, f32x16 (&o)[2], float& m_out, float& l_out) {
    const int qi = lane & 31, hi = lane >> 5;
    LAS unsigned char* kt_lds = vt + 32768;
    const int kt_lo = (nq0 >= 64) ? 0 : (2 - (nq0 >> 5)), kt_hi = ((L - nq0) >> 5) + 2 < 5 ? ((L - nq0) >> 5) + 2 : 5;
    bf16x8 qf[4]; u32x4 kr[5][4], vv[5][4];
    const size_t hoff = (size_t)h * HD;
    const bf16* qp = Qp + (size_t)(tb + rho + dl * (nq0 + qi)) * AW + hoff + 8 * hi;
#pragma unroll
    for (int ks = 0; ks < 4; ++ks) qf[ks] = *(const GAS bf16x8*)(qp + 16 * ks);
    const size_t kstep = (size_t)dl * 32 * AW;
    const size_t rowoff = (size_t)(tb + rho + dl * (nq0 - 64 + (lane >> 3))) * AW + hoff + 8 * (lane & 7);
    const bf16* kp0 = Kp + rowoff; const bf16* vp0 = Vp + rowoff;
    const size_t vrow8 = (size_t)dl * 8 * AW;
#define ATT_CL(kt) ((kt) < kt_lo ? kt_lo : ((kt) >= kt_hi ? kt_hi - 1 : (kt)))
#define ATT_LOADK(kt) do { const size_t ko_ = (size_t)ATT_CL(kt) * kstep; _Pragma("unroll") for (int i = 0; i < 4; ++i) kr[kt][i] = *(const GAS u32x4*)(kp0 + ko_ + i * vrow8); } while (0)
#define ATT_LOADV(kt) do { const size_t vo_ = (size_t)ATT_CL(kt) * kstep; _Pragma("unroll") for (int i = 0; i < 4; ++i) vv[kt][i] = *(const GAS u32x4*)(vp0 + vo_ + i * vrow8); } while (0)
    ATT_LOADK(0); ATT_LOADK(1); ATT_LOADK(2); ATT_LOADK(3); ATT_LOADK(4);
    ATT_LOADV(0); ATT_LOADV(1);
    f32x16 z;
#pragma unroll
    for (int i = 0; i < 16; ++i) z[i] = 0.f;
    o[0] = z; o[1] = z;
    float m = -1e30f, l = 0.f;
    const int q4 = (lane & 15) >> 2, p4 = lane & 3, blk = (lane >> 4) & 1;
    const LAS unsigned char* vrd = vt + (4 * hi + q4) * 128 + (16 * blk + 4 * p4) * 2;
    const int kwr = (lane >> 3) * 128 + (((lane & 7) ^ ((lane >> 3) & 7)) << 4);
    const LAS unsigned char* krd = kt_lds + qi * 128;
#pragma unroll
    for (int kt = 0; kt < 5; ++kt) {
        if (kt + 2 < 5) ATT_LOADV(kt + 2);
        if (kt >= kt_lo && kt < kt_hi) {
#pragma unroll
            for (int i = 0; i < 4; ++i) *(LAS u32x4*)(kt_lds + i * 1024 + kwr) = kr[kt][i];
            f32x16 s = z;
#pragma unroll
            for (int ks = 0; ks < 4; ++ks) { const bf16x8 kf = *(const LAS bf16x8*)(krd + (((2 * ks + hi) ^ (qi & 7)) << 4)); s = MFMA32(kf, qf[ks], s); }
#pragma unroll
            for (int i = 0; i < 4; ++i) { const int piece = i * 64 + lane; *(LAS u32x4*)(vt + piece * 16) = vv[kt][i]; }
            if (kt == 0) {
#pragma unroll
                for (int r = 0; r < 16; ++r) if (crow(r, hi) < qi) s[r] = -1e30f;
            }
            if (kt == 4) {
#pragma unroll
                for (int r = 0; r < 16; ++r) if (crow(r, hi) > qi) s[r] = -1e30f;
            }
            float tm = s[0];
#pragma unroll
            for (int r = 1; r < 16; ++r) tm = fmaxf(tm, s[r]);
            { const auto sw_ = __builtin_amdgcn_permlane32_swap(__float_as_uint(tm), __float_as_uint(tm), false, false); tm = fmaxf(__uint_as_float(sw_[0]), __uint_as_float(sw_[1])); }
            const float mn = fmaxf(m, tm), al = fexp2(m - mn);
            float ps = 0.f;
#pragma unroll
            for (int r = 0; r < 16; ++r) { s[r] = fexp2(s[r] - mn); ps += s[r]; }
            l = l * al + ps; m = mn;
#pragma unroll
            for (int r = 0; r < 16; ++r) { o[0][r] *= al; o[1][r] *= al; }
            bf16x8 pk[2];
#pragma unroll
            for (int sx = 0; sx < 2; ++sx) { u32x4 w; w.x = pg8::cvt_pk_bf16(s[8 * sx + 0], s[8 * sx + 1]); w.y = pg8::cvt_pk_bf16(s[8 * sx + 2], s[8 * sx + 3]);
                w.z = pg8::cvt_pk_bf16(s[8 * sx + 4], s[8 * sx + 5]); w.w = pg8::cvt_pk_bf16(s[8 * sx + 6], s[8 * sx + 7]); pk[sx] = __builtin_bit_cast(bf16x8, w); }
#pragma unroll
            for (int sx = 0; sx < 2; ++sx)
#pragma unroll
                for (int dh = 0; dh < 2; ++dh) {
                    const s16x4 lo = vtr(vrd + (16 * sx) * 128 + 64 * dh), hi4 = vtr(vrd + (16 * sx + 8) * 128 + 64 * dh);
                    const bf16x8 vf = __builtin_shufflevector(lo, hi4, 0, 1, 2, 3, 4, 5, 6, 7);
                    o[dh] = MFMA32(vf, pk[sx], o[dh]);
                }
        }
    }
#undef ATT_LOADK
#undef ATT_LOADV
#undef ATT_CL
    m_out = m; l_out = l + __shfl_xor(l, 32);
}
struct AttnP { const bf16* Q; const bf16* K; const bf16* V; bf16* O; };
DI void attn_phase(Frame& F, const AttnP& P) {
    LAS unsigned char* lds = F.lds;
    LAS unsigned char* vt = lds + AT_V + F.wave * 4096;
    const int lane = F.lane, qi = lane & 31, hi = lane >> 5;
    for (int unit = F.vcu; unit < NB * NH * (SEQ / 512); unit += F.G) {
        const int sp = unit & 15, h = (unit >> 4) & 7, b = unit >> 7;
        const int tb = b * SEQ, P0 = 512 * sp;
#pragma unroll 1
        for (int g = 0; g < 3; ++g) {
            const int dl = g == 0 ? 1 : (g == 1 ? 4 : 16), L = SEQ / dl;
#pragma unroll 1
            for (int xx = 0; xx < 2; ++xx) {
                const int x = F.wave + 8 * xx;
                int rho, nq0, qp0, qst;
                if (g == 0) { rho = 0; nq0 = P0 + 32 * x; qp0 = 32 * x; qst = 1; }
                else if (g == 1) { rho = x & 3; nq0 = P0 / 4 + 32 * (x >> 2); qp0 = rho + 128 * (x >> 2); qst = 4; }
                else { rho = x; nq0 = P0 / 16; qp0 = rho; qst = 16; }
                f32x16 o[2]; float m, l;
                attn_tile(P.Q, P.K, P.V, tb, h, rho, dl, nq0, L, vt, lane, o, m, l);
                const int qpos = qp0 + qst * qi;
                LAS unsigned char* orow = lds + AT_OACC + qpos * 128 + 8 * hi;
                LAS f32x2* ml = (LAS f32x2*)(lds + AT_ML) + qpos;
                float w2 = frcp(l), w1 = 0.f;
                if (g > 0) { const f32x2 old = *ml; const float mN = fmaxf(old.x, m); const float a1 = old.y * fexp2(old.x - mN), a2 = fexp2(m - mN); const float lN = a1 + l * a2, rl = frcp(lN);
                    w1 = a1 * rl; w2 = a2 * rl; m = mN; l = lN; }
#pragma unroll
                for (int dh = 0; dh < 2; ++dh)
#pragma unroll
                    for (int gq = 0; gq < 4; ++gq) {
                        LAS u32x2* p = (LAS u32x2*)(orow + (32 * dh + 8 * gq) * 2);
                        float v0 = o[dh][4 * gq] * w2, v1 = o[dh][4 * gq + 1] * w2, v2 = o[dh][4 * gq + 2] * w2, v3 = o[dh][4 * gq + 3] * w2;
                        if (g > 0) { const u32x2 ow = *p; v0 += bflo(ow.x) * w1; v1 += bfhi(ow.x) * w1; v2 += bflo(ow.y) * w1; v3 += bfhi(ow.y) * w1; }
                        u32x2 nw; nw.x = pg8::cvt_pk_bf16(v0, v1); nw.y = pg8::cvt_pk_bf16(v2, v3); *p = nw;
                    }
                if (hi == 0) *ml = (f32x2){m, l};
            }
            __syncthreads();
        }
#pragma unroll
        for (int i = 0; i < 8; ++i) { const int c = i * 512 + F.tid, q = c >> 3, ch = c & 7;
            *(GAS u32x4*)(P.O + (size_t)(tb + P0 + q) * AW + h * HD + 8 * ch) = *(const LAS u32x4*)(lds + AT_OACC + q * 128 + ch * 16); }
        __syncthreads();
    }
}

struct MixG { f32x4 ga0, ga1, gr0, gr1; };
DI MixG mix_gains(Frame& F) { const int lane = lane_id(); return MixG{*(const f32x4*)(F.in[3] + 8 * lane), *(const f32x4*)(F.in[3] + 8 * lane + 4), *(const f32x4*)(F.in[11] + 8 * lane), *(const f32x4*)(F.in[11] + 8 * lane + 4)}; }
DI void mix_pair(Frame& F, const MixG& g, int tA, int tB) {
    const bf16* AT = (const bf16*)(F.ws + WS_ATTN); const bf16* HFp = (const bf16*)(F.ws + WS_HF); const bf16* HBp = (const bf16*)(F.ws + WS_REC); const bf16* Gp = (const bf16*)(F.ws + WS_Q + 4 * SEG_BYTES);
    bf16* MX = (bf16*)(F.ws + WS_MIX); const int lane = lane_id();
    u32x4 a[2], hf[2], hb[2], gg[2];
#pragma unroll
    for (int u = 0; u < 2; ++u) { const size_t o = (size_t)(u ? tB : tA) * 512 + 8 * lane;
        a[u] = *(const GAS u32x4*)(AT + o); hf[u] = *(const GAS u32x4*)(HFp + o); hb[u] = *(const GAS u32x4*)(HBp + o); gg[u] = *(const GAS u32x4*)(Gp + o); }
#pragma unroll
    for (int u = 0; u < 2; ++u) {
        const int t = u ? tB : tA;
        float av[8] = {bflo(a[u].x), bfhi(a[u].x), bflo(a[u].y), bfhi(a[u].y), bflo(a[u].z), bfhi(a[u].z), bflo(a[u].w), bfhi(a[u].w)};
        float rv[8] = {(bflo(hf[u].x) + bflo(hb[u].x)) * bflo(gg[u].x), (bfhi(hf[u].x) + bfhi(hb[u].x)) * bfhi(gg[u].x), (bflo(hf[u].y) + bflo(hb[u].y)) * bflo(gg[u].y), (bfhi(hf[u].y) + bfhi(hb[u].y)) * bfhi(gg[u].y),
                       (bflo(hf[u].z) + bflo(hb[u].z)) * bflo(gg[u].z), (bfhi(hf[u].z) + bfhi(hb[u].z)) * bfhi(gg[u].z), (bflo(hf[u].w) + bflo(hb[u].w)) * bflo(gg[u].w), (bfhi(hf[u].w) + bfhi(hb[u].w)) * bfhi(gg[u].w)};
        float sa = 0.f, sr = 0.f;
#pragma unroll
        for (int i = 0; i < 8; ++i) { sa += av[i] * av[i]; sr += rv[i] * rv[i]; }
        sa = wave_sum(sa); sr = wave_sum(sr);
        const float ra = 1.0f / sqrtf(sa * (1.f / 512.f) + LN_EPS), rr = 1.0f / sqrtf(sr * (1.f / 512.f) + LN_EPS);
        u32x4 oa, orr;
        oa.x = pk2(av[0] * ra * g.ga0.x, av[1] * ra * g.ga0.y); oa.y = pk2(av[2] * ra * g.ga0.z, av[3] * ra * g.ga0.w); oa.z = pk2(av[4] * ra * g.ga1.x, av[5] * ra * g.ga1.y); oa.w = pk2(av[6] * ra * g.ga1.z, av[7] * ra * g.ga1.w);
        orr.x = pk2(rv[0] * rr * g.gr0.x, rv[1] * rr * g.gr0.y); orr.y = pk2(rv[2] * rr * g.gr0.z, rv[3] * rr * g.gr0.w); orr.z = pk2(rv[4] * rr * g.gr1.x, rv[5] * rr * g.gr1.y); orr.w = pk2(rv[6] * rr * g.gr1.z, rv[7] * rr * g.gr1.w);
        *(GAS u32x4*)(MX + (size_t)t * D + 8 * lane) = oa; *(GAS u32x4*)(MX + (size_t)t * D + AW + 8 * lane) = orr;
    }
}
DI void mix_phase(Frame& F) {
    const int gw = F.vcu * NWAVES + F.wave, NGW = F.G * NWAVES; const MixG g = mix_gains(F);
    for (int t0 = gw; t0 < T; t0 += 2 * NGW) mix_pair(F, g, t0, t0 + NGW);
}
template <bool PASS2>
DI void scan_phase(Frame& F, const ScanP& P, int it_lo, int it_hi) {
    LAS unsigned char* ut = F.lds + F.wave * 16640;
    LAS float* scr = (LAS float*)(F.lds + F.wave * 16640);
    const int gw = F.vcu * NWAVES + F.wave, NGW = F.G * NWAVES;
    const bool conv_first = F.wave < 4;
    const bool wg_units = PASS2 && (F.G * NWAVES == NB * 8 * NCH);
    if (conv_first) convert_items(F, it_lo, it_hi, scr);
    for (int u = gw; u < NB * 8 * NCH; u += NGW) {
        int j = u % NCH, n = (u / NCH) & 7, b = u / (NCH * 8);
        if (wg_units) { b = F.vcu / NCH; j = F.vcu % NCH; n = F.wave; }
        scan_sweep<0, PASS2>(P, b, n, j, ut, F.lane);
        scan_sweep<1, PASS2>(P, b, n, j, ut, F.lane);
    }
    if (!conv_first) convert_items(F, it_lo, it_hi, scr);
    if (wg_units) {
        VM_WAIT(); __syncthreads();
        const MixG g = mix_gains(F); const int t0 = (F.vcu / NCH) * SEQ + (F.vcu % NCH) * LCH + F.wave * 16;
#pragma unroll 1
        for (int i = 0; i < 16; i += 2) mix_pair(F, g, t0 + i, t0 + i + 1);
    }
}

DI void ln1_phase(Frame& F) {
    const bf16* Yb = (const bf16*)(F.ws + WS_V1); const float* X = F.in[0]; bf16* X1B = (bf16*)(F.ws + WS_X1B);
    const int gw = F.vcu * NWAVES + F.wave, NGW = F.G * NWAVES, lane = F.lane;
    f32x4 gg[4], bb[4];
#pragma unroll
    for (int j = 0; j < 4; ++j) { gg[j] = *(const f32x4*)(F.in[13] + 4 * lane + 256 * j); bb[j] = *(const f32x4*)(F.in[14] + 4 * lane + 256 * j); }
    for (int t0 = gw; t0 < T; t0 += 2 * NGW) {
        f32x4 v[2][4]; u32x2 yv[2][4];
#pragma unroll
        for (int u = 0; u < 2; ++u) { const GAS f32x4* xr = (const GAS f32x4*)(X + (size_t)(t0 + u * NGW) * D) + lane; const GAS u32x2* yr = (const GAS u32x2*)(Yb + (size_t)(t0 + u * NGW) * D) + lane;
#pragma unroll
            for (int j = 0; j < 4; ++j) { v[u][j] = xr[64 * j]; yv[u][j] = yr[64 * j]; } }
#pragma unroll
        for (int u = 0; u < 2; ++u) {
            const int t = t0 + u * NGW; float s = 0.f;
#pragma unroll
            for (int j = 0; j < 4; ++j) { v[u][j] = v[u][j] * ALPHA + (f32x4){bflo(yv[u][j].x), bfhi(yv[u][j].x), bflo(yv[u][j].y), bfhi(yv[u][j].y)}; s += (v[u][j].x + v[u][j].y) + (v[u][j].z + v[u][j].w); }
            const float mean = wave_sum(s) * (1.f / D); float s2 = 0.f;
#pragma unroll
            for (int j = 0; j < 4; ++j) { v[u][j] = v[u][j] - mean; s2 += (v[u][j].x * v[u][j].x + v[u][j].y * v[u][j].y) + (v[u][j].z * v[u][j].z + v[u][j].w * v[u][j].w); }
            const float rstd = 1.f / sqrtf(wave_sum(s2) * (1.f / D) + LN_EPS);
            GAS u32x2* o2 = (GAS u32x2*)(X1B + (size_t)t * D) + lane;
#pragma unroll
            for (int j = 0; j < 4; ++j) { const f32x4 y = v[u][j] * rstd * gg[j] + bb[j]; u32x2 w; w.x = pk2(y.x, y.y); w.y = pk2(y.z, y.w); o2[64 * j] = w; }
        }
    }
}
template <bool DRY>
DI void route_phase(Frame& F, int it_lo, int it_hi) {
    LAS float* cscr = (LAS float*)(F.lds + 8192 + F.wave * 16640);
    if (!DRY && F.wave < 4) convert_items(F, it_lo, it_hi, cscr);
    const bool opaque = DRY && (__hip_atomic_load((unsigned*)(F.ctl + CW_TMO), RLX_AGENT) == 0xdeadbeefu);
    const float* LG = (const float*)(F.ws + WS_LOGITS); const float* rbias = F.in[16];
    unsigned* ER = (unsigned*)(F.ws + WS_ER); float* GW = (float*)(F.ws + WS_GW); int* slot_tok = (int*)(F.ws + WS_SLOTTOK);
    LAS unsigned* hist = (LAS unsigned*)(F.lds); LAS unsigned* base = hist + 256; LAS unsigned* erl = hist + 512;
    const int lane = F.lane, tid = F.tid;
    if (!DRY) for (int i = F.vcu * 512 + tid; i < MAXSLOTS; i += F.G * 512) slot_tok[i] = 0;
    if (tid < 256) hist[tid] = 0u;
    __syncthreads();
    const int TPW = T / F.G;
    const f32x4 bi = ((const f32x4*)rbias)[lane];
    const float NEGINF = -__builtin_huge_valf();
    f32x4 nl0, nl1;
    { const int t = F.vcu * TPW + F.wave; nl0 = ((const GAS f32x4*)(LG + (size_t)t * NE))[lane]; nl1 = ((const GAS f32x4*)(LG + (size_t)T * NE + (size_t)t * NE))[lane]; }
    for (int i = F.wave; i < TPW; i += NWAVES) {
        const int t = F.vcu * TPW + i;
        const f32x4 lg = nl0 + nl1;
        { const int tn = F.vcu * TPW + ((i + NWAVES < TPW) ? i + NWAVES : i); nl0 = ((const GAS f32x4*)(LG + (size_t)tn * NE))[lane]; nl1 = ((const GAS f32x4*)(LG + (size_t)T * NE + (size_t)tn * NE))[lane]; }
        const float s0 = 1.f / (1.f + expf(-lg.x)), s1 = 1.f / (1.f + expf(-lg.y)), s2 = 1.f / (1.f + expf(-lg.z)), s3 = 1.f / (1.f + expf(-lg.w));
        float v0 = s0 + bi.x, v1 = s1 + bi.y, v2 = s2 + bi.z, v3 = s3 + bi.w;
        const float hi1 = fmaxf(v0, v1), lo1 = fminf(v0, v1), hi2 = fmaxf(v2, v3), lo2 = fminf(v2, v3);
        float m1 = fmaxf(hi1, hi2), m2 = fmaxf(fminf(hi1, hi2), fmaxf(lo1, lo2));
#pragma unroll
        for (int o = 1; o < 8; o <<= 1) { const float o1 = __shfl_xor(m1, o), o2 = __shfl_xor(m2, o); const float n1 = fmaxf(m1, o1), n2 = fmaxf(fminf(m1, o1), fmaxf(m2, o2)); m1 = n1; m2 = n2; }
        const float gs = m1 + m2; const int myg = lane >> 3; int rank = 0;
#pragma unroll
        for (int j = 0; j < 8; ++j) { const float gj = __shfl(gs, 8 * j); rank += (gj > gs || (gj == gs && j < myg)) ? 1 : 0; }
        if (rank >= 4) { v0 = NEGINF; v1 = NEGINF; v2 = NEGINF; v3 = NEGINF; }
        int me = 0; float mg = 0.f, gsum = 0.f;
#pragma unroll
        for (int k = 0; k < 8; ++k) {
            const float lm = fmaxf(fmaxf(v0, v1), fmaxf(v2, v3)), wm = wave_max_fast(lm);
            int cand = 1 << 20;
            if (v3 == wm) cand = 4 * lane + 3;
            if (v2 == wm) cand = 4 * lane + 2;
            if (v1 == wm) cand = 4 * lane + 1;
            if (v0 == wm) cand = 4 * lane + 0;
            const int e = wave_min_i_fast(cand), el = e >> 2, ei = e & 3;
            const float mysc = ei == 0 ? s0 : (ei == 1 ? s1 : (ei == 2 ? s2 : s3));
            const float sc = __shfl(mysc, el);
            if (lane == el) { if (ei == 0) v0 = NEGINF; else if (ei == 1) v1 = NEGINF; else if (ei == 2) v2 = NEGINF; else v3 = NEGINF; }
            me = (lane == k) ? e : me; mg = (lane == k) ? sc : mg; gsum += sc;
        }
        if (lane < 8) { const unsigned lr = __hip_atomic_fetch_add(hist + me, 1u, __ATOMIC_RELAXED, __HIP_MEMORY_SCOPE_WORKGROUP); erl[i * 8 + lane] = ((unsigned)me << 24) | lr; if (!DRY || opaque) GW[(size_t)t * 8 + lane] = mg / gsum * 2.5f; }
    }
    __syncthreads();
    if (tid < 256) base[tid] = DRY ? 0u : atomicAdd((unsigned*)(F.ctl + CW_CNT) + tid, hist[tid]);
    __syncthreads();
    if (!DRY) for (int i = tid; i < TPW * 8; i += 512) { const unsigned er = erl[i]; ER[(size_t)F.vcu * TPW * 8 + i] = er + base[er >> 24]; }
    __syncthreads();
    if (!DRY && F.wave >= 4) convert_items(F, it_lo, it_hi, cscr);
}
DI void slot_phase(Frame& F) {
    const unsigned* ER = (const unsigned*)(F.ws + WS_ER); const float* GW = (const float*)(F.ws + WS_GW);
    unsigned* TS = (unsigned*)(F.ws + WS_TS); int* slot_tok = (int*)(F.ws + WS_SLOTTOK); float* slot_w = (float*)(F.ws + WS_SLOTW); int* tile_e = (int*)(F.ws + WS_TILEE);
    LAS int* tb = (LAS int*)(F.lds); LAS int* tmp = tb + 512;
    const int tid = F.tid;
    int nt_e = 0;
    if (tid < 256) { nt_e = ((int)__hip_atomic_load((unsigned*)(F.ctl + CW_CNT) + tid, RLX_AGENT) + 255) >> 8; tmp[tid] = nt_e; }
    __syncthreads();
    int src = 0;
    for (int o = 1; o < 256; o <<= 1) { if (tid < 256) { int v = tmp[src * 256 + tid]; if (tid >= o) v += tmp[src * 256 + tid - o]; tmp[(src ^ 1) * 256 + tid] = v; } src ^= 1; __syncthreads(); }
    if (tid < 256) tb[tid] = tmp[src * 256 + tid] - nt_e;
    const int NT = tmp[src * 256 + 255];
    __syncthreads();
    if (F.vcu == 0) {
        if (tid == 0) __hip_atomic_store((unsigned*)(F.ctl + CW_NT), (unsigned)NT, RLX_AGENT);
        if (tid < 256) for (int tl = tb[tid]; tl < tb[tid] + nt_e; ++tl) tile_e[tl] = tid;
        for (int i = tid; i < NSHT; i += 512) tile_e[NT + i] = NE;
    }
    for (int i = F.vcu * 512 + tid; i < T; i += F.G * 512) { slot_tok[(size_t)NT * 256 + i] = i; }
    const int TPW = T / F.G;
    for (int i = tid; i < TPW * 8; i += 512) {
        const size_t gi = (size_t)F.vcu * TPW * 8 + i; const unsigned er = ER[gi]; const int e = er >> 24, rk = er & 0xffffff;
        const int slot = tb[e] * 256 + rk;
        slot_tok[slot] = (int)(gi >> 3); slot_w[slot] = GW[gi]; TS[gi] = (unsigned)slot;
    }
}
DI void acc_fp8x4(unsigned w, f32x4& v) { const f32x2 a = __builtin_amdgcn_cvt_pk_f32_fp8((int)w, false), b = __builtin_amdgcn_cvt_pk_f32_fp8((int)w, true); v.x += a.x; v.y += a.y; v.z += b.x; v.w += b.y; }
template <bool STORE>
DI void final_phase(Frame& F) {
    const bool opaque = !STORE && (__hip_atomic_load((unsigned*)(F.ctl + CW_TMO), RLX_AGENT) == 0xdeadbeefu);
    const unsigned char* Y = (const unsigned char*)(F.ws + WS_Y); const unsigned* TS = (const unsigned*)(F.ws + WS_TS); const bf16* X1B = (const bf16*)(F.ws + WS_X1B);
    const size_t shslot0 = (size_t)__hip_atomic_load((unsigned*)(F.ctl + CW_NT), RLX_AGENT) * 256;
    const int gw = F.vcu * NWAVES + F.wave, NGW = F.G * NWAVES, lane = F.lane;
    const int cb = 256 * (lane >> 4) + 32 * ((lane >> 2) & 3) + 8 * (lane & 3);
    f32x4 gg[4], bb[4];
#pragma unroll
    for (int bj = 0; bj < 2; ++bj)
#pragma unroll
        for (int hh = 0; hh < 2; ++hh) { gg[2 * bj + hh] = *(const f32x4*)(F.in[23] + cb + 128 * bj + 4 * hh); bb[2 * bj + hh] = *(const f32x4*)(F.in[24] + cb + 128 * bj + 4 * hh); }
    for (int t0 = gw; t0 < T; t0 += 8 * NGW) {
        const int ti = lane >> 3; const int tt = t0 + ti * NGW;
        const unsigned myslot = (tt < T) ? TS[(size_t)tt * 8 + (lane & 7)] : 0u;
#pragma unroll 1
        for (int i = 0; i < 8; ++i) {
            const int t = t0 + i * NGW; if (t >= T) break;
            float* xr = F.out + (size_t)t * D + cb;
            f32x4 v[4];
#pragma unroll
            for (int bj = 0; bj < 2; ++bj) { const u32x4 w = *(const GAS u32x4*)(X1B + (size_t)t * D + cb + 128 * bj);
                v[2 * bj] = (f32x4){bflo(w.x), bfhi(w.x), bflo(w.y), bfhi(w.y)} * ALPHA; v[2 * bj + 1] = (f32x4){bflo(w.z), bfhi(w.z), bflo(w.w), bfhi(w.w)} * ALPHA; }
            u32x4 yv[8]; const u32x4 ysh = ((const GAS u32x4*)(Y + (shslot0 + (size_t)t) * 1024))[lane];
#pragma unroll
            for (int k = 0; k < 8; ++k) { const unsigned slot = __shfl(myslot, i * 8 + k); yv[k] = ((const GAS u32x4*)(Y + (size_t)slot * 1024))[lane]; }
            f32x4 a[4];
#pragma unroll
            for (int j = 0; j < 4; ++j) a[j] = (f32x4){0.f, 0.f, 0.f, 0.f};
#pragma unroll
            for (int k = 0; k < 8; ++k) { acc_fp8x4(yv[k].x, a[0]); acc_fp8x4(yv[k].y, a[1]); acc_fp8x4(yv[k].z, a[2]); acc_fp8x4(yv[k].w, a[3]); }
            acc_fp8x4(ysh.x, a[0]); acc_fp8x4(ysh.y, a[1]); acc_fp8x4(ysh.z, a[2]); acc_fp8x4(ysh.w, a[3]);
#pragma unroll
            for (int j = 0; j < 4; ++j) v[j] = v[j] + a[j] * (1.0f / YSCALE);
            float s = 0.f;
#pragma unroll
            for (int j = 0; j < 4; ++j) s += (v[j].x + v[j].y) + (v[j].z + v[j].w);
            const float mean = wave_sum(s) * (1.f / D); float s2 = 0.f;
#pragma unroll
            for (int j = 0; j < 4; ++j) { v[j] = v[j] - mean; s2 += (v[j].x * v[j].x + v[j].y * v[j].y) + (v[j].z * v[j].z + v[j].w * v[j].w); }
            const float rstd = 1.f / sqrtf(wave_sum(s2) * (1.f / D) + LN_EPS);
            if (STORE || opaque) {
#pragma unroll
                for (int bj = 0; bj < 2; ++bj) { *(GAS f32x4*)(xr + 128 * bj) = v[2 * bj] * rstd * gg[2 * bj] + bb[2 * bj]; *(GAS f32x4*)(xr + 128 * bj + 4) = v[2 * bj + 1] * rstd * gg[2 * bj + 1] + bb[2 * bj + 1]; } }
        }
    }
}

#ifndef REPMASK
#define REPMASK 0
#endif
constexpr int N_PHASES = 13;
constexpr int XC_P1 = (XI_ALL * 37 / 100) & ~2047, XC_P2 = (XI_ALL * 57 / 100) & ~2047, XC_P3 = (XI_ALL * 87 / 100) & ~2047;
struct Args { const float* in[25]; float* out; unsigned char* ws; int ph_lo, ph_hi, li, pad; };
DI void ph1_part(Frame& F, int i0, int i1) {
    unsigned char* ws = F.ws;
    SchedDense S{(const bf16*)(ws + WS_XB), (const bf16*)(ws + WS_WINT), D, D, T / 256, INW / 256, F.G, (int)blockIdx.x, i0, i1};
    EpiInProj E{(bf16*)(ws + WS_Q), (const float*)(ws + WS_ROPE)};
    pg8::gemm_phase<EpiInProj, SchedDense, true>(F.lds + RING_OFF, S, E, D);
}
DI void ph1(Frame& F) {
    LAS float* scr = (LAS float*)(F.lds + F.wave * 16640);
    const int grp = F.vcu % 3;
    if (grp == 0) { convert_items(F, 0, XC_P1, scr); __syncthreads(); }
    ph1_part(F, 0, 2);
    if (grp == 1) { __syncthreads(); convert_items(F, 0, XC_P1, scr); __syncthreads(); }
    ph1_part(F, 2, 1 << 20);
    if (grp == 2) { __syncthreads(); convert_items(F, 0, XC_P1, scr); }
}
DI ScanP mk_scanp(Frame& F) { unsigned char* ws = F.ws;
    return ScanP{(const bf16*)(ws + WS_Q + 3 * SEG_BYTES), (const bf16*)(ws + WS_GWT), F.in[4], F.in[5], F.in[7], F.in[9],
                 (const float*)(ws + WS_C2), (f32x2*)(ws + WS_CARRY), (bf16*)(ws + WS_HF), (bf16*)(ws + WS_REC)}; }
DI void ph2(Frame& F) {
    unsigned char* ws = F.ws;
    const ScanP SP = mk_scanp(F);
    scan_phase<false>(F, SP, XC_P1, XC_P2);
    if constexpr ((REPMASK >> 14) & 1) { __syncthreads(); scan_phase<false>(F, SP, 0, 0); }
    __syncthreads();
    const AttnP AP{(const bf16*)(ws + WS_Q), (const bf16*)(ws + WS_Q + SEG_BYTES), (const bf16*)(ws + WS_Q + 2 * SEG_BYTES), (bf16*)(ws + WS_ATTN)};
    attn_phase(F, AP);
    if constexpr ((REPMASK >> 13) & 1) { attn_phase(F, AP); }
}
DI void ph3(Frame& F) { const ScanP SP = mk_scanp(F); scan_phase<true>(F, SP, XC_P2, XC_P3); }
DI void ph5(Frame& F) {
    unsigned char* ws = F.ws;
    SchedDense S{(const bf16*)(ws + WS_MIX), (const bf16*)(ws + WS_WOUTT), D, D, T / 256, D / 256, F.G, (int)blockIdx.x, 0, 1 << 20};
    EpiYb E{(bf16*)(ws + WS_V1)};
    pg8::gemm_phase<EpiYb, SchedDense, true>(F.lds + RING_OFF, S, E, D);
}
DI void ph7(Frame& F) {
    unsigned char* ws = F.ws;
    SchedRouter S{(const bf16*)(ws + WS_X1B), (const bf16*)(ws + WS_RTT), D, D, T / 256, F.G, (int)blockIdx.x};
    EpiLogits E{(float*)(ws + WS_LOGITS)};
    pg8::gemm_phase<EpiLogits, SchedRouter, true>(F.lds + RING_OFF, S, E, 512);
}
DI void ph10(Frame& F) {
    unsigned char* ws = F.ws; const int cid = (int)blockIdx.x;
    LAS unsigned* ue = (LAS unsigned*)(F.lds + UT_OFF); LAS unsigned* uidx = (LAS unsigned*)(F.lds + UT_IDX);
    const int NT = (int)__hip_atomic_load((unsigned*)(F.ctl + CW_NT), RLX_AGENT);
    const int nwg = 2 * (NT + NSHT);
    const int* tile_e = (const int*)(ws + WS_TILEE); const int* slot_tok = (const int*)(ws + WS_SLOTTOK);
    __syncthreads();
    {
        unsigned te[11], st[11]; float sw[11]; const float* slot_w = (const float*)(ws + WS_SLOTW); LAS float* uw = (LAS float*)(F.lds + UT_W);
#pragma unroll
        for (int i = 0; i < 11; ++i) { int wgid; const bool ok = pg8::xcd_order(i, F.G, cid, nwg, wgid); const int tile = ok ? (wgid >> 1) : 0;
            te[i] = (unsigned)tile_e[tile]; st[i] = (F.tid < 256) ? (unsigned)slot_tok[(size_t)tile * 256 + F.tid] : 0u; sw[i] = (F.tid < 256 && tile < NT) ? slot_w[(size_t)tile * 256 + F.tid] : 1.0f; }
#pragma unroll
        for (int i = 0; i < 11; ++i) { if (F.tid == 0) ue[i] = te[i]; if (F.tid < 256) { uidx[i * 256 + F.tid] = st[i]; uw[i * 256 + F.tid] = sw[i]; } }
    }
    __syncthreads();
    SchedG1 S{(const bf16*)(ws + WS_X1B), (const bf16*)(ws + WS_WGUT), ue, uidx, D, nwg, F.G, cid, (size_t)0};
    EpiSwiglu E{(bf16*)(ws + WS_H), (const LAS float*)(F.lds + UT_W), NT};
    pg8::gemm_phase<EpiSwiglu, SchedG1, true, false>(F.lds + RING_OFF, S, E, D);
}
template <bool DRY>
DI void ph11a(Frame& F) {
    unsigned char* ws = F.ws; const int cid = (int)blockIdx.x;
    LAS unsigned* ue = (LAS unsigned*)(F.lds + UT_OFF);
    const int NT = (int)__hip_atomic_load((unsigned*)(F.ctl + CW_NT), RLX_AGENT);
    const int* tile_e = (const int*)(ws + WS_TILEE);
    const int nwg = 4 * (NT + NSHT);
    __syncthreads();
    for (int i = F.tid; i < 22; i += NWAVES * 64) { int wgid; if (pg8::xcd_order(i, F.G, cid, nwg, wgid)) ue[i] = (unsigned)tile_e[wgid >> 2]; }
    __syncthreads();
    SchedG2 S{(const bf16*)(ws + WS_H), (const bf16*)(ws + WS_WDT), ue, EH, nwg, F.G, cid, 0, (size_t)0};
    EpiDownY E{(unsigned char*)(ws + WS_Y), DRY && (__hip_atomic_load((unsigned*)(F.ctl + CW_TMO), RLX_AGENT) != 0xdeadbeefu)};
    pg8::gemm_phase<EpiDownY, SchedG2, true, false>(F.lds + RING_OFF, S, E, EH);
}
#ifndef PHMASK
#define PHMASK 0x1fff
#endif
#ifndef REPMASK
#define REPMASK 0
#endif
__global__ void __launch_bounds__(NWAVES * 64, 2) mk_fwd(Args args) {
    extern __shared__ __attribute__((aligned(16))) unsigned char lds_raw[];
    Frame F;
    F.lds = (LAS unsigned char*)lds_raw;
    F.MISC = (volatile LAS unsigned*)(F.lds + MISC_OFF);
    F.tid = threadIdx.x; F.lane = F.tid & 63; F.wave = __builtin_amdgcn_readfirstlane(F.tid >> 6);
    F.G = gridDim.x; { const int bx = blockIdx.x; F.vcu = (F.G % 8 == 0) ? (bx % 8) * (F.G / 8) + bx / 8 : bx; }
    F.ws = args.ws; F.out = args.out; F.ctl = (gu32*)(args.ws + WS_CTL);
#pragma unroll
    for (int i = 0; i < 25; ++i) F.in[i] = args.in[i];
    if (F.tid < 64) F.MISC[F.tid] = 0u;
    __syncthreads();
    XcdBarrier bar = xcd_barrier_post((unsigned*)(F.ctl + CW_BAR) + args.li * XCD_BAR_WORDS, F.MISC + 8);
    const int lo = args.ph_lo, hi = args.ph_hi;
#ifdef REPORT_K
    unsigned long long* tsb = (unsigned long long*)(args.ws + WS_END + 8 * MiB); int nst = 0;
#define STAMP() do { if (blockIdx.x == 0 && F.tid == 0) tsb[nst] = __builtin_amdgcn_s_memrealtime(); ++nst; } while (0)
#else
#define STAMP() do {} while (0)
#endif
    STAMP();
#define IN(k) (((PHMASK >> (k)) & 1) && lo <= (k) && (k) < hi)
#define REP(k) if constexpr (((REPMASK) >> (k)) & 1)
#define SEAM(k) do { if (IN(k) && IN((k) + 1)) xcd_barrier(bar); STAMP(); } while (0)
    if (IN(0)) { p0_prologue(F); REP(0) { __syncthreads(); p0_prologue(F); } } SEAM(0);
    if (IN(1)) { ph1(F); REP(1) ph1(F); } SEAM(1);
    if (IN(2)) { ph2(F); REP(2) ph2(F); } SEAM(2);
    if (IN(3)) { ph3(F); REP(3) ph3(F); } SEAM(3);
    const bool fused_mix = (F.G * NWAVES == NB * 8 * NCH);
    if (IN(4) && !fused_mix) { mix_phase(F); } if (!fused_mix) SEAM(4);
    if (IN(5)) { ph5(F); REP(5) ph5(F); } SEAM(5);
    if (IN(6)) { ln1_phase(F); REP(6) ln1_phase(F); } SEAM(6);
    if (IN(7)) { ph7(F); REP(7) ph7(F); } SEAM(7);
    if (IN(8)) { REP(8) { route_phase<true>(F, 0, 0); } route_phase<false>(F, XC_P3, XI_ALL); } SEAM(8);
    if (IN(9)) { slot_phase(F); REP(9) { __syncthreads(); slot_phase(F); } } SEAM(9);
    if (IN(10)) { ph10(F); REP(10) ph10(F); } SEAM(10);
    if (IN(11)) { REP(11) ph11a<true>(F); ph11a<false>(F); } SEAM(11);
    if (IN(12)) { REP(12) { final_phase<false>(F); } final_phase<true>(F); }
    STAMP();
#undef IN
#undef REP
#undef SEAM
}

#if defined(SELFCHECK) && SELFCHECK
namespace chk {
constexpr int NS = 64;
struct InP { const float* p[25]; };
__host__ __device__ inline int samp_tok(int i) { return i == 0 ? 0 : i == 1 ? 8191 : i == 2 ? 8192 : i == 3 ? T - 1 : i == 4 ? 63 : i == 5 ? 64 : i == 6 ? 8127 : i == 7 ? 16384 + 4095 : (int)(((long)i * 2039 + 17 * (i % 5)) % T); }
DI void put_err(unsigned* CHK, int stage, float num, float den) { float e = sqrtf(num / (den + 1e-30f)); if (!(e == e)) e = 1e30f; atomicMax(CHK + stage, __float_as_uint(e)); }
DI float blk_sum(float v, float* red) {
    v = wave_sum(v); __syncthreads(); if ((threadIdx.x & 63) == 0) red[threadIdx.x >> 6] = v; __syncthreads(); return red[0] + red[1] + red[2] + red[3]; }
__global__ void __launch_bounds__(256) c1(const float* x, const int* pos, const float* w_in, const unsigned char* ws, unsigned* CHK) {
    __shared__ float hrow[INW]; __shared__ float red[4];
    const int t = samp_tok(blockIdx.x), tid = threadIdx.x;
    for (int c = tid; c < INW; c += 256) { float a = 0.f; for (int k = 0; k < D; ++k) a = fmaf(x[(size_t)t * D + k], w_in[(size_t)k * INW + c], a); hrow[c] = a; }
    __syncthreads();
    if (tid < 128) { const int i = tid & 7, head = (tid >> 3) & 7, which = tid >> 6;
        const float invf[8] = {1.0f, 0x1.8d275ep-3f, 0x1.341190p-5f, 0x1.ddee9cp-8f, 0x1.72ba44p-10f, 0x1.1f91f0p-12f, 0x1.be218ap-15f, 0x1.5a0f50p-17f};
        float inv = invf[0];
#pragma unroll
        for (int j = 1; j < 8; ++j) inv = (i == j) ? invf[j] : inv;
        float c, s; sincos_acc((float)pos[t] * inv, c, s);
        float* p = hrow + which * AW + head * HD; const float t1 = p[i], t2 = p[i + 8]; p[i] = t1 * c - t2 * s; p[i + 8] = t2 * c + t1 * s; }
    __syncthreads();
    float num = 0.f, den = 0.f;
    for (int c = tid; c < INW; c += 256) { const int seg = c >> 9; float r = hrow[c]; if (seg == 0) r *= QSCALE; if (seg == 4) r = gelu_tanh(r);
        const float f = bf2f(((const bf16*)(ws + WS_Q + (size_t)seg * SEG_BYTES))[(size_t)t * 512 + (c & 511)]); num += (f - r) * (f - r); den += r * r; }
    num = blk_sum(num, red); den = blk_sum(den, red);
    if (tid == 0) put_err(CHK, 1, num, den);
}
__global__ void __launch_bounds__(64) c2(const unsigned char* ws, unsigned* CHK) {
    const bf16* Q = (const bf16*)(ws + WS_Q); const bf16* K = (const bf16*)(ws + WS_Q + SEG_BYTES); const bf16* V = (const bf16*)(ws + WS_Q + 2 * SEG_BYTES); const bf16* O = (const bf16*)(ws + WS_ATTN);
    const int lane = threadIdx.x, head = blockIdx.x & 7, t = samp_tok(blockIdx.x >> 3), b = t / SEQ, s = t % SEQ;
    const float q = bf2f(Q[(size_t)t * AW + head * HD + lane]);
    float m = -1e30f, den = 0.f, o = 0.f;
    for (int g = 0; g < 3; ++g) { const int d = g == 0 ? 1 : (g == 1 ? 4 : 16);
        for (int mm = -64; mm <= 64; ++mm) { const int j = s + d * mm; if (j < 0 || j >= SEQ) continue;
            const size_t row = (size_t)(b * SEQ + j) * AW + head * HD + lane;
            const float sc = wave_sum(q * bf2f(K[row])); const float mn = fmaxf(m, sc), al = exp2f(m - mn), p = exp2f(sc - mn);
            den = den * al + p; o = o * al + p * bf2f(V[row]); m = mn; } }
    const float r = o / den, f = bf2f(O[(size_t)t * AW + head * HD + lane]);
    const float num = wave_sum((f - r) * (f - r)), dn = wave_sum(r * r);
    if (lane == 0) put_err(CHK, 2, num, dn);
}
__global__ void __launch_bounds__(64) c3(InP ip, const unsigned char* ws, float* scratch, unsigned* CHK) {
    const float* cw = ip.p[4]; const float* cb = ip.p[5]; const float* gaw = ip.p[6]; const float* gab = ip.p[7]; const float* gxw = ip.p[8]; const float* gxb = ip.p[9]; const float* lam = ip.p[10];
    const bf16* RX = (const bf16*)(ws + WS_Q + 3 * SEG_BYTES); const bf16* G = (const bf16*)(ws + WS_Q + 4 * SEG_BYTES); const bf16* HFp = (const bf16*)(ws + WS_HF); const bf16* HBp = (const bf16*)(ws + WS_REC);
    const int lane = threadIdx.x, smp = blockIdx.x, b = smp & 3, c = (smp * 37 + 5) % RW, n = c >> 6, j = c & 63;
    float* sc = scratch + (size_t)smp * SEQ * 4;
    for (int s = lane; s < SEQ; s += 64) {
        float pa0 = 0.f, pa1 = 0.f, px0 = 0.f, px1 = 0.f, uc = 0.f;
        for (int i = 0; i < 64; ++i) { const int ci = 64 * n + i; float u = cb[ci];
            for (int k = 0; k < 4; ++k) { const int ss = s + k - 2; if (ss >= 0 && ss < SEQ) u = fmaf(cw[k * RW + ci], bf2f(RX[(size_t)(b * SEQ + ss) * RW + ci]), u); }
            if (i == j) uc = u;
            pa0 = fmaf(u, gaw[(((size_t)0 * 8 + n) * 64 + i) * 64 + j], pa0); px0 = fmaf(u, gxw[(((size_t)0 * 8 + n) * 64 + i) * 64 + j], px0);
            pa1 = fmaf(u, gaw[(((size_t)1 * 8 + n) * 64 + i) * 64 + j], pa1); px1 = fmaf(u, gxw[(((size_t)1 * 8 + n) * 64 + i) * 64 + j], px1); }
        { const float r = 1.f / (1.f + expf(-(pa0 + gab[c]))), ig = 1.f / (1.f + expf(-(px0 + gxb[c])));
          const float l = lam[c], sp = log1pf(expf(-l)), log_a = -8.0f * r * sp, a = expf(log_a);
          sc[(size_t)s * 4 + 0] = a; sc[(size_t)s * 4 + 1] = sqrtf(-expm1f(2.0f * log_a)) * ig * uc; }
        { const float r = 1.f / (1.f + expf(-(pa1 + gab[RW + c]))), ig = 1.f / (1.f + expf(-(px1 + gxb[RW + c])));
          const float l = lam[RW + c], sp = log1pf(expf(-l)), log_a = -8.0f * r * sp, a = expf(log_a);
          sc[(size_t)s * 4 + 2] = a; sc[(size_t)s * 4 + 3] = sqrtf(-expm1f(2.0f * log_a)) * ig * uc; }
    }
    __syncthreads();
    if (lane == 0) { float h = 0.f; for (int s = 0; s < SEQ; ++s) { h = fmaf(sc[(size_t)s * 4], h, sc[(size_t)s * 4 + 1]); sc[(size_t)s * 4 + 1] = h; } }
    if (lane == 1) { float h = 0.f; for (int s = SEQ - 1; s >= 0; --s) { h = fmaf(sc[(size_t)s * 4 + 2], h, sc[(size_t)s * 4 + 3]); sc[(size_t)s * 4 + 3] = h; } }
    __syncthreads();
    float num = 0.f, den = 0.f;
    for (int s = lane; s < SEQ; s += 64) { const size_t o = (size_t)(b * SEQ + s) * RW + c; const float r = (sc[(size_t)s * 4 + 1] + sc[(size_t)s * 4 + 3]) * bf2f(G[o]), f = (bf2f(HFp[o]) + bf2f(HBp[o])) * bf2f(G[o]); num += (f - r) * (f - r); den += r * r; }
    num = wave_sum(num); den = wave_sum(den);
    if (lane == 0) put_err(CHK, 3, num, den);
}
__global__ void __launch_bounds__(256) c4(const float* ga, const float* gr, const unsigned char* ws, unsigned* CHK) {
    __shared__ float red[4];
    const bf16* AT = (const bf16*)(ws + WS_ATTN); const bf16* HFp = (const bf16*)(ws + WS_HF); const bf16* HBp = (const bf16*)(ws + WS_REC); const bf16* Gp = (const bf16*)(ws + WS_Q + 4 * SEG_BYTES); const bf16* MX = (const bf16*)(ws + WS_MIX);
    const int t = samp_tok(blockIdx.x), tid = threadIdx.x;
    float av[2], rv[2], sa = 0.f, sr = 0.f;
    for (int i = 0; i < 2; ++i) { const int c = tid + 256 * i; av[i] = bf2f(AT[(size_t)t * AW + c]); rv[i] = (bf2f(HFp[(size_t)t * RW + c]) + bf2f(HBp[(size_t)t * RW + c])) * bf2f(Gp[(size_t)t * RW + c]); sa += av[i] * av[i]; sr += rv[i] * rv[i]; }
    sa = blk_sum(sa, red); sr = blk_sum(sr, red);
    const float ra = rsqrtf(sa / 512.f + LN_EPS), rr = rsqrtf(sr / 512.f + LN_EPS);
    float num = 0.f, den = 0.f;
    for (int i = 0; i < 2; ++i) { const int c = tid + 256 * i; const float r1 = av[i] * ra * ga[c], r2 = rv[i] * rr * gr[c], f1 = bf2f(MX[(size_t)t * D + c]), f2 = bf2f(MX[(size_t)t * D + AW + c]);
        num += (f1 - r1) * (f1 - r1) + (f2 - r2) * (f2 - r2); den += r1 * r1 + r2 * r2; }
    num = blk_sum(num, red); den = blk_sum(den, red);
    if (tid == 0) put_err(CHK, 4, num, den);
}
__global__ void __launch_bounds__(256) c5(const float* x, const float* w_out, const unsigned char* ws, unsigned* CHK) {
    __shared__ float red[4];
    const bf16* MX = (const bf16*)(ws + WS_MIX); const bf16* Yb = (const bf16*)(ws + WS_V1);
    const int t = samp_tok(blockIdx.x), tid = threadIdx.x; float num = 0.f, den = 0.f;
    for (int c = tid; c < D; c += 256) { float a = 0.f; for (int k = 0; k < D; ++k) a = fmaf(bf2f(MX[(size_t)t * D + k]), w_out[(size_t)k * D + c], a);
        const float r = a, f = bf2f(Yb[(size_t)t * D + c]); num += (f - r) * (f - r); den += r * r; }
    num = blk_sum(num, red); den = blk_sum(den, red);
    if (tid == 0) put_err(CHK, 5, num, den);
}
__global__ void __launch_bounds__(256) c6(const float* g, const float* bb, const float* x, const unsigned char* ws, unsigned* CHK) {
    __shared__ float red[4];
    const bf16* Yb = (const bf16*)(ws + WS_V1); const bf16* X1B = (const bf16*)(ws + WS_X1B);
    const int t = samp_tok(blockIdx.x), tid = threadIdx.x; float v[4], s = 0.f;
    for (int i = 0; i < 4; ++i) { v[i] = ALPHA * x[(size_t)t * D + tid + 256 * i] + bf2f(Yb[(size_t)t * D + tid + 256 * i]); s += v[i]; }
    const float mu = blk_sum(s, red) / D; float q = 0.f;
    for (int i = 0; i < 4; ++i) { const float d = v[i] - mu; q += d * d; }
    const float rs = rsqrtf(blk_sum(q, red) / D + LN_EPS); float num = 0.f, den = 0.f;
    for (int i = 0; i < 4; ++i) { const int c = tid + 256 * i; const float r = (v[i] - mu) * rs * g[c] + bb[c], f2 = bf2f(X1B[(size_t)t * D + c]);
        num += (f2 - r) * (f2 - r); den += r * r; }
    num = blk_sum(num, red); den = blk_sum(den, red);
    if (tid == 0) put_err(CHK, 6, num, den);
}
__global__ void __launch_bounds__(256) c7(const float* router_w, const unsigned char* ws, unsigned* CHK) {
    __shared__ float red[4];
    const bf16* X1B = (const bf16*)(ws + WS_X1B); const float* LG = (const float*)(ws + WS_LOGITS);
    const int t = samp_tok(blockIdx.x), c = threadIdx.x; float a = 0.f;
    for (int k = 0; k < D; ++k) a = fmaf(bf2f(X1B[(size_t)t * D + k]), router_w[(size_t)k * NE + c], a);
    const float f = LG[(size_t)t * NE + c] + LG[(size_t)T * NE + (size_t)t * NE + c];
    const float num = blk_sum((f - a) * (f - a), red), den = blk_sum(a * a, red);
    if (c == 0) put_err(CHK, 7, num, den);
}
__global__ void __launch_bounds__(64) c8(const float* rbias, const unsigned char* ws, const unsigned* ctl, unsigned* CHK) {
    __shared__ float sc[NE], bs[NE]; __shared__ int sel[8]; __shared__ float gate[8]; __shared__ float gsc[8]; __shared__ int gm[8];
    const float* LG = (const float*)(ws + WS_LOGITS); const unsigned* TS = (const unsigned*)(ws + WS_TS); const int* slot_tok = (const int*)(ws + WS_SLOTTOK);
    const float* slot_w = (const float*)(ws + WS_SLOTW); const int* tile_e = (const int*)(ws + WS_TILEE);
    const int t = samp_tok(blockIdx.x), lane = threadIdx.x;
    for (int e = lane; e < NE; e += 64) { const float l = LG[(size_t)t * NE + e] + LG[(size_t)T * NE + (size_t)t * NE + e]; sc[e] = 1.f / (1.f + expf(-l)); bs[e] = sc[e] + rbias[e]; }
    __syncthreads();
    if (lane == 0) {
        for (int g = 0; g < 8; ++g) { float a = -1e30f, b2 = -1e30f; for (int i = 0; i < 32; ++i) { const float v = bs[32 * g + i]; if (v > a) { b2 = a; a = v; } else if (v > b2) b2 = v; } gsc[g] = a + b2; gm[g] = 0; }
        for (int k = 0; k < 4; ++k) { int best = -1; for (int g = 0; g < 8; ++g) if (!gm[g] && (best < 0 || gsc[g] > gsc[best])) best = g; gm[best] = 1; }
        float sum = 0.f;
        for (int k = 0; k < 8; ++k) { int best = -1; for (int e = 0; e < NE; ++e) { if (!gm[e >> 5]) continue; bool used = false; for (int q = 0; q < k; ++q) used |= (sel[q] == e); if (used) continue; if (best < 0 || bs[e] > bs[best]) best = e; } sel[k] = best; sum += sc[best]; }
        for (int k = 0; k < 8; ++k) gate[k] = sc[sel[k]] / sum * 2.5f;
        int bad = 0; const int NT = (int)ctl[CW_NT];
        for (int k = 0; k < 8; ++k) { const unsigned slot = TS[(size_t)t * 8 + k]; const int e = tile_e[slot >> 8];
            if (slot >= (unsigned)NT * 256) { ++bad; continue; }
            if (slot_tok[slot] != t) ++bad;
            int q = -1; for (int k2 = 0; k2 < 8; ++k2) if (sel[k2] == e) q = k2;
            if (q < 0) ++bad; else if (fabsf(slot_w[slot] - gate[q]) > 1e-5f) ++bad; }
        atomicMax(CHK + 8, __float_as_uint((float)bad));
    }
}
DI void samp_slot(int i, const unsigned char* ws, const unsigned* ctl, int& slot, int& e, int& tok) {
    const unsigned* TS = (const unsigned*)(ws + WS_TS); const int* tile_e = (const int*)(ws + WS_TILEE); const int NT = (int)ctl[CW_NT];
    tok = samp_tok(i); if (i >= 32 && (i & 1)) { slot = NT * 256 + tok; e = NE; } else { slot = (int)TS[(size_t)tok * 8 + (i & 7)]; e = tile_e[slot >> 8]; } }
__global__ void __launch_bounds__(256) c9(InP ip, const unsigned char* ws, const unsigned* ctl, unsigned* CHK) {
    __shared__ float red[4];
    int slot, e, tok; samp_slot(blockIdx.x, ws, ctl, slot, e, tok);
    const float* wg = e < NE ? ip.p[17] + (size_t)e * D * EH : ip.p[20]; const float* wu = e < NE ? ip.p[18] + (size_t)e * D * EH : ip.p[21];
    const bf16* X1B = (const bf16*)(ws + WS_X1B); const bf16* Hh = (const bf16*)(ws + WS_H);
    const int c = threadIdx.x; float g = 0.f, u = 0.f;
    for (int k = 0; k < D; ++k) { const float xv = bf2f(X1B[(size_t)tok * D + k]); g = fmaf(xv, wg[(size_t)k * EH + c], g); u = fmaf(xv, wu[(size_t)k * EH + c], u); }
    const float wgt = e < NE ? ((const float*)(ws + WS_SLOTW))[slot] : 1.f; const float r = g / (1.f + expf(-g)) * u * wgt, f = bf2f(Hh[(size_t)slot * EH + c]);
    const float num = blk_sum((f - r) * (f - r), red), den = blk_sum(r * r, red);
    if (c == 0) put_err(CHK, 9, num, den);
}
DI float y_at(const unsigned char* Yb, size_t slot, int c) {
    const int pn = c >> 8, bj = (c >> 7) & 1, wc = (c >> 5) & 3, fq = (c >> 3) & 3, i = c & 7; const unsigned b = Yb[slot * 1024 + ((pn * 4 + wc) * 4 + fq) * 16 + bj * 8 + i];
    const int e = (b >> 3) & 15, m = b & 7; const float mag = e == 0 ? (float)m * 0.001953125f : (1.f + (float)m * 0.125f) * exp2f((float)(e - 7)); return ((b & 128) ? -mag : mag) * (1.0f / YSCALE); }
__global__ void __launch_bounds__(256) c10(InP ip, const unsigned char* ws, const unsigned* ctl, unsigned* CHK) {
    __shared__ float red[4];
    int slot, e, tok; samp_slot(blockIdx.x & 31, ws, ctl, slot, e, tok);
    const float* wd = ip.p[19] + (size_t)e * EH * D; const bf16* Hh = (const bf16*)(ws + WS_H); const unsigned char* Y = (const unsigned char*)(ws + WS_Y);
    float num = 0.f, den = 0.f;
    for (int c = threadIdx.x; c < D; c += 256) { float a = 0.f; for (int k = 0; k < EH; ++k) a = fmaf(bf2f(Hh[(size_t)slot * EH + k]), wd[(size_t)k * D + c], a);
        const float r = a, f = y_at(Y, (size_t)slot, c); num += (f - r) * (f - r); den += r * r; }
    num = blk_sum(num, red); den = blk_sum(den, red);
    if (threadIdx.x == 0) put_err(CHK, 10, num, den);
}
__global__ void __launch_bounds__(256) save_x1b(const unsigned char* ws, bf16* dst) { const bf16* X1B = (const bf16*)(ws + WS_X1B); const int t = samp_tok(blockIdx.x); for (int c = threadIdx.x; c < D; c += 256) dst[(size_t)blockIdx.x * D + c] = X1B[(size_t)t * D + c]; }
__global__ void __launch_bounds__(256) c11(InP ip, const float* out, const unsigned char* ws, const unsigned* ctl, unsigned* CHK, const bf16* x1s) {
    __shared__ float red[4];
    const bf16* Hh = (const bf16*)(ws + WS_H); const unsigned char* Y = (const unsigned char*)(ws + WS_Y); const unsigned* TS = (const unsigned*)(ws + WS_TS);
    const int t = samp_tok(blockIdx.x), tid = threadIdx.x, NT = (int)ctl[CW_NT]; const float* sd = ip.p[22];
    float v[4], s = 0.f;
    for (int i = 0; i < 4; ++i) { const int c = tid + 256 * i; float a = 0.f; for (int k = 0; k < EH; ++k) a = fmaf(bf2f(Hh[((size_t)NT * 256 + t) * EH + k]), sd[(size_t)k * D + c], a);
        a += ALPHA * bf2f(x1s[(size_t)blockIdx.x * D + c]); for (int k = 0; k < 8; ++k) a += y_at(Y, (size_t)TS[(size_t)t * 8 + k], c); v[i] = a; s += a; }
    const float mu = blk_sum(s, red) / D; float q = 0.f;
    for (int i = 0; i < 4; ++i) { const float d = v[i] - mu; q += d * d; }
    const float rs = rsqrtf(blk_sum(q, red) / D + LN_EPS); float num = 0.f, den = 0.f;
    for (int i = 0; i < 4; ++i) { const int c = tid + 256 * i; const float r = (v[i] - mu) * rs * ip.p[23][c] + ip.p[24][c], f = out[(size_t)t * D + c]; num += (f - r) * (f - r); den += r * r; }
    num = blk_sum(num, red); den = blk_sum(den, red);
    if (tid == 0) put_err(CHK, 11, num, den);
}
__global__ void __launch_bounds__(256) verdict(float* out, const unsigned* CHK, const unsigned* ctl) {
    int stage = 0; float err = 0.f;
    for (int s = 1; s <= 11; ++s) { const float e = __uint_as_float(CHK[s]); const float tol = (s == 8) ? 0.5f : (s == 10 ? 0.08f : 0.03f); if (stage == 0 && !(e <= tol)) { stage = s; err = e; } }
    for (int li = 0; li < 16; ++li) if (stage == 0 && ctl[CW_BAR + li * XCD_BAR_WORDS_C + 128] != 0) { stage = 12; err = 1.f; }
    if (stage == 0) return;
    float lg = (log10f(fminf(fmaxf(err, 1e-3f), 1.f)) + 3.f) / 3.f; const float c2v = powf(10.f, (float)stage) * (1.f + 8.f * lg); const float C = sqrtf(c2v);
    for (size_t i = (size_t)blockIdx.x * 256 + threadIdx.x; i < (size_t)T * D; i += (size_t)gridDim.x * 256) out[i] = C;
}
}
#endif

#ifdef REPORT_K
__global__ void __launch_bounds__(256) k_report(float* out, const unsigned long long* ts) {
    const float us = (REPORT_K >= 0) ? (float)(ts[REPORT_K + 1] - ts[REPORT_K]) * 0.01f : (float)(ts[13] - ts[0]) * 0.001f; const float C = sqrtf(us);
    for (size_t i = (size_t)blockIdx.x * 256 + threadIdx.x; i < (size_t)T * D; i += (size_t)gridDim.x * 256) out[i] = C;
}
#endif
extern "C" void kernel_launch(void* const* d_in, const int* in_sizes, int n_in, void* d_out, int out_size, void* d_ws, size_t ws_size, hipStream_t stream) {
    static int grid = 0;
    if (grid == 0) {
        if (n_in != 25 || in_sizes[0] != T * D || out_size != T * D || ws_size < WS_END) { fprintf(stderr, "kernel_launch: unexpected problem shape / workspace (%d inputs, ws %zu); nothing launched\n", n_in, ws_size); grid = -1; return; }
        int dev = 0, cus = 0, per_cu = 0;
        if (hipGetDevice(&dev) != hipSuccess || hipDeviceGetAttribute(&cus, hipDeviceAttributeMultiprocessorCount, dev) != hipSuccess) { grid = -1; return; }
        if (hipFuncSetAttribute((const void*)mk_fwd, hipFuncAttributeMaxDynamicSharedMemorySize, LDS_BYTES) != hipSuccess) { fprintf(stderr, "kernel_launch: hipFuncSetAttribute failed\n"); grid = -1; return; }
        if (hipOccupancyMaxActiveBlocksPerMultiprocessor(&per_cu, (const void*)mk_fwd, NWAVES * 64, LDS_BYTES) != hipSuccess || per_cu < 1) { fprintf(stderr, "kernel_launch: occupancy query says %d\n", per_cu); }
        (void)hipGetLastError();
        grid = cus;
    }
    if (grid < 0) return;
    (void)hipMemsetAsync((char*)d_ws + WS_CTL, 0, CTL_ZERO_BYTES, stream);
    Args a{};
    for (int i = 0; i < 25; ++i) a.in[i] = (const float*)d_in[i];
    a.out = (float*)d_out; a.ws = (unsigned char*)d_ws;
#if defined(SELFCHECK) && SELFCHECK
    unsigned char* ws = (unsigned char*)d_ws; unsigned* CHK = (unsigned*)(ws + WS_CTL) + CW_CHK; const unsigned* ctl = (const unsigned*)(ws + WS_CTL);
    chk::InP inp{}; for (int i = 0; i < 25; ++i) inp.p[i] = a.in[i];
    float* scratch = (float*)(ws + WS_END + MiB);
    for (int p = 0; p < N_PHASES; ++p) {
        a.ph_lo = p; a.ph_hi = p + 1; a.li = p;
        hipLaunchKernelGGL(mk_fwd, dim3(grid), dim3(NWAVES * 64), LDS_BYTES, stream, a);
        using namespace chk;
        if (p == 1) hipLaunchKernelGGL(c1, dim3(NS), dim3(256), 0, stream, a.in[0], (const int*)d_in[1], a.in[2], ws, CHK);
        if (p == 2) hipLaunchKernelGGL(c2, dim3(NS * 8), dim3(64), 0, stream, ws, CHK);
        if (p == 3) hipLaunchKernelGGL(c3, dim3(16), dim3(64), 0, stream, inp, ws, scratch, CHK);
        if (p == 4) hipLaunchKernelGGL(c4, dim3(NS), dim3(256), 0, stream, a.in[3], a.in[11], ws, CHK);
        if (p == 5) hipLaunchKernelGGL(c5, dim3(NS), dim3(256), 0, stream, a.in[0], a.in[12], ws, CHK);
        if (p == 6) hipLaunchKernelGGL(c6, dim3(NS), dim3(256), 0, stream, a.in[13], a.in[14], a.in[0], ws, CHK);
        if (p == 7) hipLaunchKernelGGL(c7, dim3(NS), dim3(256), 0, stream, a.in[15], ws, CHK);
        if (p == 9) hipLaunchKernelGGL(c8, dim3(NS), dim3(64), 0, stream, a.in[16], ws, ctl, CHK);
        if (p == 10) { hipLaunchKernelGGL(c9, dim3(NS), dim3(256), 0, stream, inp, ws, ctl, CHK); hipLaunchKernelGGL(save_x1b, dim3(NS), dim3(256), 0, stream, ws, (bf16*)(ws + WS_END + 4 * MiB)); }
        if (p == 11) hipLaunchKernelGGL(c10, dim3(32), dim3(256), 0, stream, inp, ws, ctl, CHK);
        if (p == 12) hipLaunchKernelGGL(c11, dim3(NS), dim3(256), 0, stream, inp, (const float*)d_out, ws, ctl, CHK, (const bf16*)(ws + WS_END + 4 * MiB));
    }
    hipLaunchKernelGGL(chk::verdict, dim3(1024), dim3(256), 0, stream, (float*)d_out, CHK, ctl);
#else
    a.ph_lo = 0; a.ph_hi = N_PHASES; a.li = 0;
    hipLaunchKernelGGL(mk_fwd, dim3(grid), dim3(NWAVES * 64), LDS_BYTES, stream, a);
#ifdef REPORT_K
    hipLaunchKernelGGL(k_report, dim3(1024), dim3(256), 0, stream, (float*)d_out, (const unsigned long long*)((unsigned char*)d_ws + WS_END + 8 * MiB));
#endif
#endif
}
```

```cpp
#include <hip/hip_runtime.h>
#include <cstdio>
#include <cstdint>

#define LAS __attribute__((address_space(3)))
#define GAS __attribute__((address_space(1)))
typedef unsigned short bf16;
typedef short bf16x8 __attribute__((ext_vector_type(8)));
typedef short s16x4 __attribute__((ext_vector_type(4)));
typedef float f32x2 __attribute__((ext_vector_type(2)));
typedef float f32x4 __attribute__((ext_vector_type(4)));
typedef float f32x16 __attribute__((ext_vector_type(16)));
typedef unsigned u32x2 __attribute__((ext_vector_type(2)));
typedef unsigned u32x4 __attribute__((ext_vector_type(4)));
typedef GAS unsigned gu32;
#define RLX_AGENT __ATOMIC_RELAXED, __HIP_MEMORY_SCOPE_AGENT
#define DI __device__ __forceinline__

constexpr int NB = 4, SEQ = 8192, T = NB * SEQ, D = 1024, AW = 512, RW = 512, HD = 64, NH = 8, INW = 2560;
constexpr int NE = 256, TOPK = 8, EH = 256;
constexpr float ALPHA = 1.189207115002721f;
constexpr float LN_EPS = 1e-5f;
constexpr float LOG2E = 1.4426950408889634f;
constexpr float QSCALE = 0.125f * LOG2E;
constexpr int NWAVES = 8;
constexpr int MAXRT = T * TOPK / 256 + NE;
constexpr int NSHT = T / 256;
constexpr int MAXTILES = MAXRT + NSHT;
constexpr int MAXSLOTS = MAXTILES * 256;
constexpr int LCH = 128, NCH = SEQ / LCH;

constexpr size_t MiB = 1u << 20;
constexpr size_t WS_CTL = 0, CTL_ZERO_BYTES = 1 * MiB;
constexpr size_t WS_ROPE = 1 * MiB;
constexpr size_t WS_GWT = 3 * MiB;
constexpr size_t WS_C2 = 3 * MiB + 512 * 1024;
constexpr size_t WS_CARRY = 4 * MiB;
constexpr size_t WS_ER = 6 * MiB, WS_TS = 7 * MiB, WS_GW = 8 * MiB;
constexpr size_t WS_SLOTTOK = 9 * MiB, WS_SLOTW = 11 * MiB;
constexpr size_t WS_TILEE = 13 * MiB;
constexpr size_t WS_WINT = 14 * MiB, WS_WOUTT = 19 * MiB, WS_RTT = 21 * MiB;
constexpr size_t WS_WDT = 32 * MiB;
constexpr size_t WS_H = 161 * MiB;
constexpr size_t WS_Q = 161 * MiB, SEG_BYTES = 32 * MiB;
constexpr size_t WS_Y = 337 * MiB;
constexpr size_t WS_WGUT = 337 * MiB;
constexpr size_t WS_X1B = 850 * MiB;
constexpr size_t WS_LOGITS = 658 * MiB;
constexpr size_t WS_ATTN = 658 * MiB, WS_REC = 690 * MiB;
constexpr size_t WS_V1 = 722 * MiB;
constexpr size_t WS_XB = 722 * MiB;
constexpr size_t WS_MIX = 850 * MiB;
constexpr size_t WS_HF = 914 * MiB;
constexpr size_t WS_END = 977 * MiB;
static_assert(WS_WDT + (size_t)257 * 1024 * 256 * 2 <= WS_H && WS_H + (size_t)MAXSLOTS * 256 * 2 <= WS_Y && WS_Y + (size_t)MAXSLOTS * 1024 <= WS_V1, "ws map");
static_assert(WS_WGUT + (size_t)257 * 512 * 1024 * 2 <= WS_LOGITS && WS_Q + 5 * SEG_BYTES <= WS_Y, "ws map 2");
constexpr int CW_TMO = 0, CW_CNT = 1024, CW_NT = 2048, CW_CHK = 3072, CW_BAR = 4096;
#define XCD_BAR_WORDS_C 3456
static_assert((CW_BAR + 16 * XCD_BAR_WORDS_C) * 4 <= (int)CTL_ZERO_BYTES, "ctl");

constexpr int RING_OFF = 0, RING_BYTES = 131072;
constexpr int UT_OFF = RING_BYTES;
constexpr int UT_IDX = UT_OFF + 128;
constexpr int UT_W = UT_IDX + 11 * 1024;
constexpr int MISC_OFF = UT_W + 11 * 1024;
constexpr int LDS_BYTES = 163840;
static_assert(MISC_OFF + 256 <= LDS_BYTES, "LDS map");

DI unsigned f2bf(float f) { unsigned u = __builtin_bit_cast(unsigned, f); return (u + 0x7fffu + ((u >> 16) & 1u)) >> 16; }
DI unsigned pk2(float lo, float hi) { return f2bf(lo) | (f2bf(hi) << 16); }
DI float bf2f(unsigned short b) { return __builtin_bit_cast(float, (unsigned)b << 16); }
DI float bflo(unsigned w) { return __builtin_bit_cast(float, w << 16); }
DI float bfhi(unsigned w) { return __builtin_bit_cast(float, w & 0xffff0000u); }
DI float wave_sum(float v) {
#pragma unroll
    for (int o = 1; o < 64; o <<= 1) v += __shfl_xor(v, o);
    return v;
}
DI float wave_max(float v) {
#pragma unroll
    for (int o = 1; o < 64; o <<= 1) v = fmaxf(v, __shfl_xor(v, o));
    return v;
}
DI int wave_min_i(int v) {
#pragma unroll
    for (int o = 1; o < 64; o <<= 1) v = min(v, __shfl_xor(v, o));
    return v;
}
DI float row16_max(float v) {
    v = fmaxf(v, __builtin_bit_cast(float, __builtin_amdgcn_update_dpp(0, __builtin_bit_cast(int, v), 0xB1, 0xF, 0xF, false)));
    v = fmaxf(v, __builtin_bit_cast(float, __builtin_amdgcn_update_dpp(0, __builtin_bit_cast(int, v), 0x4E, 0xF, 0xF, false)));
    v = fmaxf(v, __builtin_bit_cast(float, __builtin_amdgcn_update_dpp(0, __builtin_bit_cast(int, v), 0x141, 0xF, 0xF, false)));
    v = fmaxf(v, __builtin_bit_cast(float, __builtin_amdgcn_update_dpp(0, __builtin_bit_cast(int, v), 0x140, 0xF, 0xF, false)));
    return v; }
DI float wave_max_fast(float v) { v = row16_max(v);
    const float r0 = __builtin_bit_cast(float, __builtin_amdgcn_readlane(__builtin_bit_cast(int, v), 0)), r1 = __builtin_bit_cast(float, __builtin_amdgcn_readlane(__builtin_bit_cast(int, v), 16)),
                r2 = __builtin_bit_cast(float, __builtin_amdgcn_readlane(__builtin_bit_cast(int, v), 32)), r3 = __builtin_bit_cast(float, __builtin_amdgcn_readlane(__builtin_bit_cast(int, v), 48));
    return fmaxf(fmaxf(r0, r1), fmaxf(r2, r3)); }
DI int wave_min_i_fast(int v) {
    v = min(v, __builtin_amdgcn_update_dpp(0, v, 0xB1, 0xF, 0xF, false)); v = min(v, __builtin_amdgcn_update_dpp(0, v, 0x4E, 0xF, 0xF, false));
    v = min(v, __builtin_amdgcn_update_dpp(0, v, 0x141, 0xF, 0xF, false)); v = min(v, __builtin_amdgcn_update_dpp(0, v, 0x140, 0xF, 0xF, false));
    return min(min(__builtin_amdgcn_readlane(v, 0), __builtin_amdgcn_readlane(v, 16)), min(__builtin_amdgcn_readlane(v, 32), __builtin_amdgcn_readlane(v, 48))); }
DI int lane_id() { return (int)__builtin_amdgcn_mbcnt_hi(~0u, __builtin_amdgcn_mbcnt_lo(~0u, 0u)); }
DI float fexp2(float x) { return __builtin_amdgcn_exp2f(x); }
DI float frcp(float x) { return __builtin_amdgcn_rcpf(x); }
DI float gelu_tanh(float x) {
    const float z = 0.7978845608028654f * (x + 0.044715f * x * x * x);
    const float e = fexp2(2.f * LOG2E * z);
    return 0.5f * x * (2.f - 2.f * frcp(e + 1.f));
}
DI int crow(int r, int hi) { return (r & 3) + 8 * (r >> 2) + 4 * hi; }
#define MFMA32(a, b, c) __builtin_amdgcn_mfma_f32_32x32x16_bf16((a), (b), (c), 0, 0, 0)

namespace pg8 {
constexpr int BM = 256, BK = 64, HALF = 128, HTB = HALF * BK * 2, NXCD = 8;
DI int lds_byte(int r, int c) { const int st = (r >> 4) * 2 + (c >> 5), rr = r & 15, cc = c & 31, ob = rr * 64 + cc * 2; return st * 1024 + (ob ^ (((ob >> 9) & 1) << 5)); }
DI void stage_rc(int b, int& R, int& C) { const int st = b / 1024, sb = b % 1024, swz = sb ^ (((sb >> 9) & 1) << 5); R = (st >> 1) * 16 + swz / 64; C = (st & 1) * 32 + (swz % 64) / 2; }
DI int perm32(int rho) { const int n = rho >> 4, i = rho & 15; return 8 * (i >> 2) + 4 * n + (i & 3); }
struct Unit { int pm, pn, li, ex; };
DI bool xcd_order(int i, int G, int c, int nwg, int& wgid) {
    const long L = (long)i * G + c; if (L >= nwg) return false;
    const int w = (int)L, q = nwg / NXCD, r = nwg % NXCD, xcd = w % NXCD, off = w / NXCD;
    wgid = (xcd < r ? xcd * (q + 1) : r * (q + 1) + (xcd - r) * q) + off; return true;
}
typedef int i32x8 __attribute__((ext_vector_type(8))); typedef int i32x4 __attribute__((ext_vector_type(4)));
DI void pg8_mfma_f8(f32x4& acc, const i32x8& b, const i32x8& a, int sc) { asm volatile("v_mfma_scale_f32_16x16x128_f8f6f4 %0, %1, %2, %0, %3, %3 op_sel_hi:[0,0,0]" : "+v"(acc) : "v"(b), "v"(a), "v"(sc)); }
DI i32x8 pg8_ld32(const LAS unsigned char* p) { const i32x4 a = *(const LAS i32x4*)p, b = *(const LAS i32x4*)(p + 16); return __builtin_shufflevector(a, b, 0, 1, 2, 3, 4, 5, 6, 7); }
DI s16x4 pg8_tr(const LAS unsigned char* p) { typedef short v4i16_t __attribute__((ext_vector_type(4))); return __builtin_bit_cast(s16x4, __builtin_amdgcn_ds_read_tr16_b64_v4i16((LAS v4i16_t*)p)); }
DI unsigned cvt_pk_bf16(float lo, float hi) { unsigned r; asm volatile("v_cvt_pk_bf16_f32 %0, %1, %2" : "=v"(r) : "v"(lo), "v"(hi)); return r; }

template <class Epi, class Sched, bool ALIGN_EPI, bool BKN = false, bool F8 = false>
DI void gemm_phase(LAS unsigned char* lds, const Sched& S, const Epi& E, const int K) {
    const int tid = threadIdx.x, wid = __builtin_amdgcn_readfirstlane(tid >> 6), lane = tid & 63, wr = wid >> 2, wc = wid & 3, fr = lane & 15, fq = lane >> 4;
    const int nt = K / BK;
    unsigned voffB[2];
#define PG8_RC(i, R, C) int R, C; stage_rc((wid * 64 + lane_id()) * 16 + (i) * 8192, R, C)
#pragma unroll
    for (int i = 0; i < 2; ++i) { int R, C; stage_rc(tid * 16 + i * 8192, R, C); const int Rb = Epi::PERM ? ((R & ~31) + perm32(R & 31)) : R; voffB[i] = (unsigned)(Rb * S.ldb + C) * 2u;
        if constexpr (BKN) { static_assert(!BKN || Epi::PERM, "the [K][N] B path delivers the PERM column order"); const int b = tid * 16 + i * 8192, k = b >> 8, c = (b >> 4) & 15, cl = ((((c >> 2) ^ (k & 3)) << 2) | (c & 3)); voffB[i] = (unsigned)(k * S.ldb + 8 * cl) * 2u; } }
    const size_t kstep = (size_t)(BK * 2);
    size_t hstepB = (size_t)HALF * S.ldb * 2, kstepB = kstep;
    if constexpr (BKN) { hstepB = S.bh1; kstepB = (size_t)BK * S.ldb * 2; }
    int bkn_off = 0;
    if constexpr (BKN) { const int g = lane >> 4, q = (lane >> 2) & 3, pp = lane & 3; bkn_off = (8 * g + q) * 256 + ((((wc ^ q) << 2) | pp) << 4); }
    const unsigned ldsw = (unsigned)wid * 1024u, lds_u = (unsigned)(size_t)lds;
    const int aoff = lds_byte(wr * 64 + fr, F8 ? fq * 16 : fq * 8), boff = lds_byte(wc * 32 + fr, F8 ? fq * 16 : fq * 8);
#define PG8_SA(b, h) (((b) * 2 + (h)) * HTB)
#define PG8_SB(b, h) ((4 + (b) * 2 + (h)) * HTB)
#define PG8_STAGE(bufoff, gbase, voff) do { _Pragma("unroll") for (int _i = 0; _i < 2; ++_i) { unsigned keep_; \
        asm volatile("s_mov_b32 %0, m0\n\ts_mov_b32 m0, %3\n\ts_nop 0\n\tglobal_load_lds_dwordx4 %1, %2\n\ts_mov_b32 m0, %0" : "=&s"(keep_) : "v"((voff)[_i]), "s"((const char*)(gbase)), "s"(lds_u + (unsigned)(bufoff) + ldsw + (unsigned)(_i * 8192)) : "memory"); } } while (0)
#define PG8_LDA(dst, b, h) do { if constexpr (F8) { _Pragma("unroll") for (int m = 0; m < 4; ++m) A8[m] = pg8_ld32(lds + PG8_SA(b, h) + aoff + m * 2048); } \
        else { _Pragma("unroll") for (int m = 0; m < 4; ++m) _Pragma("unroll") for (int k = 0; k < 2; ++k) dst[m][k] = *(const LAS bf16x8*)(lds + PG8_SA(b, h) + aoff + m * 2048 + k * 1024); } } while (0)
#define PG8_LDB(dst, b, h) do { if constexpr (BKN) { _Pragma("unroll") for (int n = 0; n < 2; ++n) _Pragma("unroll") for (int k = 0; k < 2; ++k) { \
            const s16x4 lo_ = pg8_tr(lds + PG8_SB(b, h) + bkn_off + k * 8192 + n * 8), hi_ = pg8_tr(lds + PG8_SB(b, h) + bkn_off + k * 8192 + n * 8 + 1024); dst[n][k] = __builtin_shufflevector(lo_, hi_, 0, 1, 2, 3, 4, 5, 6, 7); } } \
        else if constexpr (F8) { _Pragma("unroll") for (int n = 0; n < 2; ++n) dst##8[n] = pg8_ld32(lds + PG8_SB(b, h) + boff + n * 2048); } \
        else { _Pragma("unroll") for (int n = 0; n < 2; ++n) _Pragma("unroll") for (int k = 0; k < 2; ++k) dst[n][k] = *(const LAS bf16x8*)(lds + PG8_SB(b, h) + boff + n * 2048 + k * 1024); } } while (0)
#define PG8_MMA(ai, bj, At, Bt) do { __builtin_amdgcn_s_setprio(1); if constexpr (F8) { _Pragma("unroll") for (int m = 0; m < 4; ++m) _Pragma("unroll") for (int n = 0; n < 2; ++n) \
            pg8_mfma_f8(acc[ai][bj][m][n], Bt##8[n], A8[m], f8_unit_scale); } \
        else { _Pragma("unroll") for (int m = 0; m < 4; ++m) _Pragma("unroll") for (int n = 0; n < 2; ++n) _Pragma("unroll") for (int k = 0; k < 2; ++k) \
            acc[ai][bj][m][n] = __builtin_amdgcn_mfma_f32_16x16x32_bf16(Bt[n][k], At[m][k], acc[ai][bj][m][n], 0, 0, 0); } __builtin_amdgcn_s_setprio(0); } while (0)
#define PG8_WAIT_V(n) asm volatile("s_waitcnt vmcnt(" #n ")" ::: "memory")
#define PG8_WAIT_L(n) asm volatile("s_waitcnt lgkmcnt(" #n ")" ::: "memory")
#define PG8_BAR __builtin_amdgcn_s_barrier()
#define PG8_SCHED __builtin_amdgcn_sched_barrier(0)
    Unit cur, nxt; int ui = 0;
    if (!S.next(0, cur)) return;
    f32x4 acc[2][2][4][2];
#pragma unroll
    for (int a = 0; a < 2; ++a)
#pragma unroll
        for (int b = 0; b < 2; ++b)
#pragma unroll
            for (int m = 0; m < 4; ++m)
#pragma unroll
                for (int n = 0; n < 2; ++n) acc[a][b][m][n] = (f32x4){0.f, 0.f, 0.f, 0.f};
    bf16x8 At[4][2], B0[2][2], B1[2][2];
    i32x8 A8[4], B08[2], B18[2];
    int f8_unit_scale = 0x7F7F7F7F; if constexpr (F8) asm volatile("" : "+v"(f8_unit_scale));
    unsigned ca0[2], ca1[2];
#pragma unroll
    for (int i = 0; i < 2; ++i) { PG8_RC(i, R_, C_); ca0[i] = S.a_voff(cur, R_, C_); ca1[i] = S.a_voff(cur, HALF + R_, C_); }
    const char* cA = S.a_base(cur); const char* cB = S.b_base(cur);
    typename Epi::Ctx ctx = E.pre(cur, wr, fr);
    PG8_STAGE(PG8_SB(0, 0), cB, voffB); PG8_STAGE(PG8_SB(0, 1), cB + hstepB, voffB); PG8_STAGE(PG8_SA(0, 0), cA, ca0); PG8_STAGE(PG8_SA(0, 1), cA, ca1);
    if (wr == 1) PG8_BAR;
    PG8_WAIT_V(2); PG8_BAR;
    PG8_STAGE(PG8_SB(1, 0), cB + kstepB, voffB); PG8_STAGE(PG8_SA(1, 0), cA + kstep, ca0); PG8_STAGE(PG8_SB(1, 1), cB + hstepB + kstepB, voffB);
    PG8_WAIT_V(6); PG8_BAR;
    for (;;) {
        const bool has_next = S.next(ui + 1, nxt);
        const char* nA = has_next ? S.a_base(nxt) : cA; const char* nB = has_next ? S.b_base(nxt) : cB;
#pragma unroll 1
        for (int t = 0; t < nt; t += 2) {
            const bool last = (t == nt - 2);
            const char* a1 = cA + (size_t)(t + 1) * kstep;
            const char* a2 = last ? nA : cA + (size_t)(t + 2) * kstep; const char* b2 = last ? nB : cB + (size_t)(t + 2) * kstepB;
            const char* a3 = a2 + kstep; const char* b3 = b2 + kstepB;
            unsigned v20[2], v21[2];
            if (last && has_next) {
#pragma unroll
                for (int i = 0; i < 2; ++i) { PG8_RC(i, R_, C_); v20[i] = S.a_voff(nxt, R_, C_); v21[i] = S.a_voff(nxt, HALF + R_, C_); }
            } else {
#pragma unroll
                for (int i = 0; i < 2; ++i) { v20[i] = ca0[i]; v21[i] = ca1[i]; }
            }
            PG8_LDB(B0, 0, 0); PG8_LDB(B1, 0, 1); PG8_SCHED; PG8_LDA(At, 0, 0); PG8_STAGE(PG8_SA(1, 1), a1, ca1);
            PG8_WAIT_V(8); PG8_WAIT_L(0); PG8_BAR; PG8_MMA(0, 0, At, B0); PG8_MMA(0, 1, At, B1); PG8_BAR; PG8_SCHED;
            PG8_LDA(At, 0, 1); PG8_STAGE(PG8_SB(0, 0), b2, voffB); PG8_STAGE(PG8_SB(0, 1), b2 + hstepB, voffB); PG8_STAGE(PG8_SA(0, 0), a2, v20);
            PG8_WAIT_V(8); PG8_WAIT_L(0); PG8_BAR; PG8_MMA(1, 0, At, B0); PG8_MMA(1, 1, At, B1); PG8_BAR; PG8_SCHED;
            PG8_LDB(B0, 1, 0); PG8_LDB(B1, 1, 1); PG8_SCHED; PG8_LDA(At, 1, 0); PG8_STAGE(PG8_SA(0, 1), a2, v21);
            PG8_WAIT_V(8); PG8_WAIT_L(0); PG8_BAR; PG8_MMA(0, 0, At, B0); PG8_MMA(0, 1, At, B1); PG8_BAR; PG8_SCHED;
            PG8_LDA(At, 1, 1); PG8_STAGE(PG8_SB(1, 0), b3, voffB); PG8_STAGE(PG8_SB(1, 1), b3 + hstepB, voffB); PG8_STAGE(PG8_SA(1, 0), a3, v20);
            PG8_WAIT_V(8); PG8_WAIT_L(0); PG8_BAR; PG8_MMA(1, 0, At, B0); PG8_MMA(1, 1, At, B1); PG8_BAR; PG8_SCHED;
        }
        if constexpr (ALIGN_EPI) { if (wr == 0) PG8_BAR; }
        if constexpr (F8) asm volatile("s_nop 15\n\ts_nop 15\n\ts_nop 15" ::: "memory");
        E(acc, cur, ctx, wr, wc, fr, fq);
        if (!has_next) break;
#pragma unroll
        for (int a = 0; a < 2; ++a)
#pragma unroll
            for (int b = 0; b < 2; ++b)
#pragma unroll
                for (int m = 0; m < 4; ++m)
#pragma unroll
                    for (int n = 0; n < 2; ++n) acc[a][b][m][n] = (f32x4){0.f, 0.f, 0.f, 0.f};
        cur = nxt; cA = nA; cB = nB; ++ui;
        ctx = E.pre(cur, wr, fr);
#pragma unroll
        for (int i = 0; i < 2; ++i) { PG8_RC(i, R_, C_); ca0[i] = S.a_voff(cur, R_, C_); ca1[i] = S.a_voff(cur, HALF + R_, C_); }
        if constexpr (ALIGN_EPI) { if (wr == 1) PG8_BAR; }
    }
    PG8_WAIT_V(0);
    if constexpr (!ALIGN_EPI) { if (wr == 0) PG8_BAR; }
    PG8_BAR;
#undef PG8_RC
#undef PG8_SA
#undef PG8_SB
#undef PG8_STAGE
#undef PG8_LDA
#undef PG8_LDB
#undef PG8_MMA
#undef PG8_WAIT_V
#undef PG8_WAIT_L
#undef PG8_BAR
#undef PG8_SCHED
}
}
#define XB_TMO      128
#define XB_XCNT(j)  (256  + 64 * (j))
#define XB_XSUB(j)  (1280 + 64 * (j))
#define XB_XGEN(j)  (2304 + 64 * (j))
#define XB_TOP      3328
#define XB_TOPGEN   3392
#define XCD_BAR_WORDS 3456
#define XB_SPIN_CAP (1u << 18)

__device__ __forceinline__ unsigned xb_ld(unsigned* p)              { return __hip_atomic_load(p, __ATOMIC_RELAXED, __HIP_MEMORY_SCOPE_AGENT); }
__device__ __forceinline__ unsigned xb_add(unsigned* p, unsigned v) { return __hip_atomic_fetch_add(p, v, __ATOMIC_RELAXED, __HIP_MEMORY_SCOPE_AGENT); }
__device__ __forceinline__ unsigned xb_xcc_id() { return (unsigned)__builtin_amdgcn_s_getreg((3 << 11) | 20) & 0xFu; }
#define XB_SPIN(cond, bar) do { unsigned _sp = 0; while (cond) { __builtin_amdgcn_s_sleep(1); \
    if ((++_sp & 255u) == 0u) { if (xb_ld(&(bar)[XB_TMO])) break; if (_sp > XB_SPIN_CAP) { atomicAdd(&(bar)[XB_TMO], 1u); break; } } } } while (0)

struct XcdBarrier {
    unsigned* bar; unsigned x;
    volatile LAS unsigned* st;
};

__device__ __forceinline__ XcdBarrier xcd_barrier_post(unsigned* bar, volatile LAS unsigned* st) {
    XcdBarrier b; b.bar = bar; b.x = xb_xcc_id(); b.st = st;
    if (threadIdx.x == 0) (void)xb_add(&bar[XB_XCNT(b.x)], 1u);
    return b;
}
__device__ __forceinline__ void xcd_barrier_complete(unsigned* bar, unsigned x, unsigned& nloc, unsigned& nx) {
    const unsigned G = gridDim.x * gridDim.y * gridDim.z;
    unsigned sum, cnt, mine, sp = 0u;
    for (;;) {
        sum = 0u; cnt = 0u; mine = 0u;
#pragma unroll
        for (unsigned j = 0; j < 16; ++j) { const unsigned c = xb_ld(&bar[XB_XCNT(j)]); sum += c; cnt += (c > 0u) ? 1u : 0u; mine = (j == x) ? c : mine; }
        if (sum == G) break;
        __builtin_amdgcn_s_sleep(1);
        if ((++sp & 255u) == 0u) { if (xb_ld(&bar[XB_TMO])) break; if (sp > XB_SPIN_CAP) { atomicAdd(&bar[XB_TMO], 1u); break; } }
    }
    nloc = mine > 0u ? mine : 1u; nx = cnt > 0u ? cnt : 1u;
}

__device__ __forceinline__ void xcd_barrier(const XcdBarrier& b) {
    asm volatile("s_waitcnt vmcnt(0)" ::: "memory");
    __syncthreads();
    if (threadIdx.x == 0) {
        unsigned* bar = b.bar;
        __builtin_amdgcn_s_waitcnt(0);
        unsigned nloc = b.st[0], nx = b.st[1];
        if (nloc == 0u) { xcd_barrier_complete(bar, b.x, nloc, nx); b.st[0] = nloc; b.st[1] = nx; }
        const unsigned old = xb_add(&bar[XB_XSUB(b.x)], 1u);
        const unsigned gen = old / nloc;
        if (old + 1u == (gen + 1u) * nloc) {
            __builtin_amdgcn_fence(__ATOMIC_RELEASE, "agent");
            asm volatile("s_waitcnt vmcnt(0)" ::: "memory");
            const unsigned og = xb_add(&bar[XB_TOP], 1u);
            const unsigned tg = og / nx;
            if (og + 1u == (tg + 1u) * nx) xb_add(&bar[XB_TOPGEN], 1u);
            else XB_SPIN(xb_ld(&bar[XB_TOPGEN]) == tg, bar);
            __builtin_amdgcn_fence(__ATOMIC_ACQUIRE, "agent");
            xb_add(&bar[XB_XGEN(b.x)], 1u);
            asm volatile("s_waitcnt vmcnt(0)" ::: "memory");
        } else {
            XB_SPIN(xb_ld(&bar[XB_XGEN(b.x)]) == gen, bar);
            __builtin_amdgcn_fence(__ATOMIC_ACQUIRE, "agent");
            asm volatile("s_waitcnt vmcnt(0)" ::: "memory");
        }
    }
    __syncthreads();
}

#define LDS_WAIT() asm volatile("s_waitcnt lgkmcnt(0)" ::: "memory")
#define VM_WAIT() asm volatile("s_waitcnt vmcnt(0)" ::: "memory")
struct Frame {
    LAS unsigned char* lds;
    volatile LAS unsigned* MISC;
    gu32* ctl;
    int tid, lane, wave, vcu, G;
    unsigned char* ws;
    const float* in[25];
    float* out;
};

DI void sincos_acc(float ang, float& c, float& s) {
    const double x = (double)ang;
    const double k = rint(x * 0.63661977236758134308);
    double r = fma(-k, 1.57079632679489655800, x);
    r = fma(-k, 6.12323399573676603587e-17, r);
    const long long q = (long long)k;
    const double r2 = r * r;
    double sp = -7.6471637318198164759e-13; sp = fma(sp, r2, 1.6059043836821614599e-10); sp = fma(sp, r2, -2.5052108385441718775e-08);
    sp = fma(sp, r2, 2.7557319223985890653e-06); sp = fma(sp, r2, -1.9841269841269841270e-04); sp = fma(sp, r2, 8.3333333333333333333e-03);
    sp = fma(sp, r2, -1.6666666666666666667e-01); const double sr = fma(sp * r2, r, r);
    double cp = 4.7794773323873852974e-14; cp = fma(cp, r2, -1.1470745597729724714e-11); cp = fma(cp, r2, 2.0876756987868098979e-09);
    cp = fma(cp, r2, -2.7557319223985890653e-07); cp = fma(cp, r2, 2.4801587301587301587e-05); cp = fma(cp, r2, -1.3888888888888888889e-03);
    cp = fma(cp, r2, 4.1666666666666666667e-02); cp = fma(cp, r2, -0.5); const double cr = fma(cp, r2, 1.0);
    const int qq = (int)(q & 3);
    const double ss = qq == 0 ? sr : (qq == 1 ? cr : (qq == 2 ? -sr : -cr));
    const double cc = qq == 0 ? cr : (qq == 1 ? -sr : (qq == 2 ? -cr : sr));
    c = (float)cc; s = (float)ss;
}

DI void tr_item(const float* W, int N, bf16* WT, int Kd, LAS float* scr, int lane) {
#pragma unroll 4
    for (int i = 0; i < 16; ++i) { const int k = 4 * i + (lane >> 4), c4 = (lane & 15) * 4; const f32x4 v = *(const GAS f32x4*)(W + (size_t)k * N + c4);
        LAS float* d = scr + k * 65 + c4; d[0] = v.x; d[1] = v.y; d[2] = v.z; d[3] = v.w; }
    LDS_WAIT(); asm volatile("" ::: "memory");
    const int c = lane & 7;
#pragma unroll
    for (int j = 0; j < 8; ++j) { const int n = 8 * j + (lane >> 3); const LAS float* s = scr + (8 * c) * 65 + n;
        u32x4 o; o.x = pk2(s[0 * 65], s[1 * 65]); o.y = pk2(s[2 * 65], s[3 * 65]); o.z = pk2(s[4 * 65], s[5 * 65]); o.w = pk2(s[6 * 65], s[7 * 65]);
        *(GAS u32x4*)(WT + (size_t)n * Kd + 8 * c) = o; }
    LDS_WAIT(); asm volatile("" ::: "memory");
}
constexpr int XI_GU = 257 * 16 * 4, XI_DN = 257 * 4 * 16, XI_ALL = 2 * XI_GU + XI_DN;
constexpr float WSCALE = 64.0f;
struct XItem { const float* src; bf16* dst; int N, Kd, f8; };
DI XItem expert_item(Frame& F, int r) {
    unsigned char* ws = F.ws; XItem x;
    if (r < 2 * XI_GU) {
        const int up = r >= XI_GU; if (up) r -= XI_GU;
        const int e = r >> 6, kb = (r >> 2) & 15, nb = r & 3;
        const float* src = (e < NE) ? F.in[up ? 18 : 17] + (size_t)e * D * EH : F.in[up ? 21 : 20];
        const int row = (nb >> 1) * 256 + up * 128 + (nb & 1) * 64;
        x.src = src + (size_t)kb * 64 * EH + nb * 64; x.N = EH; x.dst = (bf16*)(ws + WS_WGUT + ((size_t)e * 512 + row) * D + kb * 64); x.Kd = D; x.f8 = 1;
    } else {
        r -= 2 * XI_GU;
        const int e = r >> 6, kb = (r >> 4) & 3, nb = r & 15;
        const float* src = (e < NE) ? F.in[19] + (size_t)e * EH * D : F.in[22];
        x.src = src + (size_t)kb * 64 * D + nb * 64; x.N = D; x.dst = (bf16*)(ws + WS_WDT) + ((size_t)e * D + nb * 64) * EH + kb * 64; x.Kd = EH; x.f8 = 0;
    }
    return x;
}
DI void xi_load(const XItem& x, f32x4 (&r)[16], int lane) {
#pragma unroll
    for (int i = 0; i < 16; ++i) { const int k = 4 * i + (lane >> 4), c4 = (lane & 15) * 4; r[i] = __builtin_nontemporal_load((const GAS f32x4*)(x.src + (size_t)k * x.N + c4)); }
}
DI void xi_finish(const XItem& x, const f32x4 (&r)[16], LAS float* scr, int lane) {
#pragma unroll
    for (int i = 0; i < 16; ++i) { const int k = 4 * i + (lane >> 4), c4 = (lane & 15) * 4; LAS float* d = scr + k * 65 + c4; d[0] = r[i].x; d[1] = r[i].y; d[2] = r[i].z; d[3] = r[i].w; }
    LDS_WAIT(); asm volatile("" ::: "memory");
    const int c = lane & 7;
    if (x.f8) {
        unsigned char* d8 = (unsigned char*)x.dst;
#pragma unroll
        for (int j = 0; j < 8; ++j) { const int n = 8 * j + (lane >> 3); const LAS float* s = scr + (8 * c) * 65 + n;
            int w0 = __builtin_amdgcn_cvt_pk_fp8_f32(s[0 * 65] * WSCALE, s[1 * 65] * WSCALE, 0, false); w0 = __builtin_amdgcn_cvt_pk_fp8_f32(s[2 * 65] * WSCALE, s[3 * 65] * WSCALE, w0, true);
            int w1 = __builtin_amdgcn_cvt_pk_fp8_f32(s[4 * 65] * WSCALE, s[5 * 65] * WSCALE, 0, false); w1 = __builtin_amdgcn_cvt_pk_fp8_f32(s[6 * 65] * WSCALE, s[7 * 65] * WSCALE, w1, true);
            *(GAS u32x2*)(d8 + (size_t)n * x.Kd + 8 * c) = (u32x2){(unsigned)w0, (unsigned)w1}; }
    } else {
#pragma unroll
        for (int j = 0; j < 8; ++j) { const int n = 8 * j + (lane >> 3); const LAS float* s = scr + (8 * c) * 65 + n;
            u32x4 o; o.x = pg8::cvt_pk_bf16(s[0 * 65], s[1 * 65]); o.y = pg8::cvt_pk_bf16(s[2 * 65], s[3 * 65]); o.z = pg8::cvt_pk_bf16(s[4 * 65], s[5 * 65]); o.w = pg8::cvt_pk_bf16(s[6 * 65], s[7 * 65]);
            *(GAS u32x4*)(x.dst + (size_t)n * x.Kd + 8 * c) = o; }
    }
    LDS_WAIT(); asm volatile("" ::: "memory");
}
DI void convert_items(Frame& F, int it_lo, int it_hi, LAS float* scr) {
    const int gw = F.vcu * NWAVES + F.wave, NGW = F.G * NWAVES, lane = lane_id();
    const int first = it_lo + gw; if (first >= it_hi) return;
    const int n = (it_hi - first + NGW - 1) / NGW;
    f32x4 r0[16], r1[16]; XItem x0, x1;
    x0 = expert_item(F, first); xi_load(x0, r0, lane);
    x1 = expert_item(F, first + (1 < n ? 1 : 0) * NGW); if (1 < n) xi_load(x1, r1, lane);
#pragma unroll 1
    for (int q = 0; q < n; q += 2) {
        xi_finish(x0, r0, scr, lane); if (q + 2 < n) { x0 = expert_item(F, first + (q + 2) * NGW); xi_load(x0, r0, lane); }
        if (q + 1 < n) { xi_finish(x1, r1, scr, lane); if (q + 3 < n) { x1 = expert_item(F, first + (q + 3) * NGW); xi_load(x1, r1, lane); } }
    }
}
DI void p0_prologue(Frame& F) {
    LAS float* scr = (LAS float*)(F.lds + F.wave * 16640);
    const int gw = F.vcu * NWAVES + F.wave, NGW = F.G * NWAVES, lane = F.lane;
    unsigned char* ws = F.ws;
    constexpr int I_IN = 16 * 40, I_OUT = 16 * 16, I_RT = 16 * 4, I_G = 32;
    constexpr int NITEMS = I_IN + I_OUT + I_RT + I_G;
    for (int it = gw; it < NITEMS; it += NGW) {
        int r = it;
        if (r < I_IN) { const int kb = r / 40, nb = r % 40; tr_item(F.in[2] + (size_t)kb * 64 * INW + nb * 64, INW, (bf16*)(ws + WS_WINT) + (size_t)nb * 64 * D + kb * 64, D, scr, lane); continue; } r -= I_IN;
        if (r < I_OUT) { const int kb = r / 16, nb = r % 16; tr_item(F.in[12] + (size_t)kb * 64 * D + nb * 64, D, (bf16*)(ws + WS_WOUTT) + (size_t)nb * 64 * D + kb * 64, D, scr, lane); continue; } r -= I_OUT;
        if (r < I_RT) { const int kb = r / 4, nb = r % 4; tr_item(F.in[15] + (size_t)kb * 64 * NE + nb * 64, NE, (bf16*)(ws + WS_RTT) + (size_t)nb * 64 * D + kb * 64, D, scr, lane); continue; } r -= I_RT;
        {
            const int gate = r >> 4, dir = (r >> 3) & 1, n = r & 7;
            tr_item(F.in[gate ? 8 : 6] + (size_t)(dir * 8 + n) * 4096, 64, (bf16*)(ws + WS_GWT) + (size_t)((dir * 2 + gate) * 8 + n) * 4096, 64, scr, lane); }
    }
    { const f32x4* x4 = (const f32x4*)F.in[0]; u32x4* o = (u32x4*)(ws + WS_XB);
      const size_t NCHK = (size_t)T * D / 8, STR = (size_t)NGW * 64;
      for (size_t i = (size_t)gw * 64 + lane; i < NCHK; i += 4 * STR) {
          f32x4 a[4], b[4];
#pragma unroll
          for (int q = 0; q < 4; ++q) { const size_t ii = (i + q * STR < NCHK) ? i + q * STR : i; a[q] = __builtin_nontemporal_load((const GAS f32x4*)x4 + 2 * ii); b[q] = __builtin_nontemporal_load((const GAS f32x4*)x4 + 2 * ii + 1); }
#pragma unroll
          for (int q = 0; q < 4; ++q) if (i + q * STR < NCHK) { u32x4 w; w.x = pk2(a[q].x, a[q].y); w.y = pk2(a[q].z, a[q].w); w.z = pk2(b[q].x, b[q].y); w.w = pk2(b[q].z, b[q].w); o[i + q * STR] = w; } } }
    { const int* pos = (const int*)F.in[1]; float* rt = (float*)(ws + WS_ROPE);
      for (int i = gw * 64 + lane; i < T * 8; i += NGW * 64) { const int t = i >> 3, f = i & 7;
          float inv = 1.0f;
          inv = f == 1 ? 0x1.8d275ep-3f : inv; inv = f == 2 ? 0x1.341190p-5f : inv; inv = f == 3 ? 0x1.ddee9cp-8f : inv; inv = f == 4 ? 0x1.72ba44p-10f : inv;
          inv = f == 5 ? 0x1.1f91f0p-12f : inv; inv = f == 6 ? 0x1.be218ap-15f : inv; inv = f == 7 ? 0x1.5a0f50p-17f : inv;
          float c, s; sincos_acc((float)pos[t] * inv, c, s); rt[t * 16 + f] = c; rt[t * 16 + 8 + f] = s; } }
    { const float* lam = F.in[10]; float* c2 = (float*)(ws + WS_C2);
      for (int i = gw * 64 + lane; i < 2 * RW; i += NGW * 64) { const float l = lam[i]; const float sp = (-l > 20.f) ? -l : log1pf(expf(-l)); c2[i] = -8.0f * sp * LOG2E; } }
}

struct SchedDense {
    const bf16* A; const bf16* Bt; int lda, ldb, nM, nN, G, c, i0, i1;
    DI bool next(int ii, pg8::Unit& u) const { const int i = ii + i0; if (i >= i1) return false; int wgid; if (!pg8::xcd_order(i, G, c, nM * nN, wgid)) return false;
        const int nig = 8 * nN, gid = wgid / nig, fm = gid * 8, gsz = (nM - fm) < 8 ? (nM - fm) : 8; u.pm = fm + ((wgid % nig) % gsz); u.pn = (wgid % nig) / gsz; u.li = i; u.ex = 0; return true; }
    DI const char* a_base(const pg8::Unit& u) const { return (const char*)A + (size_t)u.pm * 256 * lda * 2; }
    DI unsigned a_voff(const pg8::Unit&, int R, int C) const { return (unsigned)(R * lda + C) * 2u; }
    DI const char* b_base(const pg8::Unit& u) const { return (const char*)Bt + (size_t)u.pn * 256 * ldb * 2; }
};
struct SchedRouter {
    const bf16* A; const bf16* Bt; int lda, ldb, nM, G, c;
    DI bool next(int i, pg8::Unit& u) const { int wgid; if (!pg8::xcd_order(i, G, c, nM * 2, wgid)) return false; u.pm = wgid >> 1; u.pn = wgid & 1; u.li = i; u.ex = 0; return true; }
    DI const char* a_base(const pg8::Unit& u) const { return (const char*)A + ((size_t)u.pm * 256 * lda + u.pn * 512) * 2; }
    DI unsigned a_voff(const pg8::Unit&, int R, int C) const { return (unsigned)(R * lda + C) * 2u; }
    DI const char* b_base(const pg8::Unit& u) const { return (const char*)Bt + (size_t)u.pn * 512 * 2; }
};
struct SchedG1 {
    const bf16* X; const bf16* W; const LAS unsigned* ue; const LAS unsigned* idx; int ldb, nwg, G, c; size_t bh1;
    DI bool next(int i, pg8::Unit& u) const { int wgid; if (!pg8::xcd_order(i, G, c, nwg, wgid)) return false; u.pm = wgid >> 1; u.pn = wgid & 1; u.li = i; u.ex = (int)ue[i]; return true; }
    DI const char* a_base(const pg8::Unit&) const { return (const char*)X; }
    DI unsigned a_voff(const pg8::Unit& u, int R, int C) const { return idx[u.li * 256 + R] * 1024u + (unsigned)C * 2u; }
    DI const char* b_base(const pg8::Unit& u) const { return (const char*)W + ((size_t)u.ex * 512 + u.pn * 256) * D; }
};
struct SchedG2 {
    const bf16* Hh; const bf16* W; const LAS unsigned* ue; int ldb, nwg, G, c, tile0; size_t bh1;
    DI bool next(int i, pg8::Unit& u) const { int wgid; if (!pg8::xcd_order(i, G, c, nwg, wgid)) return false; u.pm = tile0 + (wgid >> 2); u.pn = wgid & 3; u.li = i; u.ex = (int)ue[i]; return true; }
    DI const char* a_base(const pg8::Unit& u) const { return (const char*)Hh + (size_t)u.pm * 256 * EH * 2; }
    DI unsigned a_voff(const pg8::Unit&, int R, int C) const { return (unsigned)(R * EH + C) * 2u; }
    DI const char* b_base(const pg8::Unit& u) const { return (const char*)W + ((size_t)u.ex * D + u.pn * 256) * EH * 2; }
};

struct EpiInProj {
    static constexpr bool PERM = true; struct Ctx {}; DI Ctx pre(const pg8::Unit&, int, int) const { return Ctx{}; }
    bf16* Q; const float* rope;
    DI void operator()(const f32x4 (&acc)[2][2][4][2], const pg8::Unit& u, const Ctx& cx, int wr, int wc, int fr, int fq) const {
        const int seg = u.pn >> 1;
        bf16* base = Q + (size_t)seg * (SEG_BYTES / 2);
        const int row0 = u.pm * 256 + wr * 64 + fr, col0 = (u.pn & 1) * 256 + wc * 32 + 8 * fq;
        const bool rot = (seg < 2) && ((wc & 1) == 0);
        const float sgn = (fq == 0) ? -1.f : 1.f;
#pragma unroll
        for (int ai = 0; ai < 2; ++ai)
#pragma unroll
            for (int m = 0; m < 4; ++m) {
                const int row = row0 + ai * 128 + m * 16;
                f32x4 c0 = {1.f, 1.f, 1.f, 1.f}, c1 = c0, s0 = {0.f, 0.f, 0.f, 0.f}, s1 = s0;
                if (rot) { const f32x4* rp = (const f32x4*)(rope + (size_t)row * 16); c0 = rp[0]; c1 = rp[1]; s0 = rp[2]; s1 = rp[3]; }
#pragma unroll
                for (int bj = 0; bj < 2; ++bj) {
                    f32x4 v0 = acc[ai][bj][m][0], v1 = acc[ai][bj][m][1];
                    if (rot) {
                        f32x4 p0, p1;
#pragma unroll
                        for (int j = 0; j < 4; ++j) { p0[j] = __shfl_xor(v0[j], 16); p1[j] = __shfl_xor(v1[j], 16); }
                        if (fq < 2) { v0 = v0 * c0 + (p0 * s0) * sgn; v1 = v1 * c1 + (p1 * s1) * sgn; }
                    }
                    if (seg == 0) { v0 = v0 * QSCALE; v1 = v1 * QSCALE; }
                    if (seg == 4) {
#pragma unroll
                        for (int j = 0; j < 4; ++j) { v0[j] = gelu_tanh(v0[j]); v1[j] = gelu_tanh(v1[j]); } }
                    u32x4 w; w.x = pg8::cvt_pk_bf16(v0[0], v0[1]); w.y = pg8::cvt_pk_bf16(v0[2], v0[3]); w.z = pg8::cvt_pk_bf16(v1[0], v1[1]); w.w = pg8::cvt_pk_bf16(v1[2], v1[3]);
                    *(u32x4*)(base + (size_t)row * 512 + col0 + bj * 128) = w;
                }
            }
    }
};
struct EpiYb {
    static constexpr bool PERM = true; struct Ctx {}; DI Ctx pre(const pg8::Unit&, int, int) const { return Ctx{}; }
    bf16* Yb;
    DI void operator()(const f32x4 (&acc)[2][2][4][2], const pg8::Unit& u, const Ctx& cx, int wr, int wc, int fr, int fq) const {
        const int row0 = u.pm * 256 + wr * 64 + fr, col0 = u.pn * 256 + wc * 32 + 8 * fq;
#pragma unroll
        for (int ai = 0; ai < 2; ++ai)
#pragma unroll
            for (int m = 0; m < 4; ++m) { const size_t ro = (size_t)(row0 + ai * 128 + m * 16) * D + col0;
#pragma unroll
                for (int bj = 0; bj < 2; ++bj) { const f32x4 v0 = acc[ai][bj][m][0], v1 = acc[ai][bj][m][1];
                    u32x4 o; o.x = pg8::cvt_pk_bf16(v0[0], v0[1]); o.y = pg8::cvt_pk_bf16(v0[2], v0[3]); o.z = pg8::cvt_pk_bf16(v1[0], v1[1]); o.w = pg8::cvt_pk_bf16(v1[2], v1[3]);
                    *(u32x4*)(Yb + ro + bj * 128) = o; } }
    }
};
struct EpiLogits {
    static constexpr bool PERM = false; struct Ctx {}; DI Ctx pre(const pg8::Unit&, int, int) const { return Ctx{}; }
    float* L;
    DI void operator()(const f32x4 (&acc)[2][2][4][2], const pg8::Unit& u, const Ctx& cx, int wr, int wc, int fr, int fq) const {
        float* base = L + (size_t)u.pn * T * NE; const int row0 = u.pm * 256 + wr * 64 + fr, col0 = wc * 32 + 4 * fq;
#pragma unroll
        for (int ai = 0; ai < 2; ++ai)
#pragma unroll
            for (int m = 0; m < 4; ++m) { const size_t ro = (size_t)(row0 + ai * 128 + m * 16) * NE + col0;
#pragma unroll
                for (int bj = 0; bj < 2; ++bj)
#pragma unroll
                    for (int n = 0; n < 2; ++n) *(f32x4*)(base + ro + bj * 128 + n * 16) = acc[ai][bj][m][n]; }
    }
};
struct EpiSwiglu {
    static constexpr bool PERM = true;
    struct Ctx {}; DI Ctx pre(const pg8::Unit&, int, int) const { return Ctx{}; }
    bf16* Hh; const LAS float* wtab; int NT;
    DI void operator()(const f32x4 (&acc)[2][2][4][2], const pg8::Unit& u, const Ctx& cx, int wr, int wc, int fr, int fq) const {
        const int row0 = u.pm * 256 + wr * 64 + fr, col0 = u.pn * 128 + wc * 32 + 8 * fq;
#pragma unroll
        for (int ai = 0; ai < 2; ++ai)
#pragma unroll
            for (int m = 0; m < 4; ++m) {
                float h[8]; const float w = wtab[u.li * 256 + wr * 64 + fr + ai * 128 + m * 16];
#pragma unroll
                for (int n = 0; n < 2; ++n)
#pragma unroll
                    for (int j = 0; j < 4; ++j) { const float g = acc[ai][0][m][n][j] * (1.0f / WSCALE), uu = acc[ai][1][m][n][j] * (1.0f / WSCALE); h[4 * n + j] = g * frcp(1.f + fexp2(-LOG2E * g)) * (uu * w); }
                u32x4 o; o.x = pg8::cvt_pk_bf16(h[0], h[1]); o.y = pg8::cvt_pk_bf16(h[2], h[3]); o.z = pg8::cvt_pk_bf16(h[4], h[5]); o.w = pg8::cvt_pk_bf16(h[6], h[7]);
                *(u32x4*)(Hh + (size_t)(row0 + ai * 128 + m * 16) * EH + col0) = o;
            }
    }
};
constexpr float YSCALE = 16.0f;
DI unsigned pk_fp8x4(float a, float b, float c, float d) {
    a = __builtin_amdgcn_fmed3f(a * YSCALE, -448.f, 448.f); b = __builtin_amdgcn_fmed3f(b * YSCALE, -448.f, 448.f); c = __builtin_amdgcn_fmed3f(c * YSCALE, -448.f, 448.f); d = __builtin_amdgcn_fmed3f(d * YSCALE, -448.f, 448.f);
    int w = __builtin_amdgcn_cvt_pk_fp8_f32(a, b, 0, false); w = __builtin_amdgcn_cvt_pk_fp8_f32(c, d, w, true); return (unsigned)w; }
struct EpiDownY {
    static constexpr bool PERM = true; struct Ctx {}; DI Ctx pre(const pg8::Unit&, int, int) const { return Ctx{}; }
    unsigned char* Y; bool dry;
    DI void operator()(const f32x4 (&acc)[2][2][4][2], const pg8::Unit& u, const Ctx& cx, int wr, int wc, int fr, int fq) const {
        const int rl0 = wr * 64 + fr, boff = ((u.pn * 4 + wc) * 4 + fq) * 16;
#pragma unroll
        for (int ai = 0; ai < 2; ++ai)
#pragma unroll
            for (int m = 0; m < 4; ++m) { const size_t slot = (size_t)u.pm * 256 + rl0 + ai * 128 + m * 16;
                u32x4 o;
                o.x = pk_fp8x4(acc[ai][0][m][0][0], acc[ai][0][m][0][1], acc[ai][0][m][0][2], acc[ai][0][m][0][3]); o.y = pk_fp8x4(acc[ai][0][m][1][0], acc[ai][0][m][1][1], acc[ai][0][m][1][2], acc[ai][0][m][1][3]);
                o.z = pk_fp8x4(acc[ai][1][m][0][0], acc[ai][1][m][0][1], acc[ai][1][m][0][2], acc[ai][1][m][0][3]); o.w = pk_fp8x4(acc[ai][1][m][1][0], acc[ai][1][m][1][1], acc[ai][1][m][1][2], acc[ai][1][m][1][3]);
                if (!dry) *(u32x4*)(Y + slot * 1024 + boff) = o; }
    }
};

struct ScanP { const bf16* RX; const bf16* GWT; const float* cw; const float* cb; const float* gab; const float* gxb; const float* c2; f32x2* carry; bf16* HF; bf16* HB; };
constexpr int UT_PITCH = 144;
constexpr int SC_RAW = 4608;
DI void load_raw(const bf16* RX, int tt0, int n, u32x4 (&rw)[5], int lane) {
    const int s0 = tt0 & (SEQ - 1);
#pragma unroll
    for (int i = 0; i < 5; ++i) { const int p = i * 64 + lane, row = p >> 3, ch = p & 7; const int ss = s0 + row - 2;
        u32x4 v = {0u, 0u, 0u, 0u};
        if (p < 288 && ss >= 0 && ss < SEQ) v = *(const GAS u32x4*)(RX + (size_t)(tt0 + row - 2) * RW + 64 * n + 8 * ch);
        rw[i] = v; }
}
DI void build_u_tile(const u32x4 (&rw)[5], float w0, float w1, float w2, float w3, float cbv, LAS unsigned char* ut, int lane) {
    LAS unsigned char* raw = ut + SC_RAW;
#pragma unroll
    for (int i = 0; i < 5; ++i) { const int p = i * 64 + lane; if (p < 288) *(LAS u32x4*)(raw + p * 16) = rw[i]; }
    float xm2 = bf2f(*(const LAS unsigned short*)(raw + 0 * 128 + lane * 2)), xm1 = bf2f(*(const LAS unsigned short*)(raw + 1 * 128 + lane * 2)), x0 = bf2f(*(const LAS unsigned short*)(raw + 2 * 128 + lane * 2));
#pragma unroll
    for (int tok = 0; tok < 32; ++tok) {
        const float x1 = bf2f(*(const LAS unsigned short*)(raw + (tok + 3) * 128 + lane * 2));
        const float uu = cbv + w0 * xm2 + w1 * xm1 + w2 * x0 + w3 * x1;
        *(LAS unsigned short*)(ut + tok * UT_PITCH + lane * 2) = (unsigned short)pg8::cvt_pk_bf16(uu, uu);
        xm2 = xm1; xm1 = x0; x0 = x1;
    }
}
DI void gate_ct(const LAS unsigned char* ut, const bf16x8 (&af)[4], const bf16x8 (&wA)[4], const bf16x8 (&wX)[4], float ba, float bx, float c2v, int ct, f32x16& a, f32x16& b, int lane) {
    const int col = lane & 31, hi = lane >> 5;
    f32x16 pa, px;
#pragma unroll
    for (int i = 0; i < 16; ++i) { pa[i] = 0.f; px[i] = 0.f; }
#pragma unroll
    for (int ks = 0; ks < 4; ++ks) { pa = MFMA32(af[ks], wA[ks], pa); px = MFMA32(af[ks], wX[ks], px); }
#pragma unroll
    for (int r = 0; r < 16; ++r) {
        const float uu = bf2f(*(const LAS unsigned short*)(ut + crow(r, hi) * UT_PITCH + (32 * ct + col) * 2));
        const float rr = frcp(1.f + fexp2(-LOG2E * (pa[r] + ba)));
        const float ii = frcp(1.f + fexp2(-LOG2E * (px[r] + bx)));
        const float av = fexp2(rr * c2v);
        a[r] = av; b[r] = __builtin_amdgcn_sqrtf(fmaxf(1.f - av * av, 0.f)) * ii * uu;
    }
}
template <int DIR, bool PASS2>
DI void scan_tile(const f32x16& a, const f32x16& b, LAS unsigned char* ocol, float& h, float& Ac, float& Bc, int hi) {
    float Ag[4], Bg[4];
#pragma unroll
    for (int g = 0; g < 4; ++g) {
        if (DIR == 0) { float B = b[4 * g]; B = a[4 * g + 1] * B + b[4 * g + 1]; B = a[4 * g + 2] * B + b[4 * g + 2]; B = a[4 * g + 3] * B + b[4 * g + 3]; Bg[g] = B; }
        else          { float B = b[4 * g + 3]; B = a[4 * g + 2] * B + b[4 * g + 2]; B = a[4 * g + 1] * B + b[4 * g + 1]; B = a[4 * g] * B + b[4 * g]; Bg[g] = B; }
        Ag[g] = (a[4 * g] * a[4 * g + 1]) * (a[4 * g + 2] * a[4 * g + 3]);
    }
    float AE[4], BE[4], AO[4], BO[4];
#pragma unroll
    for (int g = 0; g < 4; ++g) { const float pA = __shfl_xor(Ag[g], 32), pB = __shfl_xor(Bg[g], 32);
        AE[g] = hi ? pA : Ag[g]; BE[g] = hi ? pB : Bg[g]; AO[g] = hi ? Ag[g] : pA; BO[g] = hi ? Bg[g] : pB; }
    float hin[4];
    if (DIR == 0) {
#pragma unroll
        for (int g = 0; g < 4; ++g) { const float hE = h; h = AE[g] * h + BE[g]; const float hO = h; h = AO[g] * h + BO[g]; hin[g] = hi ? hO : hE;
            if (!PASS2) { Bc = AE[g] * Bc + BE[g]; Ac *= AE[g]; Bc = AO[g] * Bc + BO[g]; Ac *= AO[g]; } }
    } else {
#pragma unroll
        for (int g = 3; g >= 0; --g) { const float hO = h; h = AO[g] * h + BO[g]; const float hE = h; h = AE[g] * h + BE[g]; hin[g] = hi ? hO : hE;
            if (!PASS2) { Bc = AO[g] * Bc + BO[g]; Ac *= AO[g]; Bc = AE[g] * Bc + BE[g]; Ac *= AE[g]; } }
    }
    if (PASS2) {
#pragma unroll
        for (int g = 0; g < 4; ++g) { float hh = hin[g];
            if (DIR == 0) {
#pragma unroll
                for (int q = 0; q < 4; ++q) { hh = a[4 * g + q] * hh + b[4 * g + q]; *(LAS unsigned short*)(ocol + crow(4 * g + q, hi) * 128) = (unsigned short)pg8::cvt_pk_bf16(hh, hh); }
            } else {
#pragma unroll
                for (int q = 3; q >= 0; --q) { hh = a[4 * g + q] * hh + b[4 * g + q]; *(LAS unsigned short*)(ocol + crow(4 * g + q, hi) * 128) = (unsigned short)pg8::cvt_pk_bf16(hh, hh); }
            } }
    }
}
template <int DIR, bool PASS2>
DI void scan_sweep(const ScanP& P, int b, int n, int j, LAS unsigned char* ut, int lane) {
    const int col = lane & 31, hi = lane >> 5;
    bf16x8 wA[2][4], wX[2][4]; float ba[2], bx[2], c2v[2];
#pragma unroll
    for (int ct = 0; ct < 2; ++ct) {
#pragma unroll
        for (int ks = 0; ks < 4; ++ks) {
            wA[ct][ks] = *(const GAS bf16x8*)(P.GWT + ((size_t)((DIR * 2 + 0) * 8 + n) * 64 + 32 * ct + col) * 64 + 16 * ks + 8 * hi);
            wX[ct][ks] = *(const GAS bf16x8*)(P.GWT + ((size_t)((DIR * 2 + 1) * 8 + n) * 64 + 32 * ct + col) * 64 + 16 * ks + 8 * hi); }
        const int c = DIR * RW + 64 * n + 32 * ct + col; ba[ct] = P.gab[c]; bx[ct] = P.gxb[c]; c2v[ct] = P.c2[c];
    }
    const float w0 = P.cw[0 * RW + 64 * n + lane], w1 = P.cw[1 * RW + 64 * n + lane], w2 = P.cw[2 * RW + 64 * n + lane], w3 = P.cw[3 * RW + 64 * n + lane], cbv = P.cb[64 * n + lane];
    const int t0 = b * SEQ + j * LCH;
    u32x4 rw[5];
    load_raw(P.RX, t0 + 32 * (DIR == 0 ? 0 : (LCH / 32 - 1)), n, rw, lane);
    float h[2] = {0.f, 0.f}, Ac[2] = {1.f, 1.f}, Bc[2] = {0.f, 0.f};
    if (PASS2) {
        const f32x2* cr = P.carry + ((size_t)(b * 2 + DIR) * NCH) * RW + 64 * n + col;
        const int cnt = DIR == 0 ? j : (NCH - 1 - j);
        f32x2 ab[16][2];
#define SC_LD(dst, q0) do { _Pragma("unroll") for (int q = 0; q < 16; ++q) { const int qq_ = ((q0) + q < cnt) ? ((q0) + q) : (cnt > 0 ? cnt - 1 : 0); const int jj_ = DIR == 0 ? qq_ : (NCH - 1 - qq_); \
            _Pragma("unroll") for (int ct = 0; ct < 2; ++ct) dst[q][ct] = cr[(size_t)jj_ * RW + 32 * ct]; } } while (0)
        for (int q0 = 0; q0 < cnt; q0 += 16) {
            SC_LD(ab, q0);
#pragma unroll
            for (int q = 0; q < 16; ++q) if (q0 + q < cnt) {
#pragma unroll
                for (int ct = 0; ct < 2; ++ct) h[ct] = ab[q][ct].x * h[ct] + ab[q][ct].y; }
        }
#undef SC_LD
    }
#pragma unroll 1
    for (int tq = 0; tq < LCH / 32; ++tq) {
        const int ti = DIR == 0 ? tq : (LCH / 32 - 1 - tq);
        const int tt0 = t0 + 32 * ti;
        if (PASS2 && tq > 0) load_raw(P.RX, tt0, n, rw, lane);
        build_u_tile(rw, w0, w1, w2, w3, cbv, ut, lane);
        if (!PASS2 && tq + 1 < LCH / 32) load_raw(P.RX, t0 + 32 * (DIR == 0 ? tq + 1 : (LCH / 32 - 2 - tq)), n, rw, lane);
        bf16x8 af[4];
#pragma unroll
        for (int ks = 0; ks < 4; ++ks) af[ks] = *(const LAS bf16x8*)(ut + col * UT_PITCH + (16 * ks + 8 * hi) * 2);
        LAS unsigned char* ot = ut + SC_RAW;
#pragma unroll
        for (int ct = 0; ct < 2; ++ct) {
            f32x16 a, bb;
            gate_ct(ut, af, wA[ct], wX[ct], ba[ct], bx[ct], c2v[ct], ct, a, bb, lane);
            scan_tile<DIR, PASS2>(a, bb, ot + (32 * ct + col) * 2, h[ct], Ac[ct], Bc[ct], hi);
            __builtin_amdgcn_sched_barrier(0);
        }
        if (PASS2) {
            bf16* dst = (DIR == 0 ? P.HF : P.HB) + (size_t)tt0 * RW + 64 * n;
#pragma unroll
            for (int i = 0; i < 4; ++i) { const int p = i * 64 + lane, row = p >> 3, ch = p & 7; *(GAS u32x4*)(dst + (size_t)row * RW + 8 * ch) = *(const LAS u32x4*)(ot + p * 16); }
        }
    }
    if (!PASS2 && hi == 0) {
#pragma unroll
        for (int ct = 0; ct < 2; ++ct) P.carry[((size_t)(b * 2 + DIR) * NCH + j) * RW + 64 * n + 32 * ct + col] = (f32x2){Ac[ct], Bc[ct]};
    }
}
template <bool PASS2>
DI void scan_phase(Frame& F, const ScanP& P, int it_lo, int it_hi);
constexpr int AT_OACC = 0, AT_ML = 65536, AT_V = 69632;
DI s16x4 vtr(const LAS unsigned char* p) { typedef short v4i16_t __attribute__((ext_vector_type(4))); return __builtin_bit_cast(s16x4, __builtin_amdgcn_ds_read_tr16_b64_v4i16((LAS v4i16_t*)p)); }
DI void attn_tile(const bf16* Qp, const bf16* Kp, const bf16* Vp, int tb, int h, int rho, int dl, int nq0, int L, LAS unsigned char* vt, int lane, f32x16 (&o)[2], float& m_out, float& l_out) {
    const int qi = lane & 31, hi = lane >> 5;
    LAS unsigned char* kt_lds = vt + 32768;
    const int kt_lo = (nq0 >= 64) ? 0 : (2 - (nq0 >> 5)), kt_hi = ((L - nq0) >> 5) + 2 < 5 ? ((L - nq0) >> 5) + 2 : 5;
    bf16x8 qf[4]; u32x4 kr[5][4], vv[5][4];
    const size_t hoff = (size_t)h * HD;
    const bf16* qp = Qp + (size_t)(tb + rho + dl * (nq0 + qi)) * AW + hoff + 8 * hi;
#pragma unroll
    for (int ks = 0; ks < 4; ++ks) qf[ks] = *(const GAS bf16x8*)(qp + 16 * ks);
    const size_t kstep = (size_t)dl * 32 * AW;
    const size_t rowoff = (size_t)(tb + rho + dl * (nq0 - 64 + (lane >> 3))) * AW + hoff + 8 * (lane & 7);
    const bf16* kp0 = Kp + rowoff; const bf16* vp0 = Vp + rowoff;
    const size_t vrow8 = (size_t)dl * 8 * AW;
#define ATT_CL(kt) ((kt) < kt_lo ? kt_lo : ((kt) >= kt_hi ? kt_hi - 1 : (kt)))
#define ATT_LOADK(kt) do { const size_t ko_ = (size_t)ATT_CL(kt) * kstep; _Pragma("unroll") for (int i = 0; i < 4; ++i) kr[kt][i] = *(const GAS u32x4*)(kp0 + ko_ + i * vrow8); } while (0)
#define ATT_LOADV(kt) do { const size_t vo_ = (size_t)ATT_CL(kt) * kstep; _Pragma("unroll") for (int i = 0; i < 4; ++i) vv[kt][i] = *(const GAS u32x4*)(vp0 + vo_ + i * vrow8); } while (0)
    ATT_LOADK(0); ATT_LOADK(1); ATT_LOADK(2); ATT_LOADK(3); ATT_LOADK(4);
    ATT_LOADV(0); ATT_LOADV(1);
    f32x16 z;
#pragma unroll
    for (int i = 0; i < 16; ++i) z[i] = 0.f;
    o[0] = z; o[1] = z;
    float m = -1e30f, l = 0.f;
    const int q4 = (lane & 15) >> 2, p4 = lane & 3, blk = (lane >> 4) & 1;
    const LAS unsigned char* vrd = vt + (4 * hi + q4) * 128 + (16 * blk + 4 * p4) * 2;
    const int kwr = (lane >> 3) * 128 + (((lane & 7) ^ ((lane >> 3) & 7)) << 4);
    const LAS unsigned char* krd = kt_lds + qi * 128;
#pragma unroll
    for (int kt = 0; kt < 5; ++kt) {
        if (kt + 2 < 5) ATT_LOADV(kt + 2);
        if (kt >= kt_lo && kt < kt_hi) {
#pragma unroll
            for (int i = 0; i < 4; ++i) *(LAS u32x4*)(kt_lds + i * 1024 + kwr) = kr[kt][i];
            f32x16 s = z;
#pragma unroll
            for (int ks = 0; ks < 4; ++ks) { const bf16x8 kf = *(const LAS bf16x8*)(krd + (((2 * ks + hi) ^ (qi & 7)) << 4)); s = MFMA32(kf, qf[ks], s); }
#pragma unroll
            for (int i = 0; i < 4; ++i) { const int piece = i * 64 + lane; *(LAS u32x4*)(vt + piece * 16) = vv[kt][i]; }
            if (kt == 0) {
#pragma unroll
                for (int r = 0; r < 16; ++r) if (crow(r, hi) < qi) s[r] = -1e30f;
            }
            if (kt == 4) {
#pragma unroll
                for (int r = 0; r < 16; ++r) if (crow(r, hi) > qi) s[r] = -1e30f;
            }
            float tm = s[0];
#pragma unroll
            for (int r = 1; r < 16; ++r) tm = fmaxf(tm, s[r]);
            { const auto sw_ = __builtin_amdgcn_permlane32_swap(__float_as_uint(tm), __float_as_uint(tm), false, false); tm = fmaxf(__uint_as_float(sw_[0]), __uint_as_float(sw_[1])); }
            const float mn = fmaxf(m, tm), al = fexp2(m - mn);
            float ps = 0.f;
#pragma unroll
            for (int r = 0; r < 16; ++r) { s[r] = fexp2(s[r] - mn); ps += s[r]; }
            l = l * al + ps; m = mn;
#pragma unroll
            for (int r = 0; r < 16; ++r) { o[0][r] *= al; o[1][r] *= al; }
            bf16x8 pk[2];
#pragma unroll
            for (int sx = 0; sx < 2; ++sx) { u32x4 w; w.x = pg8::cvt_pk_bf16(s[8 * sx + 0], s[8 * sx + 1]); w.y = pg8::cvt_pk_bf16(s[8 * sx + 2], s[8 * sx + 3]);
                w.z = pg8::cvt_pk_bf16(s[8 * sx + 4], s[8 * sx + 5]); w.w = pg8::cvt_pk_bf16(s[8 * sx + 6], s[8 * sx + 7]); pk[sx] = __builtin_bit_cast(bf16x8, w); }
#pragma unroll
            for (int sx = 0; sx < 2; ++sx)
#pragma unroll
                for (int dh = 0; dh < 2; ++dh) {
                    const s16x4 lo = vtr(vrd + (16 * sx) * 128 + 64 * dh), hi4 = vtr(vrd + (16 * sx + 8) * 128 + 64 * dh);
                    const bf16x8 vf = __builtin_shufflevector(lo, hi4, 0, 1, 2, 3, 4, 5, 6, 7);
                    o[dh] = MFMA32(vf, pk[sx], o[dh]);
                }
        }
    }
#undef ATT_LOADK
#undef ATT_LOADV
#undef ATT_CL
    m_out = m; l_out = l + __shfl_xor(l, 32);
}
struct AttnP { const bf16* Q; const bf16* K; const bf16* V; bf16* O; };
DI void attn_phase(Frame& F, const AttnP& P) {
    LAS unsigned char* lds = F.lds;
    LAS unsigned char* vt = lds + AT_V + F.wave * 4096;
    const int lane = F.lane, qi = lane & 31, hi = lane >> 5;
    for (int unit = F.vcu; unit < NB * NH * (SEQ / 512); unit += F.G) {
        const int sp = unit & 15, h = (unit >> 4) & 7, b = unit >> 7;
        const int tb = b * SEQ, P0 = 512 * sp;
#pragma unroll 1
        for (int g = 0; g < 3; ++g) {
            const int dl = g == 0 ? 1 : (g == 1 ? 4 : 16), L = SEQ / dl;
#pragma unroll 1
            for (int xx = 0; xx < 2; ++xx) {
                const int x = F.wave + 8 * xx;
                int rho, nq0, qp0, qst;
                if (g == 0) { rho = 0; nq0 = P0 + 32 * x; qp0 = 32 * x; qst = 1; }
                else if (g == 1) { rho = x & 3; nq0 = P0 / 4 + 32 * (x >> 2); qp0 = rho + 128 * (x >> 2); qst = 4; }
                else { rho = x; nq0 = P0 / 16; qp0 = rho; qst = 16; }
                f32x16 o[2]; float m, l;
                attn_tile(P.Q, P.K, P.V, tb, h, rho, dl, nq0, L, vt, lane, o, m, l);
                const int qpos = qp0 + qst * qi;
                LAS unsigned char* orow = lds + AT_OACC + qpos * 128 + 8 * hi;
                LAS f32x2* ml = (LAS f32x2*)(lds + AT_ML) + qpos;
                float w2 = frcp(l), w1 = 0.f;
                if (g > 0) { const f32x2 old = *ml; const float mN = fmaxf(old.x, m); const float a1 = old.y * fexp2(old.x - mN), a2 = fexp2(m - mN); const float lN = a1 + l * a2, rl = frcp(lN);
                    w1 = a1 * rl; w2 = a2 * rl; m = mN; l = lN; }
#pragma unroll
                for (int dh = 0; dh < 2; ++dh)
#pragma unroll
                    for (int gq = 0; gq < 4; ++gq) {
                        LAS u32x2* p = (LAS u32x2*)(orow + (32 * dh + 8 * gq) * 2);
                        float v0 = o[dh][4 * gq] * w2, v1 = o[dh][4 * gq + 1] * w2, v2 = o[dh][4 * gq + 2] * w2, v3 = o[dh][4 * gq + 3] * w2;
                        if (g > 0) { const u32x2 ow = *p; v0 += bflo(ow.x) * w1; v1 += bfhi(ow.x) * w1; v2 += bflo(ow.y) * w1; v3 += bfhi(ow.y) * w1; }
                        u32x2 nw; nw.x = pg8::cvt_pk_bf16(v0, v1); nw.y = pg8::cvt_pk_bf16(v2, v3); *p = nw;
                    }
                if (hi == 0) *ml = (f32x2){m, l};
            }
            __syncthreads();
        }
#pragma unroll
        for (int i = 0; i < 8; ++i) { const int c = i * 512 + F.tid, q = c >> 3, ch = c & 7;
            *(GAS u32x4*)(P.O + (size_t)(tb + P0 + q) * AW + h * HD + 8 * ch) = *(const LAS u32x4*)(lds + AT_OACC + q * 128 + ch * 16); }
        __syncthreads();
    }
}

struct MixG { f32x4 ga0, ga1, gr0, gr1; };
DI MixG mix_gains(Frame& F) { const int lane = lane_id(); return MixG{*(const f32x4*)(F.in[3] + 8 * lane), *(const f32x4*)(F.in[3] + 8 * lane + 4), *(const f32x4*)(F.in[11] + 8 * lane), *(const f32x4*)(F.in[11] + 8 * lane + 4)}; }
DI void mix_pair(Frame& F, const MixG& g, int tA, int tB) {
    const bf16* AT = (const bf16*)(F.ws + WS_ATTN); const bf16* HFp = (const bf16*)(F.ws + WS_HF); const bf16* HBp = (const bf16*)(F.ws + WS_REC); const bf16* Gp = (const bf16*)(F.ws + WS_Q + 4 * SEG_BYTES);
    bf16* MX = (bf16*)(F.ws + WS_MIX); const int lane = lane_id();
    u32x4 a[2], hf[2], hb[2], gg[2];
#pragma unroll
    for (int u = 0; u < 2; ++u) { const size_t o = (size_t)(u ? tB : tA) * 512 + 8 * lane;
        a[u] = *(const GAS u32x4*)(AT + o); hf[u] = *(const GAS u32x4*)(HFp + o); hb[u] = *(const GAS u32x4*)(HBp + o); gg[u] = *(const GAS u32x4*)(Gp + o); }
#pragma unroll
    for (int u = 0; u < 2; ++u) {
        const int t = u ? tB : tA;
        float av[8] = {bflo(a[u].x), bfhi(a[u].x), bflo(a[u].y), bfhi(a[u].y), bflo(a[u].z), bfhi(a[u].z), bflo(a[u].w), bfhi(a[u].w)};
        float rv[8] = {(bflo(hf[u].x) + bflo(hb[u].x)) * bflo(gg[u].x), (bfhi(hf[u].x) + bfhi(hb[u].x)) * bfhi(gg[u].x), (bflo(hf[u].y) + bflo(hb[u].y)) * bflo(gg[u].y), (bfhi(hf[u].y) + bfhi(hb[u].y)) * bfhi(gg[u].y),
                       (bflo(hf[u].z) + bflo(hb[u].z)) * bflo(gg[u].z), (bfhi(hf[u].z) + bfhi(hb[u].z)) * bfhi(gg[u].z), (bflo(hf[u].w) + bflo(hb[u].w)) * bflo(gg[u].w), (bfhi(hf[u].w) + bfhi(hb[u].w)) * bfhi(gg[u].w)};
        float sa = 0.f, sr = 0.f;
#pragma unroll
        for (int i = 0; i < 8; ++i) { sa += av[i] * av[i]; sr += rv[i] * rv[i]; }
        sa = wave_sum(sa); sr = wave_sum(sr);
        const float ra = 1.0f / sqrtf(sa * (1.f / 512.f) + LN_EPS), rr = 1.0f / sqrtf(sr * (1.f / 512.f) + LN_EPS);
        u32x4 oa, orr;
        oa.x = pk2(av[0] * ra * g.ga0.x, av[1] * ra * g.ga0.y); oa.y = pk2(av[2] * ra * g.ga0.z, av[3] * ra * g.ga0.w); oa.z = pk2(av[4] * ra * g.ga1.x, av[5] * ra * g.ga1.y); oa.w = pk2(av[6] * ra * g.ga1.z, av[7] * ra * g.ga1.w);
        orr.x = pk2(rv[0] * rr * g.gr0.x, rv[1] * rr * g.gr0.y); orr.y = pk2(rv[2] * rr * g.gr0.z, rv[3] * rr * g.gr0.w); orr.z = pk2(rv[4] * rr * g.gr1.x, rv[5] * rr * g.gr1.y); orr.w = pk2(rv[6] * rr * g.gr1.z, rv[7] * rr * g.gr1.w);
        *(GAS u32x4*)(MX + (size_t)t * D + 8 * lane) = oa; *(GAS u32x4*)(MX + (size_t)t * D + AW + 8 * lane) = orr;
    }
}
DI void mix_phase(Frame& F) {
    const int gw = F.vcu * NWAVES + F.wave, NGW = F.G * NWAVES; const MixG g = mix_gains(F);
    for (int t0 = gw; t0 < T; t0 += 2 * NGW) mix_pair(F, g, t0, t0 + NGW);
}
template <bool PASS2>
DI void scan_phase(Frame& F, const ScanP& P, int it_lo, int it_hi) {
    LAS unsigned char* ut = F.lds + F.wave * 16640;
    LAS float* scr = (LAS float*)(F.lds + F.wave * 16640);
    const int gw = F.vcu * NWAVES + F.wave, NGW = F.G * NWAVES;
    const bool conv_first = F.wave < 4;
    const bool wg_units = PASS2 && (F.G * NWAVES == NB * 8 * NCH);
    if (conv_first) convert_items(F, it_lo, it_hi, scr);
    for (int u = gw; u < NB * 8 * NCH; u += NGW) {
        int j = u % NCH, n = (u / NCH) & 7, b = u / (NCH * 8);
        if (wg_units) { b = F.vcu / NCH; j = F.vcu % NCH; n = F.wave; }
        scan_sweep<0, PASS2>(P, b, n, j, ut, F.lane);
        scan_sweep<1, PASS2>(P, b, n, j, ut, F.lane);
    }
    if (!conv_first) convert_items(F, it_lo, it_hi, scr);
    if (wg_units) {
        VM_WAIT(); __syncthreads();
        const MixG g = mix_gains(F); const int t0 = (F.vcu / NCH) * SEQ + (F.vcu % NCH) * LCH + F.wave * 16;
#pragma unroll 1
        for (int i = 0; i < 16; i += 2) mix_pair(F, g, t0 + i, t0 + i + 1);
    }
}

DI void ln1_phase(Frame& F) {
    const bf16* Yb = (const bf16*)(F.ws + WS_V1); const float* X = F.in[0]; bf16* X1B = (bf16*)(F.ws + WS_X1B); unsigned char* X1F8 = F.ws + WS_HF;
    const int gw = F.vcu * NWAVES + F.wave, NGW = F.G * NWAVES, lane = F.lane;
    f32x4 gg[4], bb[4];
#pragma unroll
    for (int j = 0; j < 4; ++j) { gg[j] = *(const f32x4*)(F.in[13] + 4 * lane + 256 * j); bb[j] = *(const f32x4*)(F.in[14] + 4 * lane + 256 * j); }
    for (int t0 = gw; t0 < T; t0 += 2 * NGW) {
        f32x4 v[2][4]; u32x2 yv[2][4];
#pragma unroll
        for (int u = 0; u < 2; ++u) { const GAS f32x4* xr = (const GAS f32x4*)(X + (size_t)(t0 + u * NGW) * D) + lane; const GAS u32x2* yr = (const GAS u32x2*)(Yb + (size_t)(t0 + u * NGW) * D) + lane;
#pragma unroll
            for (int j = 0; j < 4; ++j) { v[u][j] = xr[64 * j]; yv[u][j] = yr[64 * j]; } }
#pragma unroll
        for (int u = 0; u < 2; ++u) {
            const int t = t0 + u * NGW; float s = 0.f;
#pragma unroll
            for (int j = 0; j < 4; ++j) { v[u][j] = v[u][j] * ALPHA + (f32x4){bflo(yv[u][j].x), bfhi(yv[u][j].x), bflo(yv[u][j].y), bfhi(yv[u][j].y)}; s += (v[u][j].x + v[u][j].y) + (v[u][j].z + v[u][j].w); }
            const float mean = wave_sum(s) * (1.f / D); float s2 = 0.f;
#pragma unroll
            for (int j = 0; j < 4; ++j) { v[u][j] = v[u][j] - mean; s2 += (v[u][j].x * v[u][j].x + v[u][j].y * v[u][j].y) + (v[u][j].z * v[u][j].z + v[u][j].w * v[u][j].w); }
            const float rstd = 1.f / sqrtf(wave_sum(s2) * (1.f / D) + LN_EPS);
            GAS u32x2* o2 = (GAS u32x2*)(X1B + (size_t)t * D) + lane;
#pragma unroll
            for (int j = 0; j < 4; ++j) { const f32x4 y = v[u][j] * rstd * gg[j] + bb[j]; u32x2 w; w.x = pk2(y.x, y.y); w.y = pk2(y.z, y.w); o2[64 * j] = w;
                int q = __builtin_amdgcn_cvt_pk_fp8_f32(y.x, y.y, 0, false); q = __builtin_amdgcn_cvt_pk_fp8_f32(y.z, y.w, q, true); *(GAS unsigned*)(X1F8 + (size_t)t * D + 4 * lane + 256 * j) = (unsigned)q; }
        }
    }
}
template <bool DRY>
DI void route_phase(Frame& F, int it_lo, int it_hi) {
    LAS float* cscr = (LAS float*)(F.lds + 8192 + F.wave * 16640);
    if (!DRY && F.wave < 4) convert_items(F, it_lo, it_hi, cscr);
    const bool opaque = DRY && (__hip_atomic_load((unsigned*)(F.ctl + CW_TMO), RLX_AGENT) == 0xdeadbeefu);
    const float* LG = (const float*)(F.ws + WS_LOGITS); const float* rbias = F.in[16];
    unsigned* ER = (unsigned*)(F.ws + WS_ER); float* GW = (float*)(F.ws + WS_GW); int* slot_tok = (int*)(F.ws + WS_SLOTTOK);
    LAS unsigned* hist = (LAS unsigned*)(F.lds); LAS unsigned* base = hist + 256; LAS unsigned* erl = hist + 512;
    const int lane = F.lane, tid = F.tid;
    if (!DRY) for (int i = F.vcu * 512 + tid; i < MAXSLOTS; i += F.G * 512) slot_tok[i] = 0;
    if (tid < 256) hist[tid] = 0u;
    __syncthreads();
    const int TPW = T / F.G;
    const f32x4 bi = ((const f32x4*)rbias)[lane];
    const float NEGINF = -__builtin_huge_valf();
    f32x4 nl0, nl1;
    { const int t = F.vcu * TPW + F.wave; nl0 = ((const GAS f32x4*)(LG + (size_t)t * NE))[lane]; nl1 = ((const GAS f32x4*)(LG + (size_t)T * NE + (size_t)t * NE))[lane]; }
    for (int i = F.wave; i < TPW; i += NWAVES) {
        const int t = F.vcu * TPW + i;
        const f32x4 lg = nl0 + nl1;
        { const int tn = F.vcu * TPW + ((i + NWAVES < TPW) ? i + NWAVES : i); nl0 = ((const GAS f32x4*)(LG + (size_t)tn * NE))[lane]; nl1 = ((const GAS f32x4*)(LG + (size_t)T * NE + (size_t)tn * NE))[lane]; }
        const float s0 = 1.f / (1.f + expf(-lg.x)), s1 = 1.f / (1.f + expf(-lg.y)), s2 = 1.f / (1.f + expf(-lg.z)), s3 = 1.f / (1.f + expf(-lg.w));
        float v0 = s0 + bi.x, v1 = s1 + bi.y, v2 = s2 + bi.z, v3 = s3 + bi.w;
        const float hi1 = fmaxf(v0, v1), lo1 = fminf(v0, v1), hi2 = fmaxf(v2, v3), lo2 = fminf(v2, v3);
        float m1 = fmaxf(hi1, hi2), m2 = fmaxf(fminf(hi1, hi2), fmaxf(lo1, lo2));
#pragma unroll
        for (int o = 1; o < 8; o <<= 1) { const float o1 = __shfl_xor(m1, o), o2 = __shfl_xor(m2, o); const float n1 = fmaxf(m1, o1), n2 = fmaxf(fminf(m1, o1), fmaxf(m2, o2)); m1 = n1; m2 = n2; }
        const float gs = m1 + m2; const int myg = lane >> 3; int rank = 0;
#pragma unroll
        for (int j = 0; j < 8; ++j) { const float gj = __shfl(gs, 8 * j); rank += (gj > gs || (gj == gs && j < myg)) ? 1 : 0; }
        if (rank >= 4) { v0 = NEGINF; v1 = NEGINF; v2 = NEGINF; v3 = NEGINF; }
        int me = 0; float mg = 0.f, gsum = 0.f;
#pragma unroll
        for (int k = 0; k < 8; ++k) {
            const float lm = fmaxf(fmaxf(v0, v1), fmaxf(v2, v3)), wm = wave_max_fast(lm);
            int cand = 1 << 20;
            if (v3 == wm) cand = 4 * lane + 3;
            if (v2 == wm) cand = 4 * lane + 2;
            if (v1 == wm) cand = 4 * lane + 1;
            if (v0 == wm) cand = 4 * lane + 0;
            const int e = wave_min_i_fast(cand), el = e >> 2, ei = e & 3;
            const float mysc = ei == 0 ? s0 : (ei == 1 ? s1 : (ei == 2 ? s2 : s3));
            const float sc = __shfl(mysc, el);
            if (lane == el) { if (ei == 0) v0 = NEGINF; else if (ei == 1) v1 = NEGINF; else if (ei == 2) v2 = NEGINF; else v3 = NEGINF; }
            me = (lane == k) ? e : me; mg = (lane == k) ? sc : mg; gsum += sc;
        }
        if (lane < 8) { const unsigned lr = __hip_atomic_fetch_add(hist + me, 1u, __ATOMIC_RELAXED, __HIP_MEMORY_SCOPE_WORKGROUP); erl[i * 8 + lane] = ((unsigned)me << 24) | lr; if (!DRY || opaque) GW[(size_t)t * 8 + lane] = mg / gsum * 2.5f; }
    }
    __syncthreads();
    if (tid < 256) base[tid] = DRY ? 0u : atomicAdd((unsigned*)(F.ctl + CW_CNT) + tid, hist[tid]);
    __syncthreads();
    if (!DRY) for (int i = tid; i < TPW * 8; i += 512) { const unsigned er = erl[i]; ER[(size_t)F.vcu * TPW * 8 + i] = er + base[er >> 24]; }
    __syncthreads();
    if (!DRY && F.wave >= 4) convert_items(F, it_lo, it_hi, cscr);
}
DI void slot_phase(Frame& F) {
    const unsigned* ER = (const unsigned*)(F.ws + WS_ER); const float* GW = (const float*)(F.ws + WS_GW);
    unsigned* TS = (unsigned*)(F.ws + WS_TS); int* slot_tok = (int*)(F.ws + WS_SLOTTOK); float* slot_w = (float*)(F.ws + WS_SLOTW); int* tile_e = (int*)(F.ws + WS_TILEE);
    LAS int* tb = (LAS int*)(F.lds); LAS int* tmp = tb + 512;
    const int tid = F.tid;
    int nt_e = 0;
    if (tid < 256) { nt_e = ((int)__hip_atomic_load((unsigned*)(F.ctl + CW_CNT) + tid, RLX_AGENT) + 255) >> 8; tmp[tid] = nt_e; }
    __syncthreads();
    int src = 0;
    for (int o = 1; o < 256; o <<= 1) { if (tid < 256) { int v = tmp[src * 256 + tid]; if (tid >= o) v += tmp[src * 256 + tid - o]; tmp[(src ^ 1) * 256 + tid] = v; } src ^= 1; __syncthreads(); }
    if (tid < 256) tb[tid] = tmp[src * 256 + tid] - nt_e;
    const int NT = tmp[src * 256 + 255];
    __syncthreads();
    if (F.vcu == 0) {
        if (tid == 0) __hip_atomic_store((unsigned*)(F.ctl + CW_NT), (unsigned)NT, RLX_AGENT);
        if (tid < 256) for (int tl = tb[tid]; tl < tb[tid] + nt_e; ++tl) tile_e[tl] = tid;
        for (int i = tid; i < NSHT; i += 512) tile_e[NT + i] = NE;
    }
    for (int i = F.vcu * 512 + tid; i < T; i += F.G * 512) { slot_tok[(size_t)NT * 256 + i] = i; }
    const int TPW = T / F.G;
    for (int i = tid; i < TPW * 8; i += 512) {
        const size_t gi = (size_t)F.vcu * TPW * 8 + i; const unsigned er = ER[gi]; const int e = er >> 24, rk = er & 0xffffff;
        const int slot = tb[e] * 256 + rk;
        slot_tok[slot] = (int)(gi >> 3); slot_w[slot] = GW[gi]; TS[gi] = (unsigned)slot;
    }
}
DI void acc_fp8x4(unsigned w, f32x4& v) { const f32x2 a = __builtin_amdgcn_cvt_pk_f32_fp8((int)w, false), b = __builtin_amdgcn_cvt_pk_f32_fp8((int)w, true); v.x += a.x; v.y += a.y; v.z += b.x; v.w += b.y; }
template <bool STORE>
DI void final_phase(Frame& F) {
    const bool opaque = !STORE && (__hip_atomic_load((unsigned*)(F.ctl + CW_TMO), RLX_AGENT) == 0xdeadbeefu);
    const unsigned char* Y = (const unsigned char*)(F.ws + WS_Y); const unsigned* TS = (const unsigned*)(F.ws + WS_TS); const bf16* X1B = (const bf16*)(F.ws + WS_X1B);
    const size_t shslot0 = (size_t)__hip_atomic_load((unsigned*)(F.ctl + CW_NT), RLX_AGENT) * 256;
    const int gw = F.vcu * NWAVES + F.wave, NGW = F.G * NWAVES, lane = F.lane;
    const int cb = 256 * (lane >> 4) + 32 * ((lane >> 2) & 3) + 8 * (lane & 3);
    f32x4 gg[4], bb[4];
#pragma unroll
    for (int bj = 0; bj < 2; ++bj)
#pragma unroll
        for (int hh = 0; hh < 2; ++hh) { gg[2 * bj + hh] = *(const f32x4*)(F.in[23] + cb + 128 * bj + 4 * hh); bb[2 * bj + hh] = *(const f32x4*)(F.in[24] + cb + 128 * bj + 4 * hh); }
    for (int t0 = gw; t0 < T; t0 += 8 * NGW) {
        const int ti = lane >> 3; const int tt = t0 + ti * NGW;
        const unsigned myslot = (tt < T) ? TS[(size_t)tt * 8 + (lane & 7)] : 0u;
#pragma unroll 1
        for (int i = 0; i < 8; ++i) {
            const int t = t0 + i * NGW; if (t >= T) break;
            float* xr = F.out + (size_t)t * D + cb;
            f32x4 v[4];
#pragma unroll
            for (int bj = 0; bj < 2; ++bj) { const u32x4 w = *(const GAS u32x4*)(X1B + (size_t)t * D + cb + 128 * bj);
                v[2 * bj] = (f32x4){bflo(w.x), bfhi(w.x), bflo(w.y), bfhi(w.y)} * ALPHA; v[2 * bj + 1] = (f32x4){bflo(w.z), bfhi(w.z), bflo(w.w), bfhi(w.w)} * ALPHA; }
            u32x4 yv[8]; const u32x4 ysh = ((const GAS u32x4*)(Y + (shslot0 + (size_t)t) * 1024))[lane];
#pragma unroll
            for (int k = 0; k < 8; ++k) { const unsigned slot = __shfl(myslot, i * 8 + k); yv[k] = ((const GAS u32x4*)(Y + (size_t)slot * 1024))[lane]; }
            f32x4 a[4];
#pragma unroll
            for (int j = 0; j < 4; ++j) a[j] = (f32x4){0.f, 0.f, 0.f, 0.f};
#pragma unroll
            for (int k = 0; k < 8; ++k) { acc_fp8x4(yv[k].x, a[0]); acc_fp8x4(yv[k].y, a[1]); acc_fp8x4(yv[k].z, a[2]); acc_fp8x4(yv[k].w, a[3]); }
            acc_fp8x4(ysh.x, a[0]); acc_fp8x4(ysh.y, a[1]); acc_fp8x4(ysh.z, a[2]); acc_fp8x4(ysh.w, a[3]);
#pragma unroll
            for (int j = 0; j < 4; ++j) v[j] = v[j] + a[j] * (1.0f / YSCALE);
            float s = 0.f;
#pragma unroll
            for (int j = 0; j < 4; ++j) s += (v[j].x + v[j].y) + (v[j].z + v[j].w);
            const float mean = wave_sum(s) * (1.f / D); float s2 = 0.f;
#pragma unroll
            for (int j = 0; j < 4; ++j) { v[j] = v[j] - mean; s2 += (v[j].x * v[j].x + v[j].y * v[j].y) + (v[j].z * v[j].z + v[j].w * v[j].w); }
            const float rstd = 1.f / sqrtf(wave_sum(s2) * (1.f / D) + LN_EPS);
            if (STORE || opaque) {
#pragma unroll
                for (int bj = 0; bj < 2; ++bj) { *(GAS f32x4*)(xr + 128 * bj) = v[2 * bj] * rstd * gg[2 * bj] + bb[2 * bj]; *(GAS f32x4*)(xr + 128 * bj + 4) = v[2 * bj + 1] * rstd * gg[2 * bj + 1] + bb[2 * bj + 1]; } }
        }
    }
}

#ifndef REPMASK
#define REPMASK 0
#endif
constexpr int N_PHASES = 13;
constexpr int XC_P1 = (XI_ALL * 37 / 100) & ~2047, XC_P2 = (XI_ALL * 57 / 100) & ~2047, XC_P3 = (XI_ALL * 87 / 100) & ~2047;
struct Args { const float* in[25]; float* out; unsigned char* ws; int ph_lo, ph_hi, li, pad; };
DI void ph1_part(Frame& F, int i0, int i1) {
    unsigned char* ws = F.ws;
    SchedDense S{(const bf16*)(ws + WS_XB), (const bf16*)(ws + WS_WINT), D, D, T / 256, INW / 256, F.G, (int)blockIdx.x, i0, i1};
    EpiInProj E{(bf16*)(ws + WS_Q), (const float*)(ws + WS_ROPE)};
    pg8::gemm_phase<EpiInProj, SchedDense, true>(F.lds + RING_OFF, S, E, D);
}
DI void ph1(Frame& F) {
    LAS float* scr = (LAS float*)(F.lds + F.wave * 16640);
    const int grp = F.vcu % 3;
    if (grp == 0) { convert_items(F, 0, XC_P1, scr); __syncthreads(); }
    ph1_part(F, 0, 2);
    if (grp == 1) { __syncthreads(); convert_items(F, 0, XC_P1, scr); __syncthreads(); }
    ph1_part(F, 2, 1 << 20);
    if (grp == 2) { __syncthreads(); convert_items(F, 0, XC_P1, scr); }
}
DI ScanP mk_scanp(Frame& F) { unsigned char* ws = F.ws;
    return ScanP{(const bf16*)(ws + WS_Q + 3 * SEG_BYTES), (const bf16*)(ws + WS_GWT), F.in[4], F.in[5], F.in[7], F.in[9],
                 (const float*)(ws + WS_C2), (f32x2*)(ws + WS_CARRY), (bf16*)(ws + WS_HF), (bf16*)(ws + WS_REC)}; }
DI void ph2(Frame& F) {
    unsigned char* ws = F.ws;
    const ScanP SP = mk_scanp(F);
    scan_phase<false>(F, SP, XC_P1, XC_P2);
    if constexpr ((REPMASK >> 14) & 1) { __syncthreads(); scan_phase<false>(F, SP, 0, 0); }
    __syncthreads();
    const AttnP AP{(const bf16*)(ws + WS_Q), (const bf16*)(ws + WS_Q + SEG_BYTES), (const bf16*)(ws + WS_Q + 2 * SEG_BYTES), (bf16*)(ws + WS_ATTN)};
    attn_phase(F, AP);
    if constexpr ((REPMASK >> 13) & 1) { attn_phase(F, AP); }
}
DI void ph3(Frame& F) { const ScanP SP = mk_scanp(F); scan_phase<true>(F, SP, XC_P2, XC_P3); }
DI void ph5(Frame& F) {
    unsigned char* ws = F.ws;
    SchedDense S{(const bf16*)(ws + WS_MIX), (const bf16*)(ws + WS_WOUTT), D, D, T / 256, D / 256, F.G, (int)blockIdx.x, 0, 1 << 20};
    EpiYb E{(bf16*)(ws + WS_V1)};
    pg8::gemm_phase<EpiYb, SchedDense, true>(F.lds + RING_OFF, S, E, D);
}
DI void ph7(Frame& F) {
    unsigned char* ws = F.ws;
    SchedRouter S{(const bf16*)(ws + WS_X1B), (const bf16*)(ws + WS_RTT), D, D, T / 256, F.G, (int)blockIdx.x};
    EpiLogits E{(float*)(ws + WS_LOGITS)};
    pg8::gemm_phase<EpiLogits, SchedRouter, true>(F.lds + RING_OFF, S, E, 512);
}
DI void ph10(Frame& F) {
    unsigned char* ws = F.ws; const int cid = (int)blockIdx.x;
    LAS unsigned* ue = (LAS unsigned*)(F.lds + UT_OFF); LAS unsigned* uidx = (LAS unsigned*)(F.lds + UT_IDX);
    const int NT = (int)__hip_atomic_load((unsigned*)(F.ctl + CW_NT), RLX_AGENT);
    const int nwg = 2 * (NT + NSHT);
    const int* tile_e = (const int*)(ws + WS_TILEE); const int* slot_tok = (const int*)(ws + WS_SLOTTOK);
    __syncthreads();
    {
        unsigned te[11], st[11]; float sw[11]; const float* slot_w = (const float*)(ws + WS_SLOTW); LAS float* uw = (LAS float*)(F.lds + UT_W);
#pragma unroll
        for (int i = 0; i < 11; ++i) { int wgid; const bool ok = pg8::xcd_order(i, F.G, cid, nwg, wgid); const int tile = ok ? (wgid >> 1) : 0;
            te[i] = (unsigned)tile_e[tile]; st[i] = (F.tid < 256) ? (unsigned)slot_tok[(size_t)tile * 256 + F.tid] : 0u; sw[i] = (F.tid < 256 && tile < NT) ? slot_w[(size_t)tile * 256 + F.tid] : 1.0f; }
#pragma unroll
        for (int i = 0; i < 11; ++i) { if (F.tid == 0) ue[i] = te[i]; if (F.tid < 256) { uidx[i * 256 + F.tid] = st[i]; uw[i * 256 + F.tid] = sw[i]; } }
    }
    __syncthreads();
    SchedG1 S{(const bf16*)(ws + WS_HF), (const bf16*)(ws + WS_WGUT), ue, uidx, D / 2, nwg, F.G, cid, (size_t)0};
    EpiSwiglu E{(bf16*)(ws + WS_H), (const LAS float*)(F.lds + UT_W), NT};
    pg8::gemm_phase<EpiSwiglu, SchedG1, true, false, true>(F.lds + RING_OFF, S, E, D / 2);
}
template <bool DRY>
DI void ph11a(Frame& F) {
    unsigned char* ws = F.ws; const int cid = (int)blockIdx.x;
    LAS unsigned* ue = (LAS unsigned*)(F.lds + UT_OFF);
    const int NT = (int)__hip_atomic_load((unsigned*)(F.ctl + CW_NT), RLX_AGENT);
    const int* tile_e = (const int*)(ws + WS_TILEE);
    const int nwg = 4 * (NT + NSHT);
    __syncthreads();
    for (int i = F.tid; i < 22; i += NWAVES * 64) { int wgid; if (pg8::xcd_order(i, F.G, cid, nwg, wgid)) ue[i] = (unsigned)tile_e[wgid >> 2]; }
    __syncthreads();
    SchedG2 S{(const bf16*)(ws + WS_H), (const bf16*)(ws + WS_WDT), ue, EH, nwg, F.G, cid, 0, (size_t)0};
    EpiDownY E{(unsigned char*)(ws + WS_Y), DRY && (__hip_atomic_load((unsigned*)(F.ctl + CW_TMO), RLX_AGENT) != 0xdeadbeefu)};
    pg8::gemm_phase<EpiDownY, SchedG2, true, false>(F.lds + RING_OFF, S, E, EH);
}
#ifndef PHMASK
#define PHMASK 0x1fff
#endif
#ifndef REPMASK
#define REPMASK 0
#endif
__global__ void __launch_bounds__(NWAVES * 64, 2) mk_fwd(Args args) {
    extern __shared__ __attribute__((aligned(16))) unsigned char lds_raw[];
    Frame F;
    F.lds = (LAS unsigned char*)lds_raw;
    F.MISC = (volatile LAS unsigned*)(F.lds + MISC_OFF);
    F.tid = threadIdx.x; F.lane = F.tid & 63; F.wave = __builtin_amdgcn_readfirstlane(F.tid >> 6);
    F.G = gridDim.x; { const int bx = blockIdx.x; F.vcu = (F.G % 8 == 0) ? (bx % 8) * (F.G / 8) + bx / 8 : bx; }
    F.ws = args.ws; F.out = args.out; F.ctl = (gu32*)(args.ws + WS_CTL);
#pragma unroll
    for (int i = 0; i < 25; ++i) F.in[i] = args.in[i];
    if (F.tid < 64) F.MISC[F.tid] = 0u;
    __syncthreads();
    XcdBarrier bar = xcd_barrier_post((unsigned*)(F.ctl + CW_BAR) + args.li * XCD_BAR_WORDS, F.MISC + 8);
    const int lo = args.ph_lo, hi = args.ph_hi;
#ifdef REPORT_K
    unsigned long long* tsb = (unsigned long long*)(args.ws + WS_END + 8 * MiB); int nst = 0;
#define STAMP() do { if (blockIdx.x == 0 && F.tid == 0) tsb[nst] = __builtin_amdgcn_s_memrealtime(); ++nst; } while (0)
#else
#define STAMP() do {} while (0)
#endif
    STAMP();
#define IN(k) (((PHMASK >> (k)) & 1) && lo <= (k) && (k) < hi)
#define REP(k) if constexpr (((REPMASK) >> (k)) & 1)
#define SEAM(k) do { if (IN(k) && IN((k) + 1)) xcd_barrier(bar); STAMP(); } while (0)
    if (IN(0)) { p0_prologue(F); REP(0) { __syncthreads(); p0_prologue(F); } } SEAM(0);
    if (IN(1)) { ph1(F); REP(1) ph1(F); } SEAM(1);
    if (IN(2)) { ph2(F); REP(2) ph2(F); } SEAM(2);
    if (IN(3)) { ph3(F); REP(3) ph3(F); } SEAM(3);
    const bool fused_mix = (F.G * NWAVES == NB * 8 * NCH);
    if (IN(4) && !fused_mix) { mix_phase(F); } if (!fused_mix) SEAM(4);
    if (IN(5)) { ph5(F); REP(5) ph5(F); } SEAM(5);
    if (IN(6)) { ln1_phase(F); REP(6) ln1_phase(F); } SEAM(6);
    if (IN(7)) { ph7(F); REP(7) ph7(F); } SEAM(7);
    if (IN(8)) { REP(8) { route_phase<true>(F, 0, 0); } route_phase<false>(F, XC_P3, XI_ALL); } SEAM(8);
    if (IN(9)) { slot_phase(F); REP(9) { __syncthreads(); slot_phase(F); } } SEAM(9);
    if (IN(10)) { ph10(F); REP(10) ph10(F); } SEAM(10);
    if (IN(11)) { REP(11) ph11a<true>(F); ph11a<false>(F); } SEAM(11);
    if (IN(12)) { REP(12) { final_phase<false>(F); } final_phase<true>(F); }
    STAMP();
#undef IN
#undef REP
#undef SEAM
}

#if defined(SELFCHECK) && SELFCHECK
namespace chk {
constexpr int NS = 64;
struct InP { const float* p[25]; };
__host__ __device__ inline int samp_tok(int i) { return i == 0 ? 0 : i == 1 ? 8191 : i == 2 ? 8192 : i == 3 ? T - 1 : i == 4 ? 63 : i == 5 ? 64 : i == 6 ? 8127 : i == 7 ? 16384 + 4095 : (int)(((long)i * 2039 + 17 * (i % 5)) % T); }
DI void put_err(unsigned* CHK, int stage, float num, float den) { float e = sqrtf(num / (den + 1e-30f)); if (!(e == e)) e = 1e30f; atomicMax(CHK + stage, __float_as_uint(e)); }
DI float blk_sum(float v, float* red) {
    v = wave_sum(v); __syncthreads(); if ((threadIdx.x & 63) == 0) red[threadIdx.x >> 6] = v; __syncthreads(); return red[0] + red[1] + red[2] + red[3]; }
__global__ void __launch_bounds__(256) c1(const float* x, const int* pos, const float* w_in, const unsigned char* ws, unsigned* CHK) {
    __shared__ float hrow[INW]; __shared__ float red[4];
    const int t = samp_tok(blockIdx.x), tid = threadIdx.x;
    for (int c = tid; c < INW; c += 256) { float a = 0.f; for (int k = 0; k < D; ++k) a = fmaf(x[(size_t)t * D + k], w_in[(size_t)k * INW + c], a); hrow[c] = a; }
    __syncthreads();
    if (tid < 128) { const int i = tid & 7, head = (tid >> 3) & 7, which = tid >> 6;
        const float invf[8] = {1.0f, 0x1.8d275ep-3f, 0x1.341190p-5f, 0x1.ddee9cp-8f, 0x1.72ba44p-10f, 0x1.1f91f0p-12f, 0x1.be218ap-15f, 0x1.5a0f50p-17f};
        float inv = invf[0];
#pragma unroll
        for (int j = 1; j < 8; ++j) inv = (i == j) ? invf[j] : inv;
        float c, s; sincos_acc((float)pos[t] * inv, c, s);
        float* p = hrow + which * AW + head * HD; const float t1 = p[i], t2 = p[i + 8]; p[i] = t1 * c - t2 * s; p[i + 8] = t2 * c + t1 * s; }
    __syncthreads();
    float num = 0.f, den = 0.f;
    for (int c = tid; c < INW; c += 256) { const int seg = c >> 9; float r = hrow[c]; if (seg == 0) r *= QSCALE; if (seg == 4) r = gelu_tanh(r);
        const float f = bf2f(((const bf16*)(ws + WS_Q + (size_t)seg * SEG_BYTES))[(size_t)t * 512 + (c & 511)]); num += (f - r) * (f - r); den += r * r; }
    num = blk_sum(num, red); den = blk_sum(den, red);
    if (tid == 0) put_err(CHK, 1, num, den);
}
__global__ void __launch_bounds__(64) c2(const unsigned char* ws, unsigned* CHK) {
    const bf16* Q = (const bf16*)(ws + WS_Q); const bf16* K = (const bf16*)(ws + WS_Q + SEG_BYTES); const bf16* V = (const bf16*)(ws + WS_Q + 2 * SEG_BYTES); const bf16* O = (const bf16*)(ws + WS_ATTN);
    const int lane = threadIdx.x, head = blockIdx.x & 7, t = samp_tok(blockIdx.x >> 3), b = t / SEQ, s = t % SEQ;
    const float q = bf2f(Q[(size_t)t * AW + head * HD + lane]);
    float m = -1e30f, den = 0.f, o = 0.f;
    for (int g = 0; g < 3; ++g) { const int d = g == 0 ? 1 : (g == 1 ? 4 : 16);
        for (int mm = -64; mm <= 64; ++mm) { const int j = s + d * mm; if (j < 0 || j >= SEQ) continue;
            const size_t row = (size_t)(b * SEQ + j) * AW + head * HD + lane;
            const float sc = wave_sum(q * bf2f(K[row])); const float mn = fmaxf(m, sc), al = exp2f(m - mn), p = exp2f(sc - mn);
            den = den * al + p; o = o * al + p * bf2f(V[row]); m = mn; } }
    const float r = o / den, f = bf2f(O[(size_t)t * AW + head * HD + lane]);
    const float num = wave_sum((f - r) * (f - r)), dn = wave_sum(r * r);
    if (lane == 0) put_err(CHK, 2, num, dn);
}
__global__ void __launch_bounds__(64) c3(InP ip, const unsigned char* ws, float* scratch, unsigned* CHK) {
    const float* cw = ip.p[4]; const float* cb = ip.p[5]; const float* gaw = ip.p[6]; const float* gab = ip.p[7]; const float* gxw = ip.p[8]; const float* gxb = ip.p[9]; const float* lam = ip.p[10];
    const bf16* RX = (const bf16*)(ws + WS_Q + 3 * SEG_BYTES); const bf16* G = (const bf16*)(ws + WS_Q + 4 * SEG_BYTES); const bf16* HFp = (const bf16*)(ws + WS_HF); const bf16* HBp = (const bf16*)(ws + WS_REC);
    const int lane = threadIdx.x, smp = blockIdx.x, b = smp & 3, c = (smp * 37 + 5) % RW, n = c >> 6, j = c & 63;
    float* sc = scratch + (size_t)smp * SEQ * 4;
    for (int s = lane; s < SEQ; s += 64) {
        float pa0 = 0.f, pa1 = 0.f, px0 = 0.f, px1 = 0.f, uc = 0.f;
        for (int i = 0; i < 64; ++i) { const int ci = 64 * n + i; float u = cb[ci];
            for (int k = 0; k < 4; ++k) { const int ss = s + k - 2; if (ss >= 0 && ss < SEQ) u = fmaf(cw[k * RW + ci], bf2f(RX[(size_t)(b * SEQ + ss) * RW + ci]), u); }
            if (i == j) uc = u;
            pa0 = fmaf(u, gaw[(((size_t)0 * 8 + n) * 64 + i) * 64 + j], pa0); px0 = fmaf(u, gxw[(((size_t)0 * 8 + n) * 64 + i) * 64 + j], px0);
            pa1 = fmaf(u, gaw[(((size_t)1 * 8 + n) * 64 + i) * 64 + j], pa1); px1 = fmaf(u, gxw[(((size_t)1 * 8 + n) * 64 + i) * 64 + j], px1); }
        { const float r = 1.f / (1.f + expf(-(pa0 + gab[c]))), ig = 1.f / (1.f + expf(-(px0 + gxb[c])));
          const float l = lam[c], sp = log1pf(expf(-l)), log_a = -8.0f * r * sp, a = expf(log_a);
          sc[(size_t)s * 4 + 0] = a; sc[(size_t)s * 4 + 1] = sqrtf(-expm1f(2.0f * log_a)) * ig * uc; }
        { const float r = 1.f / (1.f + expf(-(pa1 + gab[RW + c]))), ig = 1.f / (1.f + expf(-(px1 + gxb[RW + c])));
          const float l = lam[RW + c], sp = log1pf(expf(-l)), log_a = -8.0f * r * sp, a = expf(log_a);
          sc[(size_t)s * 4 + 2] = a; sc[(size_t)s * 4 + 3] = sqrtf(-expm1f(2.0f * log_a)) * ig * uc; }
    }
    __syncthreads();
    if (lane == 0) { float h = 0.f; for (int s = 0; s < SEQ; ++s) { h = fmaf(sc[(size_t)s * 4], h, sc[(size_t)s * 4 + 1]); sc[(size_t)s * 4 + 1] = h; } }
    if (lane == 1) { float h = 0.f; for (int s = SEQ - 1; s >= 0; --s) { h = fmaf(sc[(size_t)s * 4 + 2], h, sc[(size_t)s * 4 + 3]); sc[(size_t)s * 4 + 3] = h; } }
    __syncthreads();
    float num = 0.f, den = 0.f;
    for (int s = lane; s < SEQ; s += 64) { const size_t o = (size_t)(b * SEQ + s) * RW + c; const float r = (sc[(size_t)s * 4 + 1] + sc[(size_t)s * 4 + 3]) * bf2f(G[o]), f = (bf2f(HFp[o]) + bf2f(HBp[o])) * bf2f(G[o]); num += (f - r) * (f - r); den += r * r; }
    num = wave_sum(num); den = wave_sum(den);
    if (lane == 0) put_err(CHK, 3, num, den);
}
__global__ void __launch_bounds__(256) c4(const float* ga, const float* gr, const unsigned char* ws, unsigned* CHK) {
    __shared__ float red[4];
    const bf16* AT = (const bf16*)(ws + WS_ATTN); const bf16* HFp = (const bf16*)(ws + WS_HF); const bf16* HBp = (const bf16*)(ws + WS_REC); const bf16* Gp = (const bf16*)(ws + WS_Q + 4 * SEG_BYTES); const bf16* MX = (const bf16*)(ws + WS_MIX);
    const int t = samp_tok(blockIdx.x), tid = threadIdx.x;
    float av[2], rv[2], sa = 0.f, sr = 0.f;
    for (int i = 0; i < 2; ++i) { const int c = tid + 256 * i; av[i] = bf2f(AT[(size_t)t * AW + c]); rv[i] = (bf2f(HFp[(size_t)t * RW + c]) + bf2f(HBp[(size_t)t * RW + c])) * bf2f(Gp[(size_t)t * RW + c]); sa += av[i] * av[i]; sr += rv[i] * rv[i]; }
    sa = blk_sum(sa, red); sr = blk_sum(sr, red);
    const float ra = rsqrtf(sa / 512.f + LN_EPS), rr = rsqrtf(sr / 512.f + LN_EPS);
    float num = 0.f, den = 0.f;
    for (int i = 0; i < 2; ++i) { const int c = tid + 256 * i; const float r1 = av[i] * ra * ga[c], r2 = rv[i] * rr * gr[c], f1 = bf2f(MX[(size_t)t * D + c]), f2 = bf2f(MX[(size_t)t * D + AW + c]);
        num += (f1 - r1) * (f1 - r1) + (f2 - r2) * (f2 - r2); den += r1 * r1 + r2 * r2; }
    num = blk_sum(num, red); den = blk_sum(den, red);
    if (tid == 0) put_err(CHK, 4, num, den);
}
__global__ void __launch_bounds__(256) c5(const float* x, const float* w_out, const unsigned char* ws, unsigned* CHK) {
    __shared__ float red[4];
    const bf16* MX = (const bf16*)(ws + WS_MIX); const bf16* Yb = (const bf16*)(ws + WS_V1);
    const int t = samp_tok(blockIdx.x), tid = threadIdx.x; float num = 0.f, den = 0.f;
    for (int c = tid; c < D; c += 256) { float a = 0.f; for (int k = 0; k < D; ++k) a = fmaf(bf2f(MX[(size_t)t * D + k]), w_out[(size_t)k * D + c], a);
        const float r = a, f = bf2f(Yb[(size_t)t * D + c]); num += (f - r) * (f - r); den += r * r; }
    num = blk_sum(num, red); den = blk_sum(den, red);
    if (tid == 0) put_err(CHK, 5, num, den);
}
__global__ void __launch_bounds__(256) c6(const float* g, const float* bb, const float* x, const unsigned char* ws, unsigned* CHK) {
    __shared__ float red[4];
    const bf16* Yb = (const bf16*)(ws + WS_V1); const bf16* X1B = (const bf16*)(ws + WS_X1B);
    const int t = samp_tok(blockIdx.x), tid = threadIdx.x; float v[4], s = 0.f;
    for (int i = 0; i < 4; ++i) { v[i] = ALPHA * x[(size_t)t * D + tid + 256 * i] + bf2f(Yb[(size_t)t * D + tid + 256 * i]); s += v[i]; }
    const float mu = blk_sum(s, red) / D; float q = 0.f;
    for (int i = 0; i < 4; ++i) { const float d = v[i] - mu; q += d * d; }
    const float rs = rsqrtf(blk_sum(q, red) / D + LN_EPS); float num = 0.f, den = 0.f;
    for (int i = 0; i < 4; ++i) { const int c = tid + 256 * i; const float r = (v[i] - mu) * rs * g[c] + bb[c], f2 = bf2f(X1B[(size_t)t * D + c]);
        num += (f2 - r) * (f2 - r); den += r * r; }
    num = blk_sum(num, red); den = blk_sum(den, red);
    if (tid == 0) put_err(CHK, 6, num, den);
}
__global__ void __launch_bounds__(256) c7(const float* router_w, const unsigned char* ws, unsigned* CHK) {
    __shared__ float red[4];
    const bf16* X1B = (const bf16*)(ws + WS_X1B); const float* LG = (const float*)(ws + WS_LOGITS);
    const int t = samp_tok(blockIdx.x), c = threadIdx.x; float a = 0.f;
    for (int k = 0; k < D; ++k) a = fmaf(bf2f(X1B[(size_t)t * D + k]), router_w[(size_t)k * NE + c], a);
    const float f = LG[(size_t)t * NE + c] + LG[(size_t)T * NE + (size_t)t * NE + c];
    const float num = blk_sum((f - a) * (f - a), red), den = blk_sum(a * a, red);
    if (c == 0) put_err(CHK, 7, num, den);
}
__global__ void __launch_bounds__(64) c8(const float* rbias, const unsigned char* ws, const unsigned* ctl, unsigned* CHK) {
    __shared__ float sc[NE], bs[NE]; __shared__ int sel[8]; __shared__ float gate[8]; __shared__ float gsc[8]; __shared__ int gm[8];
    const float* LG = (const float*)(ws + WS_LOGITS); const unsigned* TS = (const unsigned*)(ws + WS_TS); const int* slot_tok = (const int*)(ws + WS_SLOTTOK);
    const float* slot_w = (const float*)(ws + WS_SLOTW); const int* tile_e = (const int*)(ws + WS_TILEE);
    const int t = samp_tok(blockIdx.x), lane = threadIdx.x;
    for (int e = lane; e < NE; e += 64) { const float l = LG[(size_t)t * NE + e] + LG[(size_t)T * NE + (size_t)t * NE + e]; sc[e] = 1.f / (1.f + expf(-l)); bs[e] = sc[e] + rbias[e]; }
    __syncthreads();
    if (lane == 0) {
        for (int g = 0; g < 8; ++g) { float a = -1e30f, b2 = -1e30f; for (int i = 0; i < 32; ++i) { const float v = bs[32 * g + i]; if (v > a) { b2 = a; a = v; } else if (v > b2) b2 = v; } gsc[g] = a + b2; gm[g] = 0; }
        for (int k = 0; k < 4; ++k) { int best = -1; for (int g = 0; g < 8; ++g) if (!gm[g] && (best < 0 || gsc[g] > gsc[best])) best = g; gm[best] = 1; }
        float sum = 0.f;
        for (int k = 0; k < 8; ++k) { int best = -1; for (int e = 0; e < NE; ++e) { if (!gm[e >> 5]) continue; bool used = false; for (int q = 0; q < k; ++q) used |= (sel[q] == e); if (used) continue; if (best < 0 || bs[e] > bs[best]) best = e; } sel[k] = best; sum += sc[best]; }
        for (int k = 0; k < 8; ++k) gate[k] = sc[sel[k]] / sum * 2.5f;
        int bad = 0; const int NT = (int)ctl[CW_NT];
        for (int k = 0; k < 8; ++k) { const unsigned slot = TS[(size_t)t * 8 + k]; const int e = tile_e[slot >> 8];
            if (slot >= (unsigned)NT * 256) { ++bad; continue; }
            if (slot_tok[slot] != t) ++bad;
            int q = -1; for (int k2 = 0; k2 < 8; ++k2) if (sel[k2] == e) q = k2;
            if (q < 0) ++bad; else if (fabsf(slot_w[slot] - gate[q]) > 1e-5f) ++bad; }
        atomicMax(CHK + 8, __float_as_uint((float)bad));
    }
}
DI void samp_slot(int i, const unsigned char* ws, const unsigned* ctl, int& slot, int& e, int& tok) {
    const unsigned* TS = (const unsigned*)(ws + WS_TS); const int* tile_e = (const int*)(ws + WS_TILEE); const int NT = (int)ctl[CW_NT];
    tok = samp_tok(i); if (i >= 32 && (i & 1)) { slot = NT * 256 + tok; e = NE; } else { slot = (int)TS[(size_t)tok * 8 + (i & 7)]; e = tile_e[slot >> 8]; } }
__global__ void __launch_bounds__(256) c9(InP ip, const unsigned char* ws, const unsigned* ctl, unsigned* CHK) {
    __shared__ float red[4];
    int slot, e, tok; samp_slot(blockIdx.x, ws, ctl, slot, e, tok);
    const float* wg = e < NE ? ip.p[17] + (size_t)e * D * EH : ip.p[20]; const float* wu = e < NE ? ip.p[18] + (size_t)e * D * EH : ip.p[21];
    const bf16* X1B = (const bf16*)(ws + WS_X1B); const bf16* Hh = (const bf16*)(ws + WS_H);
    const int c = threadIdx.x; float g = 0.f, u = 0.f;
    for (int k = 0; k < D; ++k) { const float xv = bf2f(X1B[(size_t)tok * D + k]); g = fmaf(xv, wg[(size_t)k * EH + c], g); u = fmaf(xv, wu[(size_t)k * EH + c], u); }
    const float wgt = e < NE ? ((const float*)(ws + WS_SLOTW))[slot] : 1.f; const float r = g / (1.f + expf(-g)) * u * wgt, f = bf2f(Hh[(size_t)slot * EH + c]);
    const float num = blk_sum((f - r) * (f - r), red), den = blk_sum(r * r, red);
    if (c == 0) put_err(CHK, 9, num, den);
}
DI float y_at(const unsigned char* Yb, size_t slot, int c) {
    const int pn = c >> 8, bj = (c >> 7) & 1, wc = (c >> 5) & 3, fq = (c >> 3) & 3, i = c & 7; const unsigned b = Yb[slot * 1024 + ((pn * 4 + wc) * 4 + fq) * 16 + bj * 8 + i];
    const int e = (b >> 3) & 15, m = b & 7; const float mag = e == 0 ? (float)m * 0.001953125f : (1.f + (float)m * 0.125f) * exp2f((float)(e - 7)); return ((b & 128) ? -mag : mag) * (1.0f / YSCALE); }
__global__ void __launch_bounds__(256) c10(InP ip, const unsigned char* ws, const unsigned* ctl, unsigned* CHK) {
    __shared__ float red[4];
    int slot, e, tok; samp_slot(blockIdx.x & 31, ws, ctl, slot, e, tok);
    const float* wd = ip.p[19] + (size_t)e * EH * D; const bf16* Hh = (const bf16*)(ws + WS_H); const unsigned char* Y = (const unsigned char*)(ws + WS_Y);
    float num = 0.f, den = 0.f;
    for (int c = threadIdx.x; c < D; c += 256) { float a = 0.f; for (int k = 0; k < EH; ++k) a = fmaf(bf2f(Hh[(size_t)slot * EH + k]), wd[(size_t)k * D + c], a);
        const float r = a, f = y_at(Y, (size_t)slot, c); num += (f - r) * (f - r); den += r * r; }
    num = blk_sum(num, red); den = blk_sum(den, red);
    if (threadIdx.x == 0) put_err(CHK, 10, num, den);
}
__global__ void __launch_bounds__(256) save_x1b(const unsigned char* ws, bf16* dst) { const bf16* X1B = (const bf16*)(ws + WS_X1B); const int t = samp_tok(blockIdx.x); for (int c = threadIdx.x; c < D; c += 256) dst[(size_t)blockIdx.x * D + c] = X1B[(size_t)t * D + c]; }
__global__ void __launch_bounds__(256) c11(InP ip, const float* out, const unsigned char* ws, const unsigned* ctl, unsigned* CHK, const bf16* x1s) {
    __shared__ float red[4];
    const bf16* Hh = (const bf16*)(ws + WS_H); const unsigned char* Y = (const unsigned char*)(ws + WS_Y); const unsigned* TS = (const unsigned*)(ws + WS_TS);
    const int t = samp_tok(blockIdx.x), tid = threadIdx.x, NT = (int)ctl[CW_NT]; const float* sd = ip.p[22];
    float v[4], s = 0.f;
    for (int i = 0; i < 4; ++i) { const int c = tid + 256 * i; float a = 0.f; for (int k = 0; k < EH; ++k) a = fmaf(bf2f(Hh[((size_t)NT * 256 + t) * EH + k]), sd[(size_t)k * D + c], a);
        a += ALPHA * bf2f(x1s[(size_t)blockIdx.x * D + c]); for (int k = 0; k < 8; ++k) a += y_at(Y, (size_t)TS[(size_t)t * 8 + k], c); v[i] = a; s += a; }
    const float mu = blk_sum(s, red) / D; float q = 0.f;
    for (int i = 0; i < 4; ++i) { const float d = v[i] - mu; q += d * d; }
    const float rs = rsqrtf(blk_sum(q, red) / D + LN_EPS); float num = 0.f, den = 0.f;
    for (int i = 0; i < 4; ++i) { const int c = tid + 256 * i; const float r = (v[i] - mu) * rs * ip.p[23][c] + ip.p[24][c], f = out[(size_t)t * D + c]; num += (f - r) * (f - r); den += r * r; }
    num = blk_sum(num, red); den = blk_sum(den, red);
    if (tid == 0) put_err(CHK, 11, num, den);
}
__global__ void __launch_bounds__(256) verdict(float* out, const unsigned* CHK, const unsigned* ctl) {
    int stage = 0; float err = 0.f;
    for (int s = 1; s <= 11; ++s) { const float e = __uint_as_float(CHK[s]); const float tol = (s == 8) ? 0.5f : (s == 10 ? 0.08f : (s == 9 ? 0.12f : 0.03f)); if (stage == 0 && !(e <= tol)) { stage = s; err = e; } }
    for (int li = 0; li < 16; ++li) if (stage == 0 && ctl[CW_BAR + li * XCD_BAR_WORDS_C + 128] != 0) { stage = 12; err = 1.f; }
    if (stage == 0) return;
    float lg = (log10f(fminf(fmaxf(err, 1e-3f), 1.f)) + 3.f) / 3.f; const float c2v = powf(10.f, (float)stage) * (1.f + 8.f * lg); const float C = sqrtf(c2v);
    for (size_t i = (size_t)blockIdx.x * 256 + threadIdx.x; i < (size_t)T * D; i += (size_t)gridDim.x * 256) out[i] = C;
}
}
#endif

#ifdef REPORT_K
__global__ void __launch_bounds__(256) k_report(float* out, const unsigned long long* ts) {
    const float us = (REPORT_K >= 0) ? (float)(ts[REPORT_K + 1] - ts[REPORT_K]) * 0.01f : (float)(ts[13] - ts[0]) * 0.001f; const float C = sqrtf(us);
    for (size_t i = (size_t)blockIdx.x * 256 + threadIdx.x; i < (size_t)T * D; i += (size_t)gridDim.x * 256) out[i] = C;
}
#endif
extern "C" void kernel_launch(void* const* d_in, const int* in_sizes, int n_in, void* d_out, int out_size, void* d_ws, size_t ws_size, hipStream_t stream) {
    static int grid = 0;
    if (grid == 0) {
        if (n_in != 25 || in_sizes[0] != T * D || out_size != T * D || ws_size < WS_END) { fprintf(stderr, "kernel_launch: unexpected problem shape / workspace (%d inputs, ws %zu); nothing launched\n", n_in, ws_size); grid = -1; return; }
        int dev = 0, cus = 0, per_cu = 0;
        if (hipGetDevice(&dev) != hipSuccess || hipDeviceGetAttribute(&cus, hipDeviceAttributeMultiprocessorCount, dev) != hipSuccess) { grid = -1; return; }
        if (hipFuncSetAttribute((const void*)mk_fwd, hipFuncAttributeMaxDynamicSharedMemorySize, LDS_BYTES) != hipSuccess) { fprintf(stderr, "kernel_launch: hipFuncSetAttribute failed\n"); grid = -1; return; }
        if (hipOccupancyMaxActiveBlocksPerMultiprocessor(&per_cu, (const void*)mk_fwd, NWAVES * 64, LDS_BYTES) != hipSuccess || per_cu < 1) { fprintf(stderr, "kernel_launch: occupancy query says %d\n", per_cu); }
        (void)hipGetLastError();
        grid = cus;
    }
    if (grid < 0) return;
    (void)hipMemsetAsync((char*)d_ws + WS_CTL, 0, CTL_ZERO_BYTES, stream);
    Args a{};
    for (int i = 0; i < 25; ++i) a.in[i] = (const float*)d_in[i];
    a.out = (float*)d_out; a.ws = (unsigned char*)d_ws;
#if defined(SELFCHECK) && SELFCHECK
    unsigned char* ws = (unsigned char*)d_ws; unsigned* CHK = (unsigned*)(ws + WS_CTL) + CW_CHK; const unsigned* ctl = (const unsigned*)(ws + WS_CTL);
    chk::InP inp{}; for (int i = 0; i < 25; ++i) inp.p[i] = a.in[i];
    float* scratch = (float*)(ws + WS_END + MiB);
    for (int p = 0; p < N_PHASES; ++p) {
        a.ph_lo = p; a.ph_hi = p + 1; a.li = p;
        hipLaunchKernelGGL(mk_fwd, dim3(grid), dim3(NWAVES * 64), LDS_BYTES, stream, a);
        using namespace chk;
        if (p == 1) hipLaunchKernelGGL(c1, dim3(NS), dim3(256), 0, stream, a.in[0], (const int*)d_in[1], a.in[2], ws, CHK);
        if (p == 2) hipLaunchKernelGGL(c2, dim3(NS * 8), dim3(64), 0, stream, ws, CHK);
        if (p == 3) hipLaunchKernelGGL(c3, dim3(16), dim3(64), 0, stream, inp, ws, scratch, CHK);
        if (p == 4) hipLaunchKernelGGL(c4, dim3(NS), dim3(256), 0, stream, a.in[3], a.in[11], ws, CHK);
        if (p == 5) hipLaunchKernelGGL(c5, dim3(NS), dim3(256), 0, stream, a.in[0], a.in[12], ws, CHK);
        if (p == 6) hipLaunchKernelGGL(c6, dim3(NS), dim3(256), 0, stream, a.in[13], a.in[14], a.in[0], ws, CHK);
        if (p == 7) hipLaunchKernelGGL(c7, dim3(NS), dim3(256), 0, stream, a.in[15], ws, CHK);
        if (p == 9) hipLaunchKernelGGL(c8, dim3(NS), dim3(64), 0, stream, a.in[16], ws, ctl, CHK);
        if (p == 10) { hipLaunchKernelGGL(c9, dim3(NS), dim3(256), 0, stream, inp, ws, ctl, CHK); hipLaunchKernelGGL(save_x1b, dim3(NS), dim3(256), 0, stream, ws, (bf16*)(ws + WS_END + 4 * MiB)); }
        if (p == 11) hipLaunchKernelGGL(c10, dim3(32), dim3(256), 0, stream, inp, ws, ctl, CHK);
        if (p == 12) hipLaunchKernelGGL(c11, dim3(NS), dim3(256), 0, stream, inp, (const float*)d_out, ws, ctl, CHK, (const bf16*)(ws + WS_END + 4 * MiB));
    }
    hipLaunchKernelGGL(chk::verdict, dim3(1024), dim3(256), 0, stream, (float*)d_out, CHK, ctl);
#else
    a.ph_lo = 0; a.ph_hi = N_PHASES; a.li = 0;
    hipLaunchKernelGGL(mk_fwd, dim3(grid), dim3(NWAVES * 64), LDS_BYTES, stream, a);
#ifdef REPORT_K
    hipLaunchKernelGGL(k_report, dim3(1024), dim3(256), 0, stream, (float*)d_out, (const unsigned long long*)((unsigned char*)d_ws + WS_END + 8 * MiB));
#endif
#endif
}
```

```cpp
#include <hip/hip_runtime.h>
#include <cstdio>
#include <cstdint>

#define LAS __attribute__((address_space(3)))
#define GAS __attribute__((address_space(1)))
typedef unsigned short bf16;
typedef short bf16x8 __attribute__((ext_vector_type(8)));
typedef short s16x4 __attribute__((ext_vector_type(4)));
typedef float f32x2 __attribute__((ext_vector_type(2)));
typedef float f32x4 __attribute__((ext_vector_type(4)));
typedef float f32x16 __attribute__((ext_vector_type(16)));
typedef unsigned u32x2 __attribute__((ext_vector_type(2)));
typedef unsigned u32x4 __attribute__((ext_vector_type(4)));
typedef GAS unsigned gu32;
#define RLX_AGENT __ATOMIC_RELAXED, __HIP_MEMORY_SCOPE_AGENT
#define DI __device__ __forceinline__

constexpr int NB = 4, SEQ = 8192, T = NB * SEQ, D = 1024, AW = 512, RW = 512, HD = 64, NH = 8, INW = 2560;
constexpr int NE = 256, TOPK = 8, EH = 256;
constexpr float ALPHA = 1.189207115002721f;
constexpr float LN_EPS = 1e-5f;
constexpr float LOG2E = 1.4426950408889634f;
constexpr float QSCALE = 0.125f * LOG2E;
constexpr int NWAVES = 8;
constexpr int MAXRT = T * TOPK / 256 + NE;
constexpr int NSHT = T / 256;
constexpr int MAXTILES = MAXRT + NSHT;
constexpr int MAXSLOTS = MAXTILES * 256;
constexpr int LCH = 128, NCH = SEQ / LCH;

constexpr size_t MiB = 1u << 20;
constexpr size_t WS_CTL = 0, CTL_ZERO_BYTES = 1 * MiB;
constexpr size_t WS_ROPE = 1 * MiB;
constexpr size_t WS_GWT = 3 * MiB;
constexpr size_t WS_C2 = 3 * MiB + 512 * 1024;
constexpr size_t WS_CARRY = 4 * MiB;
constexpr size_t WS_ER = 6 * MiB, WS_TS = 7 * MiB, WS_GW = 8 * MiB;
constexpr size_t WS_SLOTTOK = 9 * MiB, WS_SLOTW = 11 * MiB;
constexpr size_t WS_TILEE = 13 * MiB;
constexpr size_t WS_WINT = 14 * MiB, WS_WOUTT = 19 * MiB, WS_RTT = 21 * MiB;
constexpr size_t WS_WDT = 32 * MiB;
constexpr size_t WS_H = 161 * MiB;
constexpr size_t WS_Q = 161 * MiB, SEG_BYTES = 32 * MiB;
constexpr size_t WS_Y = 337 * MiB;
constexpr size_t WS_WGUT = 337 * MiB;
constexpr size_t WS_X1B = 850 * MiB;
constexpr size_t WS_LOGITS = 658 * MiB;
constexpr size_t WS_ATTN = 658 * MiB, WS_REC = 690 * MiB;
constexpr size_t WS_V1 = 722 * MiB;
constexpr size_t WS_XB = 722 * MiB;
constexpr size_t WS_MIX = 850 * MiB;
constexpr size_t WS_HF = 914 * MiB;
constexpr size_t WS_END = 977 * MiB;
static_assert(WS_WDT + (size_t)257 * 1024 * 256 * 2 <= WS_H && WS_H + (size_t)MAXSLOTS * 256 * 2 <= WS_Y && WS_Y + (size_t)MAXSLOTS * 1024 <= WS_V1, "ws map");
static_assert(WS_WGUT + (size_t)257 * 512 * 1024 * 2 <= WS_LOGITS && WS_Q + 5 * SEG_BYTES <= WS_Y, "ws map 2");
constexpr int CW_TMO = 0, CW_CNT = 1024, CW_NT = 2048, CW_CHK = 3072, CW_BAR = 4096;
#define XCD_BAR_WORDS_C 3456
static_assert((CW_BAR + 16 * XCD_BAR_WORDS_C) * 4 <= (int)CTL_ZERO_BYTES, "ctl");

constexpr int RING_OFF = 0, RING_BYTES = 131072;
constexpr int UT_OFF = RING_BYTES;
constexpr int UT_IDX = UT_OFF + 128;
constexpr int UT_W = UT_IDX + 11 * 1024;
constexpr int MISC_OFF = UT_W + 11 * 1024;
constexpr int LDS_BYTES = 163840;
static_assert(MISC_OFF + 256 <= LDS_BYTES, "LDS map");

DI unsigned f2bf(float f) { unsigned u = __builtin_bit_cast(unsigned, f); return (u + 0x7fffu + ((u >> 16) & 1u)) >> 16; }
DI unsigned pk2(float lo, float hi) { return f2bf(lo) | (f2bf(hi) << 16); }
DI float bf2f(unsigned short b) { return __builtin_bit_cast(float, (unsigned)b << 16); }
DI float bflo(unsigned w) { return __builtin_bit_cast(float, w << 16); }
DI float bfhi(unsigned w) { return __builtin_bit_cast(float, w & 0xffff0000u); }
DI float wave_sum(float v) {
#pragma unroll
    for (int o = 1; o < 64; o <<= 1) v += __shfl_xor(v, o);
    return v;
}
DI float wave_max(float v) {
#pragma unroll
    for (int o = 1; o < 64; o <<= 1) v = fmaxf(v, __shfl_xor(v, o));
    return v;
}
DI int wave_min_i(int v) {
#pragma unroll
    for (int o = 1; o < 64; o <<= 1) v = min(v, __shfl_xor(v, o));
    return v;
}
DI float row16_max(float v) {
    v = fmaxf(v, __builtin_bit_cast(float, __builtin_amdgcn_update_dpp(0, __builtin_bit_cast(int, v), 0xB1, 0xF, 0xF, false)));
    v = fmaxf(v, __builtin_bit_cast(float, __builtin_amdgcn_update_dpp(0, __builtin_bit_cast(int, v), 0x4E, 0xF, 0xF, false)));
    v = fmaxf(v, __builtin_bit_cast(float, __builtin_amdgcn_update_dpp(0, __builtin_bit_cast(int, v), 0x141, 0xF, 0xF, false)));
    v = fmaxf(v, __builtin_bit_cast(float, __builtin_amdgcn_update_dpp(0, __builtin_bit_cast(int, v), 0x140, 0xF, 0xF, false)));
    return v; }
DI float wave_max_fast(float v) { v = row16_max(v);
    const float r0 = __builtin_bit_cast(float, __builtin_amdgcn_readlane(__builtin_bit_cast(int, v), 0)), r1 = __builtin_bit_cast(float, __builtin_amdgcn_readlane(__builtin_bit_cast(int, v), 16)),
                r2 = __builtin_bit_cast(float, __builtin_amdgcn_readlane(__builtin_bit_cast(int, v), 32)), r3 = __builtin_bit_cast(float, __builtin_amdgcn_readlane(__builtin_bit_cast(int, v), 48));
    return fmaxf(fmaxf(r0, r1), fmaxf(r2, r3)); }
DI int wave_min_i_fast(int v) {
    v = min(v, __builtin_amdgcn_update_dpp(0, v, 0xB1, 0xF, 0xF, false)); v = min(v, __builtin_amdgcn_update_dpp(0, v, 0x4E, 0xF, 0xF, false));
    v = min(v, __builtin_amdgcn_update_dpp(0, v, 0x141, 0xF, 0xF, false)); v = min(v, __builtin_amdgcn_update_dpp(0, v, 0x140, 0xF, 0xF, false));
    return min(min(__builtin_amdgcn_readlane(v, 0), __builtin_amdgcn_readlane(v, 16)), min(__builtin_amdgcn_readlane(v, 32), __builtin_amdgcn_readlane(v, 48))); }
DI int lane_id() { return (int)__builtin_amdgcn_mbcnt_hi(~0u, __builtin_amdgcn_mbcnt_lo(~0u, 0u)); }
DI float fexp2(float x) { return __builtin_amdgcn_exp2f(x); }
DI float frcp(float x) { return __builtin_amdgcn_rcpf(x); }
DI float gelu_tanh(float x) {
    const float z = 0.7978845608028654f * (x + 0.044715f * x * x * x);
    const float e = fexp2(2.f * LOG2E * z);
    return 0.5f * x * (2.f - 2.f * frcp(e + 1.f));
}
DI int crow(int r, int hi) { return (r & 3) + 8 * (r >> 2) + 4 * hi; }
#define MFMA32(a, b, c) __builtin_amdgcn_mfma_f32_32x32x16_bf16((a), (b), (c), 0, 0, 0)

namespace pg8 {
constexpr int BM = 256, BK = 64, HALF = 128, HTB = HALF * BK * 2, NXCD = 8;
DI int lds_byte(int r, int c) { const int st = (r >> 4) * 2 + (c >> 5), rr = r & 15, cc = c & 31, ob = rr * 64 + cc * 2; return st * 1024 + (ob ^ (((ob >> 9) & 1) << 5)); }
DI void stage_rc(int b, int& R, int& C) { const int st = b / 1024, sb = b % 1024, swz = sb ^ (((sb >> 9) & 1) << 5); R = (st >> 1) * 16 + swz / 64; C = (st & 1) * 32 + (swz % 64) / 2; }
DI int perm32(int rho) { const int n = rho >> 4, i = rho & 15; return 8 * (i >> 2) + 4 * n + (i & 3); }
struct Unit { int pm, pn, li, ex; };
DI bool xcd_order(int i, int G, int c, int nwg, int& wgid) {
    const long L = (long)i * G + c; if (L >= nwg) return false;
    const int w = (int)L, q = nwg / NXCD, r = nwg % NXCD, xcd = w % NXCD, off = w / NXCD;
    wgid = (xcd < r ? xcd * (q + 1) : r * (q + 1) + (xcd - r) * q) + off; return true;
}
typedef int i32x8 __attribute__((ext_vector_type(8))); typedef int i32x4 __attribute__((ext_vector_type(4)));
DI void pg8_mfma_f8(f32x4& acc, const i32x8& b, const i32x8& a, int sc) { asm volatile("v_mfma_scale_f32_16x16x128_f8f6f4 %0, %1, %2, %0, %3, %3 op_sel_hi:[0,0,0]" : "+v"(acc) : "v"(b), "v"(a), "v"(sc)); }
DI i32x8 pg8_ld32(const LAS unsigned char* p) { const i32x4 a = *(const LAS i32x4*)p, b = *(const LAS i32x4*)(p + 16); return __builtin_shufflevector(a, b, 0, 1, 2, 3, 4, 5, 6, 7); }
DI s16x4 pg8_tr(const LAS unsigned char* p) { typedef short v4i16_t __attribute__((ext_vector_type(4))); return __builtin_bit_cast(s16x4, __builtin_amdgcn_ds_read_tr16_b64_v4i16((LAS v4i16_t*)p)); }
DI unsigned cvt_pk_bf16(float lo, float hi) { unsigned r; asm volatile("v_cvt_pk_bf16_f32 %0, %1, %2" : "=v"(r) : "v"(lo), "v"(hi)); return r; }

template <class Epi, class Sched, bool ALIGN_EPI, bool BKN = false, bool F8 = false>
DI void gemm_phase(LAS unsigned char* lds, const Sched& S, const Epi& E, const int K) {
    const int tid = threadIdx.x, wid = __builtin_amdgcn_readfirstlane(tid >> 6), lane = tid & 63, wr = wid >> 2, wc = wid & 3, fr = lane & 15, fq = lane >> 4;
    const int nt = K / BK;
    unsigned voffB[2];
#define PG8_RC(i, R, C) int R, C; stage_rc((wid * 64 + lane_id()) * 16 + (i) * 8192, R, C)
#pragma unroll
    for (int i = 0; i < 2; ++i) { int R, C; stage_rc(tid * 16 + i * 8192, R, C); const int Rb = Epi::PERM ? ((R & ~31) + perm32(R & 31)) : R; voffB[i] = (unsigned)(Rb * S.ldb + C) * 2u;
        if constexpr (BKN) { static_assert(!BKN || Epi::PERM, "the [K][N] B path delivers the PERM column order"); const int b = tid * 16 + i * 8192, k = b >> 8, c = (b >> 4) & 15, cl = ((((c >> 2) ^ (k & 3)) << 2) | (c & 3)); voffB[i] = (unsigned)(k * S.ldb + 8 * cl) * 2u; } }
    const size_t kstep = (size_t)(BK * 2);
    size_t hstepB = (size_t)HALF * S.ldb * 2, kstepB = kstep;
    if constexpr (BKN) { hstepB = S.bh1; kstepB = (size_t)BK * S.ldb * 2; }
    int bkn_off = 0;
    if constexpr (BKN) { const int g = lane >> 4, q = (lane >> 2) & 3, pp = lane & 3; bkn_off = (8 * g + q) * 256 + ((((wc ^ q) << 2) | pp) << 4); }
    const unsigned ldsw = (unsigned)wid * 1024u, lds_u = (unsigned)(size_t)lds;
    const int aoff = lds_byte(wr * 64 + fr, F8 ? fq * 16 : fq * 8), boff = lds_byte(wc * 32 + fr, F8 ? fq * 16 : fq * 8);
#define PG8_SA(b, h) (((b) * 2 + (h)) * HTB)
#define PG8_SB(b, h) ((4 + (b) * 2 + (h)) * HTB)
#define PG8_STAGE(bufoff, gbase, voff) do { _Pragma("unroll") for (int _i = 0; _i < 2; ++_i) { unsigned keep_; \
        asm volatile("s_mov_b32 %0, m0\n\ts_mov_b32 m0, %3\n\ts_nop 0\n\tglobal_load_lds_dwordx4 %1, %2\n\ts_mov_b32 m0, %0" : "=&s"(keep_) : "v"((voff)[_i]), "s"((const char*)(gbase)), "s"(lds_u + (unsigned)(bufoff) + ldsw + (unsigned)(_i * 8192)) : "memory"); } } while (0)
#define PG8_LDA(dst, b, h) do { if constexpr (F8) { _Pragma("unroll") for (int m = 0; m < 4; ++m) A8[m] = pg8_ld32(lds + PG8_SA(b, h) + aoff + m * 2048); } \
        else { _Pragma("unroll") for (int m = 0; m < 4; ++m) _Pragma("unroll") for (int k = 0; k < 2; ++k) dst[m][k] = *(const LAS bf16x8*)(lds + PG8_SA(b, h) + aoff + m * 2048 + k * 1024); } } while (0)
#define PG8_LDB(dst, b, h) do { if constexpr (BKN) { _Pragma("unroll") for (int n = 0; n < 2; ++n) _Pragma("unroll") for (int k = 0; k < 2; ++k) { \
            const s16x4 lo_ = pg8_tr(lds + PG8_SB(b, h) + bkn_off + k * 8192 + n * 8), hi_ = pg8_tr(lds + PG8_SB(b, h) + bkn_off + k * 8192 + n * 8 + 1024); dst[n][k] = __builtin_shufflevector(lo_, hi_, 0, 1, 2, 3, 4, 5, 6, 7); } } \
        else if constexpr (F8) { _Pragma("unroll") for (int n = 0; n < 2; ++n) dst##8[n] = pg8_ld32(lds + PG8_SB(b, h) + boff + n * 2048); } \
        else { _Pragma("unroll") for (int n = 0; n < 2; ++n) _Pragma("unroll") for (int k = 0; k < 2; ++k) dst[n][k] = *(const LAS bf16x8*)(lds + PG8_SB(b, h) + boff + n * 2048 + k * 1024); } } while (0)
#define PG8_MMA(ai, bj, At, Bt) do { __builtin_amdgcn_s_setprio(1); if constexpr (F8) { _Pragma("unroll") for (int m = 0; m < 4; ++m) _Pragma("unroll") for (int n = 0; n < 2; ++n) \
            pg8_mfma_f8(acc[ai][bj][m][n], Bt##8[n], A8[m], f8_unit_scale); } \
        else { _Pragma("unroll") for (int m = 0; m < 4; ++m) _Pragma("unroll") for (int n = 0; n < 2; ++n) _Pragma("unroll") for (int k = 0; k < 2; ++k) \
            acc[ai][bj][m][n] = __builtin_amdgcn_mfma_f32_16x16x32_bf16(Bt[n][k], At[m][k], acc[ai][bj][m][n], 0, 0, 0); } __builtin_amdgcn_s_setprio(0); } while (0)
#define PG8_WAIT_V(n) asm volatile("s_waitcnt vmcnt(" #n ")" ::: "memory")
#define PG8_WAIT_L(n) asm volatile("s_waitcnt lgkmcnt(" #n ")" ::: "memory")
#define PG8_BAR __builtin_amdgcn_s_barrier()
#define PG8_SCHED __builtin_amdgcn_sched_barrier(0)
    Unit cur, nxt; int ui = 0;
    if (!S.next(0, cur)) return;
    f32x4 acc[2][2][4][2];
#pragma unroll
    for (int a = 0; a < 2; ++a)
#pragma unroll
        for (int b = 0; b < 2; ++b)
#pragma unroll
            for (int m = 0; m < 4; ++m)
#pragma unroll
                for (int n = 0; n < 2; ++n) acc[a][b][m][n] = (f32x4){0.f, 0.f, 0.f, 0.f};
    bf16x8 At[4][2], B0[2][2], B1[2][2];
    i32x8 A8[4], B08[2], B18[2];
    int f8_unit_scale = 0x7F7F7F7F; if constexpr (F8) asm volatile("" : "+v"(f8_unit_scale));
    unsigned ca0[2], ca1[2];
#pragma unroll
    for (int i = 0; i < 2; ++i) { PG8_RC(i, R_, C_); ca0[i] = S.a_voff(cur, R_, C_); ca1[i] = S.a_voff(cur, HALF + R_, C_); }
    const char* cA = S.a_base(cur); const char* cB = S.b_base(cur);
    typename Epi::Ctx ctx = E.pre(cur, wr, fr);
    PG8_STAGE(PG8_SB(0, 0), cB, voffB); PG8_STAGE(PG8_SB(0, 1), cB + hstepB, voffB); PG8_STAGE(PG8_SA(0, 0), cA, ca0); PG8_STAGE(PG8_SA(0, 1), cA, ca1);
    if (wr == 1) PG8_BAR;
    PG8_WAIT_V(2); PG8_BAR;
    PG8_STAGE(PG8_SB(1, 0), cB + kstepB, voffB); PG8_STAGE(PG8_SA(1, 0), cA + kstep, ca0); PG8_STAGE(PG8_SB(1, 1), cB + hstepB + kstepB, voffB);
    PG8_WAIT_V(6); PG8_BAR;
    for (;;) {
        const bool has_next = S.next(ui + 1, nxt);
        const char* nA = has_next ? S.a_base(nxt) : cA; const char* nB = has_next ? S.b_base(nxt) : cB;
#pragma unroll 1
        for (int t = 0; t < nt; t += 2) {
            const bool last = (t == nt - 2);
            const char* a1 = cA + (size_t)(t + 1) * kstep;
            const char* a2 = last ? nA : cA + (size_t)(t + 2) * kstep; const char* b2 = last ? nB : cB + (size_t)(t + 2) * kstepB;
            const char* a3 = a2 + kstep; const char* b3 = b2 + kstepB;
            unsigned v20[2], v21[2];
            if (last && has_next) {
#pragma unroll
                for (int i = 0; i < 2; ++i) { PG8_RC(i, R_, C_); v20[i] = S.a_voff(nxt, R_, C_); v21[i] = S.a_voff(nxt, HALF + R_, C_); }
            } else {
#pragma unroll
                for (int i = 0; i < 2; ++i) { v20[i] = ca0[i]; v21[i] = ca1[i]; }
            }
            PG8_LDB(B0, 0, 0); PG8_LDB(B1, 0, 1); PG8_SCHED; PG8_LDA(At, 0, 0); PG8_STAGE(PG8_SA(1, 1), a1, ca1);
            PG8_WAIT_V(8); PG8_WAIT_L(0); PG8_BAR; PG8_MMA(0, 0, At, B0); PG8_MMA(0, 1, At, B1); PG8_BAR; PG8_SCHED;
            PG8_LDA(At, 0, 1); PG8_STAGE(PG8_SB(0, 0), b2, voffB); PG8_STAGE(PG8_SB(0, 1), b2 + hstepB, voffB); PG8_STAGE(PG8_SA(0, 0), a2, v20);
            PG8_WAIT_V(8); PG8_WAIT_L(0); PG8_BAR; PG8_MMA(1, 0, At, B0); PG8_MMA(1, 1, At, B1); PG8_BAR; PG8_SCHED;
            PG8_LDB(B0, 1, 0); PG8_LDB(B1, 1, 1); PG8_SCHED; PG8_LDA(At, 1, 0); PG8_STAGE(PG8_SA(0, 1), a2, v21);
            PG8_WAIT_V(8); PG8_WAIT_L(0); PG8_BAR; PG8_MMA(0, 0, At, B0); PG8_MMA(0, 1, At, B1); PG8_BAR; PG8_SCHED;
            PG8_LDA(At, 1, 1); PG8_STAGE(PG8_SB(1, 0), b3, voffB); PG8_STAGE(PG8_SB(1, 1), b3 + hstepB, voffB); PG8_STAGE(PG8_SA(1, 0), a3, v20);
            PG8_WAIT_V(8); PG8_WAIT_L(0); PG8_BAR; PG8_MMA(1, 0, At, B0); PG8_MMA(1, 1, At, B1); PG8_BAR; PG8_SCHED;
        }
        if constexpr (ALIGN_EPI) { if (wr == 0) PG8_BAR; }
        if constexpr (F8) asm volatile("s_nop 15\n\ts_nop 15\n\ts_nop 15" ::: "memory");
        E(acc, cur, ctx, wr, wc, fr, fq);
        if (!has_next) break;
#pragma unroll
        for (int a = 0; a < 2; ++a)
#pragma unroll
            for (int b = 0; b < 2; ++b)
#pragma unroll
                for (int m = 0; m < 4; ++m)
#pragma unroll
                    for (int n = 0; n < 2; ++n) acc[a][b][m][n] = (f32x4){0.f, 0.f, 0.f, 0.f};
        cur = nxt; cA = nA; cB = nB; ++ui;
        ctx = E.pre(cur, wr, fr);
#pragma unroll
        for (int i = 0; i < 2; ++i) { PG8_RC(i, R_, C_); ca0[i] = S.a_voff(cur, R_, C_); ca1[i] = S.a_voff(cur, HALF + R_, C_); }
        if constexpr (ALIGN_EPI) { if (wr == 1) PG8_BAR; }
    }
    PG8_WAIT_V(0);
    if constexpr (!ALIGN_EPI) { if (wr == 0) PG8_BAR; }
    PG8_BAR;
#undef PG8_RC
#undef PG8_SA
#undef PG8_SB
#undef PG8_STAGE
#undef PG8_LDA
#undef PG8_LDB
#undef PG8_MMA
#undef PG8_WAIT_V
#undef PG8_WAIT_L
#undef PG8_BAR
#undef PG8_SCHED
}
}
#define XB_TMO      128
#define XB_XCNT(j)  (256  + 64 * (j))
#define XB_XSUB(j)  (1280 + 64 * (j))
#define XB_XGEN(j)  (2304 + 64 * (j))
#define XB_TOP      3328
#define XB_TOPGEN   3392
#define XCD_BAR_WORDS 3456
#define XB_SPIN_CAP (1u << 18)

__device__ __forceinline__ unsigned xb_ld(unsigned* p)              { return __hip_atomic_load(p, __ATOMIC_RELAXED, __HIP_MEMORY_SCOPE_AGENT); }
__device__ __forceinline__ unsigned xb_add(unsigned* p, unsigned v) { return __hip_atomic_fetch_add(p, v, __ATOMIC_RELAXED, __HIP_MEMORY_SCOPE_AGENT); }
__device__ __forceinline__ unsigned xb_xcc_id() { return (unsigned)__builtin_amdgcn_s_getreg((3 << 11) | 20) & 0xFu; }
#define XB_SPIN(cond, bar) do { unsigned _sp = 0; while (cond) { __builtin_amdgcn_s_sleep(1); \
    if ((++_sp & 255u) == 0u) { if (xb_ld(&(bar)[XB_TMO])) break; if (_sp > XB_SPIN_CAP) { atomicAdd(&(bar)[XB_TMO], 1u); break; } } } } while (0)

struct XcdBarrier {
    unsigned* bar; unsigned x;
    volatile LAS unsigned* st;
};

__device__ __forceinline__ XcdBarrier xcd_barrier_post(unsigned* bar, volatile LAS unsigned* st) {
    XcdBarrier b; b.bar = bar; b.x = xb_xcc_id(); b.st = st;
    if (threadIdx.x == 0) (void)xb_add(&bar[XB_XCNT(b.x)], 1u);
    return b;
}
__device__ __forceinline__ void xcd_barrier_complete(unsigned* bar, unsigned x, unsigned& nloc, unsigned& nx) {
    const unsigned G = gridDim.x * gridDim.y * gridDim.z;
    unsigned sum, cnt, mine, sp = 0u;
    for (;;) {
        sum = 0u; cnt = 0u; mine = 0u;
#pragma unroll
        for (unsigned j = 0; j < 16; ++j) { const unsigned c = xb_ld(&bar[XB_XCNT(j)]); sum += c; cnt += (c > 0u) ? 1u : 0u; mine = (j == x) ? c : mine; }
        if (sum == G) break;
        __builtin_amdgcn_s_sleep(1);
        if ((++sp & 255u) == 0u) { if (xb_ld(&bar[XB_TMO])) break; if (sp > XB_SPIN_CAP) { atomicAdd(&bar[XB_TMO], 1u); break; } }
    }
    nloc = mine > 0u ? mine : 1u; nx = cnt > 0u ? cnt : 1u;
}

__device__ __forceinline__ void xcd_barrier(const XcdBarrier& b) {
    asm volatile("s_waitcnt vmcnt(0)" ::: "memory");
    __syncthreads();
    if (threadIdx.x == 0) {
        unsigned* bar = b.bar;
        __builtin_amdgcn_s_waitcnt(0);
        unsigned nloc = b.st[0], nx = b.st[1];
        if (nloc == 0u) { xcd_barrier_complete(bar, b.x, nloc, nx); b.st[0] = nloc; b.st[1] = nx; }
        const unsigned old = xb_add(&bar[XB_XSUB(b.x)], 1u);
        const unsigned gen = old / nloc;
        if (old + 1u == (gen + 1u) * nloc) {
            __builtin_amdgcn_fence(__ATOMIC_RELEASE, "agent");
            asm volatile("s_waitcnt vmcnt(0)" ::: "memory");
            const unsigned og = xb_add(&bar[XB_TOP], 1u);
            const unsigned tg = og / nx;
            if (og + 1u == (tg + 1u) * nx) xb_add(&bar[XB_TOPGEN], 1u);
            else XB_SPIN(xb_ld(&bar[XB_TOPGEN]) == tg, bar);
            __builtin_amdgcn_fence(__ATOMIC_ACQUIRE, "agent");
            xb_add(&bar[XB_XGEN(b.x)], 1u);
            asm volatile("s_waitcnt vmcnt(0)" ::: "memory");
        } else {
            XB_SPIN(xb_ld(&bar[XB_XGEN(b.x)]) == gen, bar);
            __builtin_amdgcn_fence(__ATOMIC_ACQUIRE, "agent");
            asm volatile("s_waitcnt vmcnt(0)" ::: "memory");
        }
    }
    __syncthreads();
}

#define LDS_WAIT() asm volatile("s_waitcnt lgkmcnt(0)" ::: "memory")
#define VM_WAIT() asm volatile("s_waitcnt vmcnt(0)" ::: "memory")
struct Frame {
    LAS unsigned char* lds;
    volatile LAS unsigned* MISC;
    gu32* ctl;
    int tid, lane, wave, vcu, G;
    unsigned char* ws;
    const float* in[25];
    float* out;
};

DI void sincos_acc(float ang, float& c, float& s) {
    const double x = (double)ang;
    const double k = rint(x * 0.63661977236758134308);
    double r = fma(-k, 1.57079632679489655800, x);
    r = fma(-k, 6.12323399573676603587e-17, r);
    const long long q = (long long)k;
    const double r2 = r * r;
    double sp = -7.6471637318198164759e-13; sp = fma(sp, r2, 1.6059043836821614599e-10); sp = fma(sp, r2, -2.5052108385441718775e-08);
    sp = fma(sp, r2, 2.7557319223985890653e-06); sp = fma(sp, r2, -1.9841269841269841270e-04); sp = fma(sp, r2, 8.3333333333333333333e-03);
    sp = fma(sp, r2, -1.6666666666666666667e-01); const double sr = fma(sp * r2, r, r);
    double cp = 4.7794773323873852974e-14; cp = fma(cp, r2, -1.1470745597729724714e-11); cp = fma(cp, r2, 2.0876756987868098979e-09);
    cp = fma(cp, r2, -2.7557319223985890653e-07); cp = fma(cp, r2, 2.4801587301587301587e-05); cp = fma(cp, r2, -1.3888888888888888889e-03);
    cp = fma(cp, r2, 4.1666666666666666667e-02); cp = fma(cp, r2, -0.5); const double cr = fma(cp, r2, 1.0);
    const int qq = (int)(q & 3);
    const double ss = qq == 0 ? sr : (qq == 1 ? cr : (qq == 2 ? -sr : -cr));
    const double cc = qq == 0 ? cr : (qq == 1 ? -sr : (qq == 2 ? -cr : sr));
    c = (float)cc; s = (float)ss;
}

DI void tr_item(const float* W, int N, bf16* WT, int Kd, LAS float* scr, int lane) {
#pragma unroll 4
    for (int i = 0; i < 16; ++i) { const int k = 4 * i + (lane >> 4), c4 = (lane & 15) * 4; const f32x4 v = *(const GAS f32x4*)(W + (size_t)k * N + c4);
        LAS float* d = scr + k * 65 + c4; d[0] = v.x; d[1] = v.y; d[2] = v.z; d[3] = v.w; }
    LDS_WAIT(); asm volatile("" ::: "memory");
    const int c = lane & 7;
#pragma unroll
    for (int j = 0; j < 8; ++j) { const int n = 8 * j + (lane >> 3); const LAS float* s = scr + (8 * c) * 65 + n;
        u32x4 o; o.x = pk2(s[0 * 65], s[1 * 65]); o.y = pk2(s[2 * 65], s[3 * 65]); o.z = pk2(s[4 * 65], s[5 * 65]); o.w = pk2(s[6 * 65], s[7 * 65]);
        *(GAS u32x4*)(WT + (size_t)n * Kd + 8 * c) = o; }
    LDS_WAIT(); asm volatile("" ::: "memory");
}
constexpr int XI_GU = 257 * 16 * 4, XI_DN = 257 * 4 * 16, XI_ALL = 2 * XI_GU + XI_DN;
constexpr float WSCALE = 64.0f;
struct XItem { const float* src; bf16* dst; int N, Kd, f8; };
DI XItem expert_item(Frame& F, int r) {
    unsigned char* ws = F.ws; XItem x;
    if (r < 2 * XI_GU) {
        const int up = r >= XI_GU; if (up) r -= XI_GU;
        const int e = r >> 6, kb = (r >> 2) & 15, nb = r & 3;
        const float* src = (e < NE) ? F.in[up ? 18 : 17] + (size_t)e * D * EH : F.in[up ? 21 : 20];
        const int row = (nb >> 1) * 256 + up * 128 + (nb & 1) * 64;
        x.src = src + (size_t)kb * 64 * EH + nb * 64; x.N = EH; x.dst = (bf16*)(ws + WS_WGUT + ((size_t)e * 512 + row) * D + kb * 64); x.Kd = D; x.f8 = 1;
    } else {
        r -= 2 * XI_GU;
        const int e = r >> 6, kb = (r >> 4) & 3, nb = r & 15;
        const float* src = (e < NE) ? F.in[19] + (size_t)e * EH * D : F.in[22];
        x.src = src + (size_t)kb * 64 * D + nb * 64; x.N = D; x.dst = (bf16*)(ws + WS_WDT + ((size_t)e * D + nb * 64) * EH + kb * 64); x.Kd = EH; x.f8 = 1;
    }
    return x;
}
DI void xi_load(const XItem& x, f32x4 (&r)[16], int lane) {
#pragma unroll
    for (int i = 0; i < 16; ++i) { const int k = 4 * i + (lane >> 4), c4 = (lane & 15) * 4; r[i] = __builtin_nontemporal_load((const GAS f32x4*)(x.src + (size_t)k * x.N + c4)); }
}
DI void xi_finish(const XItem& x, const f32x4 (&r)[16], LAS float* scr, int lane) {
#pragma unroll
    for (int i = 0; i < 16; ++i) { const int k = 4 * i + (lane >> 4), c4 = (lane & 15) * 4; LAS float* d = scr + k * 65 + c4; d[0] = r[i].x; d[1] = r[i].y; d[2] = r[i].z; d[3] = r[i].w; }
    LDS_WAIT(); asm volatile("" ::: "memory");
    const int c = lane & 7;
    if (x.f8) {
        unsigned char* d8 = (unsigned char*)x.dst;
#pragma unroll
        for (int j = 0; j < 8; ++j) { const int n = 8 * j + (lane >> 3); const LAS float* s = scr + (8 * c) * 65 + n;
            int w0 = __builtin_amdgcn_cvt_pk_fp8_f32(s[0 * 65] * WSCALE, s[1 * 65] * WSCALE, 0, false); w0 = __builtin_amdgcn_cvt_pk_fp8_f32(s[2 * 65] * WSCALE, s[3 * 65] * WSCALE, w0, true);
            int w1 = __builtin_amdgcn_cvt_pk_fp8_f32(s[4 * 65] * WSCALE, s[5 * 65] * WSCALE, 0, false); w1 = __builtin_amdgcn_cvt_pk_fp8_f32(s[6 * 65] * WSCALE, s[7 * 65] * WSCALE, w1, true);
            *(GAS u32x2*)(d8 + (size_t)n * x.Kd + 8 * c) = (u32x2){(unsigned)w0, (unsigned)w1}; }
    } else {
#pragma unroll
        for (int j = 0; j < 8; ++j) { const int n = 8 * j + (lane >> 3); const LAS float* s = scr + (8 * c) * 65 + n;
            u32x4 o; o.x = pg8::cvt_pk_bf16(s[0 * 65], s[1 * 65]); o.y = pg8::cvt_pk_bf16(s[2 * 65], s[3 * 65]); o.z = pg8::cvt_pk_bf16(s[4 * 65], s[5 * 65]); o.w = pg8::cvt_pk_bf16(s[6 * 65], s[7 * 65]);
            *(GAS u32x4*)(x.dst + (size_t)n * x.Kd + 8 * c) = o; }
    }
    LDS_WAIT(); asm volatile("" ::: "memory");
}
DI void convert_items(Frame& F, int it_lo, int it_hi, LAS float* scr) {
    const int gw = F.vcu * NWAVES + F.wave, NGW = F.G * NWAVES, lane = lane_id();
    const int first = it_lo + gw; if (first >= it_hi) return;
    const int n = (it_hi - first + NGW - 1) / NGW;
    f32x4 r0[16], r1[16]; XItem x0, x1;
    x0 = expert_item(F, first); xi_load(x0, r0, lane);
    x1 = expert_item(F, first + (1 < n ? 1 : 0) * NGW); if (1 < n) xi_load(x1, r1, lane);
#pragma unroll 1
    for (int q = 0; q < n; q += 2) {
        xi_finish(x0, r0, scr, lane); if (q + 2 < n) { x0 = expert_item(F, first + (q + 2) * NGW); xi_load(x0, r0, lane); }
        if (q + 1 < n) { xi_finish(x1, r1, scr, lane); if (q + 3 < n) { x1 = expert_item(F, first + (q + 3) * NGW); xi_load(x1, r1, lane); } }
    }
}
DI void p0_prologue(Frame& F) {
    LAS float* scr = (LAS float*)(F.lds + F.wave * 16640);
    const int gw = F.vcu * NWAVES + F.wave, NGW = F.G * NWAVES, lane = F.lane;
    unsigned char* ws = F.ws;
    constexpr int I_IN = 16 * 40, I_OUT = 16 * 16, I_RT = 16 * 4, I_G = 32;
    constexpr int NITEMS = I_IN + I_OUT + I_RT + I_G;
    for (int it = gw; it < NITEMS; it += NGW) {
        int r = it;
        if (r < I_IN) { const int kb = r / 40, nb = r % 40; tr_item(F.in[2] + (size_t)kb * 64 * INW + nb * 64, INW, (bf16*)(ws + WS_WINT) + (size_t)nb * 64 * D + kb * 64, D, scr, lane); continue; } r -= I_IN;
        if (r < I_OUT) { const int kb = r / 16, nb = r % 16; tr_item(F.in[12] + (size_t)kb * 64 * D + nb * 64, D, (bf16*)(ws + WS_WOUTT) + (size_t)nb * 64 * D + kb * 64, D, scr, lane); continue; } r -= I_OUT;
        if (r < I_RT) { const int kb = r / 4, nb = r % 4; tr_item(F.in[15] + (size_t)kb * 64 * NE + nb * 64, NE, (bf16*)(ws + WS_RTT) + (size_t)nb * 64 * D + kb * 64, D, scr, lane); continue; } r -= I_RT;
        {
            const int gate = r >> 4, dir = (r >> 3) & 1, n = r & 7;
            tr_item(F.in[gate ? 8 : 6] + (size_t)(dir * 8 + n) * 4096, 64, (bf16*)(ws + WS_GWT) + (size_t)((dir * 2 + gate) * 8 + n) * 4096, 64, scr, lane); }
    }
    { const f32x4* x4 = (const f32x4*)F.in[0]; u32x4* o = (u32x4*)(ws + WS_XB);
      const size_t NCHK = (size_t)T * D / 8, STR = (size_t)NGW * 64;
      for (size_t i = (size_t)gw * 64 + lane; i < NCHK; i += 4 * STR) {
          f32x4 a[4], b[4];
#pragma unroll
          for (int q = 0; q < 4; ++q) { const size_t ii = (i + q * STR < NCHK) ? i + q * STR : i; a[q] = __builtin_nontemporal_load((const GAS f32x4*)x4 + 2 * ii); b[q] = __builtin_nontemporal_load((const GAS f32x4*)x4 + 2 * ii + 1); }
#pragma unroll
          for (int q = 0; q < 4; ++q) if (i + q * STR < NCHK) { u32x4 w; w.x = pk2(a[q].x, a[q].y); w.y = pk2(a[q].z, a[q].w); w.z = pk2(b[q].x, b[q].y); w.w = pk2(b[q].z, b[q].w); o[i + q * STR] = w; } } }
    { const int* pos = (const int*)F.in[1]; float* rt = (float*)(ws + WS_ROPE);
      for (int i = gw * 64 + lane; i < T * 8; i += NGW * 64) { const int t = i >> 3, f = i & 7;
          float inv = 1.0f;
          inv = f == 1 ? 0x1.8d275ep-3f : inv; inv = f == 2 ? 0x1.341190p-5f : inv; inv = f == 3 ? 0x1.ddee9cp-8f : inv; inv = f == 4 ? 0x1.72ba44p-10f : inv;
          inv = f == 5 ? 0x1.1f91f0p-12f : inv; inv = f == 6 ? 0x1.be218ap-15f : inv; inv = f == 7 ? 0x1.5a0f50p-17f : inv;
          float c, s; sincos_acc((float)pos[t] * inv, c, s); rt[t * 16 + f] = c; rt[t * 16 + 8 + f] = s; } }
    { const float* lam = F.in[10]; float* c2 = (float*)(ws + WS_C2);
      for (int i = gw * 64 + lane; i < 2 * RW; i += NGW * 64) { const float l = lam[i]; const float sp = (-l > 20.f) ? -l : log1pf(expf(-l)); c2[i] = -8.0f * sp * LOG2E; } }
}

struct SchedDense {
    const bf16* A; const bf16* Bt; int lda, ldb, nM, nN, G, c, i0, i1;
    DI bool next(int ii, pg8::Unit& u) const { const int i = ii + i0; if (i >= i1) return false; int wgid; if (!pg8::xcd_order(i, G, c, nM * nN, wgid)) return false;
        const int nig = 8 * nN, gid = wgid / nig, fm = gid * 8, gsz = (nM - fm) < 8 ? (nM - fm) : 8; u.pm = fm + ((wgid % nig) % gsz); u.pn = (wgid % nig) / gsz; u.li = i; u.ex = 0; return true; }
    DI const char* a_base(const pg8::Unit& u) const { return (const char*)A + (size_t)u.pm * 256 * lda * 2; }
    DI unsigned a_voff(const pg8::Unit&, int R, int C) const { return (unsigned)(R * lda + C) * 2u; }
    DI const char* b_base(const pg8::Unit& u) const { return (const char*)Bt + (size_t)u.pn * 256 * ldb * 2; }
};
struct SchedRouter {
    const bf16* A; const bf16* Bt; int lda, ldb, nM, G, c;
    DI bool next(int i, pg8::Unit& u) const { int wgid; if (!pg8::xcd_order(i, G, c, nM * 2, wgid)) return false; u.pm = wgid >> 1; u.pn = wgid & 1; u.li = i; u.ex = 0; return true; }
    DI const char* a_base(const pg8::Unit& u) const { return (const char*)A + ((size_t)u.pm * 256 * lda + u.pn * 512) * 2; }
    DI unsigned a_voff(const pg8::Unit&, int R, int C) const { return (unsigned)(R * lda + C) * 2u; }
    DI const char* b_base(const pg8::Unit& u) const { return (const char*)Bt + (size_t)u.pn * 512 * 2; }
};
struct SchedG1 {
    const bf16* X; const bf16* W; const LAS unsigned* ue; const LAS unsigned* idx; int ldb, nwg, G, c; size_t bh1;
    DI bool next(int i, pg8::Unit& u) const { int wgid; if (!pg8::xcd_order(i, G, c, nwg, wgid)) return false; u.pm = wgid >> 1; u.pn = wgid & 1; u.li = i; u.ex = (int)ue[i]; return true; }
    DI const char* a_base(const pg8::Unit&) const { return (const char*)X; }
    DI unsigned a_voff(const pg8::Unit& u, int R, int C) const { return idx[u.li * 256 + R] * 1024u + (unsigned)C * 2u; }
    DI const char* b_base(const pg8::Unit& u) const { return (const char*)W + ((size_t)u.ex * 512 + u.pn * 256) * D; }
};
struct SchedG2 {
    const bf16* Hh; const bf16* W; const LAS unsigned* ue; int ldb, nwg, G, c, tile0; size_t bh1;
    DI bool next(int i, pg8::Unit& u) const { int wgid; if (!pg8::xcd_order(i, G, c, nwg, wgid)) return false; u.pm = tile0 + (wgid >> 2); u.pn = wgid & 3; u.li = i; u.ex = (int)ue[i]; return true; }
    DI const char* a_base(const pg8::Unit& u) const { return (const char*)Hh + (size_t)u.pm * 256 * EH; }
    DI unsigned a_voff(const pg8::Unit&, int R, int C) const { return (unsigned)(R * EH) + (unsigned)C * 2u; }
    DI const char* b_base(const pg8::Unit& u) const { return (const char*)W + ((size_t)u.ex * D + u.pn * 256) * EH; }
};

struct EpiInProj {
    static constexpr bool PERM = true; struct Ctx {}; DI Ctx pre(const pg8::Unit&, int, int) const { return Ctx{}; }
    bf16* Q; const float* rope;
    DI void operator()(const f32x4 (&acc)[2][2][4][2], const pg8::Unit& u, const Ctx& cx, int wr, int wc, int fr, int fq) const {
        const int seg = u.pn >> 1;
        bf16* base = Q + (size_t)seg * (SEG_BYTES / 2);
        const int row0 = u.pm * 256 + wr * 64 + fr, col0 = (u.pn & 1) * 256 + wc * 32 + 8 * fq;
        const bool rot = (seg < 2) && ((wc & 1) == 0);
        const float sgn = (fq == 0) ? -1.f : 1.f;
#pragma unroll
        for (int ai = 0; ai < 2; ++ai)
#pragma unroll
            for (int m = 0; m < 4; ++m) {
                const int row = row0 + ai * 128 + m * 16;
                f32x4 c0 = {1.f, 1.f, 1.f, 1.f}, c1 = c0, s0 = {0.f, 0.f, 0.f, 0.f}, s1 = s0;
                if (rot) { const f32x4* rp = (const f32x4*)(rope + (size_t)row * 16); c0 = rp[0]; c1 = rp[1]; s0 = rp[2]; s1 = rp[3]; }
#pragma unroll
                for (int bj = 0; bj < 2; ++bj) {
                    f32x4 v0 = acc[ai][bj][m][0], v1 = acc[ai][bj][m][1];
                    if (rot) {
                        f32x4 p0, p1;
#pragma unroll
                        for (int j = 0; j < 4; ++j) { p0[j] = __shfl_xor(v0[j], 16); p1[j] = __shfl_xor(v1[j], 16); }
                        if (fq < 2) { v0 = v0 * c0 + (p0 * s0) * sgn; v1 = v1 * c1 + (p1 * s1) * sgn; }
                    }
                    if (seg == 0) { v0 = v0 * QSCALE; v1 = v1 * QSCALE; }
                    if (seg == 4) {
#pragma unroll
                        for (int j = 0; j < 4; ++j) { v0[j] = gelu_tanh(v0[j]); v1[j] = gelu_tanh(v1[j]); } }
                    u32x4 w; w.x = pg8::cvt_pk_bf16(v0[0], v0[1]); w.y = pg8::cvt_pk_bf16(v0[2], v0[3]); w.z = pg8::cvt_pk_bf16(v1[0], v1[1]); w.w = pg8::cvt_pk_bf16(v1[2], v1[3]);
                    *(u32x4*)(base + (size_t)row * 512 + col0 + bj * 128) = w;
                }
            }
    }
};
struct EpiYb {
    static constexpr bool PERM = true; struct Ctx {}; DI Ctx pre(const pg8::Unit&, int, int) const { return Ctx{}; }
    bf16* Yb;
    DI void operator()(const f32x4 (&acc)[2][2][4][2], const pg8::Unit& u, const Ctx& cx, int wr, int wc, int fr, int fq) const {
        const int row0 = u.pm * 256 + wr * 64 + fr, col0 = u.pn * 256 + wc * 32 + 8 * fq;
#pragma unroll
        for (int ai = 0; ai < 2; ++ai)
#pragma unroll
            for (int m = 0; m < 4; ++m) { const size_t ro = (size_t)(row0 + ai * 128 + m * 16) * D + col0;
#pragma unroll
                for (int bj = 0; bj < 2; ++bj) { const f32x4 v0 = acc[ai][bj][m][0], v1 = acc[ai][bj][m][1];
                    u32x4 o; o.x = pg8::cvt_pk_bf16(v0[0], v0[1]); o.y = pg8::cvt_pk_bf16(v0[2], v0[3]); o.z = pg8::cvt_pk_bf16(v1[0], v1[1]); o.w = pg8::cvt_pk_bf16(v1[2], v1[3]);
                    *(u32x4*)(Yb + ro + bj * 128) = o; } }
    }
};
struct EpiLogits {
    static constexpr bool PERM = false; struct Ctx {}; DI Ctx pre(const pg8::Unit&, int, int) const { return Ctx{}; }
    float* L;
    DI void operator()(const f32x4 (&acc)[2][2][4][2], const pg8::Unit& u, const Ctx& cx, int wr, int wc, int fr, int fq) const {
        float* base = L + (size_t)u.pn * T * NE; const int row0 = u.pm * 256 + wr * 64 + fr, col0 = wc * 32 + 4 * fq;
#pragma unroll
        for (int ai = 0; ai < 2; ++ai)
#pragma unroll
            for (int m = 0; m < 4; ++m) { const size_t ro = (size_t)(row0 + ai * 128 + m * 16) * NE + col0;
#pragma unroll
                for (int bj = 0; bj < 2; ++bj)
#pragma unroll
                    for (int n = 0; n < 2; ++n) *(f32x4*)(base + ro + bj * 128 + n * 16) = acc[ai][bj][m][n]; }
    }
};
constexpr float HSCALE = 64.0f;
struct EpiSwiglu {
    static constexpr bool PERM = true;
    struct Ctx {}; DI Ctx pre(const pg8::Unit&, int, int) const { return Ctx{}; }
    unsigned char* Hh; const LAS float* wtab; int NT;
    DI void operator()(const f32x4 (&acc)[2][2][4][2], const pg8::Unit& u, const Ctx& cx, int wr, int wc, int fr, int fq) const {
        const int row0 = u.pm * 256 + wr * 64 + fr, col0 = u.pn * 128 + wc * 32 + 8 * fq;
#pragma unroll
        for (int ai = 0; ai < 2; ++ai)
#pragma unroll
            for (int m = 0; m < 4; ++m) {
                float h[8]; const float w = wtab[u.li * 256 + wr * 64 + fr + ai * 128 + m * 16];
#pragma unroll
                for (int n = 0; n < 2; ++n)
#pragma unroll
                    for (int j = 0; j < 4; ++j) { const float g = acc[ai][0][m][n][j] * (1.0f / WSCALE), uu = acc[ai][1][m][n][j] * (1.0f / WSCALE); h[4 * n + j] = g * frcp(1.f + fexp2(-LOG2E * g)) * (uu * w); }
#pragma unroll
                for (int q = 0; q < 8; ++q) h[q] = __builtin_amdgcn_fmed3f(h[q] * HSCALE, -448.f, 448.f);
                int q0 = __builtin_amdgcn_cvt_pk_fp8_f32(h[0], h[1], 0, false); q0 = __builtin_amdgcn_cvt_pk_fp8_f32(h[2], h[3], q0, true);
                int q1 = __builtin_amdgcn_cvt_pk_fp8_f32(h[4], h[5], 0, false); q1 = __builtin_amdgcn_cvt_pk_fp8_f32(h[6], h[7], q1, true);
                *(u32x2*)(Hh + (size_t)(row0 + ai * 128 + m * 16) * EH + col0) = (u32x2){(unsigned)q0, (unsigned)q1};
            }
    }
};
constexpr float YSCALE = 16.0f;
DI unsigned pk_fp8x4(float a, float b, float c, float d) {
    constexpr float SC = YSCALE / (HSCALE * WSCALE);
    a = __builtin_amdgcn_fmed3f(a * SC, -448.f, 448.f); b = __builtin_amdgcn_fmed3f(b * SC, -448.f, 448.f); c = __builtin_amdgcn_fmed3f(c * SC, -448.f, 448.f); d = __builtin_amdgcn_fmed3f(d * SC, -448.f, 448.f);
    int w = __builtin_amdgcn_cvt_pk_fp8_f32(a, b, 0, false); w = __builtin_amdgcn_cvt_pk_fp8_f32(c, d, w, true); return (unsigned)w; }
struct EpiDownY {
    static constexpr bool PERM = true; struct Ctx {}; DI Ctx pre(const pg8::Unit&, int, int) const { return Ctx{}; }
    unsigned char* Y; bool dry;
    DI void operator()(const f32x4 (&acc)[2][2][4][2], const pg8::Unit& u, const Ctx& cx, int wr, int wc, int fr, int fq) const {
        const int rl0 = wr * 64 + fr, boff = ((u.pn * 4 + wc) * 4 + fq) * 16;
#pragma unroll
        for (int ai = 0; ai < 2; ++ai)
#pragma unroll
            for (int m = 0; m < 4; ++m) { const size_t slot = (size_t)u.pm * 256 + rl0 + ai * 128 + m * 16;
                u32x4 o;
                o.x = pk_fp8x4(acc[ai][0][m][0][0], acc[ai][0][m][0][1], acc[ai][0][m][0][2], acc[ai][0][m][0][3]); o.y = pk_fp8x4(acc[ai][0][m][1][0], acc[ai][0][m][1][1], acc[ai][0][m][1][2], acc[ai][0][m][1][3]);
                o.z = pk_fp8x4(acc[ai][1][m][0][0], acc[ai][1][m][0][1], acc[ai][1][m][0][2], acc[ai][1][m][0][3]); o.w = pk_fp8x4(acc[ai][1][m][1][0], acc[ai][1][m][1][1], acc[ai][1][m][1][2], acc[ai][1][m][1][3]);
                if (!dry) *(u32x4*)(Y + slot * 1024 + boff) = o; }
    }
};

struct ScanP { const bf16* RX; const bf16* GWT; const float* cw; const float* cb; const float* gab; const float* gxb; const float* c2; f32x2* carry; bf16* HF; bf16* HB; };
constexpr int UT_PITCH = 144;
constexpr int SC_RAW = 4608;
DI void load_raw(const bf16* RX, int tt0, int n, u32x4 (&rw)[5], int lane) {
    const int s0 = tt0 & (SEQ - 1);
#pragma unroll
    for (int i = 0; i < 5; ++i) { const int p = i * 64 + lane, row = p >> 3, ch = p & 7; const int ss = s0 + row - 2;
        u32x4 v = {0u, 0u, 0u, 0u};
        if (p < 288 && ss >= 0 && ss < SEQ) v = *(const GAS u32x4*)(RX + (size_t)(tt0 + row - 2) * RW + 64 * n + 8 * ch);
        rw[i] = v; }
}
DI void build_u_tile(const u32x4 (&rw)[5], float w0, float w1, float w2, float w3, float cbv, LAS unsigned char* ut, int lane) {
    LAS unsigned char* raw = ut + SC_RAW;
#pragma unroll
    for (int i = 0; i < 5; ++i) { const int p = i * 64 + lane; if (p < 288) *(LAS u32x4*)(raw + p * 16) = rw[i]; }
    float xm2 = bf2f(*(const LAS unsigned short*)(raw + 0 * 128 + lane * 2)), xm1 = bf2f(*(const LAS unsigned short*)(raw + 1 * 128 + lane * 2)), x0 = bf2f(*(const LAS unsigned short*)(raw + 2 * 128 + lane * 2));
#pragma unroll
    for (int tok = 0; tok < 32; ++tok) {
        const float x1 = bf2f(*(const LAS unsigned short*)(raw + (tok + 3) * 128 + lane * 2));
        const float uu = cbv + w0 * xm2 + w1 * xm1 + w2 * x0 + w3 * x1;
        *(LAS unsigned short*)(ut + tok * UT_PITCH + lane * 2) = (unsigned short)pg8::cvt_pk_bf16(uu, uu);
        xm2 = xm1; xm1 = x0; x0 = x1;
    }
}
DI void gate_ct(const LAS unsigned char* ut, const bf16x8 (&af)[4], const bf16x8 (&wA)[4], const bf16x8 (&wX)[4], float ba, float bx, float c2v, int ct, f32x16& a, f32x16& b, int lane) {
    const int col = lane & 31, hi = lane >> 5;
    f32x16 pa, px;
#pragma unroll
    for (int i = 0; i < 16; ++i) { pa[i] = 0.f; px[i] = 0.f; }
#pragma unroll
    for (int ks = 0; ks < 4; ++ks) { pa = MFMA32(af[ks], wA[ks], pa); px = MFMA32(af[ks], wX[ks], px); }
#pragma unroll
    for (int r = 0; r < 16; ++r) {
        const float uu = bf2f(*(const LAS unsigned short*)(ut + crow(r, hi) * UT_PITCH + (32 * ct + col) * 2));
        const float rr = frcp(1.f + fexp2(-LOG2E * (pa[r] + ba)));
        const float ii = frcp(1.f + fexp2(-LOG2E * (px[r] + bx)));
        const float av = fexp2(rr * c2v);
        a[r] = av; b[r] = __builtin_amdgcn_sqrtf(fmaxf(1.f - av * av, 0.f)) * ii * uu;
    }
}
template <int DIR, bool PASS2>
DI void scan_tile(const f32x16& a, const f32x16& b, LAS unsigned char* ocol, float& h, float& Ac, float& Bc, int hi) {
    float Ag[4], Bg[4];
#pragma unroll
    for (int g = 0; g < 4; ++g) {
        if (DIR == 0) { float B = b[4 * g]; B = a[4 * g + 1] * B + b[4 * g + 1]; B = a[4 * g + 2] * B + b[4 * g + 2]; B = a[4 * g + 3] * B + b[4 * g + 3]; Bg[g] = B; }
        else          { float B = b[4 * g + 3]; B = a[4 * g + 2] * B + b[4 * g + 2]; B = a[4 * g + 1] * B + b[4 * g + 1]; B = a[4 * g] * B + b[4 * g]; Bg[g] = B; }
        Ag[g] = (a[4 * g] * a[4 * g + 1]) * (a[4 * g + 2] * a[4 * g + 3]);
    }
    float AE[4], BE[4], AO[4], BO[4];
#pragma unroll
    for (int g = 0; g < 4; ++g) { const float pA = __shfl_xor(Ag[g], 32), pB = __shfl_xor(Bg[g], 32);
        AE[g] = hi ? pA : Ag[g]; BE[g] = hi ? pB : Bg[g]; AO[g] = hi ? Ag[g] : pA; BO[g] = hi ? Bg[g] : pB; }
    float hin[4];
    if (DIR == 0) {
#pragma unroll
        for (int g = 0; g < 4; ++g) { const float hE = h; h = AE[g] * h + BE[g]; const float hO = h; h = AO[g] * h + BO[g]; hin[g] = hi ? hO : hE;
            if (!PASS2) { Bc = AE[g] * Bc + BE[g]; Ac *= AE[g]; Bc = AO[g] * Bc + BO[g]; Ac *= AO[g]; } }
    } else {
#pragma unroll
        for (int g = 3; g >= 0; --g) { const float hO = h; h = AO[g] * h + BO[g]; const float hE = h; h = AE[g] * h + BE[g]; hin[g] = hi ? hO : hE;
            if (!PASS2) { Bc = AO[g] * Bc + BO[g]; Ac *= AO[g]; Bc = AE[g] * Bc + BE[g]; Ac *= AE[g]; } }
    }
    if (PASS2) {
#pragma unroll
        for (int g = 0; g < 4; ++g) { float hh = hin[g];
            if (DIR == 0) {
#pragma unroll
                for (int q = 0; q < 4; ++q) { hh = a[4 * g + q] * hh + b[4 * g + q]; *(LAS unsigned short*)(ocol + crow(4 * g + q, hi) * 128) = (unsigned short)pg8::cvt_pk_bf16(hh, hh); }
            } else {
#pragma unroll
                for (int q = 3; q >= 0; --q) { hh = a[4 * g + q] * hh + b[4 * g + q]; *(LAS unsigned short*)(ocol + crow(4 * g + q, hi) * 128) = (unsigned short)pg8::cvt_pk_bf16(hh, hh); }
            } }
    }
}
template <int DIR, bool PASS2>
DI void scan_sweep(const ScanP& P, int b, int n, int j, LAS unsigned char* ut, int lane) {
    const int col = lane & 31, hi = lane >> 5;
    bf16x8 wA[2][4], wX[2][4]; float ba[2], bx[2], c2v[2];
#pragma unroll
    for (int ct = 0; ct < 2; ++ct) {
#pragma unroll
        for (int ks = 0; ks < 4; ++ks) {
            wA[ct][ks] = *(const GAS bf16x8*)(P.GWT + ((size_t)((DIR * 2 + 0) * 8 + n) * 64 + 32 * ct + col) * 64 + 16 * ks + 8 * hi);
            wX[ct][ks] = *(const GAS bf16x8*)(P.GWT + ((size_t)((DIR * 2 + 1) * 8 + n) * 64 + 32 * ct + col) * 64 + 16 * ks + 8 * hi); }
        const int c = DIR * RW + 64 * n + 32 * ct + col; ba[ct] = P.gab[c]; bx[ct] = P.gxb[c]; c2v[ct] = P.c2[c];
    }
    const float w0 = P.cw[0 * RW + 64 * n + lane], w1 = P.cw[1 * RW + 64 * n + lane], w2 = P.cw[2 * RW + 64 * n + lane], w3 = P.cw[3 * RW + 64 * n + lane], cbv = P.cb[64 * n + lane];
    const int t0 = b * SEQ + j * LCH;
    u32x4 rw[5];
    load_raw(P.RX, t0 + 32 * (DIR == 0 ? 0 : (LCH / 32 - 1)), n, rw, lane);
    float h[2] = {0.f, 0.f}, Ac[2] = {1.f, 1.f}, Bc[2] = {0.f, 0.f};
    if (PASS2) {
        const f32x2* cr = P.carry + ((size_t)(b * 2 + DIR) * NCH) * RW + 64 * n + col;
        const int cnt = DIR == 0 ? j : (NCH - 1 - j);
        f32x2 ab[16][2];
#define SC_LD(dst, q0) do { _Pragma("unroll") for (int q = 0; q < 16; ++q) { const int qq_ = ((q0) + q < cnt) ? ((q0) + q) : (cnt > 0 ? cnt - 1 : 0); const int jj_ = DIR == 0 ? qq_ : (NCH - 1 - qq_); \
            _Pragma("unroll") for (int ct = 0; ct < 2; ++ct) dst[q][ct] = cr[(size_t)jj_ * RW + 32 * ct]; } } while (0)
        for (int q0 = 0; q0 < cnt; q0 += 16) {
            SC_LD(ab, q0);
#pragma unroll
            for (int q = 0; q < 16; ++q) if (q0 + q < cnt) {
#pragma unroll
                for (int ct = 0; ct < 2; ++ct) h[ct] = ab[q][ct].x * h[ct] + ab[q][ct].y; }
        }
#undef SC_LD
    }
#pragma unroll 1
    for (int tq = 0; tq < LCH / 32; ++tq) {
        const int ti = DIR == 0 ? tq : (LCH / 32 - 1 - tq);
        const int tt0 = t0 + 32 * ti;
        if (PASS2 && tq > 0) load_raw(P.RX, tt0, n, rw, lane);
        build_u_tile(rw, w0, w1, w2, w3, cbv, ut, lane);
        if (!PASS2 && tq + 1 < LCH / 32) load_raw(P.RX, t0 + 32 * (DIR == 0 ? tq + 1 : (LCH / 32 - 2 - tq)), n, rw, lane);
        bf16x8 af[4];
#pragma unroll
        for (int ks = 0; ks < 4; ++ks) af[ks] = *(const LAS bf16x8*)(ut + col * UT_PITCH + (16 * ks + 8 * hi) * 2);
        LAS unsigned char* ot = ut + SC_RAW;
#pragma unroll
        for (int ct = 0; ct < 2; ++ct) {
            f32x16 a, bb;
            gate_ct(ut, af, wA[ct], wX[ct], ba[ct], bx[ct], c2v[ct], ct, a, bb, lane);
            scan_tile<DIR, PASS2>(a, bb, ot + (32 * ct + col) * 2, h[ct], Ac[ct], Bc[ct], hi);
            __builtin_amdgcn_sched_barrier(0);
        }
        if (PASS2) {
            bf16* dst = (DIR == 0 ? P.HF : P.HB) + (size_t)tt0 * RW + 64 * n;
#pragma unroll
            for (int i = 0; i < 4; ++i) { const int p = i * 64 + lane, row = p >> 3, ch = p & 7; *(GAS u32x4*)(dst + (size_t)row * RW + 8 * ch) = *(const LAS u32x4*)(ot + p * 16); }
        }
    }
    if (!PASS2 && hi == 0) {
#pragma unroll
        for (int ct = 0; ct < 2; ++ct) P.carry[((size_t)(b * 2 + DIR) * NCH + j) * RW + 64 * n + 32 * ct + col] = (f32x2){Ac[ct], Bc[ct]};
    }
}
template <bool PASS2>
DI void scan_phase(Frame& F, const ScanP& P, int it_lo, int it_hi);
constexpr int AT_OACC = 0, AT_ML = 65536, AT_V = 69632;
DI s16x4 vtr(const LAS unsigned char* p) { typedef short v4i16_t __attribute__((ext_vector_type(4))); return __builtin_bit_cast(s16x4, __builtin_amdgcn_ds_read_tr16_b64_v4i16((LAS v4i16_t*)p)); }
DI void attn_tile(const bf16* Qp, const bf16* Kp, const bf16* Vp, int tb, int h, int rho, int dl, int nq0, int L, LAS unsigned char* vt, int lane, f32x16 (&o)[2], float& m_out, float& l_out) {
    const int qi = lane & 31, hi = lane >> 5;
    LAS unsigned char* kt_lds = vt + 32768;
    const int kt_lo = (nq0 >= 64) ? 0 : (2 - (nq0 >> 5)), kt_hi = ((L - nq0) >> 5) + 2 < 5 ? ((L - nq0) >> 5) + 2 : 5;
    bf16x8 qf[4]; u32x4 kr[5][4], vv[5][4];
    const size_t hoff = (size_t)h * HD;
    const bf16* qp = Qp + (size_t)(tb + rho + dl * (nq0 + qi)) * AW + hoff + 8 * hi;
#pragma unroll
    for (int ks = 0; ks < 4; ++ks) qf[ks] = *(const GAS bf16x8*)(qp + 16 * ks);
    const size_t kstep = (size_t)dl * 32 * AW;
    const size_t rowoff = (size_t)(tb + rho + dl * (nq0 - 64 + (lane >> 3))) * AW + hoff + 8 * (lane & 7);
    const bf16* kp0 = Kp + rowoff; const bf16* vp0 = Vp + rowoff;
    const size_t vrow8 = (size_t)dl * 8 * AW;
#define ATT_CL(kt) ((kt) < kt_lo ? kt_lo : ((kt) >= kt_hi ? kt_hi - 1 : (kt)))
#define ATT_LOADK(kt) do { const size_t ko_ = (size_t)ATT_CL(kt) * kstep; _Pragma("unroll") for (int i = 0; i < 4; ++i) kr[kt][i] = *(const GAS u32x4*)(kp0 + ko_ + i * vrow8); } while (0)
#define ATT_LOADV(kt) do { const size_t vo_ = (size_t)ATT_CL(kt) * kstep; _Pragma("unroll") for (int i = 0; i < 4; ++i) vv[kt][i] = *(const GAS u32x4*)(vp0 + vo_ + i * vrow8); } while (0)
    ATT_LOADK(0); ATT_LOADK(1); ATT_LOADK(2); ATT_LOADK(3); ATT_LOADK(4);
    ATT_LOADV(0); ATT_LOADV(1);
    f32x16 z;
#pragma unroll
    for (int i = 0; i < 16; ++i) z[i] = 0.f;
    o[0] = z; o[1] = z;
    float m = -1e30f, l = 0.f;
    const int q4 = (lane & 15) >> 2, p4 = lane & 3, blk = (lane >> 4) & 1;
    const LAS unsigned char* vrd = vt + (4 * hi + q4) * 128 + (16 * blk + 4 * p4) * 2;
    const int kwr = (lane >> 3) * 128 + (((lane & 7) ^ ((lane >> 3) & 7)) << 4);
    const LAS unsigned char* krd = kt_lds + qi * 128;
#pragma unroll
    for (int kt = 0; kt < 5; ++kt) {
        if (kt + 2 < 5) ATT_LOADV(kt + 2);
        if (kt >= kt_lo && kt < kt_hi) {
#pragma unroll
            for (int i = 0; i < 4; ++i) *(LAS u32x4*)(kt_lds + i * 1024 + kwr) = kr[kt][i];
            f32x16 s = z;
#pragma unroll
            for (int ks = 0; ks < 4; ++ks) { const bf16x8 kf = *(const LAS bf16x8*)(krd + (((2 * ks + hi) ^ (qi & 7)) << 4)); s = MFMA32(kf, qf[ks], s); }
#pragma unroll
            for (int i = 0; i < 4; ++i) { const int piece = i * 64 + lane; *(LAS u32x4*)(vt + piece * 16) = vv[kt][i]; }
            if (kt == 0) {
#pragma unroll
                for (int r = 0; r < 16; ++r) if (crow(r, hi) < qi) s[r] = -1e30f;
            }
            if (kt == 4) {
#pragma unroll
                for (int r = 0; r < 16; ++r) if (crow(r, hi) > qi) s[r] = -1e30f;
            }
            float tm = s[0];
#pragma unroll
            for (int r = 1; r < 16; ++r) tm = fmaxf(tm, s[r]);
            { const auto sw_ = __builtin_amdgcn_permlane32_swap(__float_as_uint(tm), __float_as_uint(tm), false, false); tm = fmaxf(__uint_as_float(sw_[0]), __uint_as_float(sw_[1])); }
            const float mn = fmaxf(m, tm), al = fexp2(m - mn);
            float ps = 0.f;
#pragma unroll
            for (int r = 0; r < 16; ++r) { s[r] = fexp2(s[r] - mn); ps += s[r]; }
            l = l * al + ps; m = mn;
#pragma unroll
            for (int r = 0; r < 16; ++r) { o[0][r] *= al; o[1][r] *= al; }
            bf16x8 pk[2];
#pragma unroll
            for (int sx = 0; sx < 2; ++sx) { u32x4 w; w.x = pg8::cvt_pk_bf16(s[8 * sx + 0], s[8 * sx + 1]); w.y = pg8::cvt_pk_bf16(s[8 * sx + 2], s[8 * sx + 3]);
                w.z = pg8::cvt_pk_bf16(s[8 * sx + 4], s[8 * sx + 5]); w.w = pg8::cvt_pk_bf16(s[8 * sx + 6], s[8 * sx + 7]); pk[sx] = __builtin_bit_cast(bf16x8, w); }
#pragma unroll
            for (int sx = 0; sx < 2; ++sx)
#pragma unroll
                for (int dh = 0; dh < 2; ++dh) {
                    const s16x4 lo = vtr(vrd + (16 * sx) * 128 + 64 * dh), hi4 = vtr(vrd + (16 * sx + 8) * 128 + 64 * dh);
                    const bf16x8 vf = __builtin_shufflevector(lo, hi4, 0, 1, 2, 3, 4, 5, 6, 7);
                    o[dh] = MFMA32(vf, pk[sx], o[dh]);
                }
        }
    }
#undef ATT_LOADK
#undef ATT_LOADV
#undef ATT_CL
    m_out = m; l_out = l + __shfl_xor(l, 32);
}
struct AttnP { const bf16* Q; const bf16* K; const bf16* V; bf16* O; };
DI void attn_phase(Frame& F, const AttnP& P) {
    LAS unsigned char* lds = F.lds;
    LAS unsigned char* vt = lds + AT_V + F.wave * 4096;
    const int lane = F.lane, qi = lane & 31, hi = lane >> 5;
    for (int unit = F.vcu; unit < NB * NH * (SEQ / 512); unit += F.G) {
        const int sp = unit & 15, h = (unit >> 4) & 7, b = unit >> 7;
        const int tb = b * SEQ, P0 = 512 * sp;
#pragma unroll 1
        for (int g = 0; g < 3; ++g) {
            const int dl = g == 0 ? 1 : (g == 1 ? 4 : 16), L = SEQ / dl;
#pragma unroll 1
            for (int xx = 0; xx < 2; ++xx) {
                const int x = F.wave + 8 * xx;
                int rho, nq0, qp0, qst;
                if (g == 0) { rho = 0; nq0 = P0 + 32 * x; qp0 = 32 * x; qst = 1; }
                else if (g == 1) { rho = x & 3; nq0 = P0 / 4 + 32 * (x >> 2); qp0 = rho + 128 * (x >> 2); qst = 4; }
                else { rho = x; nq0 = P0 / 16; qp0 = rho; qst = 16; }
                f32x16 o[2]; float m, l;
                attn_tile(P.Q, P.K, P.V, tb, h, rho, dl, nq0, L, vt, lane, o, m, l);
                const int qpos = qp0 + qst * qi;
                LAS unsigned char* orow = lds + AT_OACC + qpos * 128 + 8 * hi;
                LAS f32x2* ml = (LAS f32x2*)(lds + AT_ML) + qpos;
                float w2 = frcp(l), w1 = 0.f;
                if (g > 0) { const f32x2 old = *ml; const float mN = fmaxf(old.x, m); const float a1 = old.y * fexp2(old.x - mN), a2 = fexp2(m - mN); const float lN = a1 + l * a2, rl = frcp(lN);
                    w1 = a1 * rl; w2 = a2 * rl; m = mN; l = lN; }
#pragma unroll
                for (int dh = 0; dh < 2; ++dh)
#pragma unroll
                    for (int gq = 0; gq < 4; ++gq) {
                        LAS u32x2* p = (LAS u32x2*)(orow + (32 * dh + 8 * gq) * 2);
                        float v0 = o[dh][4 * gq] * w2, v1 = o[dh][4 * gq + 1] * w2, v2 = o[dh][4 * gq + 2] * w2, v3 = o[dh][4 * gq + 3] * w2;
                        if (g > 0) { const u32x2 ow = *p; v0 += bflo(ow.x) * w1; v1 += bfhi(ow.x) * w1; v2 += bflo(ow.y) * w1; v3 += bfhi(ow.y) * w1; }
                        u32x2 nw; nw.x = pg8::cvt_pk_bf16(v0, v1); nw.y = pg8::cvt_pk_bf16(v2, v3); *p = nw;
                    }
                if (hi == 0) *ml = (f32x2){m, l};
            }
            __syncthreads();
        }
#pragma unroll
        for (int i = 0; i < 8; ++i) { const int c = i * 512 + F.tid, q = c >> 3, ch = c & 7;
            *(GAS u32x4*)(P.O + (size_t)(tb + P0 + q) * AW + h * HD + 8 * ch) = *(const LAS u32x4*)(lds + AT_OACC + q * 128 + ch * 16); }
        __syncthreads();
    }
}

struct MixG { f32x4 ga0, ga1, gr0, gr1; };
DI MixG mix_gains(Frame& F) { const int lane = lane_id(); return MixG{*(const f32x4*)(F.in[3] + 8 * lane), *(const f32x4*)(F.in[3] + 8 * lane + 4), *(const f32x4*)(F.in[11] + 8 * lane), *(const f32x4*)(F.in[11] + 8 * lane + 4)}; }
DI void mix_pair(Frame& F, const MixG& g, int tA, int tB) {
    const bf16* AT = (const bf16*)(F.ws + WS_ATTN); const bf16* HFp = (const bf16*)(F.ws + WS_HF); const bf16* HBp = (const bf16*)(F.ws + WS_REC); const bf16* Gp = (const bf16*)(F.ws + WS_Q + 4 * SEG_BYTES);
    bf16* MX = (bf16*)(F.ws + WS_MIX); const int lane = lane_id();
    u32x4 a[2], hf[2], hb[2], gg[2];
#pragma unroll
    for (int u = 0; u < 2; ++u) { const size_t o = (size_t)(u ? tB : tA) * 512 + 8 * lane;
        a[u] = *(const GAS u32x4*)(AT + o); hf[u] = *(const GAS u32x4*)(HFp + o); hb[u] = *(const GAS u32x4*)(HBp + o); gg[u] = *(const GAS u32x4*)(Gp + o); }
#pragma unroll
    for (int u = 0; u < 2; ++u) {
        const int t = u ? tB : tA;
        float av[8] = {bflo(a[u].x), bfhi(a[u].x), bflo(a[u].y), bfhi(a[u].y), bflo(a[u].z), bfhi(a[u].z), bflo(a[u].w), bfhi(a[u].w)};
        float rv[8] = {(bflo(hf[u].x) + bflo(hb[u].x)) * bflo(gg[u].x), (bfhi(hf[u].x) + bfhi(hb[u].x)) * bfhi(gg[u].x), (bflo(hf[u].y) + bflo(hb[u].y)) * bflo(gg[u].y), (bfhi(hf[u].y) + bfhi(hb[u].y)) * bfhi(gg[u].y),
                       (bflo(hf[u].z) + bflo(hb[u].z)) * bflo(gg[u].z), (bfhi(hf[u].z) + bfhi(hb[u].z)) * bfhi(gg[u].z), (bflo(hf[u].w) + bflo(hb[u].w)) * bflo(gg[u].w), (bfhi(hf[u].w) + bfhi(hb[u].w)) * bfhi(gg[u].w)};
        float sa = 0.f, sr = 0.f;
#pragma unroll
        for (int i = 0; i < 8; ++i) { sa += av[i] * av[i]; sr += rv[i] * rv[i]; }
        sa = wave_sum(sa); sr = wave_sum(sr);
        const float ra = 1.0f / sqrtf(sa * (1.f / 512.f) + LN_EPS), rr = 1.0f / sqrtf(sr * (1.f / 512.f) + LN_EPS);
        u32x4 oa, orr;
        oa.x = pk2(av[0] * ra * g.ga0.x, av[1] * ra * g.ga0.y); oa.y = pk2(av[2] * ra * g.ga0.z, av[3] * ra * g.ga0.w); oa.z = pk2(av[4] * ra * g.ga1.x, av[5] * ra * g.ga1.y); oa.w = pk2(av[6] * ra * g.ga1.z, av[7] * ra * g.ga1.w);
        orr.x = pk2(rv[0] * rr * g.gr0.x, rv[1] * rr * g.gr0.y); orr.y = pk2(rv[2] * rr * g.gr0.z, rv[3] * rr * g.gr0.w); orr.z = pk2(rv[4] * rr * g.gr1.x, rv[5] * rr * g.gr1.y); orr.w = pk2(rv[6] * rr * g.gr1.z, rv[7] * rr * g.gr1.w);
        *(GAS u32x4*)(MX + (size_t)t * D + 8 * lane) = oa; *(GAS u32x4*)(MX + (size_t)t * D + AW + 8 * lane) = orr;
    }
}
DI void mix_phase(Frame& F) {
    const int gw = F.vcu * NWAVES + F.wave, NGW = F.G * NWAVES; const MixG g = mix_gains(F);
    for (int t0 = gw; t0 < T; t0 += 2 * NGW) mix_pair(F, g, t0, t0 + NGW);
}
template <bool PASS2>
DI void scan_phase(Frame& F, const ScanP& P, int it_lo, int it_hi) {
    LAS unsigned char* ut = F.lds + F.wave * 16640;
    LAS float* scr = (LAS float*)(F.lds + F.wave * 16640);
    const int gw = F.vcu * NWAVES + F.wave, NGW = F.G * NWAVES;
    const bool conv_first = F.wave < 4;
    const bool wg_units = PASS2 && (F.G * NWAVES == NB * 8 * NCH);
    if (conv_first) convert_items(F, it_lo, it_hi, scr);
    for (int u = gw; u < NB * 8 * NCH; u += NGW) {
        int j = u % NCH, n = (u / NCH) & 7, b = u / (NCH * 8);
        if (wg_units) { b = F.vcu / NCH; j = F.vcu % NCH; n = F.wave; }
        scan_sweep<0, PASS2>(P, b, n, j, ut, F.lane);
        scan_sweep<1, PASS2>(P, b, n, j, ut, F.lane);
    }
    if (!conv_first) convert_items(F, it_lo, it_hi, scr);
    if (wg_units) {
        VM_WAIT(); __syncthreads();
        const MixG g = mix_gains(F); const int t0 = (F.vcu / NCH) * SEQ + (F.vcu % NCH) * LCH + F.wave * 16;
#pragma unroll 1
        for (int i = 0; i < 16; i += 2) mix_pair(F, g, t0 + i, t0 + i + 1);
    }
}

DI void ln1_phase(Frame& F) {
    const bf16* Yb = (const bf16*)(F.ws + WS_V1); const float* X = F.in[0]; bf16* X1B = (bf16*)(F.ws + WS_X1B); unsigned char* X1F8 = F.ws + WS_HF;
    const int gw = F.vcu * NWAVES + F.wave, NGW = F.G * NWAVES, lane = F.lane;
    f32x4 gg[4], bb[4];
#pragma unroll
    for (int j = 0; j < 4; ++j) { gg[j] = *(const f32x4*)(F.in[13] + 4 * lane + 256 * j); bb[j] = *(const f32x4*)(F.in[14] + 4 * lane + 256 * j); }
    for (int t0 = gw; t0 < T; t0 += 2 * NGW) {
        f32x4 v[2][4]; u32x2 yv[2][4];
#pragma unroll
        for (int u = 0; u < 2; ++u) { const GAS f32x4* xr = (const GAS f32x4*)(X + (size_t)(t0 + u * NGW) * D) + lane; const GAS u32x2* yr = (const GAS u32x2*)(Yb + (size_t)(t0 + u * NGW) * D) + lane;
#pragma unroll
            for (int j = 0; j < 4; ++j) { v[u][j] = xr[64 * j]; yv[u][j] = yr[64 * j]; } }
#pragma unroll
        for (int u = 0; u < 2; ++u) {
            const int t = t0 + u * NGW; float s = 0.f;
#pragma unroll
            for (int j = 0; j < 4; ++j) { v[u][j] = v[u][j] * ALPHA + (f32x4){bflo(yv[u][j].x), bfhi(yv[u][j].x), bflo(yv[u][j].y), bfhi(yv[u][j].y)}; s += (v[u][j].x + v[u][j].y) + (v[u][j].z + v[u][j].w); }
            const float mean = wave_sum(s) * (1.f / D); float s2 = 0.f;
#pragma unroll
            for (int j = 0; j < 4; ++j) { v[u][j] = v[u][j] - mean; s2 += (v[u][j].x * v[u][j].x + v[u][j].y * v[u][j].y) + (v[u][j].z * v[u][j].z + v[u][j].w * v[u][j].w); }
            const float rstd = 1.f / sqrtf(wave_sum(s2) * (1.f / D) + LN_EPS);
            GAS u32x2* o2 = (GAS u32x2*)(X1B + (size_t)t * D) + lane;
#pragma unroll
            for (int j = 0; j < 4; ++j) { const f32x4 y = v[u][j] * rstd * gg[j] + bb[j]; u32x2 w; w.x = pk2(y.x, y.y); w.y = pk2(y.z, y.w); o2[64 * j] = w;
                int q = __builtin_amdgcn_cvt_pk_fp8_f32(y.x, y.y, 0, false); q = __builtin_amdgcn_cvt_pk_fp8_f32(y.z, y.w, q, true); *(GAS unsigned*)(X1F8 + (size_t)t * D + 4 * lane + 256 * j) = (unsigned)q; }
        }
    }
}
template <bool DRY>
DI void route_phase(Frame& F, int it_lo, int it_hi) {
    LAS float* cscr = (LAS float*)(F.lds + 8192 + F.wave * 16640);
    if (!DRY && F.wave < 4) convert_items(F, it_lo, it_hi, cscr);
    const bool opaque = DRY && (__hip_atomic_load((unsigned*)(F.ctl + CW_TMO), RLX_AGENT) == 0xdeadbeefu);
    const float* LG = (const float*)(F.ws + WS_LOGITS); const float* rbias = F.in[16];
    unsigned* ER = (unsigned*)(F.ws + WS_ER); float* GW = (float*)(F.ws + WS_GW); int* slot_tok = (int*)(F.ws + WS_SLOTTOK);
    LAS unsigned* hist = (LAS unsigned*)(F.lds); LAS unsigned* base = hist + 256; LAS unsigned* erl = hist + 512;
    const int lane = F.lane, tid = F.tid;
    if (!DRY) for (int i = F.vcu * 512 + tid; i < MAXSLOTS; i += F.G * 512) slot_tok[i] = 0;
    if (tid < 256) hist[tid] = 0u;
    __syncthreads();
    const int TPW = T / F.G;
    const f32x4 bi = ((const f32x4*)rbias)[lane];
    const float NEGINF = -__builtin_huge_valf();
    f32x4 nl0, nl1;
    { const int t = F.vcu * TPW + F.wave; nl0 = ((const GAS f32x4*)(LG + (size_t)t * NE))[lane]; nl1 = ((const GAS f32x4*)(LG + (size_t)T * NE + (size_t)t * NE))[lane]; }
    for (int i = F.wave; i < TPW; i += NWAVES) {
        const int t = F.vcu * TPW + i;
        const f32x4 lg = nl0 + nl1;
        { const int tn = F.vcu * TPW + ((i + NWAVES < TPW) ? i + NWAVES : i); nl0 = ((const GAS f32x4*)(LG + (size_t)tn * NE))[lane]; nl1 = ((const GAS f32x4*)(LG + (size_t)T * NE + (size_t)tn * NE))[lane]; }
        const float s0 = 1.f / (1.f + expf(-lg.x)), s1 = 1.f / (1.f + expf(-lg.y)), s2 = 1.f / (1.f + expf(-lg.z)), s3 = 1.f / (1.f + expf(-lg.w));
        float v0 = s0 + bi.x, v1 = s1 + bi.y, v2 = s2 + bi.z, v3 = s3 + bi.w;
        const float hi1 = fmaxf(v0, v1), lo1 = fminf(v0, v1), hi2 = fmaxf(v2, v3), lo2 = fminf(v2, v3);
        float m1 = fmaxf(hi1, hi2), m2 = fmaxf(fminf(hi1, hi2), fmaxf(lo1, lo2));
#pragma unroll
        for (int o = 1; o < 8; o <<= 1) { const float o1 = __shfl_xor(m1, o), o2 = __shfl_xor(m2, o); const float n1 = fmaxf(m1, o1), n2 = fmaxf(fminf(m1, o1), fmaxf(m2, o2)); m1 = n1; m2 = n2; }
        const float gs = m1 + m2; const int myg = lane >> 3; int rank = 0;
#pragma unroll
        for (int j = 0; j < 8; ++j) { const float gj = __shfl(gs, 8 * j); rank += (gj > gs || (gj == gs && j < myg)) ? 1 : 0; }
        if (rank >= 4) { v0 = NEGINF; v1 = NEGINF; v2 = NEGINF; v3 = NEGINF; }
        int me = 0; float mg = 0.f, gsum = 0.f;
#pragma unroll
        for (int k = 0; k < 8; ++k) {
            const float lm = fmaxf(fmaxf(v0, v1), fmaxf(v2, v3)), wm = wave_max_fast(lm);
            int cand = 1 << 20;
            if (v3 == wm) cand = 4 * lane + 3;
            if (v2 == wm) cand = 4 * lane + 2;
            if (v1 == wm) cand = 4 * lane + 1;
            if (v0 == wm) cand = 4 * lane + 0;
            const int e = wave_min_i_fast(cand), el = e >> 2, ei = e & 3;
            const float mysc = ei == 0 ? s0 : (ei == 1 ? s1 : (ei == 2 ? s2 : s3));
            const float sc = __shfl(mysc, el);
            if (lane == el) { if (ei == 0) v0 = NEGINF; else if (ei == 1) v1 = NEGINF; else if (ei == 2) v2 = NEGINF; else v3 = NEGINF; }
            me = (lane == k) ? e : me; mg = (lane == k) ? sc : mg; gsum += sc;
        }
        if (lane < 8) { const unsigned lr = __hip_atomic_fetch_add(hist + me, 1u, __ATOMIC_RELAXED, __HIP_MEMORY_SCOPE_WORKGROUP); erl[i * 8 + lane] = ((unsigned)me << 24) | lr; if (!DRY || opaque) GW[(size_t)t * 8 + lane] = mg / gsum * 2.5f; }
    }
    __syncthreads();
    if (tid < 256) base[tid] = DRY ? 0u : atomicAdd((unsigned*)(F.ctl + CW_CNT) + tid, hist[tid]);
    __syncthreads();
    if (!DRY) for (int i = tid; i < TPW * 8; i += 512) { const unsigned er = erl[i]; ER[(size_t)F.vcu * TPW * 8 + i] = er + base[er >> 24]; }
    __syncthreads();
    if (!DRY && F.wave >= 4) convert_items(F, it_lo, it_hi, cscr);
}
DI void slot_phase(Frame& F) {
    const unsigned* ER = (const unsigned*)(F.ws + WS_ER); const float* GW = (const float*)(F.ws + WS_GW);
    unsigned* TS = (unsigned*)(F.ws + WS_TS); int* slot_tok = (int*)(F.ws + WS_SLOTTOK); float* slot_w = (float*)(F.ws + WS_SLOTW); int* tile_e = (int*)(F.ws + WS_TILEE);
    LAS int* tb = (LAS int*)(F.lds); LAS int* tmp = tb + 512;
    const int tid = F.tid;
    int nt_e = 0;
    if (tid < 256) { nt_e = ((int)__hip_atomic_load((unsigned*)(F.ctl + CW_CNT) + tid, RLX_AGENT) + 255) >> 8; tmp[tid] = nt_e; }
    __syncthreads();
    int src = 0;
    for (int o = 1; o < 256; o <<= 1) { if (tid < 256) { int v = tmp[src * 256 + tid]; if (tid >= o) v += tmp[src * 256 + tid - o]; tmp[(src ^ 1) * 256 + tid] = v; } src ^= 1; __syncthreads(); }
    if (tid < 256) tb[tid] = tmp[src * 256 + tid] - nt_e;
    const int NT = tmp[src * 256 + 255];
    __syncthreads();
    if (F.vcu == 0) {
        if (tid == 0) __hip_atomic_store((unsigned*)(F.ctl + CW_NT), (unsigned)NT, RLX_AGENT);
        if (tid < 256) for (int tl = tb[tid]; tl < tb[tid] + nt_e; ++tl) tile_e[tl] = tid;
        for (int i = tid; i < NSHT; i += 512) tile_e[NT + i] = NE;
    }
    for (int i = F.vcu * 512 + tid; i < T; i += F.G * 512) { slot_tok[(size_t)NT * 256 + i] = i; }
    const int TPW = T / F.G;
    for (int i = tid; i < TPW * 8; i += 512) {
        const size_t gi = (size_t)F.vcu * TPW * 8 + i; const unsigned er = ER[gi]; const int e = er >> 24, rk = er & 0xffffff;
        const int slot = tb[e] * 256 + rk;
        slot_tok[slot] = (int)(gi >> 3); slot_w[slot] = GW[gi]; TS[gi] = (unsigned)slot;
    }
}
DI void acc_fp8x4(unsigned w, f32x4& v) { const f32x2 a = __builtin_amdgcn_cvt_pk_f32_fp8((int)w, false), b = __builtin_amdgcn_cvt_pk_f32_fp8((int)w, true); v.x += a.x; v.y += a.y; v.z += b.x; v.w += b.y; }
template <bool STORE>
DI void final_phase(Frame& F) {
    const bool opaque = !STORE && (__hip_atomic_load((unsigned*)(F.ctl + CW_TMO), RLX_AGENT) == 0xdeadbeefu);
    const unsigned char* Y = (const unsigned char*)(F.ws + WS_Y); const unsigned* TS = (const unsigned*)(F.ws + WS_TS); const bf16* X1B = (const bf16*)(F.ws + WS_X1B);
    const size_t shslot0 = (size_t)__hip_atomic_load((unsigned*)(F.ctl + CW_NT), RLX_AGENT) * 256;
    const int gw = F.vcu * NWAVES + F.wave, NGW = F.G * NWAVES, lane = F.lane;
    const int cb = 256 * (lane >> 4) + 32 * ((lane >> 2) & 3) + 8 * (lane & 3);
    f32x4 gg[4], bb[4];
#pragma unroll
    for (int bj = 0; bj < 2; ++bj)
#pragma unroll
        for (int hh = 0; hh < 2; ++hh) { gg[2 * bj + hh] = *(const f32x4*)(F.in[23] + cb + 128 * bj + 4 * hh); bb[2 * bj + hh] = *(const f32x4*)(F.in[24] + cb + 128 * bj + 4 * hh); }
    for (int t0 = gw; t0 < T; t0 += 8 * NGW) {
        const int ti = lane >> 3; const int tt = t0 + ti * NGW;
        const unsigned myslot = (tt < T) ? TS[(size_t)tt * 8 + (lane & 7)] : 0u;
#pragma unroll 1
        for (int i = 0; i < 8; ++i) {
            const int t = t0 + i * NGW; if (t >= T) break;
            float* xr = F.out + (size_t)t * D + cb;
            f32x4 v[4];
#pragma unroll
            for (int bj = 0; bj < 2; ++bj) { const u32x4 w = *(const GAS u32x4*)(X1B + (size_t)t * D + cb + 128 * bj);
                v[2 * bj] = (f32x4){bflo(w.x), bfhi(w.x), bflo(w.y), bfhi(w.y)} * ALPHA; v[2 * bj + 1] = (f32x4){bflo(w.z), bfhi(w.z), bflo(w.w), bfhi(w.w)} * ALPHA; }
            u32x4 yv[8]; const u32x4 ysh = ((const GAS u32x4*)(Y + (shslot0 + (size_t)t) * 1024))[lane];
#pragma unroll
            for (int k = 0; k < 8; ++k) { const unsigned slot = __shfl(myslot, i * 8 + k); yv[k] = ((const GAS u32x4*)(Y + (size_t)slot * 1024))[lane]; }
            f32x4 a[4];
#pragma unroll
            for (int j = 0; j < 4; ++j) a[j] = (f32x4){0.f, 0.f, 0.f, 0.f};
#pragma unroll
            for (int k = 0; k < 8; ++k) { acc_fp8x4(yv[k].x, a[0]); acc_fp8x4(yv[k].y, a[1]); acc_fp8x4(yv[k].z, a[2]); acc_fp8x4(yv[k].w, a[3]); }
            acc_fp8x4(ysh.x, a[0]); acc_fp8x4(ysh.y, a[1]); acc_fp8x4(ysh.z, a[2]); acc_fp8x4(ysh.w, a[3]);
#pragma unroll
            for (int j = 0; j < 4; ++j) v[j] = v[j] + a[j] * (1.0f / YSCALE);
            float s = 0.f;
#pragma unroll
            for (int j = 0; j < 4; ++j) s += (v[j].x + v[j].y) + (v[j].z + v[j].w);
            const float mean = wave_sum(s) * (1.f / D); float s2 = 0.f;
#pragma unroll
            for (int j = 0; j < 4; ++j) { v[j] = v[j] - mean; s2 += (v[j].x * v[j].x + v[j].y * v[j].y) + (v[j].z * v[j].z + v[j].w * v[j].w); }
            const float rstd = 1.f / sqrtf(wave_sum(s2) * (1.f / D) + LN_EPS);
            if (STORE || opaque) {
#pragma unroll
                for (int bj = 0; bj < 2; ++bj) { *(GAS f32x4*)(xr + 128 * bj) = v[2 * bj] * rstd * gg[2 * bj] + bb[2 * bj]; *(GAS f32x4*)(xr + 128 * bj + 4) = v[2 * bj + 1] * rstd * gg[2 * bj + 1] + bb[2 * bj + 1]; } }
        }
    }
}

#ifndef REPMASK
#define REPMASK 0
#endif
constexpr int N_PHASES = 13;
constexpr int XC_P1 = (XI_ALL * 37 / 100) & ~2047, XC_P2 = (XI_ALL * 57 / 100) & ~2047, XC_P3 = (XI_ALL * 87 / 100) & ~2047;
struct Args { const float* in[25]; float* out; unsigned char* ws; int ph_lo, ph_hi, li, pad; };
DI void ph1_part(Frame& F, int i0, int i1) {
    unsigned char* ws = F.ws;
    SchedDense S{(const bf16*)(ws + WS_XB), (const bf16*)(ws + WS_WINT), D, D, T / 256, INW / 256, F.G, (int)blockIdx.x, i0, i1};
    EpiInProj E{(bf16*)(ws + WS_Q), (const float*)(ws + WS_ROPE)};
    pg8::gemm_phase<EpiInProj, SchedDense, true>(F.lds + RING_OFF, S, E, D);
}
DI void ph1(Frame& F) {
    LAS float* scr = (LAS float*)(F.lds + F.wave * 16640);
    const int grp = F.vcu % 3;
    if (grp == 0) { convert_items(F, 0, XC_P1, scr); __syncthreads(); }
    ph1_part(F, 0, 2);
    if (grp == 1) { __syncthreads(); convert_items(F, 0, XC_P1, scr); __syncthreads(); }
    ph1_part(F, 2, 1 << 20);
    if (grp == 2) { __syncthreads(); convert_items(F, 0, XC_P1, scr); }
}
DI ScanP mk_scanp(Frame& F) { unsigned char* ws = F.ws;
    return ScanP{(const bf16*)(ws + WS_Q + 3 * SEG_BYTES), (const bf16*)(ws + WS_GWT), F.in[4], F.in[5], F.in[7], F.in[9],
                 (const float*)(ws + WS_C2), (f32x2*)(ws + WS_CARRY), (bf16*)(ws + WS_HF), (bf16*)(ws + WS_REC)}; }
DI void ph2(Frame& F) {
    unsigned char* ws = F.ws;
    const ScanP SP = mk_scanp(F);
    scan_phase<false>(F, SP, XC_P1, XC_P2);
    if constexpr ((REPMASK >> 14) & 1) { __syncthreads(); scan_phase<false>(F, SP, 0, 0); }
    __syncthreads();
    const AttnP AP{(const bf16*)(ws + WS_Q), (const bf16*)(ws + WS_Q + SEG_BYTES), (const bf16*)(ws + WS_Q + 2 * SEG_BYTES), (bf16*)(ws + WS_ATTN)};
    attn_phase(F, AP);
    if constexpr ((REPMASK >> 13) & 1) { attn_phase(F, AP); }
}
DI void ph3(Frame& F) { const ScanP SP = mk_scanp(F); scan_phase<true>(F, SP, XC_P2, XC_P3); }
DI void ph5(Frame& F) {
    unsigned char* ws = F.ws;
    SchedDense S{(const bf16*)(ws + WS_MIX), (const bf16*)(ws + WS_WOUTT), D, D, T / 256, D / 256, F.G, (int)blockIdx.x, 0, 1 << 20};
    EpiYb E{(bf16*)(ws + WS_V1)};
    pg8::gemm_phase<EpiYb, SchedDense, true>(F.lds + RING_OFF, S, E, D);
}
DI void ph7(Frame& F) {
    unsigned char* ws = F.ws;
    SchedRouter S{(const bf16*)(ws + WS_X1B), (const bf16*)(ws + WS_RTT), D, D, T / 256, F.G, (int)blockIdx.x};
    EpiLogits E{(float*)(ws + WS_LOGITS)};
    pg8::gemm_phase<EpiLogits, SchedRouter, true>(F.lds + RING_OFF, S, E, 512);
}
DI void ph10(Frame& F) {
    unsigned char* ws = F.ws; const int cid = (int)blockIdx.x;
    LAS unsigned* ue = (LAS unsigned*)(F.lds + UT_OFF); LAS unsigned* uidx = (LAS unsigned*)(F.lds + UT_IDX);
    const int NT = (int)__hip_atomic_load((unsigned*)(F.ctl + CW_NT), RLX_AGENT);
    const int nwg = 2 * (NT + NSHT);
    const int* tile_e = (const int*)(ws + WS_TILEE); const int* slot_tok = (const int*)(ws + WS_SLOTTOK);
    __syncthreads();
    {
        unsigned te[11], st[11]; float sw[11]; const float* slot_w = (const float*)(ws + WS_SLOTW); LAS float* uw = (LAS float*)(F.lds + UT_W);
#pragma unroll
        for (int i = 0; i < 11; ++i) { int wgid; const bool ok = pg8::xcd_order(i, F.G, cid, nwg, wgid); const int tile = ok ? (wgid >> 1) : 0;
            te[i] = (unsigned)tile_e[tile]; st[i] = (F.tid < 256) ? (unsigned)slot_tok[(size_t)tile * 256 + F.tid] : 0u; sw[i] = (F.tid < 256 && tile < NT) ? slot_w[(size_t)tile * 256 + F.tid] : 1.0f; }
#pragma unroll
        for (int i = 0; i < 11; ++i) { if (F.tid == 0) ue[i] = te[i]; if (F.tid < 256) { uidx[i * 256 + F.tid] = st[i]; uw[i * 256 + F.tid] = sw[i]; } }
    }
    __syncthreads();
    SchedG1 S{(const bf16*)(ws + WS_HF), (const bf16*)(ws + WS_WGUT), ue, uidx, D / 2, nwg, F.G, cid, (size_t)0};
    EpiSwiglu E{(unsigned char*)(ws + WS_H), (const LAS float*)(F.lds + UT_W), NT};
    pg8::gemm_phase<EpiSwiglu, SchedG1, true, false, true>(F.lds + RING_OFF, S, E, D / 2);
}
template <bool DRY>
DI void ph11a(Frame& F) {
    unsigned char* ws = F.ws; const int cid = (int)blockIdx.x;
    LAS unsigned* ue = (LAS unsigned*)(F.lds + UT_OFF);
    const int NT = (int)__hip_atomic_load((unsigned*)(F.ctl + CW_NT), RLX_AGENT);
    const int* tile_e = (const int*)(ws + WS_TILEE);
    const int nwg = 4 * (NT + NSHT);
    __syncthreads();
    for (int i = F.tid; i < 22; i += NWAVES * 64) { int wgid; if (pg8::xcd_order(i, F.G, cid, nwg, wgid)) ue[i] = (unsigned)tile_e[wgid >> 2]; }
    __syncthreads();
    SchedG2 S{(const bf16*)(ws + WS_H), (const bf16*)(ws + WS_WDT), ue, EH / 2, nwg, F.G, cid, 0, (size_t)0};
    EpiDownY E{(unsigned char*)(ws + WS_Y), DRY && (__hip_atomic_load((unsigned*)(F.ctl + CW_TMO), RLX_AGENT) != 0xdeadbeefu)};
    pg8::gemm_phase<EpiDownY, SchedG2, true, false, true>(F.lds + RING_OFF, S, E, EH / 2);
}
#ifndef PHMASK
#define PHMASK 0x1fff
#endif
#ifndef REPMASK
#define REPMASK 0
#endif
__global__ void __launch_bounds__(NWAVES * 64, 2) mk_fwd(Args args) {
    extern __shared__ __attribute__((aligned(16))) unsigned char lds_raw[];
    Frame F;
    F.lds = (LAS unsigned char*)lds_raw;
    F.MISC = (volatile LAS unsigned*)(F.lds + MISC_OFF);
    F.tid = threadIdx.x; F.lane = F.tid & 63; F.wave = __builtin_amdgcn_readfirstlane(F.tid >> 6);
    F.G = gridDim.x; { const int bx = blockIdx.x; F.vcu = (F.G % 8 == 0) ? (bx % 8) * (F.G / 8) + bx / 8 : bx; }
    F.ws = args.ws; F.out = args.out; F.ctl = (gu32*)(args.ws + WS_CTL);
#pragma unroll
    for (int i = 0; i < 25; ++i) F.in[i] = args.in[i];
    if (F.tid < 64) F.MISC[F.tid] = 0u;
    __syncthreads();
    XcdBarrier bar = xcd_barrier_post((unsigned*)(F.ctl + CW_BAR) + args.li * XCD_BAR_WORDS, F.MISC + 8);
    const int lo = args.ph_lo, hi = args.ph_hi;
#ifdef REPORT_K
    unsigned long long* tsb = (unsigned long long*)(args.ws + WS_END + 8 * MiB); int nst = 0;
#define STAMP() do { if (blockIdx.x == 0 && F.tid == 0) tsb[nst] = __builtin_amdgcn_s_memrealtime(); ++nst; } while (0)
#else
#define STAMP() do {} while (0)
#endif
    STAMP();
#define IN(k) (((PHMASK >> (k)) & 1) && lo <= (k) && (k) < hi)
#define REP(k) if constexpr (((REPMASK) >> (k)) & 1)
#define SEAM(k) do { if (IN(k) && IN((k) + 1)) xcd_barrier(bar); STAMP(); } while (0)
    if (IN(0)) { p0_prologue(F); REP(0) { __syncthreads(); p0_prologue(F); } } SEAM(0);
    if (IN(1)) { ph1(F); REP(1) ph1(F); } SEAM(1);
    if (IN(2)) { ph2(F); REP(2) ph2(F); } SEAM(2);
    if (IN(3)) { ph3(F); REP(3) ph3(F); } SEAM(3);
    const bool fused_mix = (F.G * NWAVES == NB * 8 * NCH);
    if (IN(4) && !fused_mix) { mix_phase(F); } if (!fused_mix) SEAM(4);
    if (IN(5)) { ph5(F); REP(5) ph5(F); } SEAM(5);
    if (IN(6)) { ln1_phase(F); REP(6) ln1_phase(F); } SEAM(6);
    if (IN(7)) { ph7(F); REP(7) ph7(F); } SEAM(7);
    if (IN(8)) { REP(8) { route_phase<true>(F, 0, 0); } route_phase<false>(F, XC_P3, XI_ALL); } SEAM(8);
    if (IN(9)) { slot_phase(F); REP(9) { __syncthreads(); slot_phase(F); } } SEAM(9);
    if (IN(10)) { ph10(F); REP(10) ph10(F); } SEAM(10);
    if (IN(11)) { REP(11) ph11a<true>(F); ph11a<false>(F); } SEAM(11);
    if (IN(12)) { REP(12) { final_phase<false>(F); } final_phase<true>(F); }
    STAMP();
#undef IN
#undef REP
#undef SEAM
}

#if defined(SELFCHECK) && SELFCHECK
namespace chk {
constexpr int NS = 64;
struct InP { const float* p[25]; };
DI float f8dec(unsigned b) { const int e = (b >> 3) & 15, m = b & 7; const float mag = e == 0 ? (float)m * 0.001953125f : (1.f + (float)m * 0.125f) * exp2f((float)(e - 7)); return (b & 128) ? -mag : mag; }
DI float h_at(const unsigned char* ws, size_t slot, int c) { return f8dec(ws[WS_H + slot * EH + c]) * (1.0f / HSCALE); }

__host__ __device__ inline int samp_tok(int i) { return i == 0 ? 0 : i == 1 ? 8191 : i == 2 ? 8192 : i == 3 ? T - 1 : i == 4 ? 63 : i == 5 ? 64 : i == 6 ? 8127 : i == 7 ? 16384 + 4095 : (int)(((long)i * 2039 + 17 * (i % 5)) % T); }
DI void put_err(unsigned* CHK, int stage, float num, float den) { float e = sqrtf(num / (den + 1e-30f)); if (!(e == e)) e = 1e30f; atomicMax(CHK + stage, __float_as_uint(e)); }
DI float blk_sum(float v, float* red) {
    v = wave_sum(v); __syncthreads(); if ((threadIdx.x & 63) == 0) red[threadIdx.x >> 6] = v; __syncthreads(); return red[0] + red[1] + red[2] + red[3]; }
__global__ void __launch_bounds__(256) c1(const float* x, const int* pos, const float* w_in, const unsigned char* ws, unsigned* CHK) {
    __shared__ float hrow[INW]; __shared__ float red[4];
    const int t = samp_tok(blockIdx.x), tid = threadIdx.x;
    for (int c = tid; c < INW; c += 256) { float a = 0.f; for (int k = 0; k < D; ++k) a = fmaf(x[(size_t)t * D + k], w_in[(size_t)k * INW + c], a); hrow[c] = a; }
    __syncthreads();
    if (tid < 128) { const int i = tid & 7, head = (tid >> 3) & 7, which = tid >> 6;
        const float invf[8] = {1.0f, 0x1.8d275ep-3f, 0x1.341190p-5f, 0x1.ddee9cp-8f, 0x1.72ba44p-10f, 0x1.1f91f0p-12f, 0x1.be218ap-15f, 0x1.5a0f50p-17f};
        float inv = invf[0];
#pragma unroll
        for (int j = 1; j < 8; ++j) inv = (i == j) ? invf[j] : inv;
        float c, s; sincos_acc((float)pos[t] * inv, c, s);
        float* p = hrow + which * AW + head * HD; const float t1 = p[i], t2 = p[i + 8]; p[i] = t1 * c - t2 * s; p[i + 8] = t2 * c + t1 * s; }
    __syncthreads();
    float num = 0.f, den = 0.f;
    for (int c = tid; c < INW; c += 256) { const int seg = c >> 9; float r = hrow[c]; if (seg == 0) r *= QSCALE; if (seg == 4) r = gelu_tanh(r);
        const float f = bf2f(((const bf16*)(ws + WS_Q + (size_t)seg * SEG_BYTES))[(size_t)t * 512 + (c & 511)]); num += (f - r) * (f - r); den += r * r; }
    num = blk_sum(num, red); den = blk_sum(den, red);
    if (tid == 0) put_err(CHK, 1, num, den);
}
__global__ void __launch_bounds__(64) c2(const unsigned char* ws, unsigned* CHK) {
    const bf16* Q = (const bf16*)(ws + WS_Q); const bf16* K = (const bf16*)(ws + WS_Q + SEG_BYTES); const bf16* V = (const bf16*)(ws + WS_Q + 2 * SEG_BYTES); const bf16* O = (const bf16*)(ws + WS_ATTN);
    const int lane = threadIdx.x, head = blockIdx.x & 7, t = samp_tok(blockIdx.x >> 3), b = t / SEQ, s = t % SEQ;
    const float q = bf2f(Q[(size_t)t * AW + head * HD + lane]);
    float m = -1e30f, den = 0.f, o = 0.f;
    for (int g = 0; g < 3; ++g) { const int d = g == 0 ? 1 : (g == 1 ? 4 : 16);
        for (int mm = -64; mm <= 64; ++mm) { const int j = s + d * mm; if (j < 0 || j >= SEQ) continue;
            const size_t row = (size_t)(b * SEQ + j) * AW + head * HD + lane;
            const float sc = wave_sum(q * bf2f(K[row])); const float mn = fmaxf(m, sc), al = exp2f(m - mn), p = exp2f(sc - mn);
            den = den * al + p; o = o * al + p * bf2f(V[row]); m = mn; } }
    const float r = o / den, f = bf2f(O[(size_t)t * AW + head * HD + lane]);
    const float num = wave_sum((f - r) * (f - r)), dn = wave_sum(r * r);
    if (lane == 0) put_err(CHK, 2, num, dn);
}
__global__ void __launch_bounds__(64) c3(InP ip, const unsigned char* ws, float* scratch, unsigned* CHK) {
    const float* cw = ip.p[4]; const float* cb = ip.p[5]; const float* gaw = ip.p[6]; const float* gab = ip.p[7]; const float* gxw = ip.p[8]; const float* gxb = ip.p[9]; const float* lam = ip.p[10];
    const bf16* RX = (const bf16*)(ws + WS_Q + 3 * SEG_BYTES); const bf16* G = (const bf16*)(ws + WS_Q + 4 * SEG_BYTES); const bf16* HFp = (const bf16*)(ws + WS_HF); const bf16* HBp = (const bf16*)(ws + WS_REC);
    const int lane = threadIdx.x, smp = blockIdx.x, b = smp & 3, c = (smp * 37 + 5) % RW, n = c >> 6, j = c & 63;
    float* sc = scratch + (size_t)smp * SEQ * 4;
    for (int s = lane; s < SEQ; s += 64) {
        float pa0 = 0.f, pa1 = 0.f, px0 = 0.f, px1 = 0.f, uc = 0.f;
        for (int i = 0; i < 64; ++i) { const int ci = 64 * n + i; float u = cb[ci];
            for (int k = 0; k < 4; ++k) { const int ss = s + k - 2; if (ss >= 0 && ss < SEQ) u = fmaf(cw[k * RW + ci], bf2f(RX[(size_t)(b * SEQ + ss) * RW + ci]), u); }
            if (i == j) uc = u;
            pa0 = fmaf(u, gaw[(((size_t)0 * 8 + n) * 64 + i) * 64 + j], pa0); px0 = fmaf(u, gxw[(((size_t)0 * 8 + n) * 64 + i) * 64 + j], px0);
            pa1 = fmaf(u, gaw[(((size_t)1 * 8 + n) * 64 + i) * 64 + j], pa1); px1 = fmaf(u, gxw[(((size_t)1 * 8 + n) * 64 + i) * 64 + j], px1); }
        { const float r = 1.f / (1.f + expf(-(pa0 + gab[c]))), ig = 1.f / (1.f + expf(-(px0 + gxb[c])));
          const float l = lam[c], sp = log1pf(expf(-l)), log_a = -8.0f * r * sp, a = expf(log_a);
          sc[(size_t)s * 4 + 0] = a; sc[(size_t)s * 4 + 1] = sqrtf(-expm1f(2.0f * log_a)) * ig * uc; }
        { const float r = 1.f / (1.f + expf(-(pa1 + gab[RW + c]))), ig = 1.f / (1.f + expf(-(px1 + gxb[RW + c])));
          const float l = lam[RW + c], sp = log1pf(expf(-l)), log_a = -8.0f * r * sp, a = expf(log_a);
          sc[(size_t)s * 4 + 2] = a; sc[(size_t)s * 4 + 3] = sqrtf(-expm1f(2.0f * log_a)) * ig * uc; }
    }
    __syncthreads();
    if (lane == 0) { float h = 0.f; for (int s = 0; s < SEQ; ++s) { h = fmaf(sc[(size_t)s * 4], h, sc[(size_t)s * 4 + 1]); sc[(size_t)s * 4 + 1] = h; } }
    if (lane == 1) { float h = 0.f; for (int s = SEQ - 1; s >= 0; --s) { h = fmaf(sc[(size_t)s * 4 + 2], h, sc[(size_t)s * 4 + 3]); sc[(size_t)s * 4 + 3] = h; } }
    __syncthreads();
    float num = 0.f, den = 0.f;
    for (int s = lane; s < SEQ; s += 64) { const size_t o = (size_t)(b * SEQ + s) * RW + c; const float r = (sc[(size_t)s * 4 + 1] + sc[(size_t)s * 4 + 3]) * bf2f(G[o]), f = (bf2f(HFp[o]) + bf2f(HBp[o])) * bf2f(G[o]); num += (f - r) * (f - r); den += r * r; }
    num = wave_sum(num); den = wave_sum(den);
    if (lane == 0) put_err(CHK, 3, num, den);
}
__global__ void __launch_bounds__(256) c4(const float* ga, const float* gr, const unsigned char* ws, unsigned* CHK) {
    __shared__ float red[4];
    const bf16* AT = (const bf16*)(ws + WS_ATTN); const bf16* HFp = (const bf16*)(ws + WS_HF); const bf16* HBp = (const bf16*)(ws + WS_REC); const bf16* Gp = (const bf16*)(ws + WS_Q + 4 * SEG_BYTES); const bf16* MX = (const bf16*)(ws + WS_MIX);
    const int t = samp_tok(blockIdx.x), tid = threadIdx.x;
    float av[2], rv[2], sa = 0.f, sr = 0.f;
    for (int i = 0; i < 2; ++i) { const int c = tid + 256 * i; av[i] = bf2f(AT[(size_t)t * AW + c]); rv[i] = (bf2f(HFp[(size_t)t * RW + c]) + bf2f(HBp[(size_t)t * RW + c])) * bf2f(Gp[(size_t)t * RW + c]); sa += av[i] * av[i]; sr += rv[i] * rv[i]; }
    sa = blk_sum(sa, red); sr = blk_sum(sr, red);
    const float ra = rsqrtf(sa / 512.f + LN_EPS), rr = rsqrtf(sr / 512.f + LN_EPS);
    float num = 0.f, den = 0.f;
    for (int i = 0; i < 2; ++i) { const int c = tid + 256 * i; const float r1 = av[i] * ra * ga[c], r2 = rv[i] * rr * gr[c], f1 = bf2f(MX[(size_t)t * D + c]), f2 = bf2f(MX[(size_t)t * D + AW + c]);
        num += (f1 - r1) * (f1 - r1) + (f2 - r2) * (f2 - r2); den += r1 * r1 + r2 * r2; }
    num = blk_sum(num, red); den = blk_sum(den, red);
    if (tid == 0) put_err(CHK, 4, num, den);
}
__global__ void __launch_bounds__(256) c5(const float* x, const float* w_out, const unsigned char* ws, unsigned* CHK) {
    __shared__ float red[4];
    const bf16* MX = (const bf16*)(ws + WS_MIX); const bf16* Yb = (const bf16*)(ws + WS_V1);
    const int t = samp_tok(blockIdx.x), tid = threadIdx.x; float num = 0.f, den = 0.f;
    for (int c = tid; c < D; c += 256) { float a = 0.f; for (int k = 0; k < D; ++k) a = fmaf(bf2f(MX[(size_t)t * D + k]), w_out[(size_t)k * D + c], a);
        const float r = a, f = bf2f(Yb[(size_t)t * D + c]); num += (f - r) * (f - r); den += r * r; }
    num = blk_sum(num, red); den = blk_sum(den, red);
    if (tid == 0) put_err(CHK, 5, num, den);
}
__global__ void __launch_bounds__(256) c6(const float* g, const float* bb, const float* x, const unsigned char* ws, unsigned* CHK) {
    __shared__ float red[4];
    const bf16* Yb = (const bf16*)(ws + WS_V1); const bf16* X1B = (const bf16*)(ws + WS_X1B);
    const int t = samp_tok(blockIdx.x), tid = threadIdx.x; float v[4], s = 0.f;
    for (int i = 0; i < 4; ++i) { v[i] = ALPHA * x[(size_t)t * D + tid + 256 * i] + bf2f(Yb[(size_t)t * D + tid + 256 * i]); s += v[i]; }
    const float mu = blk_sum(s, red) / D; float q = 0.f;
    for (int i = 0; i < 4; ++i) { const float d = v[i] - mu; q += d * d; }
    const float rs = rsqrtf(blk_sum(q, red) / D + LN_EPS); float num = 0.f, den = 0.f;
    for (int i = 0; i < 4; ++i) { const int c = tid + 256 * i; const float r = (v[i] - mu) * rs * g[c] + bb[c], f2 = bf2f(X1B[(size_t)t * D + c]);
        num += (f2 - r) * (f2 - r); den += r * r; }
    num = blk_sum(num, red); den = blk_sum(den, red);
    if (tid == 0) put_err(CHK, 6, num, den);
}
__global__ void __launch_bounds__(256) c7(const float* router_w, const unsigned char* ws, unsigned* CHK) {
    __shared__ float red[4];
    const bf16* X1B = (const bf16*)(ws + WS_X1B); const float* LG = (const float*)(ws + WS_LOGITS);
    const int t = samp_tok(blockIdx.x), c = threadIdx.x; float a = 0.f;
    for (int k = 0; k < D; ++k) a = fmaf(bf2f(X1B[(size_t)t * D + k]), router_w[(size_t)k * NE + c], a);
    const float f = LG[(size_t)t * NE + c] + LG[(size_t)T * NE + (size_t)t * NE + c];
    const float num = blk_sum((f - a) * (f - a), red), den = blk_sum(a * a, red);
    if (c == 0) put_err(CHK, 7, num, den);
}
__global__ void __launch_bounds__(64) c8(const float* rbias, const unsigned char* ws, const unsigned* ctl, unsigned* CHK) {
    __shared__ float sc[NE], bs[NE]; __shared__ int sel[8]; __shared__ float gate[8]; __shared__ float gsc[8]; __shared__ int gm[8];
    const float* LG = (const float*)(ws + WS_LOGITS); const unsigned* TS = (const unsigned*)(ws + WS_TS); const int* slot_tok = (const int*)(ws + WS_SLOTTOK);
    const float* slot_w = (const float*)(ws + WS_SLOTW); const int* tile_e = (const int*)(ws + WS_TILEE);
    const int t = samp_tok(blockIdx.x), lane = threadIdx.x;
    for (int e = lane; e < NE; e += 64) { const float l = LG[(size_t)t * NE + e] + LG[(size_t)T * NE + (size_t)t * NE + e]; sc[e] = 1.f / (1.f + expf(-l)); bs[e] = sc[e] + rbias[e]; }
    __syncthreads();
    if (lane == 0) {
        for (int g = 0; g < 8; ++g) { float a = -1e30f, b2 = -1e30f; for (int i = 0; i < 32; ++i) { const float v = bs[32 * g + i]; if (v > a) { b2 = a; a = v; } else if (v > b2) b2 = v; } gsc[g] = a + b2; gm[g] = 0; }
        for (int k = 0; k < 4; ++k) { int best = -1; for (int g = 0; g < 8; ++g) if (!gm[g] && (best < 0 || gsc[g] > gsc[best])) best = g; gm[best] = 1; }
        float sum = 0.f;
        for (int k = 0; k < 8; ++k) { int best = -1; for (int e = 0; e < NE; ++e) { if (!gm[e >> 5]) continue; bool used = false; for (int q = 0; q < k; ++q) used |= (sel[q] == e); if (used) continue; if (best < 0 || bs[e] > bs[best]) best = e; } sel[k] = best; sum += sc[best]; }
        for (int k = 0; k < 8; ++k) gate[k] = sc[sel[k]] / sum * 2.5f;
        int bad = 0; const int NT = (int)ctl[CW_NT];
        for (int k = 0; k < 8; ++k) { const unsigned slot = TS[(size_t)t * 8 + k]; const int e = tile_e[slot >> 8];
            if (slot >= (unsigned)NT * 256) { ++bad; continue; }
            if (slot_tok[slot] != t) ++bad;
            int q = -1; for (int k2 = 0; k2 < 8; ++k2) if (sel[k2] == e) q = k2;
            if (q < 0) ++bad; else if (fabsf(slot_w[slot] - gate[q]) > 1e-5f) ++bad; }
        atomicMax(CHK + 8, __float_as_uint((float)bad));
    }
}
DI void samp_slot(int i, const unsigned char* ws, const unsigned* ctl, int& slot, int& e, int& tok) {
    const unsigned* TS = (const unsigned*)(ws + WS_TS); const int* tile_e = (const int*)(ws + WS_TILEE); const int NT = (int)ctl[CW_NT];
    tok = samp_tok(i); if (i >= 32 && (i & 1)) { slot = NT * 256 + tok; e = NE; } else { slot = (int)TS[(size_t)tok * 8 + (i & 7)]; e = tile_e[slot >> 8]; } }
__global__ void __launch_bounds__(256) c9(InP ip, const unsigned char* ws, const unsigned* ctl, unsigned* CHK) {
    __shared__ float red[4];
    int slot, e, tok; samp_slot(blockIdx.x, ws, ctl, slot, e, tok);
    const float* wg = e < NE ? ip.p[17] + (size_t)e * D * EH : ip.p[20]; const float* wu = e < NE ? ip.p[18] + (size_t)e * D * EH : ip.p[21];
    const bf16* X1B = (const bf16*)(ws + WS_X1B); const bf16* Hh = (const bf16*)(ws + WS_H);
    const int c = threadIdx.x; float g = 0.f, u = 0.f;
    for (int k = 0; k < D; ++k) { const float xv = bf2f(X1B[(size_t)tok * D + k]); g = fmaf(xv, wg[(size_t)k * EH + c], g); u = fmaf(xv, wu[(size_t)k * EH + c], u); }
    const float wgt = e < NE ? ((const float*)(ws + WS_SLOTW))[slot] : 1.f; const float r = g / (1.f + expf(-g)) * u * wgt, f = h_at(ws, (size_t)slot, c);
    const float num = blk_sum((f - r) * (f - r), red), den = blk_sum(r * r, red);
    if (c == 0) put_err(CHK, 9, num, den);
}
DI float y_at(const unsigned char* Yb, size_t slot, int c) {
    const int pn = c >> 8, bj = (c >> 7) & 1, wc = (c >> 5) & 3, fq = (c >> 3) & 3, i = c & 7; const unsigned b = Yb[slot * 1024 + ((pn * 4 + wc) * 4 + fq) * 16 + bj * 8 + i];
    const int e = (b >> 3) & 15, m = b & 7; const float mag = e == 0 ? (float)m * 0.001953125f : (1.f + (float)m * 0.125f) * exp2f((float)(e - 7)); return ((b & 128) ? -mag : mag) * (1.0f / YSCALE); }
__global__ void __launch_bounds__(256) c10(InP ip, const unsigned char* ws, const unsigned* ctl, unsigned* CHK) {
    __shared__ float red[4];
    int slot, e, tok; samp_slot(blockIdx.x & 31, ws, ctl, slot, e, tok);
    const float* wd = ip.p[19] + (size_t)e * EH * D; const bf16* Hh = (const bf16*)(ws + WS_H); const unsigned char* Y = (const unsigned char*)(ws + WS_Y);
    float num = 0.f, den = 0.f;
    for (int c = threadIdx.x; c < D; c += 256) { float a = 0.f; for (int k = 0; k < EH; ++k) a = fmaf(h_at(ws, (size_t)slot, k), wd[(size_t)k * D + c], a);
        const float r = a, f = y_at(Y, (size_t)slot, c); num += (f - r) * (f - r); den += r * r; }
    num = blk_sum(num, red); den = blk_sum(den, red);
    if (threadIdx.x == 0) put_err(CHK, 10, num, den);
}
__global__ void __launch_bounds__(256) save_x1b(const unsigned char* ws, bf16* dst) { const bf16* X1B = (const bf16*)(ws + WS_X1B); const int t = samp_tok(blockIdx.x); for (int c = threadIdx.x; c < D; c += 256) dst[(size_t)blockIdx.x * D + c] = X1B[(size_t)t * D + c]; }
__global__ void __launch_bounds__(256) c11(InP ip, const float* out, const unsigned char* ws, const unsigned* ctl, unsigned* CHK, const bf16* x1s) {
    __shared__ float red[4];
    const bf16* Hh = (const bf16*)(ws + WS_H); const unsigned char* Y = (const unsigned char*)(ws + WS_Y); const unsigned* TS = (const unsigned*)(ws + WS_TS);
    const int t = samp_tok(blockIdx.x), tid = threadIdx.x, NT = (int)ctl[CW_NT]; const float* sd = ip.p[22];
    float v[4], s = 0.f;
    for (int i = 0; i < 4; ++i) { const int c = tid + 256 * i; float a = 0.f; for (int k = 0; k < EH; ++k) a = fmaf(h_at(ws, (size_t)NT * 256 + t, k), sd[(size_t)k * D + c], a);
        a += ALPHA * bf2f(x1s[(size_t)blockIdx.x * D + c]); for (int k = 0; k < 8; ++k) a += y_at(Y, (size_t)TS[(size_t)t * 8 + k], c); v[i] = a; s += a; }
    const float mu = blk_sum(s, red) / D; float q = 0.f;
    for (int i = 0; i < 4; ++i) { const float d = v[i] - mu; q += d * d; }
    const float rs = rsqrtf(blk_sum(q, red) / D + LN_EPS); float num = 0.f, den = 0.f;
    for (int i = 0; i < 4; ++i) { const int c = tid + 256 * i; const float r = (v[i] - mu) * rs * ip.p[23][c] + ip.p[24][c], f = out[(size_t)t * D + c]; num += (f - r) * (f - r); den += r * r; }
    num = blk_sum(num, red); den = blk_sum(den, red);
    if (tid == 0) put_err(CHK, 11, num, den);
}
__global__ void __launch_bounds__(256) verdict(float* out, const unsigned* CHK, const unsigned* ctl) {
    int stage = 0; float err = 0.f;
    for (int s = 1; s <= 11; ++s) { const float e = __uint_as_float(CHK[s]); const float tol = (s == 8) ? 0.5f : (s == 10 ? 0.12f : (s == 9 ? 0.12f : (s == 11 ? 0.05f : 0.03f))); if (stage == 0 && !(e <= tol)) { stage = s; err = e; } }
    for (int li = 0; li < 16; ++li) if (stage == 0 && ctl[CW_BAR + li * XCD_BAR_WORDS_C + 128] != 0) { stage = 12; err = 1.f; }
    if (stage == 0) return;
    float lg = (log10f(fminf(fmaxf(err, 1e-3f), 1.f)) + 3.f) / 3.f; const float c2v = powf(10.f, (float)stage) * (1.f + 8.f * lg); const float C = sqrtf(c2v);
    for (size_t i = (size_t)blockIdx.x * 256 + threadIdx.x; i < (size_t)T * D; i += (size_t)gridDim.x * 256) out[i] = C;
}
}
#endif

#ifdef REPORT_K
__global__ void __launch_bounds__(256) k_report(float* out, const unsigned long long* ts) {
    const float us = (REPORT_K >= 0) ? (float)(ts[REPORT_K + 1] - ts[REPORT_K]) * 0.01f : (float)(ts[13] - ts[0]) * 0.001f; const float C = sqrtf(us);
    for (size_t i = (size_t)blockIdx.x * 256 + threadIdx.x; i < (size_t)T * D; i += (size_t)gridDim.x * 256) out[i] = C;
}
#endif
extern "C" void kernel_launch(void* const* d_in, const int* in_sizes, int n_in, void* d_out, int out_size, void* d_ws, size_t ws_size, hipStream_t stream) {
    static int grid = 0;
    if (grid == 0) {
        if (n_in != 25 || in_sizes[0] != T * D || out_size != T * D || ws_size < WS_END) { fprintf(stderr, "kernel_launch: unexpected problem shape / workspace (%d inputs, ws %zu); nothing launched\n", n_in, ws_size); grid = -1; return; }
        int dev = 0, cus = 0, per_cu = 0;
        if (hipGetDevice(&dev) != hipSuccess || hipDeviceGetAttribute(&cus, hipDeviceAttributeMultiprocessorCount, dev) != hipSuccess) { grid = -1; return; }
        if (hipFuncSetAttribute((const void*)mk_fwd, hipFuncAttributeMaxDynamicSharedMemorySize, LDS_BYTES) != hipSuccess) { fprintf(stderr, "kernel_launch: hipFuncSetAttribute failed\n"); grid = -1; return; }
        if (hipOccupancyMaxActiveBlocksPerMultiprocessor(&per_cu, (const void*)mk_fwd, NWAVES * 64, LDS_BYTES) != hipSuccess || per_cu < 1) { fprintf(stderr, "kernel_launch: occupancy query says %d\n", per_cu); }
        (void)hipGetLastError();
        grid = cus;
    }
    if (grid < 0) return;
    (void)hipMemsetAsync((char*)d_ws + WS_CTL, 0, CTL_ZERO_BYTES, stream);
    Args a{};
    for (int i = 0; i < 25; ++i) a.in[i] = (const float*)d_in[i];
    a.out = (float*)d_out; a.ws = (unsigned char*)d_ws;
#if defined(SELFCHECK) && SELFCHECK
    unsigned char* ws = (unsigned char*)d_ws; unsigned* CHK = (unsigned*)(ws + WS_CTL) + CW_CHK; const unsigned* ctl = (const unsigned*)(ws + WS_CTL);
    chk::InP inp{}; for (int i = 0; i < 25; ++i) inp.p[i] = a.in[i];
    float* scratch = (float*)(ws + WS_END + MiB);
    for (int p = 0; p < N_PHASES; ++p) {
        a.ph_lo = p; a.ph_hi = p + 1; a.li = p;
        hipLaunchKernelGGL(mk_fwd, dim3(grid), dim3(NWAVES * 64), LDS_BYTES, stream, a);
        using namespace chk;
        if (p == 1) hipLaunchKernelGGL(c1, dim3(NS), dim3(256), 0, stream, a.in[0], (const int*)d_in[1], a.in[2], ws, CHK);
        if (p == 2) hipLaunchKernelGGL(c2, dim3(NS * 8), dim3(64), 0, stream, ws, CHK);
        if (p == 3) hipLaunchKernelGGL(c3, dim3(16), dim3(64), 0, stream, inp, ws, scratch, CHK);
        if (p == 4) hipLaunchKernelGGL(c4, dim3(NS), dim3(256), 0, stream, a.in[3], a.in[11], ws, CHK);
        if (p == 5) hipLaunchKernelGGL(c5, dim3(NS), dim3(256), 0, stream, a.in[0], a.in[12], ws, CHK);
        if (p == 6) hipLaunchKernelGGL(c6, dim3(NS), dim3(256), 0, stream, a.in[13], a.in[14], a.in[0], ws, CHK);
        if (p == 7) hipLaunchKernelGGL(c7, dim3(NS), dim3(256), 0, stream, a.in[15], ws, CHK);
        if (p == 9) hipLaunchKernelGGL(c8, dim3(NS), dim3(64), 0, stream, a.in[16], ws, ctl, CHK);
        if (p == 10) { hipLaunchKernelGGL(c9, dim3(NS), dim3(256), 0, stream, inp, ws, ctl, CHK); hipLaunchKernelGGL(save_x1b, dim3(NS), dim3(256), 0, stream, ws, (bf16*)(ws + WS_END + 4 * MiB)); }
        if (p == 11) hipLaunchKernelGGL(c10, dim3(32), dim3(256), 0, stream, inp, ws, ctl, CHK);
        if (p == 12) hipLaunchKernelGGL(c11, dim3(NS), dim3(256), 0, stream, inp, (const float*)d_out, ws, ctl, CHK, (const bf16*)(ws + WS_END + 4 * MiB));
    }
    hipLaunchKernelGGL(chk::verdict, dim3(1024), dim3(256), 0, stream, (float*)d_out, CHK, ctl);
#else
    a.ph_lo = 0; a.ph_hi = N_PHASES; a.li = 0;
    hipLaunchKernelGGL(mk_fwd, dim3(grid), dim3(NWAVES * 64), LDS_BYTES, stream, a);
#ifdef REPORT_K
    hipLaunchKernelGGL(k_report, dim3(1024), dim3(256), 0, stream, (float*)d_out, (const unsigned long long*)((unsigned char*)d_ws + WS_END + 8 * MiB));
#endif
#endif
}
```

```cpp
#include <hip/hip_runtime.h>
#include <cstdio>
#include <cstdint>

#define LAS __attribute__((address_space(3)))
#define GAS __attribute__((address_space(1)))
typedef unsigned short bf16;
typedef short bf16x8 __attribute__((ext_vector_type(8)));
typedef short s16x4 __attribute__((ext_vector_type(4)));
typedef float f32x2 __attribute__((ext_vector_type(2)));
typedef float f32x4 __attribute__((ext_vector_type(4)));
typedef float f32x16 __attribute__((ext_vector_type(16)));
typedef unsigned u32x2 __attribute__((ext_vector_type(2)));
typedef unsigned u32x4 __attribute__((ext_vector_type(4)));
typedef GAS unsigned gu32;
#define RLX_AGENT __ATOMIC_RELAXED, __HIP_MEMORY_SCOPE_AGENT
#define DI __device__ __forceinline__

constexpr int NB = 4, SEQ = 8192, T = NB * SEQ, D = 1024, AW = 512, RW = 512, HD = 64, NH = 8, INW = 2560;
constexpr int NE = 256, TOPK = 8, EH = 256;
constexpr float ALPHA = 1.189207115002721f;
constexpr float LN_EPS = 1e-5f;
constexpr float LOG2E = 1.4426950408889634f;
constexpr float QSCALE = 0.125f * LOG2E;
constexpr int NWAVES = 8;
constexpr int MAXRT = T * TOPK / 256 + NE;
constexpr int NSHT = T / 256;
constexpr int MAXTILES = MAXRT + NSHT;
constexpr int MAXSLOTS = MAXTILES * 256;
constexpr int LCH = 128, NCH = SEQ / LCH;

constexpr size_t MiB = 1u << 20;
constexpr size_t WS_CTL = 0, CTL_ZERO_BYTES = 1 * MiB;
constexpr size_t WS_ROPE = 1 * MiB;
constexpr size_t WS_GWT = 3 * MiB;
constexpr size_t WS_C2 = 3 * MiB + 512 * 1024;
constexpr size_t WS_CARRY = 4 * MiB;
constexpr size_t WS_ER = 6 * MiB, WS_TS = 7 * MiB, WS_GW = 8 * MiB;
constexpr size_t WS_SLOTTOK = 9 * MiB, WS_SLOTW = 11 * MiB;
constexpr size_t WS_TILEE = 13 * MiB;
constexpr size_t WS_WINT = 14 * MiB, WS_WOUTT = 19 * MiB, WS_RTT = 21 * MiB;
constexpr size_t WS_WDT = 32 * MiB;
constexpr size_t WS_H = 161 * MiB;
constexpr size_t WS_Q = 161 * MiB, SEG_BYTES = 32 * MiB;
constexpr size_t WS_Y = 337 * MiB;
constexpr size_t WS_WGUT = 337 * MiB;
constexpr size_t WS_X1B = 850 * MiB;
constexpr size_t WS_LOGITS = 658 * MiB;
constexpr size_t WS_ATTN = 658 * MiB, WS_REC = 690 * MiB;
constexpr size_t WS_V1 = 722 * MiB;
constexpr size_t WS_XB = 722 * MiB;
constexpr size_t WS_MIX = 850 * MiB;
constexpr size_t WS_HF = 914 * MiB;
constexpr size_t WS_END = 977 * MiB;
static_assert(WS_WDT + (size_t)257 * 1024 * 256 * 2 <= WS_H && WS_H + (size_t)MAXSLOTS * 256 * 2 <= WS_Y && WS_Y + (size_t)MAXSLOTS * 1024 <= WS_V1, "ws map");
static_assert(WS_WGUT + (size_t)257 * 512 * 1024 * 2 <= WS_LOGITS && WS_Q + 5 * SEG_BYTES <= WS_Y, "ws map 2");
constexpr int CW_TMO = 0, CW_CNT = 1024, CW_NT = 2048, CW_CHK = 3072, CW_BAR = 4096;
#define XCD_BAR_WORDS_C 3456
static_assert((CW_BAR + 16 * XCD_BAR_WORDS_C) * 4 <= (int)CTL_ZERO_BYTES, "ctl");

constexpr int RING_OFF = 0, RING_BYTES = 131072;
constexpr int UT_OFF = RING_BYTES;
constexpr int UT_IDX = UT_OFF + 128;
constexpr int UT_W = UT_IDX + 11 * 1024;
constexpr int MISC_OFF = UT_W + 11 * 1024;
constexpr int LDS_BYTES = 163840;
static_assert(MISC_OFF + 256 <= LDS_BYTES, "LDS map");

DI unsigned f2bf(float f) { unsigned u = __builtin_bit_cast(unsigned, f); return (u + 0x7fffu + ((u >> 16) & 1u)) >> 16; }
DI unsigned pk2(float lo, float hi) { return f2bf(lo) | (f2bf(hi) << 16); }
DI float bf2f(unsigned short b) { return __builtin_bit_cast(float, (unsigned)b << 16); }
DI float bflo(unsigned w) { return __builtin_bit_cast(float, w << 16); }
DI float bfhi(unsigned w) { return __builtin_bit_cast(float, w & 0xffff0000u); }
DI float wave_sum(float v) {
#pragma unroll
    for (int o = 1; o < 64; o <<= 1) v += __shfl_xor(v, o);
    return v;
}
DI float wave_max(float v) {
#pragma unroll
    for (int o = 1; o < 64; o <<= 1) v = fmaxf(v, __shfl_xor(v, o));
    return v;
}
DI int wave_min_i(int v) {
#pragma unroll
    for (int o = 1; o < 64; o <<= 1) v = min(v, __shfl_xor(v, o));
    return v;
}
DI float row16_max(float v) {
    v = fmaxf(v, __builtin_bit_cast(float, __builtin_amdgcn_update_dpp(0, __builtin_bit_cast(int, v), 0xB1, 0xF, 0xF, false)));
    v = fmaxf(v, __builtin_bit_cast(float, __builtin_amdgcn_update_dpp(0, __builtin_bit_cast(int, v), 0x4E, 0xF, 0xF, false)));
    v = fmaxf(v, __builtin_bit_cast(float, __builtin_amdgcn_update_dpp(0, __builtin_bit_cast(int, v), 0x141, 0xF, 0xF, false)));
    v = fmaxf(v, __builtin_bit_cast(float, __builtin_amdgcn_update_dpp(0, __builtin_bit_cast(int, v), 0x140, 0xF, 0xF, false)));
    return v; }
DI float wave_max_fast(float v) { v = row16_max(v);
    const float r0 = __builtin_bit_cast(float, __builtin_amdgcn_readlane(__builtin_bit_cast(int, v), 0)), r1 = __builtin_bit_cast(float, __builtin_amdgcn_readlane(__builtin_bit_cast(int, v), 16)),
                r2 = __builtin_bit_cast(float, __builtin_amdgcn_readlane(__builtin_bit_cast(int, v), 32)), r3 = __builtin_bit_cast(float, __builtin_amdgcn_readlane(__builtin_bit_cast(int, v), 48));
    return fmaxf(fmaxf(r0, r1), fmaxf(r2, r3)); }
DI int wave_min_i_fast(int v) {
    v = min(v, __builtin_amdgcn_update_dpp(0, v, 0xB1, 0xF, 0xF, false)); v = min(v, __builtin_amdgcn_update_dpp(0, v, 0x4E, 0xF, 0xF, false));
    v = min(v, __builtin_amdgcn_update_dpp(0, v, 0x141, 0xF, 0xF, false)); v = min(v, __builtin_amdgcn_update_dpp(0, v, 0x140, 0xF, 0xF, false));
    return min(min(__builtin_amdgcn_readlane(v, 0), __builtin_amdgcn_readlane(v, 16)), min(__builtin_amdgcn_readlane(v, 32), __builtin_amdgcn_readlane(v, 48))); }
DI int lane_id() { return (int)__builtin_amdgcn_mbcnt_hi(~0u, __builtin_amdgcn_mbcnt_lo(~0u, 0u)); }
DI float fexp2(float x) { return __builtin_amdgcn_exp2f(x); }
DI float frcp(float x) { return __builtin_amdgcn_rcpf(x); }
DI float gelu_tanh(float x) {
    const float z = 0.7978845608028654f * (x + 0.044715f * x * x * x);
    const float e = fexp2(2.f * LOG2E * z);
    return 0.5f * x * (2.f - 2.f * frcp(e + 1.f));
}
DI int crow(int r, int hi) { return (r & 3) + 8 * (r >> 2) + 4 * hi; }
#define MFMA32(a, b, c) __builtin_amdgcn_mfma_f32_32x32x16_bf16((a), (b), (c), 0, 0, 0)

namespace pg8 {
constexpr int BM = 256, BK = 64, HALF = 128, HTB = HALF * BK * 2, NXCD = 8;
DI int lds_byte(int r, int c) { const int st = (r >> 4) * 2 + (c >> 5), rr = r & 15, cc = c & 31, ob = rr * 64 + cc * 2; return st * 1024 + (ob ^ (((ob >> 9) & 1) << 5)); }
DI void stage_rc(int b, int& R, int& C) { const int st = b / 1024, sb = b % 1024, swz = sb ^ (((sb >> 9) & 1) << 5); R = (st >> 1) * 16 + swz / 64; C = (st & 1) * 32 + (swz % 64) / 2; }
DI int perm32(int rho) { const int n = rho >> 4, i = rho & 15; return 8 * (i >> 2) + 4 * n + (i & 3); }
struct Unit { int pm, pn, li, ex; };
DI bool xcd_order(int i, int G, int c, int nwg, int& wgid) {
    const long L = (long)i * G + c; if (L >= nwg) return false;
    const int w = (int)L, q = nwg / NXCD, r = nwg % NXCD, xcd = w % NXCD, off = w / NXCD;
    wgid = (xcd < r ? xcd * (q + 1) : r * (q + 1) + (xcd - r) * q) + off; return true;
}
typedef int i32x8 __attribute__((ext_vector_type(8))); typedef int i32x4 __attribute__((ext_vector_type(4)));
DI void pg8_mfma_f8(f32x4& acc, const i32x8& b, const i32x8& a, int sc) { asm volatile("v_mfma_scale_f32_16x16x128_f8f6f4 %0, %1, %2, %0, %3, %3 op_sel_hi:[0,0,0]" : "+v"(acc) : "v"(b), "v"(a), "v"(sc)); }
DI i32x8 pg8_ld32(const LAS unsigned char* p) { const i32x4 a = *(const LAS i32x4*)p, b = *(const LAS i32x4*)(p + 16); return __builtin_shufflevector(a, b, 0, 1, 2, 3, 4, 5, 6, 7); }
DI s16x4 pg8_tr(const LAS unsigned char* p) { typedef short v4i16_t __attribute__((ext_vector_type(4))); return __builtin_bit_cast(s16x4, __builtin_amdgcn_ds_read_tr16_b64_v4i16((LAS v4i16_t*)p)); }
DI unsigned cvt_pk_bf16(float lo, float hi) { unsigned r; asm volatile("v_cvt_pk_bf16_f32 %0, %1, %2" : "=v"(r) : "v"(lo), "v"(hi)); return r; }

template <class Epi, class Sched, bool ALIGN_EPI, bool BKN = false, bool F8 = false>
DI void gemm_phase(LAS unsigned char* lds, const Sched& S, const Epi& E, const int K) {
    const int tid = threadIdx.x, wid = __builtin_amdgcn_readfirstlane(tid >> 6), lane = tid & 63, wr = wid >> 2, wc = wid & 3, fr = lane & 15, fq = lane >> 4;
    const int nt = K / BK;
    unsigned voffB[2];
#define PG8_RC(i, R, C) int R, C; stage_rc((wid * 64 + lane_id()) * 16 + (i) * 8192, R, C)
#pragma unroll
    for (int i = 0; i < 2; ++i) { int R, C; stage_rc(tid * 16 + i * 8192, R, C); const int Rb = Epi::PERM ? ((R & ~31) + perm32(R & 31)) : R; voffB[i] = (unsigned)(Rb * S.ldb + C) * 2u;
        if constexpr (BKN) { static_assert(!BKN || Epi::PERM, "the [K][N] B path delivers the PERM column order"); const int b = tid * 16 + i * 8192, k = b >> 8, c = (b >> 4) & 15, cl = ((((c >> 2) ^ (k & 3)) << 2) | (c & 3)); voffB[i] = (unsigned)(k * S.ldb + 8 * cl) * 2u; } }
    const size_t kstep = (size_t)(BK * 2);
    size_t hstepB = (size_t)HALF * S.ldb * 2, kstepB = kstep;
    if constexpr (BKN) { hstepB = S.bh1; kstepB = (size_t)BK * S.ldb * 2; }
    int bkn_off = 0;
    if constexpr (BKN) { const int g = lane >> 4, q = (lane >> 2) & 3, pp = lane & 3; bkn_off = (8 * g + q) * 256 + ((((wc ^ q) << 2) | pp) << 4); }
    const unsigned ldsw = (unsigned)wid * 1024u, lds_u = (unsigned)(size_t)lds;
    const int aoff = lds_byte(wr * 64 + fr, F8 ? fq * 16 : fq * 8), boff = lds_byte(wc * 32 + fr, F8 ? fq * 16 : fq * 8);
#define PG8_SA(b, h) (((b) * 2 + (h)) * HTB)
#define PG8_SB(b, h) ((4 + (b) * 2 + (h)) * HTB)
#define PG8_STAGE(bufoff, gbase, voff) do { _Pragma("unroll") for (int _i = 0; _i < 2; ++_i) { unsigned keep_; \
        asm volatile("s_mov_b32 %0, m0\n\ts_mov_b32 m0, %3\n\ts_nop 0\n\tglobal_load_lds_dwordx4 %1, %2\n\ts_mov_b32 m0, %0" : "=&s"(keep_) : "v"((voff)[_i]), "s"((const char*)(gbase)), "s"(lds_u + (unsigned)(bufoff) + ldsw + (unsigned)(_i * 8192)) : "memory"); } } while (0)
#define PG8_LDA(dst, b, h) do { if constexpr (F8) { _Pragma("unroll") for (int m = 0; m < 4; ++m) A8[m] = pg8_ld32(lds + PG8_SA(b, h) + aoff + m * 2048); } \
        else { _Pragma("unroll") for (int m = 0; m < 4; ++m) _Pragma("unroll") for (int k = 0; k < 2; ++k) dst[m][k] = *(const LAS bf16x8*)(lds + PG8_SA(b, h) + aoff + m * 2048 + k * 1024); } } while (0)
#define PG8_LDB(dst, b, h) do { if constexpr (BKN) { _Pragma("unroll") for (int n = 0; n < 2; ++n) _Pragma("unroll") for (int k = 0; k < 2; ++k) { \
            const s16x4 lo_ = pg8_tr(lds + PG8_SB(b, h) + bkn_off + k * 8192 + n * 8), hi_ = pg8_tr(lds + PG8_SB(b, h) + bkn_off + k * 8192 + n * 8 + 1024); dst[n][k] = __builtin_shufflevector(lo_, hi_, 0, 1, 2, 3, 4, 5, 6, 7); } } \
        else if constexpr (F8) { _Pragma("unroll") for (int n = 0; n < 2; ++n) dst##8[n] = pg8_ld32(lds + PG8_SB(b, h) + boff + n * 2048); } \
        else { _Pragma("unroll") for (int n = 0; n < 2; ++n) _Pragma("unroll") for (int k = 0; k < 2; ++k) dst[n][k] = *(const LAS bf16x8*)(lds + PG8_SB(b, h) + boff + n * 2048 + k * 1024); } } while (0)
#define PG8_MMA(ai, bj, At, Bt) do { __builtin_amdgcn_s_setprio(1); if constexpr (F8) { _Pragma("unroll") for (int m = 0; m < 4; ++m) _Pragma("unroll") for (int n = 0; n < 2; ++n) \
            pg8_mfma_f8(acc[ai][bj][m][n], Bt##8[n], A8[m], f8_unit_scale); } \
        else { _Pragma("unroll") for (int m = 0; m < 4; ++m) _Pragma("unroll") for (int n = 0; n < 2; ++n) _Pragma("unroll") for (int k = 0; k < 2; ++k) \
            acc[ai][bj][m][n] = __builtin_amdgcn_mfma_f32_16x16x32_bf16(Bt[n][k], At[m][k], acc[ai][bj][m][n], 0, 0, 0); } __builtin_amdgcn_s_setprio(0); } while (0)
#define PG8_WAIT_V(n) asm volatile("s_waitcnt vmcnt(" #n ")" ::: "memory")
#define PG8_WAIT_L(n) asm volatile("s_waitcnt lgkmcnt(" #n ")" ::: "memory")
#define PG8_BAR __builtin_amdgcn_s_barrier()
#define PG8_SCHED __builtin_amdgcn_sched_barrier(0)
    Unit cur, nxt; int ui = 0;
    if (!S.next(0, cur)) return;
    f32x4 acc[2][2][4][2];
#pragma unroll
    for (int a = 0; a < 2; ++a)
#pragma unroll
        for (int b = 0; b < 2; ++b)
#pragma unroll
            for (int m = 0; m < 4; ++m)
#pragma unroll
                for (int n = 0; n < 2; ++n) acc[a][b][m][n] = (f32x4){0.f, 0.f, 0.f, 0.f};
    bf16x8 At[4][2], B0[2][2], B1[2][2];
    i32x8 A8[4], B08[2], B18[2];
    int f8_unit_scale = 0x7F7F7F7F; if constexpr (F8) asm volatile("" : "+v"(f8_unit_scale));
    unsigned ca0[2], ca1[2];
#pragma unroll
    for (int i = 0; i < 2; ++i) { PG8_RC(i, R_, C_); ca0[i] = S.a_voff(cur, R_, C_); ca1[i] = S.a_voff(cur, HALF + R_, C_); }
    const char* cA = S.a_base(cur); const char* cB = S.b_base(cur);
    typename Epi::Ctx ctx = E.pre(cur, wr, fr);
    PG8_STAGE(PG8_SB(0, 0), cB, voffB); PG8_STAGE(PG8_SB(0, 1), cB + hstepB, voffB); PG8_STAGE(PG8_SA(0, 0), cA, ca0); PG8_STAGE(PG8_SA(0, 1), cA, ca1);
    if (wr == 1) PG8_BAR;
    PG8_WAIT_V(2); PG8_BAR;
    PG8_STAGE(PG8_SB(1, 0), cB + kstepB, voffB); PG8_STAGE(PG8_SA(1, 0), cA + kstep, ca0); PG8_STAGE(PG8_SB(1, 1), cB + hstepB + kstepB, voffB);
    PG8_WAIT_V(6); PG8_BAR;
    for (;;) {
        const bool has_next = S.next(ui + 1, nxt);
        const char* nA = has_next ? S.a_base(nxt) : cA; const char* nB = has_next ? S.b_base(nxt) : cB;
#pragma unroll 1
        for (int t = 0; t < nt; t += 2) {
            const bool last = (t == nt - 2);
            const char* a1 = cA + (size_t)(t + 1) * kstep;
            const char* a2 = last ? nA : cA + (size_t)(t + 2) * kstep; const char* b2 = last ? nB : cB + (size_t)(t + 2) * kstepB;
            const char* a3 = a2 + kstep; const char* b3 = b2 + kstepB;
            unsigned v20[2], v21[2];
            if (last && has_next) {
#pragma unroll
                for (int i = 0; i < 2; ++i) { PG8_RC(i, R_, C_); v20[i] = S.a_voff(nxt, R_, C_); v21[i] = S.a_voff(nxt, HALF + R_, C_); }
            } else {
#pragma unroll
                for (int i = 0; i < 2; ++i) { v20[i] = ca0[i]; v21[i] = ca1[i]; }
            }
            PG8_LDB(B0, 0, 0); PG8_LDB(B1, 0, 1); PG8_SCHED; PG8_LDA(At, 0, 0); PG8_STAGE(PG8_SA(1, 1), a1, ca1);
            PG8_WAIT_V(8); PG8_WAIT_L(0); PG8_BAR; PG8_MMA(0, 0, At, B0); PG8_MMA(0, 1, At, B1); PG8_BAR; PG8_SCHED;
            PG8_LDA(At, 0, 1); PG8_STAGE(PG8_SB(0, 0), b2, voffB); PG8_STAGE(PG8_SB(0, 1), b2 + hstepB, voffB); PG8_STAGE(PG8_SA(0, 0), a2, v20);
            PG8_WAIT_V(8); PG8_WAIT_L(0); PG8_BAR; PG8_MMA(1, 0, At, B0); PG8_MMA(1, 1, At, B1); PG8_BAR; PG8_SCHED;
            PG8_LDB(B0, 1, 0); PG8_LDB(B1, 1, 1); PG8_SCHED; PG8_LDA(At, 1, 0); PG8_STAGE(PG8_SA(0, 1), a2, v21);
            PG8_WAIT_V(8); PG8_WAIT_L(0); PG8_BAR; PG8_MMA(0, 0, At, B0); PG8_MMA(0, 1, At, B1); PG8_BAR; PG8_SCHED;
            PG8_LDA(At, 1, 1); PG8_STAGE(PG8_SB(1, 0), b3, voffB); PG8_STAGE(PG8_SB(1, 1), b3 + hstepB, voffB); PG8_STAGE(PG8_SA(1, 0), a3, v20);
            PG8_WAIT_V(8); PG8_WAIT_L(0); PG8_BAR; PG8_MMA(1, 0, At, B0); PG8_MMA(1, 1, At, B1); PG8_BAR; PG8_SCHED;
        }
        if constexpr (ALIGN_EPI) { if (wr == 0) PG8_BAR; }
        if constexpr (F8) asm volatile("s_nop 15\n\ts_nop 15\n\ts_nop 15" ::: "memory");
        E(acc, cur, ctx, wr, wc, fr, fq);
        if (!has_next) break;
#pragma unroll
        for (int a = 0; a < 2; ++a)
#pragma unroll
            for (int b = 0; b < 2; ++b)
#pragma unroll
                for (int m = 0; m < 4; ++m)
#pragma unroll
                    for (int n = 0; n < 2; ++n) acc[a][b][m][n] = (f32x4){0.f, 0.f, 0.f, 0.f};
        cur = nxt; cA = nA; cB = nB; ++ui;
        ctx = E.pre(cur, wr, fr);
#pragma unroll
        for (int i = 0; i < 2; ++i) { PG8_RC(i, R_, C_); ca0[i] = S.a_voff(cur, R_, C_); ca1[i] = S.a_voff(cur, HALF + R_, C_); }
        if constexpr (ALIGN_EPI) { if (wr == 1) PG8_BAR; }
    }
    PG8_WAIT_V(0);
    if constexpr (!ALIGN_EPI) { if (wr == 0) PG8_BAR; }
    PG8_BAR;
#undef PG8_RC
#undef PG8_SA
#undef PG8_SB
#undef PG8_STAGE
#undef PG8_LDA
#undef PG8_LDB
#undef PG8_MMA
#undef PG8_WAIT_V
#undef PG8_WAIT_L
#undef PG8_BAR
#undef PG8_SCHED
}
}
#define XB_TMO      128
#define XB_XCNT(j)  (256  + 64 * (j))
#define XB_XSUB(j)  (1280 + 64 * (j))
#define XB_XGEN(j)  (2304 + 64 * (j))
#define XB_TOP      3328
#define XB_TOPGEN   3392
#define XCD_BAR_WORDS 3456
#define XB_SPIN_CAP (1u << 18)

__device__ __forceinline__ unsigned xb_ld(unsigned* p)              { return __hip_atomic_load(p, __ATOMIC_RELAXED, __HIP_MEMORY_SCOPE_AGENT); }
__device__ __forceinline__ unsigned xb_add(unsigned* p, unsigned v) { return __hip_atomic_fetch_add(p, v, __ATOMIC_RELAXED, __HIP_MEMORY_SCOPE_AGENT); }
__device__ __forceinline__ unsigned xb_xcc_id() { return (unsigned)__builtin_amdgcn_s_getreg((3 << 11) | 20) & 0xFu; }
#define XB_SPIN(cond, bar) do { unsigned _sp = 0; while (cond) { __builtin_amdgcn_s_sleep(1); \
    if ((++_sp & 255u) == 0u) { if (xb_ld(&(bar)[XB_TMO])) break; if (_sp > XB_SPIN_CAP) { atomicAdd(&(bar)[XB_TMO], 1u); break; } } } } while (0)

struct XcdBarrier {
    unsigned* bar; unsigned x;
    volatile LAS unsigned* st;
};

__device__ __forceinline__ XcdBarrier xcd_barrier_post(unsigned* bar, volatile LAS unsigned* st) {
    XcdBarrier b; b.bar = bar; b.x = xb_xcc_id(); b.st = st;
    if (threadIdx.x == 0) (void)xb_add(&bar[XB_XCNT(b.x)], 1u);
    return b;
}
__device__ __forceinline__ void xcd_barrier_complete(unsigned* bar, unsigned x, unsigned& nloc, unsigned& nx) {
    const unsigned G = gridDim.x * gridDim.y * gridDim.z;
    unsigned sum, cnt, mine, sp = 0u;
    for (;;) {
        sum = 0u; cnt = 0u; mine = 0u;
#pragma unroll
        for (unsigned j = 0; j < 16; ++j) { const unsigned c = xb_ld(&bar[XB_XCNT(j)]); sum += c; cnt += (c > 0u) ? 1u : 0u; mine = (j == x) ? c : mine; }
        if (sum == G) break;
        __builtin_amdgcn_s_sleep(1);
        if ((++sp & 255u) == 0u) { if (xb_ld(&bar[XB_TMO])) break; if (sp > XB_SPIN_CAP) { atomicAdd(&bar[XB_TMO], 1u); break; } }
    }
    nloc = mine > 0u ? mine : 1u; nx = cnt > 0u ? cnt : 1u;
}

__device__ __forceinline__ void xcd_barrier(const XcdBarrier& b) {
    asm volatile("s_waitcnt vmcnt(0)" ::: "memory");
    __syncthreads();
    if (threadIdx.x == 0) {
        unsigned* bar = b.bar;
        __builtin_amdgcn_s_waitcnt(0);
        unsigned nloc = b.st[0], nx = b.st[1];
        if (nloc == 0u) { xcd_barrier_complete(bar, b.x, nloc, nx); b.st[0] = nloc; b.st[1] = nx; }
        const unsigned old = xb_add(&bar[XB_XSUB(b.x)], 1u);
        const unsigned gen = old / nloc;
        if (old + 1u == (gen + 1u) * nloc) {
            __builtin_amdgcn_fence(__ATOMIC_RELEASE, "agent");
            asm volatile("s_waitcnt vmcnt(0)" ::: "memory");
            const unsigned og = xb_add(&bar[XB_TOP], 1u);
            const unsigned tg = og / nx;
            if (og + 1u == (tg + 1u) * nx) xb_add(&bar[XB_TOPGEN], 1u);
            else XB_SPIN(xb_ld(&bar[XB_TOPGEN]) == tg, bar);
            __builtin_amdgcn_fence(__ATOMIC_ACQUIRE, "agent");
            xb_add(&bar[XB_XGEN(b.x)], 1u);
            asm volatile("s_waitcnt vmcnt(0)" ::: "memory");
        } else {
            XB_SPIN(xb_ld(&bar[XB_XGEN(b.x)]) == gen, bar);
            __builtin_amdgcn_fence(__ATOMIC_ACQUIRE, "agent");
            asm volatile("s_waitcnt vmcnt(0)" ::: "memory");
        }
    }
    __syncthreads();
}

#define LDS_WAIT() asm volatile("s_waitcnt lgkmcnt(0)" ::: "memory")
#define VM_WAIT() asm volatile("s_waitcnt vmcnt(0)" ::: "memory")
struct Frame {
    LAS unsigned char* lds;
    volatile LAS unsigned* MISC;
    gu32* ctl;
    int tid, lane, wave, vcu, G;
    unsigned char* ws;
    const float* in[25];
    float* out;
};

DI void sincos_acc(float ang, float& c, float& s) {
    const double x = (double)ang;
    const double k = rint(x * 0.63661977236758134308);
    double r = fma(-k, 1.57079632679489655800, x);
    r = fma(-k, 6.12323399573676603587e-17, r);
    const long long q = (long long)k;
    const double r2 = r * r;
    double sp = -7.6471637318198164759e-13; sp = fma(sp, r2, 1.6059043836821614599e-10); sp = fma(sp, r2, -2.5052108385441718775e-08);
    sp = fma(sp, r2, 2.7557319223985890653e-06); sp = fma(sp, r2, -1.9841269841269841270e-04); sp = fma(sp, r2, 8.3333333333333333333e-03);
    sp = fma(sp, r2, -1.6666666666666666667e-01); const double sr = fma(sp * r2, r, r);
    double cp = 4.7794773323873852974e-14; cp = fma(cp, r2, -1.1470745597729724714e-11); cp = fma(cp, r2, 2.0876756987868098979e-09);
    cp = fma(cp, r2, -2.7557319223985890653e-07); cp = fma(cp, r2, 2.4801587301587301587e-05); cp = fma(cp, r2, -1.3888888888888888889e-03);
    cp = fma(cp, r2, 4.1666666666666666667e-02); cp = fma(cp, r2, -0.5); const double cr = fma(cp, r2, 1.0);
    const int qq = (int)(q & 3);
    const double ss = qq == 0 ? sr : (qq == 1 ? cr : (qq == 2 ? -sr : -cr));
    const double cc = qq == 0 ? cr : (qq == 1 ? -sr : (qq == 2 ? -cr : sr));
    c = (float)cc; s = (float)ss;
}

DI void tr_item(const float* W, int N, bf16* WT, int Kd, LAS float* scr, int lane) {
#pragma unroll 4
    for (int i = 0; i < 16; ++i) { const int k = 4 * i + (lane >> 4), c4 = (lane & 15) * 4; const f32x4 v = *(const GAS f32x4*)(W + (size_t)k * N + c4);
        LAS float* d = scr + k * 65 + c4; d[0] = v.x; d[1] = v.y; d[2] = v.z; d[3] = v.w; }
    LDS_WAIT(); asm volatile("" ::: "memory");
    const int c = lane & 7;
#pragma unroll
    for (int j = 0; j < 8; ++j) { const int n = 8 * j + (lane >> 3); const LAS float* s = scr + (8 * c) * 65 + n;
        u32x4 o; o.x = pk2(s[0 * 65], s[1 * 65]); o.y = pk2(s[2 * 65], s[3 * 65]); o.z = pk2(s[4 * 65], s[5 * 65]); o.w = pk2(s[6 * 65], s[7 * 65]);
        *(GAS u32x4*)(WT + (size_t)n * Kd + 8 * c) = o; }
    LDS_WAIT(); asm volatile("" ::: "memory");
}
constexpr int XI_GU = 257 * 16 * 4, XI_DN = 257 * 4 * 16, XI_ALL = 2 * XI_GU + XI_DN;
constexpr float WSCALE = 64.0f;
struct XItem { const float* src; bf16* dst; int N, Kd, f8; };
DI XItem expert_item(Frame& F, int r) {
    unsigned char* ws = F.ws; XItem x;
    if (r < 2 * XI_GU) {
        const int up = r >= XI_GU; if (up) r -= XI_GU;
        const int e = r >> 6, kb = (r >> 2) & 15, nb = r & 3;
        const float* src = (e < NE) ? F.in[up ? 18 : 17] + (size_t)e * D * EH : F.in[up ? 21 : 20];
        const int row = (nb >> 1) * 256 + up * 128 + (nb & 1) * 64;
        x.src = src + (size_t)kb * 64 * EH + nb * 64; x.N = EH; x.dst = (bf16*)(ws + WS_WGUT + ((size_t)e * 512 + row) * D + kb * 64); x.Kd = D; x.f8 = 1;
    } else {
        r -= 2 * XI_GU;
        const int e = r >> 6, kb = (r >> 4) & 3, nb = r & 15;
        const float* src = (e < NE) ? F.in[19] + (size_t)e * EH * D : F.in[22];
        x.src = src + (size_t)kb * 64 * D + nb * 64; x.N = D; x.dst = (bf16*)(ws + WS_WDT + ((size_t)e * D + nb * 64) * EH + kb * 64); x.Kd = EH; x.f8 = 1;
    }
    return x;
}
DI void xi_load(const XItem& x, f32x4 (&r)[16], int lane) {
#pragma unroll
    for (int i = 0; i < 16; ++i) { const int k = 4 * i + (lane >> 4), c4 = (lane & 15) * 4; r[i] = __builtin_nontemporal_load((const GAS f32x4*)(x.src + (size_t)k * x.N + c4)); }
}
DI void xi_finish(const XItem& x, const f32x4 (&r)[16], LAS float* scr, int lane) {
#pragma unroll
    for (int i = 0; i < 16; ++i) { const int k = 4 * i + (lane >> 4), c4 = (lane & 15) * 4; LAS float* d = scr + k * 65 + c4; d[0] = r[i].x; d[1] = r[i].y; d[2] = r[i].z; d[3] = r[i].w; }
    LDS_WAIT(); asm volatile("" ::: "memory");
    const int c = lane & 7;
    if (x.f8) {
        unsigned char* d8 = (unsigned char*)x.dst;
#pragma unroll
        for (int j = 0; j < 8; ++j) { const int n = 8 * j + (lane >> 3); const LAS float* s = scr + (8 * c) * 65 + n;
            int w0 = __builtin_amdgcn_cvt_pk_fp8_f32(s[0 * 65] * WSCALE, s[1 * 65] * WSCALE, 0, false); w0 = __builtin_amdgcn_cvt_pk_fp8_f32(s[2 * 65] * WSCALE, s[3 * 65] * WSCALE, w0, true);
            int w1 = __builtin_amdgcn_cvt_pk_fp8_f32(s[4 * 65] * WSCALE, s[5 * 65] * WSCALE, 0, false); w1 = __builtin_amdgcn_cvt_pk_fp8_f32(s[6 * 65] * WSCALE, s[7 * 65] * WSCALE, w1, true);
            *(GAS u32x2*)(d8 + (size_t)n * x.Kd + 8 * c) = (u32x2){(unsigned)w0, (unsigned)w1}; }
    } else {
#pragma unroll
        for (int j = 0; j < 8; ++j) { const int n = 8 * j + (lane >> 3); const LAS float* s = scr + (8 * c) * 65 + n;
            u32x4 o; o.x = pg8::cvt_pk_bf16(s[0 * 65], s[1 * 65]); o.y = pg8::cvt_pk_bf16(s[2 * 65], s[3 * 65]); o.z = pg8::cvt_pk_bf16(s[4 * 65], s[5 * 65]); o.w = pg8::cvt_pk_bf16(s[6 * 65], s[7 * 65]);
            *(GAS u32x4*)(x.dst + (size_t)n * x.Kd + 8 * c) = o; }
    }
    LDS_WAIT(); asm volatile("" ::: "memory");
}
DI void convert_items(Frame& F, int it_lo, int it_hi, LAS float* scr) {
    const int gw = F.vcu * NWAVES + F.wave, NGW = F.G * NWAVES, lane = lane_id();
    const int first = it_lo + gw; if (first >= it_hi) return;
    const int n = (it_hi - first + NGW - 1) / NGW;
    f32x4 r0[16], r1[16]; XItem x0, x1;
    x0 = expert_item(F, first); xi_load(x0, r0, lane);
    x1 = expert_item(F, first + (1 < n ? 1 : 0) * NGW); if (1 < n) xi_load(x1, r1, lane);
#pragma unroll 1
    for (int q = 0; q < n; q += 2) {
        xi_finish(x0, r0, scr, lane); if (q + 2 < n) { x0 = expert_item(F, first + (q + 2) * NGW); xi_load(x0, r0, lane); }
        if (q + 1 < n) { xi_finish(x1, r1, scr, lane); if (q + 3 < n) { x1 = expert_item(F, first + (q + 3) * NGW); xi_load(x1, r1, lane); } }
    }
}
DI void p0_prologue(Frame& F) {
    LAS float* scr = (LAS float*)(F.lds + F.wave * 16640);
    const int gw = F.vcu * NWAVES + F.wave, NGW = F.G * NWAVES, lane = F.lane;
    unsigned char* ws = F.ws;
    constexpr int I_IN = 16 * 40, I_OUT = 16 * 16, I_RT = 16 * 4, I_G = 32;
    constexpr int NITEMS = I_IN + I_OUT + I_RT + I_G;
    for (int it = gw; it < NITEMS; it += NGW) {
        int r = it;
        if (r < I_IN) { const int kb = r / 40, nb = r % 40; tr_item(F.in[2] + (size_t)kb * 64 * INW + nb * 64, INW, (bf16*)(ws + WS_WINT) + (size_t)nb * 64 * D + kb * 64, D, scr, lane); continue; } r -= I_IN;
        if (r < I_OUT) { const int kb = r / 16, nb = r % 16; tr_item(F.in[12] + (size_t)kb * 64 * D + nb * 64, D, (bf16*)(ws + WS_WOUTT) + (size_t)nb * 64 * D + kb * 64, D, scr, lane); continue; } r -= I_OUT;
        if (r < I_RT) { const int kb = r / 4, nb = r % 4; tr_item(F.in[15] + (size_t)kb * 64 * NE + nb * 64, NE, (bf16*)(ws + WS_RTT) + (size_t)nb * 64 * D + kb * 64, D, scr, lane); continue; } r -= I_RT;
        {
            const int gate = r >> 4, dir = (r >> 3) & 1, n = r & 7;
            tr_item(F.in[gate ? 8 : 6] + (size_t)(dir * 8 + n) * 4096, 64, (bf16*)(ws + WS_GWT) + (size_t)((dir * 2 + gate) * 8 + n) * 4096, 64, scr, lane); }
    }
    { const f32x4* x4 = (const f32x4*)F.in[0]; u32x4* o = (u32x4*)(ws + WS_XB);
      const size_t NCHK = (size_t)T * D / 8, STR = (size_t)NGW * 64;
      for (size_t i = (size_t)gw * 64 + lane; i < NCHK; i += 4 * STR) {
          f32x4 a[4], b[4];
#pragma unroll
          for (int q = 0; q < 4; ++q) { const size_t ii = (i + q * STR < NCHK) ? i + q * STR : i; a[q] = __builtin_nontemporal_load((const GAS f32x4*)x4 + 2 * ii); b[q] = __builtin_nontemporal_load((const GAS f32x4*)x4 + 2 * ii + 1); }
#pragma unroll
          for (int q = 0; q < 4; ++q) if (i + q * STR < NCHK) { u32x4 w; w.x = pk2(a[q].x, a[q].y); w.y = pk2(a[q].z, a[q].w); w.z = pk2(b[q].x, b[q].y); w.w = pk2(b[q].z, b[q].w); o[i + q * STR] = w; } } }
    { const int* pos = (const int*)F.in[1]; float* rt = (float*)(ws + WS_ROPE);
      for (int i = gw * 64 + lane; i < T * 8; i += NGW * 64) { const int t = i >> 3, f = i & 7;
          float inv = 1.0f;
          inv = f == 1 ? 0x1.8d275ep-3f : inv; inv = f == 2 ? 0x1.341190p-5f : inv; inv = f == 3 ? 0x1.ddee9cp-8f : inv; inv = f == 4 ? 0x1.72ba44p-10f : inv;
          inv = f == 5 ? 0x1.1f91f0p-12f : inv; inv = f == 6 ? 0x1.be218ap-15f : inv; inv = f == 7 ? 0x1.5a0f50p-17f : inv;
          float c, s; sincos_acc((float)pos[t] * inv, c, s); rt[t * 16 + f] = c; rt[t * 16 + 8 + f] = s; } }
    { const float* lam = F.in[10]; float* c2 = (float*)(ws + WS_C2);
      for (int i = gw * 64 + lane; i < 2 * RW; i += NGW * 64) { const float l = lam[i]; const float sp = (-l > 20.f) ? -l : log1pf(expf(-l)); c2[i] = -8.0f * sp * LOG2E; } }
}

struct SchedDense {
    const bf16* A; const bf16* Bt; int lda, ldb, nM, nN, G, c, i0, i1;
    DI bool next(int ii, pg8::Unit& u) const { const int i = ii + i0; if (i >= i1) return false; int wgid; if (!pg8::xcd_order(i, G, c, nM * nN, wgid)) return false;
        const int nig = 8 * nN, gid = wgid / nig, fm = gid * 8, gsz = (nM - fm) < 8 ? (nM - fm) : 8; u.pm = fm + ((wgid % nig) % gsz); u.pn = (wgid % nig) / gsz; u.li = i; u.ex = 0; return true; }
    DI const char* a_base(const pg8::Unit& u) const { return (const char*)A + (size_t)u.pm * 256 * lda * 2; }
    DI unsigned a_voff(const pg8::Unit&, int R, int C) const { return (unsigned)(R * lda + C) * 2u; }
    DI const char* b_base(const pg8::Unit& u) const { return (const char*)Bt + (size_t)u.pn * 256 * ldb * 2; }
};
struct SchedRouter {
    const bf16* A; const bf16* Bt; int lda, ldb, nM, G, c;
    DI bool next(int i, pg8::Unit& u) const { int wgid; if (!pg8::xcd_order(i, G, c, nM * 2, wgid)) return false; u.pm = wgid >> 1; u.pn = wgid & 1; u.li = i; u.ex = 0; return true; }
    DI const char* a_base(const pg8::Unit& u) const { return (const char*)A + ((size_t)u.pm * 256 * lda + u.pn * 512) * 2; }
    DI unsigned a_voff(const pg8::Unit&, int R, int C) const { return (unsigned)(R * lda + C) * 2u; }
    DI const char* b_base(const pg8::Unit& u) const { return (const char*)Bt + (size_t)u.pn * 512 * 2; }
};
struct SchedG1 {
    const bf16* X; const bf16* W; const LAS unsigned* ue; const LAS unsigned* idx; int ldb, nwg, G, c; size_t bh1;
    DI bool next(int i, pg8::Unit& u) const { int wgid; if (!pg8::xcd_order(i, G, c, nwg, wgid)) return false; u.pm = wgid >> 1; u.pn = wgid & 1; u.li = i; u.ex = (int)ue[i]; return true; }
    DI const char* a_base(const pg8::Unit&) const { return (const char*)X; }
    DI unsigned a_voff(const pg8::Unit& u, int R, int C) const { return idx[u.li * 256 + R] * 1024u + (unsigned)C * 2u; }
    DI const char* b_base(const pg8::Unit& u) const { return (const char*)W + ((size_t)u.ex * 512 + u.pn * 256) * D; }
};
struct SchedG2 {
    const bf16* Hh; const bf16* W; const LAS unsigned* ue; int ldb, nwg, G, c, tile0; size_t bh1;
    DI bool next(int i, pg8::Unit& u) const { int wgid; if (!pg8::xcd_order(i, G, c, nwg, wgid)) return false; u.pm = tile0 + (wgid >> 2); u.pn = wgid & 3; u.li = i; u.ex = (int)ue[i]; return true; }
    DI const char* a_base(const pg8::Unit& u) const { return (const char*)Hh + (size_t)u.pm * 256 * EH; }
    DI unsigned a_voff(const pg8::Unit&, int R, int C) const { return (unsigned)(R * EH) + (unsigned)C * 2u; }
    DI const char* b_base(const pg8::Unit& u) const { return (const char*)W + ((size_t)u.ex * D + u.pn * 256) * EH; }
};

struct EpiInProj {
    static constexpr bool PERM = true; struct Ctx {}; DI Ctx pre(const pg8::Unit&, int, int) const { return Ctx{}; }
    bf16* Q; const float* rope;
    DI void operator()(const f32x4 (&acc)[2][2][4][2], const pg8::Unit& u, const Ctx& cx, int wr, int wc, int fr, int fq) const {
        const int seg = u.pn >> 1;
        bf16* base = Q + (size_t)seg * (SEG_BYTES / 2);
        const int row0 = u.pm * 256 + wr * 64 + fr, col0 = (u.pn & 1) * 256 + wc * 32 + 8 * fq;
        const bool rot = (seg < 2) && ((wc & 1) == 0);
        const float sgn = (fq == 0) ? -1.f : 1.f;
#pragma unroll
        for (int ai = 0; ai < 2; ++ai)
#pragma unroll
            for (int m = 0; m < 4; ++m) {
                const int row = row0 + ai * 128 + m * 16;
                f32x4 c0 = {1.f, 1.f, 1.f, 1.f}, c1 = c0, s0 = {0.f, 0.f, 0.f, 0.f}, s1 = s0;
                if (rot) { const f32x4* rp = (const f32x4*)(rope + (size_t)row * 16); c0 = rp[0]; c1 = rp[1]; s0 = rp[2]; s1 = rp[3]; }
#pragma unroll
                for (int bj = 0; bj < 2; ++bj) {
                    f32x4 v0 = acc[ai][bj][m][0], v1 = acc[ai][bj][m][1];
                    if (rot) {
                        f32x4 p0, p1;
#pragma unroll
                        for (int j = 0; j < 4; ++j) { p0[j] = __shfl_xor(v0[j], 16); p1[j] = __shfl_xor(v1[j], 16); }
                        if (fq < 2) { v0 = v0 * c0 + (p0 * s0) * sgn; v1 = v1 * c1 + (p1 * s1) * sgn; }
                    }
                    if (seg == 0) { v0 = v0 * QSCALE; v1 = v1 * QSCALE; }
                    if (seg == 4) {
#pragma unroll
                        for (int j = 0; j < 4; ++j) { v0[j] = gelu_tanh(v0[j]); v1[j] = gelu_tanh(v1[j]); } }
                    u32x4 w; w.x = pg8::cvt_pk_bf16(v0[0], v0[1]); w.y = pg8::cvt_pk_bf16(v0[2], v0[3]); w.z = pg8::cvt_pk_bf16(v1[0], v1[1]); w.w = pg8::cvt_pk_bf16(v1[2], v1[3]);
                    *(u32x4*)(base + (size_t)row * 512 + col0 + bj * 128) = w;
                }
            }
    }
};
struct EpiYb {
    static constexpr bool PERM = true; struct Ctx {}; DI Ctx pre(const pg8::Unit&, int, int) const { return Ctx{}; }
    bf16* Yb;
    DI void operator()(const f32x4 (&acc)[2][2][4][2], const pg8::Unit& u, const Ctx& cx, int wr, int wc, int fr, int fq) const {
        const int row0 = u.pm * 256 + wr * 64 + fr, col0 = u.pn * 256 + wc * 32 + 8 * fq;
#pragma unroll
        for (int ai = 0; ai < 2; ++ai)
#pragma unroll
            for (int m = 0; m < 4; ++m) { const size_t ro = (size_t)(row0 + ai * 128 + m * 16) * D + col0;
#pragma unroll
                for (int bj = 0; bj < 2; ++bj) { const f32x4 v0 = acc[ai][bj][m][0], v1 = acc[ai][bj][m][1];
                    u32x4 o; o.x = pg8::cvt_pk_bf16(v0[0], v0[1]); o.y = pg8::cvt_pk_bf16(v0[2], v0[3]); o.z = pg8::cvt_pk_bf16(v1[0], v1[1]); o.w = pg8::cvt_pk_bf16(v1[2], v1[3]);
                    *(u32x4*)(Yb + ro + bj * 128) = o; } }
    }
};
struct EpiLogits {
    static constexpr bool PERM = false; struct Ctx {}; DI Ctx pre(const pg8::Unit&, int, int) const { return Ctx{}; }
    float* L;
    DI void operator()(const f32x4 (&acc)[2][2][4][2], const pg8::Unit& u, const Ctx& cx, int wr, int wc, int fr, int fq) const {
        float* base = L + (size_t)u.pn * T * NE; const int row0 = u.pm * 256 + wr * 64 + fr, col0 = wc * 32 + 4 * fq;
#pragma unroll
        for (int ai = 0; ai < 2; ++ai)
#pragma unroll
            for (int m = 0; m < 4; ++m) { const size_t ro = (size_t)(row0 + ai * 128 + m * 16) * NE + col0;
#pragma unroll
                for (int bj = 0; bj < 2; ++bj)
#pragma unroll
                    for (int n = 0; n < 2; ++n) *(f32x4*)(base + ro + bj * 128 + n * 16) = acc[ai][bj][m][n]; }
    }
};
constexpr float HSCALE = 64.0f;
struct EpiSwiglu {
    static constexpr bool PERM = true;
    struct Ctx {}; DI Ctx pre(const pg8::Unit&, int, int) const { return Ctx{}; }
    unsigned char* Hh; const LAS float* wtab; int NT;
    DI void operator()(const f32x4 (&acc)[2][2][4][2], const pg8::Unit& u, const Ctx& cx, int wr, int wc, int fr, int fq) const {
        const int row0 = u.pm * 256 + wr * 64 + fr, col0 = u.pn * 128 + wc * 32 + 8 * fq;
#pragma unroll
        for (int ai = 0; ai < 2; ++ai)
#pragma unroll
            for (int m = 0; m < 4; ++m) {
                float h[8]; const float w = wtab[u.li * 256 + wr * 64 + fr + ai * 128 + m * 16];
#pragma unroll
                for (int n = 0; n < 2; ++n)
#pragma unroll
                    for (int j = 0; j < 4; ++j) { const float g = acc[ai][0][m][n][j] * (1.0f / WSCALE), uu = acc[ai][1][m][n][j] * (1.0f / WSCALE); h[4 * n + j] = g * frcp(1.f + fexp2(-LOG2E * g)) * (uu * w); }
#pragma unroll
                for (int q = 0; q < 8; ++q) h[q] = __builtin_amdgcn_fmed3f(h[q] * HSCALE, -448.f, 448.f);
                int q0 = __builtin_amdgcn_cvt_pk_fp8_f32(h[0], h[1], 0, false); q0 = __builtin_amdgcn_cvt_pk_fp8_f32(h[2], h[3], q0, true);
                int q1 = __builtin_amdgcn_cvt_pk_fp8_f32(h[4], h[5], 0, false); q1 = __builtin_amdgcn_cvt_pk_fp8_f32(h[6], h[7], q1, true);
                *(u32x2*)(Hh + (size_t)(row0 + ai * 128 + m * 16) * EH + col0) = (u32x2){(unsigned)q0, (unsigned)q1};
            }
    }
};
constexpr float YSCALE = 16.0f;
DI unsigned pk_fp8x4(float a, float b, float c, float d) {
    constexpr float SC = YSCALE / (HSCALE * WSCALE);
    a = __builtin_amdgcn_fmed3f(a * SC, -448.f, 448.f); b = __builtin_amdgcn_fmed3f(b * SC, -448.f, 448.f); c = __builtin_amdgcn_fmed3f(c * SC, -448.f, 448.f); d = __builtin_amdgcn_fmed3f(d * SC, -448.f, 448.f);
    int w = __builtin_amdgcn_cvt_pk_fp8_f32(a, b, 0, false); w = __builtin_amdgcn_cvt_pk_fp8_f32(c, d, w, true); return (unsigned)w; }
struct EpiDownY {
    static constexpr bool PERM = true; struct Ctx {}; DI Ctx pre(const pg8::Unit&, int, int) const { return Ctx{}; }
    unsigned char* Y; bool dry;
    DI void operator()(const f32x4 (&acc)[2][2][4][2], const pg8::Unit& u, const Ctx& cx, int wr, int wc, int fr, int fq) const {
        const int rl0 = wr * 64 + fr, boff = ((u.pn * 4 + wc) * 4 + fq) * 16;
#pragma unroll
        for (int ai = 0; ai < 2; ++ai)
#pragma unroll
            for (int m = 0; m < 4; ++m) { const size_t slot = (size_t)u.pm * 256 + rl0 + ai * 128 + m * 16;
                u32x4 o;
                o.x = pk_fp8x4(acc[ai][0][m][0][0], acc[ai][0][m][0][1], acc[ai][0][m][0][2], acc[ai][0][m][0][3]); o.y = pk_fp8x4(acc[ai][0][m][1][0], acc[ai][0][m][1][1], acc[ai][0][m][1][2], acc[ai][0][m][1][3]);
                o.z = pk_fp8x4(acc[ai][1][m][0][0], acc[ai][1][m][0][1], acc[ai][1][m][0][2], acc[ai][1][m][0][3]); o.w = pk_fp8x4(acc[ai][1][m][1][0], acc[ai][1][m][1][1], acc[ai][1][m][1][2], acc[ai][1][m][1][3]);
                if (!dry) *(u32x4*)(Y + slot * 1024 + boff) = o; }
    }
};

struct ScanP { const bf16* RX; const bf16* GWT; const float* cw; const float* cb; const float* gab; const float* gxb; const float* c2; f32x2* carry; bf16* HF; bf16* HB; };
constexpr int UT_PITCH = 144;
constexpr int SC_RAW = 4608;
DI void load_raw(const bf16* RX, int tt0, int n, u32x4 (&rw)[5], int lane) {
    const int s0 = tt0 & (SEQ - 1);
#pragma unroll
    for (int i = 0; i < 5; ++i) { const int p = i * 64 + lane, row = p >> 3, ch = p & 7; const int ss = s0 + row - 2;
        u32x4 v = {0u, 0u, 0u, 0u};
        if (p < 288 && ss >= 0 && ss < SEQ) v = *(const GAS u32x4*)(RX + (size_t)(tt0 + row - 2) * RW + 64 * n + 8 * ch);
        rw[i] = v; }
}
DI void build_u_tile(const u32x4 (&rw)[5], float w0, float w1, float w2, float w3, float cbv, LAS unsigned char* ut, int lane) {
    LAS unsigned char* raw = ut + SC_RAW;
#pragma unroll
    for (int i = 0; i < 5; ++i) { const int p = i * 64 + lane; if (p < 288) *(LAS u32x4*)(raw + p * 16) = rw[i]; }
    float xm2 = bf2f(*(const LAS unsigned short*)(raw + 0 * 128 + lane * 2)), xm1 = bf2f(*(const LAS unsigned short*)(raw + 1 * 128 + lane * 2)), x0 = bf2f(*(const LAS unsigned short*)(raw + 2 * 128 + lane * 2));
#pragma unroll
    for (int tok = 0; tok < 32; ++tok) {
        const float x1 = bf2f(*(const LAS unsigned short*)(raw + (tok + 3) * 128 + lane * 2));
        const float uu = cbv + w0 * xm2 + w1 * xm1 + w2 * x0 + w3 * x1;
        *(LAS unsigned short*)(ut + tok * UT_PITCH + lane * 2) = (unsigned short)pg8::cvt_pk_bf16(uu, uu);
        xm2 = xm1; xm1 = x0; x0 = x1;
    }
}
DI void gate_ct(const LAS unsigned char* ut, const bf16x8 (&af)[4], const bf16x8 (&wA)[4], const bf16x8 (&wX)[4], float ba, float bx, float c2v, int ct, f32x16& a, f32x16& b, int lane) {
    const int col = lane & 31, hi = lane >> 5;
    f32x16 pa, px;
#pragma unroll
    for (int i = 0; i < 16; ++i) { pa[i] = 0.f; px[i] = 0.f; }
#pragma unroll
    for (int ks = 0; ks < 4; ++ks) { pa = MFMA32(af[ks], wA[ks], pa); px = MFMA32(af[ks], wX[ks], px); }
#pragma unroll
    for (int r = 0; r < 16; ++r) {
        const float uu = bf2f(*(const LAS unsigned short*)(ut + crow(r, hi) * UT_PITCH + (32 * ct + col) * 2));
        const float rr = frcp(1.f + fexp2(-LOG2E * (pa[r] + ba)));
        const float ii = frcp(1.f + fexp2(-LOG2E * (px[r] + bx)));
        const float av = fexp2(rr * c2v);
        a[r] = av; b[r] = __builtin_amdgcn_sqrtf(fmaxf(1.f - av * av, 0.f)) * ii * uu;
    }
}
template <int DIR, bool PASS2>
DI void scan_tile(const f32x16& a, const f32x16& b, LAS unsigned char* ocol, float& h, float& Ac, float& Bc, int hi) {
    float Ag[4], Bg[4];
#pragma unroll
    for (int g = 0; g < 4; ++g) {
        if (DIR == 0) { float B = b[4 * g]; B = a[4 * g + 1] * B + b[4 * g + 1]; B = a[4 * g + 2] * B + b[4 * g + 2]; B = a[4 * g + 3] * B + b[4 * g + 3]; Bg[g] = B; }
        else          { float B = b[4 * g + 3]; B = a[4 * g + 2] * B + b[4 * g + 2]; B = a[4 * g + 1] * B + b[4 * g + 1]; B = a[4 * g] * B + b[4 * g]; Bg[g] = B; }
        Ag[g] = (a[4 * g] * a[4 * g + 1]) * (a[4 * g + 2] * a[4 * g + 3]);
    }
    float AE[4], BE[4], AO[4], BO[4];
#pragma unroll
    for (int g = 0; g < 4; ++g) { const float pA = __shfl_xor(Ag[g], 32), pB = __shfl_xor(Bg[g], 32);
        AE[g] = hi ? pA : Ag[g]; BE[g] = hi ? pB : Bg[g]; AO[g] = hi ? Ag[g] : pA; BO[g] = hi ? Bg[g] : pB; }
    float hin[4];
    if (DIR == 0) {
#pragma unroll
        for (int g = 0; g < 4; ++g) { const float hE = h; h = AE[g] * h + BE[g]; const float hO = h; h = AO[g] * h + BO[g]; hin[g] = hi ? hO : hE;
            if (!PASS2) { Bc = AE[g] * Bc + BE[g]; Ac *= AE[g]; Bc = AO[g] * Bc + BO[g]; Ac *= AO[g]; } }
    } else {
#pragma unroll
        for (int g = 3; g >= 0; --g) { const float hO = h; h = AO[g] * h + BO[g]; const float hE = h; h = AE[g] * h + BE[g]; hin[g] = hi ? hO : hE;
            if (!PASS2) { Bc = AO[g] * Bc + BO[g]; Ac *= AO[g]; Bc = AE[g] * Bc + BE[g]; Ac *= AE[g]; } }
    }
    if (PASS2) {
#pragma unroll
        for (int g = 0; g < 4; ++g) { float hh = hin[g];
            if (DIR == 0) {
#pragma unroll
                for (int q = 0; q < 4; ++q) { hh = a[4 * g + q] * hh + b[4 * g + q]; *(LAS unsigned short*)(ocol + crow(4 * g + q, hi) * 128) = (unsigned short)pg8::cvt_pk_bf16(hh, hh); }
            } else {
#pragma unroll
                for (int q = 3; q >= 0; --q) { hh = a[4 * g + q] * hh + b[4 * g + q]; *(LAS unsigned short*)(ocol + crow(4 * g + q, hi) * 128) = (unsigned short)pg8::cvt_pk_bf16(hh, hh); }
            } }
    }
}
template <int DIR, bool PASS2>
DI void scan_sweep(const ScanP& P, int b, int n, int j, LAS unsigned char* ut, int lane) {
    const int col = lane & 31, hi = lane >> 5;
    bf16x8 wA[2][4], wX[2][4]; float ba[2], bx[2], c2v[2];
#pragma unroll
    for (int ct = 0; ct < 2; ++ct) {
#pragma unroll
        for (int ks = 0; ks < 4; ++ks) {
            wA[ct][ks] = *(const GAS bf16x8*)(P.GWT + ((size_t)((DIR * 2 + 0) * 8 + n) * 64 + 32 * ct + col) * 64 + 16 * ks + 8 * hi);
            wX[ct][ks] = *(const GAS bf16x8*)(P.GWT + ((size_t)((DIR * 2 + 1) * 8 + n) * 64 + 32 * ct + col) * 64 + 16 * ks + 8 * hi); }
        const int c = DIR * RW + 64 * n + 32 * ct + col; ba[ct] = P.gab[c]; bx[ct] = P.gxb[c]; c2v[ct] = P.c2[c];
    }
    const float w0 = P.cw[0 * RW + 64 * n + lane], w1 = P.cw[1 * RW + 64 * n + lane], w2 = P.cw[2 * RW + 64 * n + lane], w3 = P.cw[3 * RW + 64 * n + lane], cbv = P.cb[64 * n + lane];
    const int t0 = b * SEQ + j * LCH;
    u32x4 rw[5];
    load_raw(P.RX, t0 + 32 * (DIR == 0 ? 0 : (LCH / 32 - 1)), n, rw, lane);
    float h[2] = {0.f, 0.f}, Ac[2] = {1.f, 1.f}, Bc[2] = {0.f, 0.f};
    if (PASS2) {
        const f32x2* cr = P.carry + ((size_t)(b * 2 + DIR) * NCH) * RW + 64 * n + col;
        const int cnt = DIR == 0 ? j : (NCH - 1 - j);
        f32x2 ab[16][2];
#define SC_LD(dst, q0) do { _Pragma("unroll") for (int q = 0; q < 16; ++q) { const int qq_ = ((q0) + q < cnt) ? ((q0) + q) : (cnt > 0 ? cnt - 1 : 0); const int jj_ = DIR == 0 ? qq_ : (NCH - 1 - qq_); \
            _Pragma("unroll") for (int ct = 0; ct < 2; ++ct) dst[q][ct] = cr[(size_t)jj_ * RW + 32 * ct]; } } while (0)
        for (int q0 = 0; q0 < cnt; q0 += 16) {
            SC_LD(ab, q0);
#pragma unroll
            for (int q = 0; q < 16; ++q) if (q0 + q < cnt) {
#pragma unroll
                for (int ct = 0; ct < 2; ++ct) h[ct] = ab[q][ct].x * h[ct] + ab[q][ct].y; }
        }
#undef SC_LD
    }
#pragma unroll 1
    for (int tq = 0; tq < LCH / 32; ++tq) {
        const int ti = DIR == 0 ? tq : (LCH / 32 - 1 - tq);
        const int tt0 = t0 + 32 * ti;
        if (PASS2 && tq > 0) load_raw(P.RX, tt0, n, rw, lane);
        build_u_tile(rw, w0, w1, w2, w3, cbv, ut, lane);
        if (!PASS2 && tq + 1 < LCH / 32) load_raw(P.RX, t0 + 32 * (DIR == 0 ? tq + 1 : (LCH / 32 - 2 - tq)), n, rw, lane);
        bf16x8 af[4];
#pragma unroll
        for (int ks = 0; ks < 4; ++ks) af[ks] = *(const LAS bf16x8*)(ut + col * UT_PITCH + (16 * ks + 8 * hi) * 2);
        LAS unsigned char* ot = ut + SC_RAW;
#pragma unroll
        for (int ct = 0; ct < 2; ++ct) {
            f32x16 a, bb;
            gate_ct(ut, af, wA[ct], wX[ct], ba[ct], bx[ct], c2v[ct], ct, a, bb, lane);
            scan_tile<DIR, PASS2>(a, bb, ot + (32 * ct + col) * 2, h[ct], Ac[ct], Bc[ct], hi);
            __builtin_amdgcn_sched_barrier(0);
        }
        if (PASS2) {
            bf16* dst = (DIR == 0 ? P.HF : P.HB) + (size_t)tt0 * RW + 64 * n;
#pragma unroll
            for (int i = 0; i < 4; ++i) { const int p = i * 64 + lane, row = p >> 3, ch = p & 7; *(GAS u32x4*)(dst + (size_t)row * RW + 8 * ch) = *(const LAS u32x4*)(ot + p * 16); }
        }
    }
    if (!PASS2 && hi == 0) {
#pragma unroll
        for (int ct = 0; ct < 2; ++ct) P.carry[((size_t)(b * 2 + DIR) * NCH + j) * RW + 64 * n + 32 * ct + col] = (f32x2){Ac[ct], Bc[ct]};
    }
}
template <bool PASS2>
DI void scan_phase(Frame& F, const ScanP& P, int it_lo, int it_hi);
constexpr int AT_OACC = 0, AT_ML = 65536, AT_V = 69632;
DI s16x4 vtr(const LAS unsigned char* p) { typedef short v4i16_t __attribute__((ext_vector_type(4))); return __builtin_bit_cast(s16x4, __builtin_amdgcn_ds_read_tr16_b64_v4i16((LAS v4i16_t*)p)); }
DI void attn_tile(const bf16* Qp, const bf16* Kp, const bf16* Vp, int tb, int h, int rho, int dl, int nq0, int L, LAS unsigned char* vt, int lane, f32x16 (&o)[2], float& m_out, float& l_out) {
    const int qi = lane & 31, hi = lane >> 5;
    LAS unsigned char* kt_lds = vt + 32768;
    const int kt_lo = (nq0 >= 64) ? 0 : (2 - (nq0 >> 5)), kt_hi = ((L - nq0) >> 5) + 2 < 5 ? ((L - nq0) >> 5) + 2 : 5;
    bf16x8 qf[4]; u32x4 kr[5][4], vv[5][4];
    const size_t hoff = (size_t)h * HD;
    const bf16* qp = Qp + (size_t)(tb + rho + dl * (nq0 + qi)) * AW + hoff + 8 * hi;
#pragma unroll
    for (int ks = 0; ks < 4; ++ks) qf[ks] = *(const GAS bf16x8*)(qp + 16 * ks);
    const size_t kstep = (size_t)dl * 32 * AW;
    const size_t rowoff = (size_t)(tb + rho + dl * (nq0 - 64 + (lane >> 3))) * AW + hoff + 8 * (lane & 7);
    const bf16* kp0 = Kp + rowoff; const bf16* vp0 = Vp + rowoff;
    const size_t vrow8 = (size_t)dl * 8 * AW;
#define ATT_CL(kt) ((kt) < kt_lo ? kt_lo : ((kt) >= kt_hi ? kt_hi - 1 : (kt)))
#define ATT_LOADK(kt) do { const size_t ko_ = (size_t)ATT_CL(kt) * kstep; _Pragma("unroll") for (int i = 0; i < 4; ++i) kr[kt][i] = *(const GAS u32x4*)(kp0 + ko_ + i * vrow8); } while (0)
#define ATT_LOADV(kt) do { const size_t vo_ = (size_t)ATT_CL(kt) * kstep; _Pragma("unroll") for (int i = 0; i < 4; ++i) vv[kt][i] = *(const GAS u32x4*)(vp0 + vo_ + i * vrow8); } while (0)
    ATT_LOADK(0); ATT_LOADK(1); ATT_LOADK(2); ATT_LOADK(3); ATT_LOADK(4);
    ATT_LOADV(0); ATT_LOADV(1);
    f32x16 z;
#pragma unroll
    for (int i = 0; i < 16; ++i) z[i] = 0.f;
    o[0] = z; o[1] = z;
    float m = -1e30f, l = 0.f;
    const int q4 = (lane & 15) >> 2, p4 = lane & 3, blk = (lane >> 4) & 1;
    const LAS unsigned char* vrd = vt + (4 * hi + q4) * 128 + (16 * blk + 4 * p4) * 2;
    const int kwr = (lane >> 3) * 128 + (((lane & 7) ^ ((lane >> 3) & 7)) << 4);
    const LAS unsigned char* krd = kt_lds + qi * 128;
#pragma unroll
    for (int kt = 0; kt < 5; ++kt) {
        if (kt + 2 < 5) ATT_LOADV(kt + 2);
        if (kt >= kt_lo && kt < kt_hi) {
#pragma unroll
            for (int i = 0; i < 4; ++i) *(LAS u32x4*)(kt_lds + i * 1024 + kwr) = kr[kt][i];
            f32x16 s = z;
#pragma unroll
            for (int ks = 0; ks < 4; ++ks) { const bf16x8 kf = *(const LAS bf16x8*)(krd + (((2 * ks + hi) ^ (qi & 7)) << 4)); s = MFMA32(kf, qf[ks], s); }
#pragma unroll
            for (int i = 0; i < 4; ++i) { const int piece = i * 64 + lane; *(LAS u32x4*)(vt + piece * 16) = vv[kt][i]; }
            if (kt == 0) {
#pragma unroll
                for (int r = 0; r < 16; ++r) if (crow(r, hi) < qi) s[r] = -1e30f;
            }
            if (kt == 4) {
#pragma unroll
                for (int r = 0; r < 16; ++r) if (crow(r, hi) > qi) s[r] = -1e30f;
            }
            float tm = s[0];
#pragma unroll
            for (int r = 1; r < 16; ++r) tm = fmaxf(tm, s[r]);
            { const auto sw_ = __builtin_amdgcn_permlane32_swap(__float_as_uint(tm), __float_as_uint(tm), false, false); tm = fmaxf(__uint_as_float(sw_[0]), __uint_as_float(sw_[1])); }
            const float mn = fmaxf(m, tm), al = fexp2(m - mn);
            float ps = 0.f;
#pragma unroll
            for (int r = 0; r < 16; ++r) { s[r] = fexp2(s[r] - mn); ps += s[r]; }
            l = l * al + ps; m = mn;
#pragma unroll
            for (int r = 0; r < 16; ++r) { o[0][r] *= al; o[1][r] *= al; }
            bf16x8 pk[2];
#pragma unroll
            for (int sx = 0; sx < 2; ++sx) { u32x4 w; w.x = pg8::cvt_pk_bf16(s[8 * sx + 0], s[8 * sx + 1]); w.y = pg8::cvt_pk_bf16(s[8 * sx + 2], s[8 * sx + 3]);
                w.z = pg8::cvt_pk_bf16(s[8 * sx + 4], s[8 * sx + 5]); w.w = pg8::cvt_pk_bf16(s[8 * sx + 6], s[8 * sx + 7]); pk[sx] = __builtin_bit_cast(bf16x8, w); }
#pragma unroll
            for (int sx = 0; sx < 2; ++sx)
#pragma unroll
                for (int dh = 0; dh < 2; ++dh) {
                    const s16x4 lo = vtr(vrd + (16 * sx) * 128 + 64 * dh), hi4 = vtr(vrd + (16 * sx + 8) * 128 + 64 * dh);
                    const bf16x8 vf = __builtin_shufflevector(lo, hi4, 0, 1, 2, 3, 4, 5, 6, 7);
                    o[dh] = MFMA32(vf, pk[sx], o[dh]);
                }
        }
    }
#undef ATT_LOADK
#undef ATT_LOADV
#undef ATT_CL
    m_out = m; l_out = l + __shfl_xor(l, 32);
}
struct AttnP { const bf16* Q; const bf16* K; const bf16* V; bf16* O; };
DI void attn_phase(Frame& F, const AttnP& P) {
    LAS unsigned char* lds = F.lds;
    LAS unsigned char* vt = lds + AT_V + F.wave * 4096;
    const int lane = F.lane, qi = lane & 31, hi = lane >> 5;
    for (int unit = F.vcu; unit < NB * NH * (SEQ / 512); unit += F.G) {
        const int sp = unit & 15, h = (unit >> 4) & 7, b = unit >> 7;
        const int tb = b * SEQ, P0 = 512 * sp;
#pragma unroll 1
        for (int g = 0; g < 3; ++g) {
            const int dl = g == 0 ? 1 : (g == 1 ? 4 : 16), L = SEQ / dl;
#pragma unroll 1
            for (int xx = 0; xx < 2; ++xx) {
                const int x = F.wave + 8 * xx;
                int rho, nq0, qp0, qst;
                if (g == 0) { rho = 0; nq0 = P0 + 32 * x; qp0 = 32 * x; qst = 1; }
                else if (g == 1) { rho = x & 3; nq0 = P0 / 4 + 32 * (x >> 2); qp0 = rho + 128 * (x >> 2); qst = 4; }
                else { rho = x; nq0 = P0 / 16; qp0 = rho; qst = 16; }
                f32x16 o[2]; float m, l;
                attn_tile(P.Q, P.K, P.V, tb, h, rho, dl, nq0, L, vt, lane, o, m, l);
                const int qpos = qp0 + qst * qi;
                LAS unsigned char* orow = lds + AT_OACC + qpos * 128 + 8 * hi;
                LAS f32x2* ml = (LAS f32x2*)(lds + AT_ML) + qpos;
                float w2 = frcp(l), w1 = 0.f;
                if (g > 0) { const f32x2 old = *ml; const float mN = fmaxf(old.x, m); const float a1 = old.y * fexp2(old.x - mN), a2 = fexp2(m - mN); const float lN = a1 + l * a2, rl = frcp(lN);
                    w1 = a1 * rl; w2 = a2 * rl; m = mN; l = lN; }
#pragma unroll
                for (int dh = 0; dh < 2; ++dh)
#pragma unroll
                    for (int gq = 0; gq < 4; ++gq) {
                        LAS u32x2* p = (LAS u32x2*)(orow + (32 * dh + 8 * gq) * 2);
                        float v0 = o[dh][4 * gq] * w2, v1 = o[dh][4 * gq + 1] * w2, v2 = o[dh][4 * gq + 2] * w2, v3 = o[dh][4 * gq + 3] * w2;
                        if (g > 0) { const u32x2 ow = *p; v0 += bflo(ow.x) * w1; v1 += bfhi(ow.x) * w1; v2 += bflo(ow.y) * w1; v3 += bfhi(ow.y) * w1; }
                        u32x2 nw; nw.x = pg8::cvt_pk_bf16(v0, v1); nw.y = pg8::cvt_pk_bf16(v2, v3); *p = nw;
                    }
                if (hi == 0) *ml = (f32x2){m, l};
            }
            __syncthreads();
        }
#pragma unroll
        for (int i = 0; i < 8; ++i) { const int c = i * 512 + F.tid, q = c >> 3, ch = c & 7;
            *(GAS u32x4*)(P.O + (size_t)(tb + P0 + q) * AW + h * HD + 8 * ch) = *(const LAS u32x4*)(lds + AT_OACC + q * 128 + ch * 16); }
        __syncthreads();
    }
}

struct MixG { f32x4 ga0, ga1, gr0, gr1; };
DI MixG mix_gains(Frame& F) { const int lane = lane_id(); return MixG{*(const f32x4*)(F.in[3] + 8 * lane), *(const f32x4*)(F.in[3] + 8 * lane + 4), *(const f32x4*)(F.in[11] + 8 * lane), *(const f32x4*)(F.in[11] + 8 * lane + 4)}; }
DI void mix_pair(Frame& F, const MixG& g, int tA, int tB) {
    const bf16* AT = (const bf16*)(F.ws + WS_ATTN); const bf16* HFp = (const bf16*)(F.ws + WS_HF); const bf16* HBp = (const bf16*)(F.ws + WS_REC); const bf16* Gp = (const bf16*)(F.ws + WS_Q + 4 * SEG_BYTES);
    bf16* MX = (bf16*)(F.ws + WS_MIX); const int lane = lane_id();
    u32x4 a[2], hf[2], hb[2], gg[2];
#pragma unroll
    for (int u = 0; u < 2; ++u) { const size_t o = (size_t)(u ? tB : tA) * 512 + 8 * lane;
        a[u] = *(const GAS u32x4*)(AT + o); hf[u] = *(const GAS u32x4*)(HFp + o); hb[u] = *(const GAS u32x4*)(HBp + o); gg[u] = *(const GAS u32x4*)(Gp + o); }
#pragma unroll
    for (int u = 0; u < 2; ++u) {
        const int t = u ? tB : tA;
        float av[8] = {bflo(a[u].x), bfhi(a[u].x), bflo(a[u].y), bfhi(a[u].y), bflo(a[u].z), bfhi(a[u].z), bflo(a[u].w), bfhi(a[u].w)};
        float rv[8] = {(bflo(hf[u].x) + bflo(hb[u].x)) * bflo(gg[u].x), (bfhi(hf[u].x) + bfhi(hb[u].x)) * bfhi(gg[u].x), (bflo(hf[u].y) + bflo(hb[u].y)) * bflo(gg[u].y), (bfhi(hf[u].y) + bfhi(hb[u].y)) * bfhi(gg[u].y),
                       (bflo(hf[u].z) + bflo(hb[u].z)) * bflo(gg[u].z), (bfhi(hf[u].z) + bfhi(hb[u].z)) * bfhi(gg[u].z), (bflo(hf[u].w) + bflo(hb[u].w)) * bflo(gg[u].w), (bfhi(hf[u].w) + bfhi(hb[u].w)) * bfhi(gg[u].w)};
        float sa = 0.f, sr = 0.f;
#pragma unroll
        for (int i = 0; i < 8; ++i) { sa += av[i] * av[i]; sr += rv[i] * rv[i]; }
        sa = wave_sum(sa); sr = wave_sum(sr);
        const float ra = 1.0f / sqrtf(sa * (1.f / 512.f) + LN_EPS), rr = 1.0f / sqrtf(sr * (1.f / 512.f) + LN_EPS);
        u32x4 oa, orr;
        oa.x = pk2(av[0] * ra * g.ga0.x, av[1] * ra * g.ga0.y); oa.y = pk2(av[2] * ra * g.ga0.z, av[3] * ra * g.ga0.w); oa.z = pk2(av[4] * ra * g.ga1.x, av[5] * ra * g.ga1.y); oa.w = pk2(av[6] * ra * g.ga1.z, av[7] * ra * g.ga1.w);
        orr.x = pk2(rv[0] * rr * g.gr0.x, rv[1] * rr * g.gr0.y); orr.y = pk2(rv[2] * rr * g.gr0.z, rv[3] * rr * g.gr0.w); orr.z = pk2(rv[4] * rr * g.gr1.x, rv[5] * rr * g.gr1.y); orr.w = pk2(rv[6] * rr * g.gr1.z, rv[7] * rr * g.gr1.w);
        *(GAS u32x4*)(MX + (size_t)t * D + 8 * lane) = oa; *(GAS u32x4*)(MX + (size_t)t * D + AW + 8 * lane) = orr;
    }
}
DI void mix_phase(Frame& F) {
    const int gw = F.vcu * NWAVES + F.wave, NGW = F.G * NWAVES; const MixG g = mix_gains(F);
    for (int t0 = gw; t0 < T; t0 += 2 * NGW) mix_pair(F, g, t0, t0 + NGW);
}
template <bool PASS2>
DI void scan_phase(Frame& F, const ScanP& P, int it_lo, int it_hi) {
    LAS unsigned char* ut = F.lds + F.wave * 16640;
    LAS float* scr = (LAS float*)(F.lds + F.wave * 16640);
    const int gw = F.vcu * NWAVES + F.wave, NGW = F.G * NWAVES;
    const bool conv_first = F.wave < 4;
    const bool wg_units = PASS2 && (F.G * NWAVES == NB * 8 * NCH);
    if (conv_first) convert_items(F, it_lo, it_hi, scr);
    for (int u = gw; u < NB * 8 * NCH; u += NGW) {
        int j = u % NCH, n = (u / NCH) & 7, b = u / (NCH * 8);
        if (wg_units) { b = F.vcu / NCH; j = F.vcu % NCH; n = F.wave; }
        scan_sweep<0, PASS2>(P, b, n, j, ut, F.lane);
        scan_sweep<1, PASS2>(P, b, n, j, ut, F.lane);
    }
    if (!conv_first) convert_items(F, it_lo, it_hi, scr);
    if (wg_units) {
        VM_WAIT(); __syncthreads();
        const MixG g = mix_gains(F); const int t0 = (F.vcu / NCH) * SEQ + (F.vcu % NCH) * LCH + F.wave * 16;
#pragma unroll 1
        for (int i = 0; i < 16; i += 2) mix_pair(F, g, t0 + i, t0 + i + 1);
    }
}

DI void ln1_phase(Frame& F) {
    const bf16* Yb = (const bf16*)(F.ws + WS_V1); const float* X = F.in[0]; bf16* X1B = (bf16*)(F.ws + WS_X1B); unsigned char* X1F8 = F.ws + WS_HF;
    const int gw = F.vcu * NWAVES + F.wave, NGW = F.G * NWAVES, lane = F.lane;
    f32x4 gg[4], bb[4];
#pragma unroll
    for (int j = 0; j < 4; ++j) { gg[j] = *(const f32x4*)(F.in[13] + 4 * lane + 256 * j); bb[j] = *(const f32x4*)(F.in[14] + 4 * lane + 256 * j); }
    for (int t0 = gw; t0 < T; t0 += 2 * NGW) {
        f32x4 v[2][4]; u32x2 yv[2][4];
#pragma unroll
        for (int u = 0; u < 2; ++u) { const GAS f32x4* xr = (const GAS f32x4*)(X + (size_t)(t0 + u * NGW) * D) + lane; const GAS u32x2* yr = (const GAS u32x2*)(Yb + (size_t)(t0 + u * NGW) * D) + lane;
#pragma unroll
            for (int j = 0; j < 4; ++j) { v[u][j] = xr[64 * j]; yv[u][j] = yr[64 * j]; } }
#pragma unroll
        for (int u = 0; u < 2; ++u) {
            const int t = t0 + u * NGW; float s = 0.f;
#pragma unroll
            for (int j = 0; j < 4; ++j) { v[u][j] = v[u][j] * ALPHA + (f32x4){bflo(yv[u][j].x), bfhi(yv[u][j].x), bflo(yv[u][j].y), bfhi(yv[u][j].y)}; s += (v[u][j].x + v[u][j].y) + (v[u][j].z + v[u][j].w); }
            const float mean = wave_sum(s) * (1.f / D); float s2 = 0.f;
#pragma unroll
            for (int j = 0; j < 4; ++j) { v[u][j] = v[u][j] - mean; s2 += (v[u][j].x * v[u][j].x + v[u][j].y * v[u][j].y) + (v[u][j].z * v[u][j].z + v[u][j].w * v[u][j].w); }
            const float rstd = 1.f / sqrtf(wave_sum(s2) * (1.f / D) + LN_EPS);
            GAS u32x2* o2 = (GAS u32x2*)(X1B + (size_t)t * D) + lane;
#pragma unroll
            for (int j = 0; j < 4; ++j) { const f32x4 y = v[u][j] * rstd * gg[j] + bb[j]; u32x2 w; w.x = pk2(y.x, y.y); w.y = pk2(y.z, y.w); o2[64 * j] = w;
                int q = __builtin_amdgcn_cvt_pk_fp8_f32(y.x, y.y, 0, false); q = __builtin_amdgcn_cvt_pk_fp8_f32(y.z, y.w, q, true); *(GAS unsigned*)(X1F8 + (size_t)t * D + 4 * lane + 256 * j) = (unsigned)q; }
        }
    }
}
template <bool DRY>
DI void route_phase(Frame& F, int it_lo, int it_hi) {
    LAS float* cscr = (LAS float*)(F.lds + 8192 + F.wave * 16640);
    if (!DRY && F.wave < 4) convert_items(F, it_lo, it_hi, cscr);
    const bool opaque = DRY && (__hip_atomic_load((unsigned*)(F.ctl + CW_TMO), RLX_AGENT) == 0xdeadbeefu);
    const float* LG = (const float*)(F.ws + WS_LOGITS); const float* rbias = F.in[16];
    unsigned* ER = (unsigned*)(F.ws + WS_ER); float* GW = (float*)(F.ws + WS_GW); int* slot_tok = (int*)(F.ws + WS_SLOTTOK);
    LAS unsigned* hist = (LAS unsigned*)(F.lds); LAS unsigned* base = hist + 256; LAS unsigned* erl = hist + 512;
    const int lane = F.lane, tid = F.tid;
    if (!DRY) for (int i = F.vcu * 512 + tid; i < MAXSLOTS; i += F.G * 512) slot_tok[i] = 0;
    if (tid < 256) hist[tid] = 0u;
    __syncthreads();
    const int TPW = T / F.G;
    const f32x4 bi = ((const f32x4*)rbias)[lane];
    const float NEGINF = -__builtin_huge_valf();
    f32x4 nl0, nl1;
    { const int t = F.vcu * TPW + F.wave; nl0 = ((const GAS f32x4*)(LG + (size_t)t * NE))[lane]; nl1 = ((const GAS f32x4*)(LG + (size_t)T * NE + (size_t)t * NE))[lane]; }
    for (int i = F.wave; i < TPW; i += NWAVES) {
        const int t = F.vcu * TPW + i;
        const f32x4 lg = nl0 + nl1;
        { const int tn = F.vcu * TPW + ((i + NWAVES < TPW) ? i + NWAVES : i); nl0 = ((const GAS f32x4*)(LG + (size_t)tn * NE))[lane]; nl1 = ((const GAS f32x4*)(LG + (size_t)T * NE + (size_t)tn * NE))[lane]; }
        const float s0 = 1.f / (1.f + expf(-lg.x)), s1 = 1.f / (1.f + expf(-lg.y)), s2 = 1.f / (1.f + expf(-lg.z)), s3 = 1.f / (1.f + expf(-lg.w));
        float v0 = s0 + bi.x, v1 = s1 + bi.y, v2 = s2 + bi.z, v3 = s3 + bi.w;
        const float hi1 = fmaxf(v0, v1), lo1 = fminf(v0, v1), hi2 = fmaxf(v2, v3), lo2 = fminf(v2, v3);
        float m1 = fmaxf(hi1, hi2), m2 = fmaxf(fminf(hi1, hi2), fmaxf(lo1, lo2));
#pragma unroll
        for (int o = 1; o < 8; o <<= 1) { const float o1 = __shfl_xor(m1, o), o2 = __shfl_xor(m2, o); const float n1 = fmaxf(m1, o1), n2 = fmaxf(fminf(m1, o1), fmaxf(m2, o2)); m1 = n1; m2 = n2; }
        const float gs = m1 + m2; const int myg = lane >> 3; int rank = 0;
#pragma unroll
        for (int j = 0; j < 8; ++j) { const float gj = __shfl(gs, 8 * j); rank += (gj > gs || (gj == gs && j < myg)) ? 1 : 0; }
        if (rank >= 4) { v0 = NEGINF; v1 = NEGINF; v2 = NEGINF; v3 = NEGINF; }
        int me = 0; float mg = 0.f, gsum = 0.f;
#pragma unroll
        for (int k = 0; k < 8; ++k) {
            const float lm = fmaxf(fmaxf(v0, v1), fmaxf(v2, v3)), wm = wave_max_fast(lm);
            int cand = 1 << 20;
            if (v3 == wm) cand = 4 * lane + 3;
            if (v2 == wm) cand = 4 * lane + 2;
            if (v1 == wm) cand = 4 * lane + 1;
            if (v0 == wm) cand = 4 * lane + 0;
            const int e = wave_min_i_fast(cand), el = e >> 2, ei = e & 3;
            const float mysc = ei == 0 ? s0 : (ei == 1 ? s1 : (ei == 2 ? s2 : s3));
            const float sc = __shfl(mysc, el);
            if (lane == el) { if (ei == 0) v0 = NEGINF; else if (ei == 1) v1 = NEGINF; else if (ei == 2) v2 = NEGINF; else v3 = NEGINF; }
            me = (lane == k) ? e : me; mg = (lane == k) ? sc : mg; gsum += sc;
        }
        if (lane < 8) { const unsigned lr = __hip_atomic_fetch_add(hist + me, 1u, __ATOMIC_RELAXED, __HIP_MEMORY_SCOPE_WORKGROUP); erl[i * 8 + lane] = ((unsigned)me << 24) | lr; if (!DRY || opaque) GW[(size_t)t * 8 + lane] = mg / gsum * 2.5f; }
    }
    __syncthreads();
    if (tid < 256) base[tid] = DRY ? 0u : atomicAdd((unsigned*)(F.ctl + CW_CNT) + tid, hist[tid]);
    __syncthreads();
    if (!DRY) for (int i = tid; i < TPW * 8; i += 512) { const unsigned er = erl[i]; ER[(size_t)F.vcu * TPW * 8 + i] = er + base[er >> 24]; }
    __syncthreads();
    if (!DRY && F.wave >= 4) convert_items(F, it_lo, it_hi, cscr);
}
DI void slot_phase(Frame& F) {
    const unsigned* ER = (const unsigned*)(F.ws + WS_ER); const float* GW = (const float*)(F.ws + WS_GW);
    unsigned* TS = (unsigned*)(F.ws + WS_TS); int* slot_tok = (int*)(F.ws + WS_SLOTTOK); float* slot_w = (float*)(F.ws + WS_SLOTW); int* tile_e = (int*)(F.ws + WS_TILEE);
    LAS int* tb = (LAS int*)(F.lds); LAS int* tmp = tb + 512;
    const int tid = F.tid;
    int nt_e = 0;
    if (tid < 256) { nt_e = ((int)__hip_atomic_load((unsigned*)(F.ctl + CW_CNT) + tid, RLX_AGENT) + 255) >> 8; tmp[tid] = nt_e; }
    __syncthreads();
    int src = 0;
    for (int o = 1; o < 256; o <<= 1) { if (tid < 256) { int v = tmp[src * 256 + tid]; if (tid >= o) v += tmp[src * 256 + tid - o]; tmp[(src ^ 1) * 256 + tid] = v; } src ^= 1; __syncthreads(); }
    if (tid < 256) tb[tid] = tmp[src * 256 + tid] - nt_e;
    const int NT = tmp[src * 256 + 255];
    __syncthreads();
    if (F.vcu == 0) {
        if (tid == 0) __hip_atomic_store((unsigned*)(F.ctl + CW_NT), (unsigned)NT, RLX_AGENT);
        if (tid < 256) for (int tl = tb[tid]; tl < tb[tid] + nt_e; ++tl) tile_e[tl] = tid;
        for (int i = tid; i < NSHT; i += 512) tile_e[NT + i] = NE;
    }
    for (int i = F.vcu * 512 + tid; i < T; i += F.G * 512) { slot_tok[(size_t)NT * 256 + i] = i; }
    const int TPW = T / F.G;
    for (int i = tid; i < TPW * 8; i += 512) {
        const size_t gi = (size_t)F.vcu * TPW * 8 + i; const unsigned er = ER[gi]; const int e = er >> 24, rk = er & 0xffffff;
        const int slot = tb[e] * 256 + rk;
        slot_tok[slot] = (int)(gi >> 3); slot_w[slot] = GW[gi]; TS[gi] = (unsigned)slot;
    }
}
DI void acc_fp8x4(unsigned w, f32x4& v) { const f32x2 a = __builtin_amdgcn_cvt_pk_f32_fp8((int)w, false), b = __builtin_amdgcn_cvt_pk_f32_fp8((int)w, true); v.x += a.x; v.y += a.y; v.z += b.x; v.w += b.y; }
template <bool STORE>
DI void final_phase(Frame& F) {
    const bool opaque = !STORE && (__hip_atomic_load((unsigned*)(F.ctl + CW_TMO), RLX_AGENT) == 0xdeadbeefu);
    const unsigned char* Y = (const unsigned char*)(F.ws + WS_Y); const unsigned* TS = (const unsigned*)(F.ws + WS_TS); const bf16* X1B = (const bf16*)(F.ws + WS_X1B);
    const size_t shslot0 = (size_t)__hip_atomic_load((unsigned*)(F.ctl + CW_NT), RLX_AGENT) * 256;
    const int gw = F.vcu * NWAVES + F.wave, NGW = F.G * NWAVES, lane = F.lane;
    const int cb = 256 * (lane >> 4) + 32 * ((lane >> 2) & 3) + 8 * (lane & 3);
    f32x4 gg[4], bb[4];
#pragma unroll
    for (int bj = 0; bj < 2; ++bj)
#pragma unroll
        for (int hh = 0; hh < 2; ++hh) { gg[2 * bj + hh] = *(const f32x4*)(F.in[23] + cb + 128 * bj + 4 * hh); bb[2 * bj + hh] = *(const f32x4*)(F.in[24] + cb + 128 * bj + 4 * hh); }
    for (int t0 = gw; t0 < T; t0 += 8 * NGW) {
        const int ti = lane >> 3; const int tt = t0 + ti * NGW;
        const unsigned myslot = (tt < T) ? TS[(size_t)tt * 8 + (lane & 7)] : 0u;
#pragma unroll 1
        for (int i = 0; i < 8; ++i) {
            const int t = t0 + i * NGW; if (t >= T) break;
            float* xr = F.out + (size_t)t * D + cb;
            f32x4 v[4];
#pragma unroll
            for (int bj = 0; bj < 2; ++bj) { const u32x4 w = *(const GAS u32x4*)(X1B + (size_t)t * D + cb + 128 * bj);
                v[2 * bj] = (f32x4){bflo(w.x), bfhi(w.x), bflo(w.y), bfhi(w.y)} * ALPHA; v[2 * bj + 1] = (f32x4){bflo(w.z), bfhi(w.z), bflo(w.w), bfhi(w.w)} * ALPHA; }
            u32x4 yv[8]; const u32x4 ysh = ((const GAS u32x4*)(Y + (shslot0 + (size_t)t) * 1024))[lane];
#pragma unroll
            for (int k = 0; k < 8; ++k) { const unsigned slot = __shfl(myslot, i * 8 + k); yv[k] = ((const GAS u32x4*)(Y + (size_t)slot * 1024))[lane]; }
            f32x4 a[4];
#pragma unroll
            for (int j = 0; j < 4; ++j) a[j] = (f32x4){0.f, 0.f, 0.f, 0.f};
#pragma unroll
            for (int k = 0; k < 8; ++k) { acc_fp8x4(yv[k].x, a[0]); acc_fp8x4(yv[k].y, a[1]); acc_fp8x4(yv[k].z, a[2]); acc_fp8x4(yv[k].w, a[3]); }
            acc_fp8x4(ysh.x, a[0]); acc_fp8x4(ysh.y, a[1]); acc_fp8x4(ysh.z, a[2]); acc_fp8x4(ysh.w, a[3]);
#pragma unroll
            for (int j = 0; j < 4; ++j) v[j] = v[j] + a[j] * (1.0f / YSCALE);
            float s = 0.f;
#pragma unroll
            for (int j = 0; j < 4; ++j) s += (v[j].x + v[j].y) + (v[j].z + v[j].w);
            const float mean = wave_sum(s) * (1.f / D); float s2 = 0.f;
#pragma unroll
            for (int j = 0; j < 4; ++j) { v[j] = v[j] - mean; s2 += (v[j].x * v[j].x + v[j].y * v[j].y) + (v[j].z * v[j].z + v[j].w * v[j].w); }
            const float rstd = 1.f / sqrtf(wave_sum(s2) * (1.f / D) + LN_EPS);
            if (STORE || opaque) {
#pragma unroll
                for (int bj = 0; bj < 2; ++bj) { *(GAS f32x4*)(xr + 128 * bj) = v[2 * bj] * rstd * gg[2 * bj] + bb[2 * bj]; *(GAS f32x4*)(xr + 128 * bj + 4) = v[2 * bj + 1] * rstd * gg[2 * bj + 1] + bb[2 * bj + 1]; } }
        }
    }
}

#ifndef REPMASK
#define REPMASK 0
#endif
constexpr int N_PHASES = 13;
constexpr int XC_P1 = (XI_ALL * 37 / 100) & ~2047, XC_P2 = (XI_ALL * 57 / 100) & ~2047, XC_P3 = (XI_ALL * 87 / 100) & ~2047;
struct Args { const float* in[25]; float* out; unsigned char* ws; int ph_lo, ph_hi, li, pad; };
DI void ph1_part(Frame& F, int i0, int i1) {
    unsigned char* ws = F.ws;
    SchedDense S{(const bf16*)(ws + WS_XB), (const bf16*)(ws + WS_WINT), D, D, T / 256, INW / 256, F.G, (int)blockIdx.x, i0, i1};
    EpiInProj E{(bf16*)(ws + WS_Q), (const float*)(ws + WS_ROPE)};
    pg8::gemm_phase<EpiInProj, SchedDense, true>(F.lds + RING_OFF, S, E, D);
}
DI void ph1(Frame& F) {
    LAS float* scr = (LAS float*)(F.lds + F.wave * 16640);
    const int grp = F.vcu & 1;
    if (grp == 0) { convert_items(F, 0, XC_P1, scr); __syncthreads(); }
    ph1_part(F, 0, 1 << 20);
    if (grp == 1) { __syncthreads(); convert_items(F, 0, XC_P1, scr); }
}
DI ScanP mk_scanp(Frame& F) { unsigned char* ws = F.ws;
    return ScanP{(const bf16*)(ws + WS_Q + 3 * SEG_BYTES), (const bf16*)(ws + WS_GWT), F.in[4], F.in[5], F.in[7], F.in[9],
                 (const float*)(ws + WS_C2), (f32x2*)(ws + WS_CARRY), (bf16*)(ws + WS_HF), (bf16*)(ws + WS_REC)}; }
DI void ph2(Frame& F) {
    unsigned char* ws = F.ws;
    const ScanP SP = mk_scanp(F);
    scan_phase<false>(F, SP, XC_P1, XC_P2);
    if constexpr ((REPMASK >> 14) & 1) { __syncthreads(); scan_phase<false>(F, SP, 0, 0); }
    __syncthreads();
    const AttnP AP{(const bf16*)(ws + WS_Q), (const bf16*)(ws + WS_Q + SEG_BYTES), (const bf16*)(ws + WS_Q + 2 * SEG_BYTES), (bf16*)(ws + WS_ATTN)};
    attn_phase(F, AP);
    if constexpr ((REPMASK >> 13) & 1) { attn_phase(F, AP); }
}
DI void ph3(Frame& F) { const ScanP SP = mk_scanp(F); scan_phase<true>(F, SP, XC_P2, XC_P3); }
DI void ph5(Frame& F) {
    unsigned char* ws = F.ws;
    SchedDense S{(const bf16*)(ws + WS_MIX), (const bf16*)(ws + WS_WOUTT), D, D, T / 256, D / 256, F.G, (int)blockIdx.x, 0, 1 << 20};
    EpiYb E{(bf16*)(ws + WS_V1)};
    pg8::gemm_phase<EpiYb, SchedDense, true>(F.lds + RING_OFF, S, E, D);
}
DI void ph7(Frame& F) {
    unsigned char* ws = F.ws;
    SchedRouter S{(const bf16*)(ws + WS_X1B), (const bf16*)(ws + WS_RTT), D, D, T / 256, F.G, (int)blockIdx.x};
    EpiLogits E{(float*)(ws + WS_LOGITS)};
    pg8::gemm_phase<EpiLogits, SchedRouter, true>(F.lds + RING_OFF, S, E, 512);
}
DI void ph10(Frame& F) {
    unsigned char* ws = F.ws; const int cid = (int)blockIdx.x;
    LAS unsigned* ue = (LAS unsigned*)(F.lds + UT_OFF); LAS unsigned* uidx = (LAS unsigned*)(F.lds + UT_IDX);
    const int NT = (int)__hip_atomic_load((unsigned*)(F.ctl + CW_NT), RLX_AGENT);
    const int nwg = 2 * (NT + NSHT);
    const int* tile_e = (const int*)(ws + WS_TILEE); const int* slot_tok = (const int*)(ws + WS_SLOTTOK);
    __syncthreads();
    {
        unsigned te[11], st[11]; float sw[11]; const float* slot_w = (const float*)(ws + WS_SLOTW); LAS float* uw = (LAS float*)(F.lds + UT_W);
#pragma unroll
        for (int i = 0; i < 11; ++i) { int wgid; const bool ok = pg8::xcd_order(i, F.G, cid, nwg, wgid); const int tile = ok ? (wgid >> 1) : 0;
            te[i] = (unsigned)tile_e[tile]; st[i] = (F.tid < 256) ? (unsigned)slot_tok[(size_t)tile * 256 + F.tid] : 0u; sw[i] = (F.tid < 256 && tile < NT) ? slot_w[(size_t)tile * 256 + F.tid] : 1.0f; }
#pragma unroll
        for (int i = 0; i < 11; ++i) { if (F.tid == 0) ue[i] = te[i]; if (F.tid < 256) { uidx[i * 256 + F.tid] = st[i]; uw[i * 256 + F.tid] = sw[i]; } }
    }
    __syncthreads();
    SchedG1 S{(const bf16*)(ws + WS_HF), (const bf16*)(ws + WS_WGUT), ue, uidx, D / 2, nwg, F.G, cid, (size_t)0};
    EpiSwiglu E{(unsigned char*)(ws + WS_H), (const LAS float*)(F.lds + UT_W), NT};
    pg8::gemm_phase<EpiSwiglu, SchedG1, true, false, true>(F.lds + RING_OFF, S, E, D / 2);
}
template <bool DRY>
DI void ph11a(Frame& F) {
    unsigned char* ws = F.ws; const int cid = (int)blockIdx.x;
    LAS unsigned* ue = (LAS unsigned*)(F.lds + UT_OFF);
    const int NT = (int)__hip_atomic_load((unsigned*)(F.ctl + CW_NT), RLX_AGENT);
    const int* tile_e = (const int*)(ws + WS_TILEE);
    const int nwg = 4 * (NT + NSHT);
    __syncthreads();
    for (int i = F.tid; i < 22; i += NWAVES * 64) { int wgid; if (pg8::xcd_order(i, F.G, cid, nwg, wgid)) ue[i] = (unsigned)tile_e[wgid >> 2]; }
    __syncthreads();
    SchedG2 S{(const bf16*)(ws + WS_H), (const bf16*)(ws + WS_WDT), ue, EH / 2, nwg, F.G, cid, 0, (size_t)0};
    EpiDownY E{(unsigned char*)(ws + WS_Y), DRY && (__hip_atomic_load((unsigned*)(F.ctl + CW_TMO), RLX_AGENT) != 0xdeadbeefu)};
    pg8::gemm_phase<EpiDownY, SchedG2, true, false, true>(F.lds + RING_OFF, S, E, EH / 2);
}
#ifndef PHMASK
#define PHMASK 0x1fff
#endif
#ifndef REPMASK
#define REPMASK 0
#endif
__global__ void __launch_bounds__(NWAVES * 64, 2) mk_fwd(Args args) {
    extern __shared__ __attribute__((aligned(16))) unsigned char lds_raw[];
    Frame F;
    F.lds = (LAS unsigned char*)lds_raw;
    F.MISC = (volatile LAS unsigned*)(F.lds + MISC_OFF);
    F.tid = threadIdx.x; F.lane = F.tid & 63; F.wave = __builtin_amdgcn_readfirstlane(F.tid >> 6);
    F.G = gridDim.x; { const int bx = blockIdx.x; F.vcu = (F.G % 8 == 0) ? (bx % 8) * (F.G / 8) + bx / 8 : bx; }
    F.ws = args.ws; F.out = args.out; F.ctl = (gu32*)(args.ws + WS_CTL);
#pragma unroll
    for (int i = 0; i < 25; ++i) F.in[i] = args.in[i];
    if (F.tid < 64) F.MISC[F.tid] = 0u;
    __syncthreads();
    XcdBarrier bar = xcd_barrier_post((unsigned*)(F.ctl + CW_BAR) + args.li * XCD_BAR_WORDS, F.MISC + 8);
    const int lo = args.ph_lo, hi = args.ph_hi;
#ifdef REPORT_K
    unsigned long long* tsb = (unsigned long long*)(args.ws + WS_END + 8 * MiB); int nst = 0;
#define STAMP() do { if (blockIdx.x == 0 && F.tid == 0) tsb[nst] = __builtin_amdgcn_s_memrealtime(); ++nst; } while (0)
#else
#define STAMP() do {} while (0)
#endif
    STAMP();
#define IN(k) (((PHMASK >> (k)) & 1) && lo <= (k) && (k) < hi)
#define REP(k) if constexpr (((REPMASK) >> (k)) & 1)
#define SEAM(k) do { if (IN(k) && IN((k) + 1)) xcd_barrier(bar); STAMP(); } while (0)
    if (IN(0)) { p0_prologue(F); REP(0) { __syncthreads(); p0_prologue(F); } } SEAM(0);
    if (IN(1)) { ph1(F); REP(1) ph1(F); } SEAM(1);
    if (IN(2)) { ph2(F); REP(2) ph2(F); } SEAM(2);
    if (IN(3)) { ph3(F); REP(3) ph3(F); } SEAM(3);
    const bool fused_mix = (F.G * NWAVES == NB * 8 * NCH);
    if (IN(4) && !fused_mix) { mix_phase(F); } if (!fused_mix) SEAM(4);
    if (IN(5)) { ph5(F); REP(5) ph5(F); } SEAM(5);
    if (IN(6)) { ln1_phase(F); REP(6) ln1_phase(F); } SEAM(6);
    if (IN(7)) { ph7(F); REP(7) ph7(F); } SEAM(7);
    if (IN(8)) { REP(8) { route_phase<true>(F, 0, 0); } route_phase<false>(F, XC_P3, XI_ALL); } SEAM(8);
    if (IN(9)) { slot_phase(F); REP(9) { __syncthreads(); slot_phase(F); } } SEAM(9);
    if (IN(10)) { ph10(F); REP(10) ph10(F); } SEAM(10);
    if (IN(11)) { REP(11) ph11a<true>(F); ph11a<false>(F); } SEAM(11);
    if (IN(12)) { REP(12) { final_phase<false>(F); } final_phase<true>(F); }
    STAMP();
#undef IN
#undef REP
#undef SEAM
}

#if defined(SELFCHECK) && SELFCHECK
namespace chk {
constexpr int NS = 64;
struct InP { const float* p[25]; };
DI float f8dec(unsigned b) { const int e = (b >> 3) & 15, m = b & 7; const float mag = e == 0 ? (float)m * 0.001953125f : (1.f + (float)m * 0.125f) * exp2f((float)(e - 7)); return (b & 128) ? -mag : mag; }
DI float h_at(const unsigned char* ws, size_t slot, int c) { return f8dec(ws[WS_H + slot * EH + c]) * (1.0f / HSCALE); }

__host__ __device__ inline int samp_tok(int i) { return i == 0 ? 0 : i == 1 ? 8191 : i == 2 ? 8192 : i == 3 ? T - 1 : i == 4 ? 63 : i == 5 ? 64 : i == 6 ? 8127 : i == 7 ? 16384 + 4095 : (int)(((long)i * 2039 + 17 * (i % 5)) % T); }
DI void put_err(unsigned* CHK, int stage, float num, float den) { float e = sqrtf(num / (den + 1e-30f)); if (!(e == e)) e = 1e30f; atomicMax(CHK + stage, __float_as_uint(e)); }
DI float blk_sum(float v, float* red) {
    v = wave_sum(v); __syncthreads(); if ((threadIdx.x & 63) == 0) red[threadIdx.x >> 6] = v; __syncthreads(); return red[0] + red[1] + red[2] + red[3]; }
__global__ void __launch_bounds__(256) c1(const float* x, const int* pos, const float* w_in, const unsigned char* ws, unsigned* CHK) {
    __shared__ float hrow[INW]; __shared__ float red[4];
    const int t = samp_tok(blockIdx.x), tid = threadIdx.x;
    for (int c = tid; c < INW; c += 256) { float a = 0.f; for (int k = 0; k < D; ++k) a = fmaf(x[(size_t)t * D + k], w_in[(size_t)k * INW + c], a); hrow[c] = a; }
    __syncthreads();
    if (tid < 128) { const int i = tid & 7, head = (tid >> 3) & 7, which = tid >> 6;
        const float invf[8] = {1.0f, 0x1.8d275ep-3f, 0x1.341190p-5f, 0x1.ddee9cp-8f, 0x1.72ba44p-10f, 0x1.1f91f0p-12f, 0x1.be218ap-15f, 0x1.5a0f50p-17f};
        float inv = invf[0];
#pragma unroll
        for (int j = 1; j < 8; ++j) inv = (i == j) ? invf[j] : inv;
        float c, s; sincos_acc((float)pos[t] * inv, c, s);
        float* p = hrow + which * AW + head * HD; const float t1 = p[i], t2 = p[i + 8]; p[i] = t1 * c - t2 * s; p[i + 8] = t2 * c + t1 * s; }
    __syncthreads();
    float num = 0.f, den = 0.f;
    for (int c = tid; c < INW; c += 256) { const int seg = c >> 9; float r = hrow[c]; if (seg == 0) r *= QSCALE; if (seg == 4) r = gelu_tanh(r);
        const float f = bf2f(((const bf16*)(ws + WS_Q + (size_t)seg * SEG_BYTES))[(size_t)t * 512 + (c & 511)]); num += (f - r) * (f - r); den += r * r; }
    num = blk_sum(num, red); den = blk_sum(den, red);
    if (tid == 0) put_err(CHK, 1, num, den);
}
__global__ void __launch_bounds__(64) c2(const unsigned char* ws, unsigned* CHK) {
    const bf16* Q = (const bf16*)(ws + WS_Q); const bf16* K = (const bf16*)(ws + WS_Q + SEG_BYTES); const bf16* V = (const bf16*)(ws + WS_Q + 2 * SEG_BYTES); const bf16* O = (const bf16*)(ws + WS_ATTN);
    const int lane = threadIdx.x, head = blockIdx.x & 7, t = samp_tok(blockIdx.x >> 3), b = t / SEQ, s = t % SEQ;
    const float q = bf2f(Q[(size_t)t * AW + head * HD + lane]);
    float m = -1e30f, den = 0.f, o = 0.f;
    for (int g = 0; g < 3; ++g) { const int d = g == 0 ? 1 : (g == 1 ? 4 : 16);
        for (int mm = -64; mm <= 64; ++mm) { const int j = s + d * mm; if (j < 0 || j >= SEQ) continue;
            const size_t row = (size_t)(b * SEQ + j) * AW + head * HD + lane;
            const float sc = wave_sum(q * bf2f(K[row])); const float mn = fmaxf(m, sc), al = exp2f(m - mn), p = exp2f(sc - mn);
            den = den * al + p; o = o * al + p * bf2f(V[row]); m = mn; } }
    const float r = o / den, f = bf2f(O[(size_t)t * AW + head * HD + lane]);
    const float num = wave_sum((f - r) * (f - r)), dn = wave_sum(r * r);
    if (lane == 0) put_err(CHK, 2, num, dn);
}
__global__ void __launch_bounds__(64) c3(InP ip, const unsigned char* ws, float* scratch, unsigned* CHK) {
    const float* cw = ip.p[4]; const float* cb = ip.p[5]; const float* gaw = ip.p[6]; const float* gab = ip.p[7]; const float* gxw = ip.p[8]; const float* gxb = ip.p[9]; const float* lam = ip.p[10];
    const bf16* RX = (const bf16*)(ws + WS_Q + 3 * SEG_BYTES); const bf16* G = (const bf16*)(ws + WS_Q + 4 * SEG_BYTES); const bf16* HFp = (const bf16*)(ws + WS_HF); const bf16* HBp = (const bf16*)(ws + WS_REC);
    const int lane = threadIdx.x, smp = blockIdx.x, b = smp & 3, c = (smp * 37 + 5) % RW, n = c >> 6, j = c & 63;
    float* sc = scratch + (size_t)smp * SEQ * 4;
    for (int s = lane; s < SEQ; s += 64) {
        float pa0 = 0.f, pa1 = 0.f, px0 = 0.f, px1 = 0.f, uc = 0.f;
        for (int i = 0; i < 64; ++i) { const int ci = 64 * n + i; float u = cb[ci];
            for (int k = 0; k < 4; ++k) { const int ss = s + k - 2; if (ss >= 0 && ss < SEQ) u = fmaf(cw[k * RW + ci], bf2f(RX[(size_t)(b * SEQ + ss) * RW + ci]), u); }
            if (i == j) uc = u;
            pa0 = fmaf(u, gaw[(((size_t)0 * 8 + n) * 64 + i) * 64 + j], pa0); px0 = fmaf(u, gxw[(((size_t)0 * 8 + n) * 64 + i) * 64 + j], px0);
            pa1 = fmaf(u, gaw[(((size_t)1 * 8 + n) * 64 + i) * 64 + j], pa1); px1 = fmaf(u, gxw[(((size_t)1 * 8 + n) * 64 + i) * 64 + j], px1); }
        { const float r = 1.f / (1.f + expf(-(pa0 + gab[c]))), ig = 1.f / (1.f + expf(-(px0 + gxb[c])));
          const float l = lam[c], sp = log1pf(expf(-l)), log_a = -8.0f * r * sp, a = expf(log_a);
          sc[(size_t)s * 4 + 0] = a; sc[(size_t)s * 4 + 1] = sqrtf(-expm1f(2.0f * log_a)) * ig * uc; }
        { const float r = 1.f / (1.f + expf(-(pa1 + gab[RW + c]))), ig = 1.f / (1.f + expf(-(px1 + gxb[RW + c])));
          const float l = lam[RW + c], sp = log1pf(expf(-l)), log_a = -8.0f * r * sp, a = expf(log_a);
          sc[(size_t)s * 4 + 2] = a; sc[(size_t)s * 4 + 3] = sqrtf(-expm1f(2.0f * log_a)) * ig * uc; }
    }
    __syncthreads();
    if (lane == 0) { float h = 0.f; for (int s = 0; s < SEQ; ++s) { h = fmaf(sc[(size_t)s * 4], h, sc[(size_t)s * 4 + 1]); sc[(size_t)s * 4 + 1] = h; } }
    if (lane == 1) { float h = 0.f; for (int s = SEQ - 1; s >= 0; --s) { h = fmaf(sc[(size_t)s * 4 + 2], h, sc[(size_t)s * 4 + 3]); sc[(size_t)s * 4 + 3] = h; } }
    __syncthreads();
    float num = 0.f, den = 0.f;
    for (int s = lane; s < SEQ; s += 64) { const size_t o = (size_t)(b * SEQ + s) * RW + c; const float r = (sc[(size_t)s * 4 + 1] + sc[(size_t)s * 4 + 3]) * bf2f(G[o]), f = (bf2f(HFp[o]) + bf2f(HBp[o])) * bf2f(G[o]); num += (f - r) * (f - r); den += r * r; }
    num = wave_sum(num); den = wave_sum(den);
    if (lane == 0) put_err(CHK, 3, num, den);
}
__global__ void __launch_bounds__(256) c4(const float* ga, const float* gr, const unsigned char* ws, unsigned* CHK) {
    __shared__ float red[4];
    const bf16* AT = (const bf16*)(ws + WS_ATTN); const bf16* HFp = (const bf16*)(ws + WS_HF); const bf16* HBp = (const bf16*)(ws + WS_REC); const bf16* Gp = (const bf16*)(ws + WS_Q + 4 * SEG_BYTES); const bf16* MX = (const bf16*)(ws + WS_MIX);
    const int t = samp_tok(blockIdx.x), tid = threadIdx.x;
    float av[2], rv[2], sa = 0.f, sr = 0.f;
    for (int i = 0; i < 2; ++i) { const int c = tid + 256 * i; av[i] = bf2f(AT[(size_t)t * AW + c]); rv[i] = (bf2f(HFp[(size_t)t * RW + c]) + bf2f(HBp[(size_t)t * RW + c])) * bf2f(Gp[(size_t)t * RW + c]); sa += av[i] * av[i]; sr += rv[i] * rv[i]; }
    sa = blk_sum(sa, red); sr = blk_sum(sr, red);
    const float ra = rsqrtf(sa / 512.f + LN_EPS), rr = rsqrtf(sr / 512.f + LN_EPS);
    float num = 0.f, den = 0.f;
    for (int i = 0; i < 2; ++i) { const int c = tid + 256 * i; const float r1 = av[i] * ra * ga[c], r2 = rv[i] * rr * gr[c], f1 = bf2f(MX[(size_t)t * D + c]), f2 = bf2f(MX[(size_t)t * D + AW + c]);
        num += (f1 - r1) * (f1 - r1) + (f2 - r2) * (f2 - r2); den += r1 * r1 + r2 * r2; }
    num = blk_sum(num, red); den = blk_sum(den, red);
    if (tid == 0) put_err(CHK, 4, num, den);
}
__global__ void __launch_bounds__(256) c5(const float* x, const float* w_out, const unsigned char* ws, unsigned* CHK) {
    __shared__ float red[4];
    const bf16* MX = (const bf16*)(ws + WS_MIX); const bf16* Yb = (const bf16*)(ws + WS_V1);
    const int t = samp_tok(blockIdx.x), tid = threadIdx.x; float num = 0.f, den = 0.f;
    for (int c = tid; c < D; c += 256) { float a = 0.f; for (int k = 0; k < D; ++k) a = fmaf(bf2f(MX[(size_t)t * D + k]), w_out[(size_t)k * D + c], a);
        const float r = a, f = bf2f(Yb[(size_t)t * D + c]); num += (f - r) * (f - r); den += r * r; }
    num = blk_sum(num, red); den = blk_sum(den, red);
    if (tid == 0) put_err(CHK, 5, num, den);
}
__global__ void __launch_bounds__(256) c6(const float* g, const float* bb, const float* x, const unsigned char* ws, unsigned* CHK) {
    __shared__ float red[4];
    const bf16* Yb = (const bf16*)(ws + WS_V1); const bf16* X1B = (const bf16*)(ws + WS_X1B);
    const int t = samp_tok(blockIdx.x), tid = threadIdx.x; float v[4], s = 0.f;
    for (int i = 0; i < 4; ++i) { v[i] = ALPHA * x[(size_t)t * D + tid + 256 * i] + bf2f(Yb[(size_t)t * D + tid + 256 * i]); s += v[i]; }
    const float mu = blk_sum(s, red) / D; float q = 0.f;
    for (int i = 0; i < 4; ++i) { const float d = v[i] - mu; q += d * d; }
    const float rs = rsqrtf(blk_sum(q, red) / D + LN_EPS); float num = 0.f, den = 0.f;
    for (int i = 0; i < 4; ++i) { const int c = tid + 256 * i; const float r = (v[i] - mu) * rs * g[c] + bb[c], f2 = bf2f(X1B[(size_t)t * D + c]);
        num += (f2 - r) * (f2 - r); den += r * r; }
    num = blk_sum(num, red); den = blk_sum(den, red);
    if (tid == 0) put_err(CHK, 6, num, den);
}
__global__ void __launch_bounds__(256) c7(const float* router_w, const unsigned char* ws, unsigned* CHK) {
    __shared__ float red[4];
    const bf16* X1B = (const bf16*)(ws + WS_X1B); const float* LG = (const float*)(ws + WS_LOGITS);
    const int t = samp_tok(blockIdx.x), c = threadIdx.x; float a = 0.f;
    for (int k = 0; k < D; ++k) a = fmaf(bf2f(X1B[(size_t)t * D + k]), router_w[(size_t)k * NE + c], a);
    const float f = LG[(size_t)t * NE + c] + LG[(size_t)T * NE + (size_t)t * NE + c];
    const float num = blk_sum((f - a) * (f - a), red), den = blk_sum(a * a, red);
    if (c == 0) put_err(CHK, 7, num, den);
}
__global__ void __launch_bounds__(64) c8(const float* rbias, const unsigned char* ws, const unsigned* ctl, unsigned* CHK) {
    __shared__ float sc[NE], bs[NE]; __shared__ int sel[8]; __shared__ float gate[8]; __shared__ float gsc[8]; __shared__ int gm[8];
    const float* LG = (const float*)(ws + WS_LOGITS); const unsigned* TS = (const unsigned*)(ws + WS_TS); const int* slot_tok = (const int*)(ws + WS_SLOTTOK);
    const float* slot_w = (const float*)(ws + WS_SLOTW); const int* tile_e = (const int*)(ws + WS_TILEE);
    const int t = samp_tok(blockIdx.x), lane = threadIdx.x;
    for (int e = lane; e < NE; e += 64) { const float l = LG[(size_t)t * NE + e] + LG[(size_t)T * NE + (size_t)t * NE + e]; sc[e] = 1.f / (1.f + expf(-l)); bs[e] = sc[e] + rbias[e]; }
    __syncthreads();
    if (lane == 0) {
        for (int g = 0; g < 8; ++g) { float a = -1e30f, b2 = -1e30f; for (int i = 0; i < 32; ++i) { const float v = bs[32 * g + i]; if (v > a) { b2 = a; a = v; } else if (v > b2) b2 = v; } gsc[g] = a + b2; gm[g] = 0; }
        for (int k = 0; k < 4; ++k) { int best = -1; for (int g = 0; g < 8; ++g) if (!gm[g] && (best < 0 || gsc[g] > gsc[best])) best = g; gm[best] = 1; }
        float sum = 0.f;
        for (int k = 0; k < 8; ++k) { int best = -1; for (int e = 0; e < NE; ++e) { if (!gm[e >> 5]) continue; bool used = false; for (int q = 0; q < k; ++q) used |= (sel[q] == e); if (used) continue; if (best < 0 || bs[e] > bs[best]) best = e; } sel[k] = best; sum += sc[best]; }
        for (int k = 0; k < 8; ++k) gate[k] = sc[sel[k]] / sum * 2.5f;
        int bad = 0; const int NT = (int)ctl[CW_NT];
        for (int k = 0; k < 8; ++k) { const unsigned slot = TS[(size_t)t * 8 + k]; const int e = tile_e[slot >> 8];
            if (slot >= (unsigned)NT * 256) { ++bad; continue; }
            if (slot_tok[slot] != t) ++bad;
            int q = -1; for (int k2 = 0; k2 < 8; ++k2) if (sel[k2] == e) q = k2;
            if (q < 0) ++bad; else if (fabsf(slot_w[slot] - gate[q]) > 1e-5f) ++bad; }
        atomicMax(CHK + 8, __float_as_uint((float)bad));
    }
}
DI void samp_slot(int i, const unsigned char* ws, const unsigned* ctl, int& slot, int& e, int& tok) {
    const unsigned* TS = (const unsigned*)(ws + WS_TS); const int* tile_e = (const int*)(ws + WS_TILEE); const int NT = (int)ctl[CW_NT];
    tok = samp_tok(i); if (i >= 32 && (i & 1)) { slot = NT * 256 + tok; e = NE; } else { slot = (int)TS[(size_t)tok * 8 + (i & 7)]; e = tile_e[slot >> 8]; } }
__global__ void __launch_bounds__(256) c9(InP ip, const unsigned char* ws, const unsigned* ctl, unsigned* CHK) {
    __shared__ float red[4];
    int slot, e, tok; samp_slot(blockIdx.x, ws, ctl, slot, e, tok);
    const float* wg = e < NE ? ip.p[17] + (size_t)e * D * EH : ip.p[20]; const float* wu = e < NE ? ip.p[18] + (size_t)e * D * EH : ip.p[21];
    const bf16* X1B = (const bf16*)(ws + WS_X1B); const bf16* Hh = (const bf16*)(ws + WS_H);
    const int c = threadIdx.x; float g = 0.f, u = 0.f;
    for (int k = 0; k < D; ++k) { const float xv = bf2f(X1B[(size_t)tok * D + k]); g = fmaf(xv, wg[(size_t)k * EH + c], g); u = fmaf(xv, wu[(size_t)k * EH + c], u); }
    const float wgt = e < NE ? ((const float*)(ws + WS_SLOTW))[slot] : 1.f; const float r = g / (1.f + expf(-g)) * u * wgt, f = h_at(ws, (size_t)slot, c);
    const float num = blk_sum((f - r) * (f - r), red), den = blk_sum(r * r, red);
    if (c == 0) put_err(CHK, 9, num, den);
}
DI float y_at(const unsigned char* Yb, size_t slot, int c) {
    const int pn = c >> 8, bj = (c >> 7) & 1, wc = (c >> 5) & 3, fq = (c >> 3) & 3, i = c & 7; const unsigned b = Yb[slot * 1024 + ((pn * 4 + wc) * 4 + fq) * 16 + bj * 8 + i];
    const int e = (b >> 3) & 15, m = b & 7; const float mag = e == 0 ? (float)m * 0.001953125f : (1.f + (float)m * 0.125f) * exp2f((float)(e - 7)); return ((b & 128) ? -mag : mag) * (1.0f / YSCALE); }
__global__ void __launch_bounds__(256) c10(InP ip, const unsigned char* ws, const unsigned* ctl, unsigned* CHK) {
    __shared__ float red[4];
    int slot, e, tok; samp_slot(blockIdx.x & 31, ws, ctl, slot, e, tok);
    const float* wd = ip.p[19] + (size_t)e * EH * D; const bf16* Hh = (const bf16*)(ws + WS_H); const unsigned char* Y = (const unsigned char*)(ws + WS_Y);
    float num = 0.f, den = 0.f;
    for (int c = threadIdx.x; c < D; c += 256) { float a = 0.f; for (int k = 0; k < EH; ++k) a = fmaf(h_at(ws, (size_t)slot, k), wd[(size_t)k * D + c], a);
        const float r = a, f = y_at(Y, (size_t)slot, c); num += (f - r) * (f - r); den += r * r; }
    num = blk_sum(num, red); den = blk_sum(den, red);
    if (threadIdx.x == 0) put_err(CHK, 10, num, den);
}
__global__ void __launch_bounds__(256) save_x1b(const unsigned char* ws, bf16* dst) { const bf16* X1B = (const bf16*)(ws + WS_X1B); const int t = samp_tok(blockIdx.x); for (int c = threadIdx.x; c < D; c += 256) dst[(size_t)blockIdx.x * D + c] = X1B[(size_t)t * D + c]; }
__global__ void __launch_bounds__(256) c11(InP ip, const float* out, const unsigned char* ws, const unsigned* ctl, unsigned* CHK, const bf16* x1s) {
    __shared__ float red[4];
    const bf16* Hh = (const bf16*)(ws + WS_H); const unsigned char* Y = (const unsigned char*)(ws + WS_Y); const unsigned* TS = (const unsigned*)(ws + WS_TS);
    const int t = samp_tok(blockIdx.x), tid = threadIdx.x, NT = (int)ctl[CW_NT]; const float* sd = ip.p[22];
    float v[4], s = 0.f;
    for (int i = 0; i < 4; ++i) { const int c = tid + 256 * i; float a = 0.f; for (int k = 0; k < EH; ++k) a = fmaf(h_at(ws, (size_t)NT * 256 + t, k), sd[(size_t)k * D + c], a);
        a += ALPHA * bf2f(x1s[(size_t)blockIdx.x * D + c]); for (int k = 0; k < 8; ++k) a += y_at(Y, (size_t)TS[(size_t)t * 8 + k], c); v[i] = a; s += a; }
    const float mu = blk_sum(s, red) / D; float q = 0.f;
    for (int i = 0; i < 4; ++i) { const float d = v[i] - mu; q += d * d; }
    const float rs = rsqrtf(blk_sum(q, red) / D + LN_EPS); float num = 0.f, den = 0.f;
    for (int i = 0; i < 4; ++i) { const int c = tid + 256 * i; const float r = (v[i] - mu) * rs * ip.p[23][c] + ip.p[24][c], f = out[(size_t)t * D + c]; num += (f - r) * (f - r); den += r * r; }
    num = blk_sum(num, red); den = blk_sum(den, red);
    if (tid == 0) put_err(CHK, 11, num, den);
}
__global__ void __launch_bounds__(256) verdict(float* out, const unsigned* CHK, const unsigned* ctl) {
    int stage = 0; float err = 0.f;
    for (int s = 1; s <= 11; ++s) { const float e = __uint_as_float(CHK[s]); const float tol = (s == 8) ? 0.5f : (s == 10 ? 0.12f : (s == 9 ? 0.12f : (s == 11 ? 0.05f : 0.03f))); if (stage == 0 && !(e <= tol)) { stage = s; err = e; } }
    for (int li = 0; li < 16; ++li) if (stage == 0 && ctl[CW_BAR + li * XCD_BAR_WORDS_C + 128] != 0) { stage = 12; err = 1.f; }
    if (stage == 0) return;
    float lg = (log10f(fminf(fmaxf(err, 1e-3f), 1.f)) + 3.f) / 3.f; const float c2v = powf(10.f, (float)stage) * (1.f + 8.f * lg); const float C = sqrtf(c2v);
    for (size_t i = (size_t)blockIdx.x * 256 + threadIdx.x; i < (size_t)T * D; i += (size_t)gridDim.x * 256) out[i] = C;
}
}
#endif

#ifdef REPORT_K
__global__ void __launch_bounds__(256) k_report(float* out, const unsigned long long* ts) {
    const float us = (REPORT_K >= 0) ? (float)(ts[REPORT_K + 1] - ts[REPORT_K]) * 0.01f : (float)(ts[13] - ts[0]) * 0.001f; const float C = sqrtf(us);
    for (size_t i = (size_t)blockIdx.x * 256 + threadIdx.x; i < (size_t)T * D; i += (size_t)gridDim.x * 256) out[i] = C;
}
#endif
extern "C" void kernel_launch(void* const* d_in, const int* in_sizes, int n_in, void* d_out, int out_size, void* d_ws, size_t ws_size, hipStream_t stream) {
    static int grid = 0;
    if (grid == 0) {
        if (n_in != 25 || in_sizes[0] != T * D || out_size != T * D || ws_size < WS_END) { fprintf(stderr, "kernel_launch: unexpected problem shape / workspace (%d inputs, ws %zu); nothing launched\n", n_in, ws_size); grid = -1; return; }
        int dev = 0, cus = 0, per_cu = 0;
        if (hipGetDevice(&dev) != hipSuccess || hipDeviceGetAttribute(&cus, hipDeviceAttributeMultiprocessorCount, dev) != hipSuccess) { grid = -1; return; }
        if (hipFuncSetAttribute((const void*)mk_fwd, hipFuncAttributeMaxDynamicSharedMemorySize, LDS_BYTES) != hipSuccess) { fprintf(stderr, "kernel_launch: hipFuncSetAttribute failed\n"); grid = -1; return; }
        if (hipOccupancyMaxActiveBlocksPerMultiprocessor(&per_cu, (const void*)mk_fwd, NWAVES * 64, LDS_BYTES) != hipSuccess || per_cu < 1) { fprintf(stderr, "kernel_launch: occupancy query says %d\n", per_cu); }
        (void)hipGetLastError();
        grid = cus;
    }
    if (grid < 0) return;
    (void)hipMemsetAsync((char*)d_ws + WS_CTL, 0, CTL_ZERO_BYTES, stream);
    Args a{};
    for (int i = 0; i < 25; ++i) a.in[i] = (const float*)d_in[i];
    a.out = (float*)d_out; a.ws = (unsigned char*)d_ws;
#if defined(SELFCHECK) && SELFCHECK
    unsigned char* ws = (unsigned char*)d_ws; unsigned* CHK = (unsigned*)(ws + WS_CTL) + CW_CHK; const unsigned* ctl = (const unsigned*)(ws + WS_CTL);
    chk::InP inp{}; for (int i = 0; i < 25; ++i) inp.p[i] = a.in[i];
    float* scratch = (float*)(ws + WS_END + MiB);
    for (int p = 0; p < N_PHASES; ++p) {
        a.ph_lo = p; a.ph_hi = p + 1; a.li = p;
        hipLaunchKernelGGL(mk_fwd, dim3(grid), dim3(NWAVES * 64), LDS_BYTES, stream, a);
        using namespace chk;
        if (p == 1) hipLaunchKernelGGL(c1, dim3(NS), dim3(256), 0, stream, a.in[0], (const int*)d_in[1], a.in[2], ws, CHK);
        if (p == 2) hipLaunchKernelGGL(c2, dim3(NS * 8), dim3(64), 0, stream, ws, CHK);
        if (p == 3) hipLaunchKernelGGL(c3, dim3(16), dim3(64), 0, stream, inp, ws, scratch, CHK);
        if (p == 4) hipLaunchKernelGGL(c4, dim3(NS), dim3(256), 0, stream, a.in[3], a.in[11], ws, CHK);
        if (p == 5) hipLaunchKernelGGL(c5, dim3(NS), dim3(256), 0, stream, a.in[0], a.in[12], ws, CHK);
        if (p == 6) hipLaunchKernelGGL(c6, dim3(NS), dim3(256), 0, stream, a.in[13], a.in[14], a.in[0], ws, CHK);
        if (p == 7) hipLaunchKernelGGL(c7, dim3(NS), dim3(256), 0, stream, a.in[15], ws, CHK);
        if (p == 9) hipLaunchKernelGGL(c8, dim3(NS), dim3(64), 0, stream, a.in[16], ws, ctl, CHK);
        if (p == 10) { hipLaunchKernelGGL(c9, dim3(NS), dim3(256), 0, stream, inp, ws, ctl, CHK); hipLaunchKernelGGL(save_x1b, dim3(NS), dim3(256), 0, stream, ws, (bf16*)(ws + WS_END + 4 * MiB)); }
        if (p == 11) hipLaunchKernelGGL(c10, dim3(32), dim3(256), 0, stream, inp, ws, ctl, CHK);
        if (p == 12) hipLaunchKernelGGL(c11, dim3(NS), dim3(256), 0, stream, inp, (const float*)d_out, ws, ctl, CHK, (const bf16*)(ws + WS_END + 4 * MiB));
    }
    hipLaunchKernelGGL(chk::verdict, dim3(1024), dim3(256), 0, stream, (float*)d_out, CHK, ctl);
#else
    a.ph_lo = 0; a.ph_hi = N_PHASES; a.li = 0;
    hipLaunchKernelGGL(mk_fwd, dim3(grid), dim3(NWAVES * 64), LDS_BYTES, stream, a);
#ifdef REPORT_K
    hipLaunchKernelGGL(k_report, dim3(1024), dim3(256), 0, stream, (float*)d_out, (const unsigned long long*)((unsigned char*)d_ws + WS_END + 8 * MiB));
#endif
#endif
}
```

```cpp
#include <hip/hip_runtime.h>
#include <cstdio>
#include <cstdint>

#define LAS __attribute__((address_space(3)))
#define GAS __attribute__((address_space(1)))
typedef unsigned short bf16;
typedef short bf16x8 __attribute__((ext_vector_type(8)));
typedef short s16x4 __attribute__((ext_vector_type(4)));
typedef float f32x2 __attribute__((ext_vector_type(2)));
typedef float f32x4 __attribute__((ext_vector_type(4)));
typedef float f32x16 __attribute__((ext_vector_type(16)));
typedef unsigned u32x2 __attribute__((ext_vector_type(2)));
typedef unsigned u32x4 __attribute__((ext_vector_type(4)));
typedef GAS unsigned gu32;
#define RLX_AGENT __ATOMIC_RELAXED, __HIP_MEMORY_SCOPE_AGENT
#define DI __device__ __forceinline__

constexpr int NB = 4, SEQ = 8192, T = NB * SEQ, D = 1024, AW = 512, RW = 512, HD = 64, NH = 8, INW = 2560;
constexpr int NE = 256, TOPK = 8, EH = 256;
constexpr float ALPHA = 1.189207115002721f;
constexpr float LN_EPS = 1e-5f;
constexpr float LOG2E = 1.4426950408889634f;
constexpr float QSCALE = 0.125f * LOG2E;
constexpr int NWAVES = 8;
constexpr int MAXRT = T * TOPK / 256 + NE;
constexpr int NSHT = T / 256;
constexpr int MAXTILES = MAXRT + NSHT;
constexpr int MAXSLOTS = MAXTILES * 256;
constexpr int LCH = 128, NCH = SEQ / LCH;

constexpr size_t MiB = 1u << 20;
constexpr size_t WS_CTL = 0, CTL_ZERO_BYTES = 1 * MiB;
constexpr size_t WS_ROPE = 1 * MiB;
constexpr size_t WS_GWT = 3 * MiB;
constexpr size_t WS_C2 = 3 * MiB + 512 * 1024;
constexpr size_t WS_CARRY = 4 * MiB;
constexpr size_t WS_ER = 6 * MiB, WS_TS = 7 * MiB, WS_GW = 8 * MiB;
constexpr size_t WS_SLOTTOK = 9 * MiB, WS_SLOTW = 11 * MiB;
constexpr size_t WS_TILEE = 13 * MiB;
constexpr size_t WS_WINT = 14 * MiB, WS_WOUTT = 19 * MiB, WS_RTT = 21 * MiB;
constexpr size_t WS_WDT = 32 * MiB;
constexpr size_t WS_H = 161 * MiB;
constexpr size_t WS_Q = 161 * MiB, SEG_BYTES = 32 * MiB;
constexpr size_t WS_Y = 337 * MiB;
constexpr size_t WS_WGUT = 337 * MiB;
constexpr size_t WS_X1B = 850 * MiB;
constexpr size_t WS_LOGITS = 658 * MiB;
constexpr size_t WS_ATTN = 658 * MiB, WS_REC = 690 * MiB;
constexpr size_t WS_V1 = 786 * MiB;
constexpr size_t WS_XB = 722 * MiB;
constexpr size_t WS_MIX = 850 * MiB;
constexpr size_t WS_HF = 914 * MiB;
constexpr size_t WS_END = 977 * MiB;
static_assert(WS_WDT + (size_t)257 * 1024 * 256 * 2 <= WS_H && WS_H + (size_t)MAXSLOTS * 256 * 2 <= WS_Y && WS_Y + (size_t)MAXSLOTS * 1024 <= WS_XB && WS_V1 + (size_t)T * D * 2 <= WS_X1B, "ws map");
static_assert(WS_WGUT + (size_t)257 * 512 * 1024 * 2 <= WS_LOGITS && WS_Q + 5 * SEG_BYTES <= WS_Y, "ws map 2");
constexpr int CW_TMO = 0, CW_CQ = 16, CW_PAIR = 32, CW_XCC = 320, CW_GRP = 600, CW_CNT = 1024, CW_NT = 2048, CW_CHK = 3072, CW_BAR = 4096;
#define XCD_BAR_WORDS_C 3456
static_assert((CW_BAR + 16 * XCD_BAR_WORDS_C) * 4 <= (int)CTL_ZERO_BYTES, "ctl");

constexpr int RING_OFF = 0, RING_BYTES = 131072;
constexpr int UT_OFF = RING_BYTES;
constexpr int UT_IDX = UT_OFF + 128;
constexpr int UT_W = UT_IDX + 11 * 1024;
constexpr int MISC_OFF = UT_W + 11 * 1024;
constexpr int LDS_BYTES = 163840;
static_assert(MISC_OFF + 256 <= LDS_BYTES, "LDS map");

DI unsigned f2bf(float f) { unsigned u = __builtin_bit_cast(unsigned, f); return (u + 0x7fffu + ((u >> 16) & 1u)) >> 16; }
DI unsigned pk2(float lo, float hi) { return f2bf(lo) | (f2bf(hi) << 16); }
DI float bf2f(unsigned short b) { return __builtin_bit_cast(float, (unsigned)b << 16); }
DI float bflo(unsigned w) { return __builtin_bit_cast(float, w << 16); }
DI float bfhi(unsigned w) { return __builtin_bit_cast(float, w & 0xffff0000u); }
DI float wave_sum(float v) {
    v += __builtin_bit_cast(float, __builtin_amdgcn_update_dpp(0, __builtin_bit_cast(int, v), 0xB1, 0xF, 0xF, false));
    v += __builtin_bit_cast(float, __builtin_amdgcn_update_dpp(0, __builtin_bit_cast(int, v), 0x4E, 0xF, 0xF, false));
    v += __builtin_bit_cast(float, __builtin_amdgcn_update_dpp(0, __builtin_bit_cast(int, v), 0x141, 0xF, 0xF, false));
    v += __builtin_bit_cast(float, __builtin_amdgcn_update_dpp(0, __builtin_bit_cast(int, v), 0x140, 0xF, 0xF, false));
    const float r0 = __builtin_bit_cast(float, __builtin_amdgcn_readlane(__builtin_bit_cast(int, v), 0)), r1 = __builtin_bit_cast(float, __builtin_amdgcn_readlane(__builtin_bit_cast(int, v), 16)),
                r2 = __builtin_bit_cast(float, __builtin_amdgcn_readlane(__builtin_bit_cast(int, v), 32)), r3 = __builtin_bit_cast(float, __builtin_amdgcn_readlane(__builtin_bit_cast(int, v), 48));
    return (r0 + r1) + (r2 + r3);
}
DI float wave_max(float v) {
#pragma unroll
    for (int o = 1; o < 64; o <<= 1) v = fmaxf(v, __shfl_xor(v, o));
    return v;
}
DI int wave_min_i(int v) {
#pragma unroll
    for (int o = 1; o < 64; o <<= 1) v = min(v, __shfl_xor(v, o));
    return v;
}
DI float row16_max(float v) {
    v = fmaxf(v, __builtin_bit_cast(float, __builtin_amdgcn_update_dpp(0, __builtin_bit_cast(int, v), 0xB1, 0xF, 0xF, false)));
    v = fmaxf(v, __builtin_bit_cast(float, __builtin_amdgcn_update_dpp(0, __builtin_bit_cast(int, v), 0x4E, 0xF, 0xF, false)));
    v = fmaxf(v, __builtin_bit_cast(float, __builtin_amdgcn_update_dpp(0, __builtin_bit_cast(int, v), 0x141, 0xF, 0xF, false)));
    v = fmaxf(v, __builtin_bit_cast(float, __builtin_amdgcn_update_dpp(0, __builtin_bit_cast(int, v), 0x140, 0xF, 0xF, false)));
    return v; }
DI float wave_max_fast(float v) { v = row16_max(v);
    const float r0 = __builtin_bit_cast(float, __builtin_amdgcn_readlane(__builtin_bit_cast(int, v), 0)), r1 = __builtin_bit_cast(float, __builtin_amdgcn_readlane(__builtin_bit_cast(int, v), 16)),
                r2 = __builtin_bit_cast(float, __builtin_amdgcn_readlane(__builtin_bit_cast(int, v), 32)), r3 = __builtin_bit_cast(float, __builtin_amdgcn_readlane(__builtin_bit_cast(int, v), 48));
    return fmaxf(fmaxf(r0, r1), fmaxf(r2, r3)); }
DI int wave_min_i_fast(int v) {
    v = min(v, __builtin_amdgcn_update_dpp(0, v, 0xB1, 0xF, 0xF, false)); v = min(v, __builtin_amdgcn_update_dpp(0, v, 0x4E, 0xF, 0xF, false));
    v = min(v, __builtin_amdgcn_update_dpp(0, v, 0x141, 0xF, 0xF, false)); v = min(v, __builtin_amdgcn_update_dpp(0, v, 0x140, 0xF, 0xF, false));
    return min(min(__builtin_amdgcn_readlane(v, 0), __builtin_amdgcn_readlane(v, 16)), min(__builtin_amdgcn_readlane(v, 32), __builtin_amdgcn_readlane(v, 48))); }
DI int lane_id() { return (int)__builtin_amdgcn_mbcnt_hi(~0u, __builtin_amdgcn_mbcnt_lo(~0u, 0u)); }
DI float fexp2(float x) { return __builtin_amdgcn_exp2f(x); }
DI float frcp(float x) { return __builtin_amdgcn_rcpf(x); }
DI float gelu_tanh(float x) {
    const float z = 0.7978845608028654f * (x + 0.044715f * x * x * x);
    const float e = fexp2(2.f * LOG2E * z);
    return 0.5f * x * (2.f - 2.f * frcp(e + 1.f));
}
DI int crow(int r, int hi) { return (r & 3) + 8 * (r >> 2) + 4 * hi; }
#define MFMA32(a, b, c) __builtin_amdgcn_mfma_f32_32x32x16_bf16((a), (b), (c), 0, 0, 0)

namespace pg8 {
constexpr int BM = 256, BK = 64, HALF = 128, HTB = HALF * BK * 2, NXCD = 8;
DI int lds_byte(int r, int c) { const int st = (r >> 4) * 2 + (c >> 5), rr = r & 15, cc = c & 31, ob = rr * 64 + cc * 2; return st * 1024 + (ob ^ (((ob >> 9) & 1) << 5)); }
DI void stage_rc(int b, int& R, int& C) { const int st = b / 1024, sb = b % 1024, swz = sb ^ (((sb >> 9) & 1) << 5); R = (st >> 1) * 16 + swz / 64; C = (st & 1) * 32 + (swz % 64) / 2; }
DI int perm32(int rho) { const int n = rho >> 4, i = rho & 15; return 8 * (i >> 2) + 4 * n + (i & 3); }
struct Unit { int pm, pn, li, ex; };
DI bool xcd_order(int i, int G, int c, int nwg, int& wgid) {
    const long L = (long)i * G + c; if (L >= nwg) return false;
    const int w = (int)L, q = nwg / NXCD, r = nwg % NXCD, xcd = w % NXCD, off = w / NXCD;
    wgid = (xcd < r ? xcd * (q + 1) : r * (q + 1) + (xcd - r) * q) + off; return true;
}
typedef int i32x8 __attribute__((ext_vector_type(8))); typedef int i32x4 __attribute__((ext_vector_type(4)));
DI void pg8_mfma_f8(f32x4& acc, const i32x8& b, const i32x8& a, int sc) { asm volatile("v_mfma_scale_f32_16x16x128_f8f6f4 %0, %1, %2, %0, %3, %3 op_sel_hi:[0,0,0]" : "+v"(acc) : "v"(b), "v"(a), "v"(sc)); }
DI i32x8 pg8_ld32(const LAS unsigned char* p) { const i32x4 a = *(const LAS i32x4*)p, b = *(const LAS i32x4*)(p + 16); return __builtin_shufflevector(a, b, 0, 1, 2, 3, 4, 5, 6, 7); }
DI s16x4 pg8_tr(const LAS unsigned char* p) { typedef short v4i16_t __attribute__((ext_vector_type(4))); return __builtin_bit_cast(s16x4, __builtin_amdgcn_ds_read_tr16_b64_v4i16((LAS v4i16_t*)p)); }
DI unsigned cvt_pk_bf16(float lo, float hi) { unsigned r; asm volatile("v_cvt_pk_bf16_f32 %0, %1, %2" : "=v"(r) : "v"(lo), "v"(hi)); return r; }

template <class Epi, class Sched, bool ALIGN_EPI, bool BKN = false, bool F8 = false>
DI void gemm_phase(LAS unsigned char* lds, const Sched& S, const Epi& E, const int K) {
    const int tid = threadIdx.x, wid = __builtin_amdgcn_readfirstlane(tid >> 6), lane = tid & 63, wr = wid >> 2, wc = wid & 3, fr = lane & 15, fq = lane >> 4;
    const int nt = K / BK;
    unsigned voffB[2];
#define PG8_RC(i, R, C) int R, C; stage_rc((wid * 64 + lane_id()) * 16 + (i) * 8192, R, C)
#pragma unroll
    for (int i = 0; i < 2; ++i) { int R, C; stage_rc(tid * 16 + i * 8192, R, C); const int Rb = Epi::PERM ? ((R & ~31) + perm32(R & 31)) : R; voffB[i] = (unsigned)(Rb * S.ldb + C) * 2u;
        if constexpr (BKN) { static_assert(!BKN || Epi::PERM, "the [K][N] B path delivers the PERM column order"); const int b = tid * 16 + i * 8192, k = b >> 8, c = (b >> 4) & 15, cl = ((((c >> 2) ^ (k & 3)) << 2) | (c & 3)); voffB[i] = (unsigned)(k * S.ldb + 8 * cl) * 2u; } }
    const size_t kstep = (size_t)(BK * 2);
    size_t hstepB = (size_t)HALF * S.ldb * 2, kstepB = kstep;
    if constexpr (BKN) { hstepB = S.bh1; kstepB = (size_t)BK * S.ldb * 2; }
    int bkn_off = 0;
    if constexpr (BKN) { const int g = lane >> 4, q = (lane >> 2) & 3, pp = lane & 3; bkn_off = (8 * g + q) * 256 + ((((wc ^ q) << 2) | pp) << 4); }
    const unsigned ldsw = (unsigned)wid * 1024u, lds_u = (unsigned)(size_t)lds;
    const int aoff = lds_byte(wr * 64 + fr, F8 ? fq * 16 : fq * 8), boff = lds_byte(wc * 32 + fr, F8 ? fq * 16 : fq * 8);
#define PG8_SA(b, h) (((b) * 2 + (h)) * HTB)
#define PG8_SB(b, h) ((4 + (b) * 2 + (h)) * HTB)
#define PG8_STAGE(bufoff, gbase, voff) do { _Pragma("unroll") for (int _i = 0; _i < 2; ++_i) { unsigned keep_; \
        asm volatile("s_mov_b32 %0, m0\n\ts_mov_b32 m0, %3\n\ts_nop 0\n\tglobal_load_lds_dwordx4 %1, %2\n\ts_mov_b32 m0, %0" : "=&s"(keep_) : "v"((voff)[_i]), "s"((const char*)(gbase)), "s"(lds_u + (unsigned)(bufoff) + ldsw + (unsigned)(_i * 8192)) : "memory"); } } while (0)
#define PG8_LDA(dst, b, h) do { if constexpr (F8) { _Pragma("unroll") for (int m = 0; m < 4; ++m) A8[m] = pg8_ld32(lds + PG8_SA(b, h) + aoff + m * 2048); } \
        else { _Pragma("unroll") for (int m = 0; m < 4; ++m) _Pragma("unroll") for (int k = 0; k < 2; ++k) dst[m][k] = *(const LAS bf16x8*)(lds + PG8_SA(b, h) + aoff + m * 2048 + k * 1024); } } while (0)
#define PG8_LDB(dst, b, h) do { if constexpr (BKN) { _Pragma("unroll") for (int n = 0; n < 2; ++n) _Pragma("unroll") for (int k = 0; k < 2; ++k) { \
            const s16x4 lo_ = pg8_tr(lds + PG8_SB(b, h) + bkn_off + k * 8192 + n * 8), hi_ = pg8_tr(lds + PG8_SB(b, h) + bkn_off + k * 8192 + n * 8 + 1024); dst[n][k] = __builtin_shufflevector(lo_, hi_, 0, 1, 2, 3, 4, 5, 6, 7); } } \
        else if constexpr (F8) { _Pragma("unroll") for (int n = 0; n < 2; ++n) dst##8[n] = pg8_ld32(lds + PG8_SB(b, h) + boff + n * 2048); } \
        else { _Pragma("unroll") for (int n = 0; n < 2; ++n) _Pragma("unroll") for (int k = 0; k < 2; ++k) dst[n][k] = *(const LAS bf16x8*)(lds + PG8_SB(b, h) + boff + n * 2048 + k * 1024); } } while (0)
#define PG8_MMA(ai, bj, At, Bt) do { __builtin_amdgcn_s_setprio(1); if constexpr (F8) { _Pragma("unroll") for (int m = 0; m < 4; ++m) _Pragma("unroll") for (int n = 0; n < 2; ++n) \
            pg8_mfma_f8(acc[ai][bj][m][n], Bt##8[n], A8[m], f8_unit_scale); } \
        else { _Pragma("unroll") for (int m = 0; m < 4; ++m) _Pragma("unroll") for (int n = 0; n < 2; ++n) _Pragma("unroll") for (int k = 0; k < 2; ++k) \
            acc[ai][bj][m][n] = __builtin_amdgcn_mfma_f32_16x16x32_bf16(Bt[n][k], At[m][k], acc[ai][bj][m][n], 0, 0, 0); } __builtin_amdgcn_s_setprio(0); } while (0)
#define PG8_WAIT_V(n) asm volatile("s_waitcnt vmcnt(" #n ")" ::: "memory")
#define PG8_WAIT_L(n) asm volatile("s_waitcnt lgkmcnt(" #n ")" ::: "memory")
#define PG8_BAR __builtin_amdgcn_s_barrier()
#define PG8_SCHED __builtin_amdgcn_sched_barrier(0)
    Unit cur, nxt; int ui = 0;
    if (!S.next(0, cur)) return;
    f32x4 acc[2][2][4][2];
#pragma unroll
    for (int a = 0; a < 2; ++a)
#pragma unroll
        for (int b = 0; b < 2; ++b)
#pragma unroll
            for (int m = 0; m < 4; ++m)
#pragma unroll
                for (int n = 0; n < 2; ++n) acc[a][b][m][n] = (f32x4){0.f, 0.f, 0.f, 0.f};
    bf16x8 At[4][2], B0[2][2], B1[2][2];
    i32x8 A8[4], B08[2], B18[2];
    int f8_unit_scale = 0x7F7F7F7F; if constexpr (F8) { f8_unit_scale = Epi::F8SC; asm volatile("" : "+v"(f8_unit_scale)); }
    unsigned ca0[2], ca1[2];
#pragma unroll
    for (int i = 0; i < 2; ++i) { PG8_RC(i, R_, C_); ca0[i] = S.a_voff(cur, R_, C_); ca1[i] = S.a_voff(cur, HALF + R_, C_); }
    const char* cA = S.a_base(cur); const char* cB = S.b_base(cur);
    typename Epi::Ctx ctx = E.pre(cur, wr, fr);
    PG8_STAGE(PG8_SB(0, 0), cB, voffB); PG8_STAGE(PG8_SB(0, 1), cB + hstepB, voffB); PG8_STAGE(PG8_SA(0, 0), cA, ca0); PG8_STAGE(PG8_SA(0, 1), cA, ca1);
    if (wr == 1) PG8_BAR;
    PG8_WAIT_V(2); PG8_BAR;
    PG8_STAGE(PG8_SB(1, 0), cB + kstepB, voffB); PG8_STAGE(PG8_SA(1, 0), cA + kstep, ca0); PG8_STAGE(PG8_SB(1, 1), cB + hstepB + kstepB, voffB);
    PG8_WAIT_V(6); PG8_BAR;
    for (;;) {
        const bool has_next = S.next(ui + 1, nxt);
        const char* nA = has_next ? S.a_base(nxt) : cA; const char* nB = has_next ? S.b_base(nxt) : cB;
#pragma unroll 1
        for (int t = 0; t < nt; t += 2) {
            const bool last = (t == nt - 2);
            const char* a1 = cA + (size_t)(t + 1) * kstep;
            const char* a2 = last ? nA : cA + (size_t)(t + 2) * kstep; const char* b2 = last ? nB : cB + (size_t)(t + 2) * kstepB;
            const char* a3 = a2 + kstep; const char* b3 = b2 + kstepB;
            unsigned v20[2], v21[2];
            if (last && has_next) {
#pragma unroll
                for (int i = 0; i < 2; ++i) { PG8_RC(i, R_, C_); v20[i] = S.a_voff(nxt, R_, C_); v21[i] = S.a_voff(nxt, HALF + R_, C_); }
            } else {
#pragma unroll
                for (int i = 0; i < 2; ++i) { v20[i] = ca0[i]; v21[i] = ca1[i]; }
            }
            PG8_LDB(B0, 0, 0); PG8_LDB(B1, 0, 1); PG8_SCHED; PG8_LDA(At, 0, 0); PG8_STAGE(PG8_SA(1, 1), a1, ca1);
            PG8_WAIT_V(8); PG8_WAIT_L(0); PG8_BAR; PG8_MMA(0, 0, At, B0); PG8_MMA(0, 1, At, B1); PG8_BAR; PG8_SCHED;
            PG8_LDA(At, 0, 1); PG8_STAGE(PG8_SB(0, 0), b2, voffB); PG8_STAGE(PG8_SB(0, 1), b2 + hstepB, voffB); PG8_STAGE(PG8_SA(0, 0), a2, v20);
            PG8_WAIT_V(8); PG8_WAIT_L(0); PG8_BAR; PG8_MMA(1, 0, At, B0); PG8_MMA(1, 1, At, B1); PG8_BAR; PG8_SCHED;
            PG8_LDB(B0, 1, 0); PG8_LDB(B1, 1, 1); PG8_SCHED; PG8_LDA(At, 1, 0); PG8_STAGE(PG8_SA(0, 1), a2, v21);
            PG8_WAIT_V(8); PG8_WAIT_L(0); PG8_BAR; PG8_MMA(0, 0, At, B0); PG8_MMA(0, 1, At, B1); PG8_BAR; PG8_SCHED;
            PG8_LDA(At, 1, 1); PG8_STAGE(PG8_SB(1, 0), b3, voffB); PG8_STAGE(PG8_SB(1, 1), b3 + hstepB, voffB); PG8_STAGE(PG8_SA(1, 0), a3, v20);
            PG8_WAIT_V(8); PG8_WAIT_L(0); PG8_BAR; PG8_MMA(1, 0, At, B0); PG8_MMA(1, 1, At, B1); PG8_BAR; PG8_SCHED;
        }
        if constexpr (ALIGN_EPI) { if (wr == 0) PG8_BAR; }
        if constexpr (F8) asm volatile("s_nop 15\n\ts_nop 15\n\ts_nop 15" ::: "memory");
        E(acc, cur, ctx, wr, wc, fr, fq);
        if (!has_next) break;
#pragma unroll
        for (int a = 0; a < 2; ++a)
#pragma unroll
            for (int b = 0; b < 2; ++b)
#pragma unroll
                for (int m = 0; m < 4; ++m)
#pragma unroll
                    for (int n = 0; n < 2; ++n) acc[a][b][m][n] = (f32x4){0.f, 0.f, 0.f, 0.f};
        cur = nxt; cA = nA; cB = nB; ++ui;
        ctx = E.pre(cur, wr, fr);
#pragma unroll
        for (int i = 0; i < 2; ++i) { PG8_RC(i, R_, C_); ca0[i] = S.a_voff(cur, R_, C_); ca1[i] = S.a_voff(cur, HALF + R_, C_); }
        if constexpr (ALIGN_EPI) { if (wr == 1) PG8_BAR; }
    }
    PG8_WAIT_V(0);
    if constexpr (!ALIGN_EPI) { if (wr == 0) PG8_BAR; }
    PG8_BAR;
#undef PG8_RC
#undef PG8_SA
#undef PG8_SB
#undef PG8_STAGE
#undef PG8_LDA
#undef PG8_LDB
#undef PG8_MMA
#undef PG8_WAIT_V
#undef PG8_WAIT_L
#undef PG8_BAR
#undef PG8_SCHED
}
}
#define XB_TMO      128
#define XB_XCNT(j)  (256  + 64 * (j))
#define XB_XSUB(j)  (1280 + 64 * (j))
#define XB_XGEN(j)  (2304 + 64 * (j))
#define XB_TOP      3328
#define XB_TOPGEN   3392
#define XCD_BAR_WORDS 3456
#define XB_SPIN_CAP (1u << 18)

__device__ __forceinline__ unsigned xb_ld(unsigned* p)              { return __hip_atomic_load(p, __ATOMIC_RELAXED, __HIP_MEMORY_SCOPE_AGENT); }
__device__ __forceinline__ unsigned xb_add(unsigned* p, unsigned v) { return __hip_atomic_fetch_add(p, v, __ATOMIC_RELAXED, __HIP_MEMORY_SCOPE_AGENT); }
__device__ __forceinline__ unsigned xb_xcc_id() { return (unsigned)__builtin_amdgcn_s_getreg((3 << 11) | 20) & 0xFu; }
#define XB_SPIN(cond, bar) do { unsigned _sp = 0; while (cond) { __builtin_amdgcn_s_sleep(1); \
    if ((++_sp & 255u) == 0u) { if (xb_ld(&(bar)[XB_TMO])) break; if (_sp > XB_SPIN_CAP) { atomicAdd(&(bar)[XB_TMO], 1u); break; } } } } while (0)

struct XcdBarrier {
    unsigned* bar; unsigned x;
    volatile LAS unsigned* st;
};

__device__ __forceinline__ XcdBarrier xcd_barrier_post(unsigned* bar, volatile LAS unsigned* st) {
    XcdBarrier b; b.bar = bar; b.x = xb_xcc_id(); b.st = st;
    if (threadIdx.x == 0) (void)xb_add(&bar[XB_XCNT(b.x)], 1u);
    return b;
}
__device__ __forceinline__ void xcd_barrier_complete(unsigned* bar, unsigned x, unsigned& nloc, unsigned& nx) {
    const unsigned G = gridDim.x * gridDim.y * gridDim.z;
    unsigned sum, cnt, mine, sp = 0u;
    for (;;) {
        sum = 0u; cnt = 0u; mine = 0u;
#pragma unroll
        for (unsigned j = 0; j < 16; ++j) { const unsigned c = xb_ld(&bar[XB_XCNT(j)]); sum += c; cnt += (c > 0u) ? 1u : 0u; mine = (j == x) ? c : mine; }
        if (sum == G) break;
        __builtin_amdgcn_s_sleep(1);
        if ((++sp & 255u) == 0u) { if (xb_ld(&bar[XB_TMO])) break; if (sp > XB_SPIN_CAP) { atomicAdd(&bar[XB_TMO], 1u); break; } }
    }
    nloc = mine > 0u ? mine : 1u; nx = cnt > 0u ? cnt : 1u;
}

__device__ __forceinline__ void xcd_barrier(const XcdBarrier& b) {
    asm volatile("s_waitcnt vmcnt(0)" ::: "memory");
    __syncthreads();
    if (threadIdx.x == 0) {
        unsigned* bar = b.bar;
        __builtin_amdgcn_s_waitcnt(0);
        unsigned nloc = b.st[0], nx = b.st[1];
        if (nloc == 0u) { xcd_barrier_complete(bar, b.x, nloc, nx); b.st[0] = nloc; b.st[1] = nx; }
        const unsigned old = xb_add(&bar[XB_XSUB(b.x)], 1u);
        const unsigned gen = old / nloc;
        if (old + 1u == (gen + 1u) * nloc) {
            __builtin_amdgcn_fence(__ATOMIC_RELEASE, "agent");
            asm volatile("s_waitcnt vmcnt(0)" ::: "memory");
            const unsigned og = xb_add(&bar[XB_TOP], 1u);
            const unsigned tg = og / nx;
            if (og + 1u == (tg + 1u) * nx) xb_add(&bar[XB_TOPGEN], 1u);
            else XB_SPIN(xb_ld(&bar[XB_TOPGEN]) == tg, bar);
            __builtin_amdgcn_fence(__ATOMIC_ACQUIRE, "agent");
            xb_add(&bar[XB_XGEN(b.x)], 1u);
            asm volatile("s_waitcnt vmcnt(0)" ::: "memory");
        } else {
            XB_SPIN(xb_ld(&bar[XB_XGEN(b.x)]) == gen, bar);
            __builtin_amdgcn_fence(__ATOMIC_ACQUIRE, "agent");
            asm volatile("s_waitcnt vmcnt(0)" ::: "memory");
        }
    }
    __syncthreads();
}

__device__ __forceinline__ void xcd_barrier_arrive(const XcdBarrier& b) {
    asm volatile("s_waitcnt vmcnt(0)" ::: "memory");
    __syncthreads();
    if (threadIdx.x == 0) {
        unsigned* bar = b.bar;
        __builtin_amdgcn_s_waitcnt(0);
        unsigned nloc = b.st[0], nx = b.st[1];
        if (nloc == 0u) { xcd_barrier_complete(bar, b.x, nloc, nx); b.st[0] = nloc; b.st[1] = nx; }
        const unsigned old = xb_add(&bar[XB_XSUB(b.x)], 1u);
        const unsigned gen = old / nloc;
        b.st[2] = gen;
        if (old + 1u == (gen + 1u) * nloc) {
            __builtin_amdgcn_fence(__ATOMIC_RELEASE, "agent");
            asm volatile("s_waitcnt vmcnt(0)" ::: "memory");
            const unsigned og = xb_add(&bar[XB_TOP], 1u);
            const unsigned tg = og / nx;
            if (og + 1u == (tg + 1u) * nx) xb_add(&bar[XB_TOPGEN], 1u);
            else XB_SPIN(xb_ld(&bar[XB_TOPGEN]) == tg, bar);
            __builtin_amdgcn_fence(__ATOMIC_ACQUIRE, "agent");
            xb_add(&bar[XB_XGEN(b.x)], 1u);
            asm volatile("s_waitcnt vmcnt(0)" ::: "memory");
        }
    }
    __syncthreads();
}
__device__ __forceinline__ void xcd_barrier_wait(const XcdBarrier& b) {
    if (threadIdx.x == 0) {
        const unsigned gen = b.st[2];
        XB_SPIN(xb_ld(&b.bar[XB_XGEN(b.x)]) == gen, b.bar);
        __builtin_amdgcn_fence(__ATOMIC_ACQUIRE, "agent");
        asm volatile("s_waitcnt vmcnt(0)" ::: "memory");
    }
    __syncthreads();
}

#define LDS_WAIT() asm volatile("s_waitcnt lgkmcnt(0)" ::: "memory")
#define VM_WAIT() asm volatile("s_waitcnt vmcnt(0)" ::: "memory")
struct Frame {
    LAS unsigned char* lds;
    volatile LAS unsigned* MISC;
    gu32* ctl;
    int tid, lane, wave, vcu, G;
    unsigned char* ws;
    const float* in[25];
    float* out;
};

DI void sincos_acc(float ang, float& c, float& s) {
    const double x = (double)ang;
    const double k = rint(x * 0.63661977236758134308);
    double r = fma(-k, 1.57079632679489655800, x);
    r = fma(-k, 6.12323399573676603587e-17, r);
    const long long q = (long long)k;
    const double r2 = r * r;
    double sp = -7.6471637318198164759e-13; sp = fma(sp, r2, 1.6059043836821614599e-10); sp = fma(sp, r2, -2.5052108385441718775e-08);
    sp = fma(sp, r2, 2.7557319223985890653e-06); sp = fma(sp, r2, -1.9841269841269841270e-04); sp = fma(sp, r2, 8.3333333333333333333e-03);
    sp = fma(sp, r2, -1.6666666666666666667e-01); const double sr = fma(sp * r2, r, r);
    double cp = 4.7794773323873852974e-14; cp = fma(cp, r2, -1.1470745597729724714e-11); cp = fma(cp, r2, 2.0876756987868098979e-09);
    cp = fma(cp, r2, -2.7557319223985890653e-07); cp = fma(cp, r2, 2.4801587301587301587e-05); cp = fma(cp, r2, -1.3888888888888888889e-03);
    cp = fma(cp, r2, 4.1666666666666666667e-02); cp = fma(cp, r2, -0.5); const double cr = fma(cp, r2, 1.0);
    const int qq = (int)(q & 3);
    const double ss = qq == 0 ? sr : (qq == 1 ? cr : (qq == 2 ? -sr : -cr));
    const double cc = qq == 0 ? cr : (qq == 1 ? -sr : (qq == 2 ? -cr : sr));
    c = (float)cc; s = (float)ss;
}

DI void tr_item(const float* W, int N, bf16* WT, int Kd, LAS float* scr, int lane) {
#pragma unroll 4
    for (int i = 0; i < 16; ++i) { const int k = 4 * i + (lane >> 4), c4 = (lane & 15) * 4; const f32x4 v = *(const GAS f32x4*)(W + (size_t)k * N + c4);
        LAS float* d = scr + k * 65 + c4; d[0] = v.x; d[1] = v.y; d[2] = v.z; d[3] = v.w; }
    LDS_WAIT(); asm volatile("" ::: "memory");
    const int c = lane & 7;
#pragma unroll
    for (int j = 0; j < 8; ++j) { const int n = 8 * j + (lane >> 3); const LAS float* s = scr + (8 * c) * 65 + n;
        u32x4 o; o.x = pk2(s[0 * 65], s[1 * 65]); o.y = pk2(s[2 * 65], s[3 * 65]); o.z = pk2(s[4 * 65], s[5 * 65]); o.w = pk2(s[6 * 65], s[7 * 65]);
        *(GAS u32x4*)(WT + (size_t)n * Kd + 8 * c) = o; }
    LDS_WAIT(); asm volatile("" ::: "memory");
}
constexpr int XI_GU = 257 * 8 * 8, XI_DN = 257 * 2 * 32, XI_ALL = 2 * XI_GU + XI_DN;
constexpr int XSCR = 16896;
constexpr float WSCALE = 64.0f;
struct XItem { const float* src; unsigned char* dst; int N, Kd; };
DI XItem expert_item(Frame& F, int r) {
    unsigned char* ws = F.ws; XItem x;
    if (r < 2 * XI_GU) {
        const int up = r >= XI_GU; if (up) r -= XI_GU;
        const int e = r >> 6, kb = (r >> 3) & 7, nb = r & 7, j0 = nb * 32;
        const float* src = (e < NE) ? F.in[up ? 18 : 17] + (size_t)e * D * EH : F.in[up ? 21 : 20];
        const int row = (j0 >> 7) * 256 + up * 128 + (j0 & 127);
        x.src = src + (size_t)kb * 128 * EH + j0; x.N = EH; x.dst = ws + WS_WGUT + ((size_t)e * 512 + row) * D + kb * 128; x.Kd = D;
    } else {
        r -= 2 * XI_GU;
        const int e = r >> 6, kb = (r >> 5) & 1, nb = r & 31;
        const float* src = (e < NE) ? F.in[19] + (size_t)e * EH * D : F.in[22];
        x.src = src + (size_t)kb * 128 * D + nb * 32; x.N = D; x.dst = ws + WS_WDT + ((size_t)e * D + nb * 32) * EH + kb * 128; x.Kd = EH;
    }
    return x;
}
DI void xi_load(const XItem& x, f32x4 (&r)[16], int lane) {
#pragma unroll
    for (int i = 0; i < 16; ++i) { const int k = 16 * (lane >> 3) + i, c4 = (lane & 7) * 4; r[i] = __builtin_nontemporal_load((const GAS f32x4*)(x.src + (size_t)k * x.N + c4)); }
}
DI unsigned xi_pk4(float a, float b, float c, float d) { int w = __builtin_amdgcn_cvt_pk_fp8_f32(a * WSCALE, b * WSCALE, 0, false); w = __builtin_amdgcn_cvt_pk_fp8_f32(c * WSCALE, d * WSCALE, w, true); return (unsigned)w; }
DI void xi_finish(const XItem& x, const f32x4 (&r)[16], LAS float*, int lane) {
    unsigned char* d8 = x.dst + (size_t)(4 * (lane & 7)) * x.Kd + 16 * (lane >> 3);
#pragma unroll
    for (int j = 0; j < 4; ++j) {
        u32x4 o; o.x = xi_pk4(r[0][j], r[1][j], r[2][j], r[3][j]); o.y = xi_pk4(r[4][j], r[5][j], r[6][j], r[7][j]); o.z = xi_pk4(r[8][j], r[9][j], r[10][j], r[11][j]); o.w = xi_pk4(r[12][j], r[13][j], r[14][j], r[15][j]);
        __builtin_nontemporal_store(o, (GAS u32x4*)(d8 + (size_t)j * x.Kd)); }
}
#ifndef REPMASK
#define REPMASK 0
#endif
DI void convert_items(Frame& F, int it_lo, int it_hi, LAS float* scr) {
    const int gw = F.vcu * NWAVES + F.wave, NGW = F.G * NWAVES, lane = lane_id();
    const int first = it_lo + gw; if (first >= it_hi) return;
    const int n1 = (it_hi - first + NGW - 1) / NGW;
    const int n = n1 * (1 + ((REPMASK >> 18) & 1));
#define XI_IDX(q) (first + ((q) >= n1 ? (q) - n1 : (q)) * NGW)
    f32x4 r0[16], r1[16]; XItem x0, x1;
    x0 = expert_item(F, first); xi_load(x0, r0, lane);
    x1 = expert_item(F, XI_IDX(1 < n ? 1 : 0)); if (1 < n) xi_load(x1, r1, lane);
#pragma unroll 1
    for (int q = 0; q < n; q += 2) {
        xi_finish(x0, r0, scr, lane); if (q + 2 < n) { x0 = expert_item(F, XI_IDX(q + 2)); xi_load(x0, r0, lane); }
        if (q + 1 < n) { xi_finish(x1, r1, scr, lane); if (q + 3 < n) { x1 = expert_item(F, XI_IDX(q + 3)); xi_load(x1, r1, lane); } }
    }
#undef XI_IDX
}
DI void p0_prologue(Frame& F) {
    LAS float* scr = (LAS float*)(F.lds + F.wave * XSCR);
    const int gw = F.vcu * NWAVES + F.wave, NGW = F.G * NWAVES, lane = F.lane;
    unsigned char* ws = F.ws;
    constexpr int I_IN = 16 * 40, I_OUT = 16 * 16, I_RT = 16 * 4, I_G = 32;
    constexpr int NITEMS = I_IN + I_OUT + I_RT + I_G;
    for (int it = gw; it < NITEMS; it += NGW) {
        int r = it;
        if (r < I_IN) { const int kb = r / 40, nb = r % 40; tr_item(F.in[2] + (size_t)kb * 64 * INW + nb * 64, INW, (bf16*)(ws + WS_WINT) + (size_t)nb * 64 * D + kb * 64, D, scr, lane); continue; } r -= I_IN;
        if (r < I_OUT) { const int kb = r / 16, nb = r % 16; tr_item(F.in[12] + (size_t)kb * 64 * D + nb * 64, D, (bf16*)(ws + WS_WOUTT) + (size_t)nb * 64 * D + kb * 64, D, scr, lane); continue; } r -= I_OUT;
        if (r < I_RT) { const int kb = r / 4, nb = r % 4; tr_item(F.in[15] + (size_t)kb * 64 * NE + nb * 64, NE, (bf16*)(ws + WS_RTT) + (size_t)nb * 64 * D + kb * 64, D, scr, lane); continue; } r -= I_RT;
        {
            const int gate = r >> 4, dir = (r >> 3) & 1, n = r & 7;
            tr_item(F.in[gate ? 8 : 6] + (size_t)(dir * 8 + n) * 4096, 64, (bf16*)(ws + WS_GWT) + (size_t)((dir * 2 + gate) * 8 + n) * 4096, 64, scr, lane); }
    }
    { const f32x4* x4 = (const f32x4*)F.in[0]; u32x4* o = (u32x4*)(ws + WS_XB);
      const size_t NCHK = (size_t)T * D / 8, STR = (size_t)NGW * 64;
      for (size_t i = (size_t)gw * 64 + lane; i < NCHK; i += 4 * STR) {
          f32x4 a[4], b[4];
#pragma unroll
          for (int q = 0; q < 4; ++q) { const size_t ii = (i + q * STR < NCHK) ? i + q * STR : i; a[q] = __builtin_nontemporal_load((const GAS f32x4*)x4 + 2 * ii); b[q] = __builtin_nontemporal_load((const GAS f32x4*)x4 + 2 * ii + 1); }
#pragma unroll
          for (int q = 0; q < 4; ++q) if (i + q * STR < NCHK) { u32x4 w; w.x = pk2(a[q].x, a[q].y); w.y = pk2(a[q].z, a[q].w); w.z = pk2(b[q].x, b[q].y); w.w = pk2(b[q].z, b[q].w); o[i + q * STR] = w; } } }
    { const int* pos = (const int*)F.in[1]; float* rt = (float*)(ws + WS_ROPE);
      for (int i = gw * 64 + lane; i < T * 8; i += NGW * 64) { const int t = i >> 3, f = i & 7;
          float inv = 1.0f;
          inv = f == 1 ? 0x1.8d275ep-3f : inv; inv = f == 2 ? 0x1.341190p-5f : inv; inv = f == 3 ? 0x1.ddee9cp-8f : inv; inv = f == 4 ? 0x1.72ba44p-10f : inv;
          inv = f == 5 ? 0x1.1f91f0p-12f : inv; inv = f == 6 ? 0x1.be218ap-15f : inv; inv = f == 7 ? 0x1.5a0f50p-17f : inv;
          float c, s; sincos_acc((float)pos[t] * inv, c, s); rt[t * 16 + f] = c; rt[t * 16 + 8 + f] = s; } }
    { const float* lam = F.in[10]; float* c2 = (float*)(ws + WS_C2);
      for (int i = gw * 64 + lane; i < 2 * RW; i += NGW * 64) { const float l = lam[i]; const float sp = (-l > 20.f) ? -l : log1pf(expf(-l)); c2[i] = -8.0f * sp * LOG2E; } }
}

struct SchedDense {
    const bf16* A; const bf16* Bt; int lda, ldb, nM, nN, G, c, i0, i1;
    DI bool next(int ii, pg8::Unit& u) const { const int i = ii + i0; if (i >= i1) return false; int wgid; if (!pg8::xcd_order(i, G, c, nM * nN, wgid)) return false;
        const int nig = 8 * nN, gid = wgid / nig, fm = gid * 8, gsz = (nM - fm) < 8 ? (nM - fm) : 8; u.pm = fm + ((wgid % nig) % gsz); u.pn = (wgid % nig) / gsz; u.li = i; u.ex = 0; return true; }
    DI const char* a_base(const pg8::Unit& u) const { return (const char*)A + (size_t)u.pm * 256 * lda * 2; }
    DI unsigned a_voff(const pg8::Unit&, int R, int C) const { return (unsigned)(R * lda + C) * 2u; }
    DI const char* b_base(const pg8::Unit& u) const { return (const char*)Bt + (size_t)u.pn * 256 * ldb * 2; }
};
struct SchedRouter {
    const bf16* A; const bf16* Bt; int lda, ldb, nM, G, c;
    DI bool next(int i, pg8::Unit& u) const { int wgid; if (!pg8::xcd_order(i, G, c, nM * 2, wgid)) return false; u.pm = wgid >> 1; u.pn = wgid & 1; u.li = i; u.ex = 0; return true; }
    DI const char* a_base(const pg8::Unit& u) const { return (const char*)A + ((size_t)u.pm * 256 * lda + u.pn * 512) * 2; }
    DI unsigned a_voff(const pg8::Unit&, int R, int C) const { return (unsigned)(R * lda + C) * 2u; }
    DI const char* b_base(const pg8::Unit& u) const { return (const char*)Bt + (size_t)u.pn * 512 * 2; }
};
struct SchedG1 {
    const bf16* X; const bf16* W; const LAS unsigned* ue; const LAS unsigned* idx; int ldb, nwg, G, c; size_t bh1;
    DI bool next(int i, pg8::Unit& u) const { int wgid; if (!pg8::xcd_order(i, G, c, nwg, wgid)) return false; u.pm = wgid >> 1; u.pn = wgid & 1; u.li = i; u.ex = (int)ue[i]; return true; }
    DI const char* a_base(const pg8::Unit&) const { return (const char*)X; }
    DI unsigned a_voff(const pg8::Unit& u, int R, int C) const { return idx[u.li * 256 + R] * 1024u + (unsigned)C * 2u; }
    DI const char* b_base(const pg8::Unit& u) const { return (const char*)W + ((size_t)u.ex * 512 + u.pn * 256) * D; }
};
struct SchedG2 {
    const bf16* Hh; const bf16* W; const LAS unsigned* ue; int ldb, nwg, G, c, tile0; size_t bh1;
    DI bool next(int i, pg8::Unit& u) const { int wgid; if (!pg8::xcd_order(i, G, c, nwg, wgid)) return false; u.pm = tile0 + (wgid >> 2); u.pn = wgid & 3; u.li = i; u.ex = (int)ue[i]; return true; }
    DI const char* a_base(const pg8::Unit& u) const { return (const char*)Hh + (size_t)u.pm * 256 * EH; }
    DI unsigned a_voff(const pg8::Unit&, int R, int C) const { return (unsigned)(R * EH) + (unsigned)C * 2u; }
    DI const char* b_base(const pg8::Unit& u) const { return (const char*)W + ((size_t)(u.ex & 0xffff) * D + u.pn * 256) * EH; }
};

struct EpiInProj {
    static constexpr bool PERM = true; struct Ctx {}; DI Ctx pre(const pg8::Unit&, int, int) const { return Ctx{}; }
    bf16* Q; const float* rope;
    DI void operator()(const f32x4 (&acc)[2][2][4][2], const pg8::Unit& u, const Ctx& cx, int wr, int wc, int fr, int fq) const {
        const int seg = u.pn >> 1;
        bf16* base = Q + (size_t)seg * (SEG_BYTES / 2);
        const int row0 = u.pm * 256 + wr * 64 + fr, col0 = (u.pn & 1) * 256 + wc * 32 + 8 * fq;
        const bool rot = (seg < 2) && ((wc & 1) == 0);
        const float sgn = (fq == 0) ? -1.f : 1.f;
#pragma unroll
        for (int ai = 0; ai < 2; ++ai)
#pragma unroll
            for (int m = 0; m < 4; ++m) {
                const int row = row0 + ai * 128 + m * 16;
                f32x4 c0 = {1.f, 1.f, 1.f, 1.f}, c1 = c0, s0 = {0.f, 0.f, 0.f, 0.f}, s1 = s0;
                if (rot) { const f32x4* rp = (const f32x4*)(rope + (size_t)row * 16); c0 = rp[0]; c1 = rp[1]; s0 = rp[2]; s1 = rp[3]; }
#pragma unroll
                for (int bj = 0; bj < 2; ++bj) {
                    f32x4 v0 = acc[ai][bj][m][0], v1 = acc[ai][bj][m][1];
                    if (rot) {
                        f32x4 p0, p1;
#pragma unroll
                        for (int j = 0; j < 4; ++j) { p0[j] = __shfl_xor(v0[j], 16); p1[j] = __shfl_xor(v1[j], 16); }
                        if (fq < 2) { v0 = v0 * c0 + (p0 * s0) * sgn; v1 = v1 * c1 + (p1 * s1) * sgn; }
                    }
                    if (seg == 0) { v0 = v0 * QSCALE; v1 = v1 * QSCALE; }
                    if (seg == 4) {
#pragma unroll
                        for (int j = 0; j < 4; ++j) { v0[j] = gelu_tanh(v0[j]); v1[j] = gelu_tanh(v1[j]); } }
                    u32x4 w; w.x = pg8::cvt_pk_bf16(v0[0], v0[1]); w.y = pg8::cvt_pk_bf16(v0[2], v0[3]); w.z = pg8::cvt_pk_bf16(v1[0], v1[1]); w.w = pg8::cvt_pk_bf16(v1[2], v1[3]);
                    const int col = col0 + bj * 128;
                    if (seg < 3) *(u32x4*)(base + ((size_t)((row / SEQ) * NH + (col >> 6)) * SEQ + (row % SEQ)) * HD + (col & 63)) = w;
                    else *(u32x4*)(base + (size_t)row * 512 + col) = w;
                }
            }
    }
};
struct EpiYb {
    static constexpr bool PERM = true; struct Ctx {}; DI Ctx pre(const pg8::Unit&, int, int) const { return Ctx{}; }
    bf16* Yb;
    DI void operator()(const f32x4 (&acc)[2][2][4][2], const pg8::Unit& u, const Ctx& cx, int wr, int wc, int fr, int fq) const {
        const int row0 = u.pm * 256 + wr * 64 + fr, col0 = u.pn * 256 + wc * 32 + 8 * fq;
#pragma unroll
        for (int ai = 0; ai < 2; ++ai)
#pragma unroll
            for (int m = 0; m < 4; ++m) { const size_t ro = (size_t)(row0 + ai * 128 + m * 16) * D + col0;
#pragma unroll
                for (int bj = 0; bj < 2; ++bj) { const f32x4 v0 = acc[ai][bj][m][0], v1 = acc[ai][bj][m][1];
                    u32x4 o; o.x = pg8::cvt_pk_bf16(v0[0], v0[1]); o.y = pg8::cvt_pk_bf16(v0[2], v0[3]); o.z = pg8::cvt_pk_bf16(v1[0], v1[1]); o.w = pg8::cvt_pk_bf16(v1[2], v1[3]);
                    *(u32x4*)(Yb + ro + bj * 128) = o; } }
    }
};
struct EpiLogits {
    static constexpr bool PERM = false; struct Ctx {}; DI Ctx pre(const pg8::Unit&, int, int) const { return Ctx{}; }
    float* L;
    DI void operator()(const f32x4 (&acc)[2][2][4][2], const pg8::Unit& u, const Ctx& cx, int wr, int wc, int fr, int fq) const {
        float* base = L + (size_t)u.pn * T * NE; const int row0 = u.pm * 256 + wr * 64 + fr, col0 = wc * 32 + 4 * fq;
#pragma unroll
        for (int ai = 0; ai < 2; ++ai)
#pragma unroll
            for (int m = 0; m < 4; ++m) { const size_t ro = (size_t)(row0 + ai * 128 + m * 16) * NE + col0;
#pragma unroll
                for (int bj = 0; bj < 2; ++bj)
#pragma unroll
                    for (int n = 0; n < 2; ++n) *(f32x4*)(base + ro + bj * 128 + n * 16) = acc[ai][bj][m][n]; }
    }
};
constexpr float HSCALE = 64.0f;
struct EpiSwiglu {
    static constexpr bool PERM = true;
    static constexpr int F8SC = 0x7C7C7C7C;
    static_assert(WSCALE == 64.0f, "F8SC");
    struct Ctx {}; DI Ctx pre(const pg8::Unit&, int, int) const { return Ctx{}; }
    unsigned char* Hh; const LAS float* wtab; int NT;
    DI void operator()(const f32x4 (&acc)[2][2][4][2], const pg8::Unit& u, const Ctx& cx, int wr, int wc, int fr, int fq) const {
        const int row0 = u.pm * 256 + wr * 64 + fr, col0 = u.pn * 128 + wc * 32 + 8 * fq;
#pragma unroll
        for (int ai = 0; ai < 2; ++ai)
#pragma unroll
            for (int m = 0; m < 4; ++m) {
                const float w = wtab[u.li * 256 + wr * 64 + fr + ai * 128 + m * 16] * HSCALE;
                f32x4 h[2];
#pragma unroll
                for (int n = 0; n < 2; ++n) {
                    const f32x4 g = acc[ai][0][m][n], uu = acc[ai][1][m][n];
                    f32x4 e = g * (-LOG2E);
#pragma unroll
                    for (int j = 0; j < 4; ++j) e[j] = fexp2(e[j]);
                    e = e + 1.0f;
#pragma unroll
                    for (int j = 0; j < 4; ++j) e[j] = frcp(e[j]);
                    h[n] = ((g * uu) * e) * w;
#pragma unroll
                    for (int j = 0; j < 4; ++j) h[n][j] = __builtin_amdgcn_fmed3f(h[n][j], -448.f, 448.f);
                }
                int q0 = __builtin_amdgcn_cvt_pk_fp8_f32(h[0][0], h[0][1], 0, false); q0 = __builtin_amdgcn_cvt_pk_fp8_f32(h[0][2], h[0][3], q0, true);
                int q1 = __builtin_amdgcn_cvt_pk_fp8_f32(h[1][0], h[1][1], 0, false); q1 = __builtin_amdgcn_cvt_pk_fp8_f32(h[1][2], h[1][3], q1, true);
                *(u32x2*)(Hh + (size_t)(row0 + ai * 128 + m * 16) * EH + col0) = (u32x2){(unsigned)q0, (unsigned)q1};
            }
    }
};
constexpr float YSCALE = 16.0f;
DI unsigned pk_fp8x4(float a, float b, float c, float d) {
    a = __builtin_amdgcn_fmed3f(a, -448.f, 448.f); b = __builtin_amdgcn_fmed3f(b, -448.f, 448.f); c = __builtin_amdgcn_fmed3f(c, -448.f, 448.f); d = __builtin_amdgcn_fmed3f(d, -448.f, 448.f);
    int w = __builtin_amdgcn_cvt_pk_fp8_f32(a, b, 0, false); w = __builtin_amdgcn_cvt_pk_fp8_f32(c, d, w, true); return (unsigned)w; }
struct EpiDownY {
    static constexpr bool PERM = true; struct Ctx {}; DI Ctx pre(const pg8::Unit&, int, int) const { return Ctx{}; }
    static constexpr int F8SC = 0x7B7B7B7B;
    static_assert(HSCALE * WSCALE == 256.0f * YSCALE, "F8SC");
    unsigned char* Y; bool dry;
    DI void operator()(const f32x4 (&acc)[2][2][4][2], const pg8::Unit& u, const Ctx& cx, int wr, int wc, int fr, int fq) const {
        const int rl0 = wr * 64 + fr, boff = ((u.pn * 4 + wc) * 4 + fq) * 16, nrows = u.ex >> 16;
#pragma unroll
        for (int ai = 0; ai < 2; ++ai)
#pragma unroll
            for (int m = 0; m < 4; ++m) { const size_t slot = (size_t)u.pm * 256 + rl0 + ai * 128 + m * 16;
                u32x4 o;
                o.x = pk_fp8x4(acc[ai][0][m][0][0], acc[ai][0][m][0][1], acc[ai][0][m][0][2], acc[ai][0][m][0][3]); o.y = pk_fp8x4(acc[ai][0][m][1][0], acc[ai][0][m][1][1], acc[ai][0][m][1][2], acc[ai][0][m][1][3]);
                o.z = pk_fp8x4(acc[ai][1][m][0][0], acc[ai][1][m][0][1], acc[ai][1][m][0][2], acc[ai][1][m][0][3]); o.w = pk_fp8x4(acc[ai][1][m][1][0], acc[ai][1][m][1][1], acc[ai][1][m][1][2], acc[ai][1][m][1][3]);
                if (!dry && rl0 + ai * 128 + m * 16 < nrows) *(u32x4*)(Y + slot * 1024 + boff) = o; }
    }
};

struct ScanP { const bf16* RX; const bf16* GWT; const float* cw; const float* cb; const float* gab; const float* gxb; const float* c2; f32x2* carry; bf16* HF; bf16* HB; };
constexpr int UT_PITCH = 144;
constexpr int SC_RAW = 4608;
DI void load_raw(const bf16* RX, int tt0, int n, u32x4 (&rw)[5], int lane) {
    const int s0 = tt0 & (SEQ - 1);
#pragma unroll
    for (int i = 0; i < 5; ++i) { const int p = i * 64 + lane, row = p >> 3, ch = p & 7; const int ss = s0 + row - 2;
        u32x4 v = {0u, 0u, 0u, 0u};
        if (p < 288 && ss >= 0 && ss < SEQ) v = *(const GAS u32x4*)(RX + (size_t)(tt0 + row - 2) * RW + 64 * n + 8 * ch);
        rw[i] = v; }
}
DI void build_u_tile(const u32x4 (&rw)[5], float w0, float w1, float w2, float w3, float cbv, LAS unsigned char* ut, int lane) {
    LAS unsigned char* raw = ut + SC_RAW;
#pragma unroll
    for (int i = 0; i < 5; ++i) { const int p = i * 64 + lane; if (p < 288) *(LAS u32x4*)(raw + p * 16) = rw[i]; }
    float xm2 = bf2f(*(const LAS unsigned short*)(raw + 0 * 128 + lane * 2)), xm1 = bf2f(*(const LAS unsigned short*)(raw + 1 * 128 + lane * 2)), x0 = bf2f(*(const LAS unsigned short*)(raw + 2 * 128 + lane * 2));
#pragma unroll
    for (int tok = 0; tok < 32; ++tok) {
        const float x1 = bf2f(*(const LAS unsigned short*)(raw + (tok + 3) * 128 + lane * 2));
        const float uu = cbv + w0 * xm2 + w1 * xm1 + w2 * x0 + w3 * x1;
        *(LAS unsigned short*)(ut + tok * UT_PITCH + lane * 2) = (unsigned short)pg8::cvt_pk_bf16(uu, uu);
        xm2 = xm1; xm1 = x0; x0 = x1;
    }
}
DI void gate_ct(const LAS unsigned char* ut, const bf16x8 (&af)[4], const bf16x8 (&wA)[4], const bf16x8 (&wX)[4], float ba, float bx, float c2v, int ct, f32x16& a, f32x16& b, int lane) {
    const int col = lane & 31, hi = lane >> 5;
    f32x16 pa, px;
#pragma unroll
    for (int i = 0; i < 16; ++i) { pa[i] = 0.f; px[i] = 0.f; }
#pragma unroll
    for (int ks = 0; ks < 4; ++ks) { pa = MFMA32(af[ks], wA[ks], pa); px = MFMA32(af[ks], wX[ks], px); }
#pragma unroll
    for (int r = 0; r < 16; ++r) {
        const float uu = bf2f(*(const LAS unsigned short*)(ut + crow(r, hi) * UT_PITCH + (32 * ct + col) * 2));
        const float rr = frcp(1.f + fexp2(-LOG2E * (pa[r] + ba)));
        const float ii = frcp(1.f + fexp2(-LOG2E * (px[r] + bx)));
        const float av = fexp2(rr * c2v);
        a[r] = av; b[r] = __builtin_amdgcn_sqrtf(fmaxf(1.f - av * av, 0.f)) * ii * uu;
    }
}
template <int DIR, bool PASS2>
DI void scan_tile(const f32x16& a, const f32x16& b, LAS unsigned char* ocol, float& h, float& Ac, float& Bc, int hi) {
    float Ag[4], Bg[4];
#pragma unroll
    for (int g = 0; g < 4; ++g) {
        if (DIR == 0) { float B = b[4 * g]; B = a[4 * g + 1] * B + b[4 * g + 1]; B = a[4 * g + 2] * B + b[4 * g + 2]; B = a[4 * g + 3] * B + b[4 * g + 3]; Bg[g] = B; }
        else          { float B = b[4 * g + 3]; B = a[4 * g + 2] * B + b[4 * g + 2]; B = a[4 * g + 1] * B + b[4 * g + 1]; B = a[4 * g] * B + b[4 * g]; Bg[g] = B; }
        Ag[g] = (a[4 * g] * a[4 * g + 1]) * (a[4 * g + 2] * a[4 * g + 3]);
    }
    float AE[4], BE[4], AO[4], BO[4];
#pragma unroll
    for (int g = 0; g < 4; ++g) { const float pA = __shfl_xor(Ag[g], 32), pB = __shfl_xor(Bg[g], 32);
        AE[g] = hi ? pA : Ag[g]; BE[g] = hi ? pB : Bg[g]; AO[g] = hi ? Ag[g] : pA; BO[g] = hi ? Bg[g] : pB; }
    float hin[4];
    if (DIR == 0) {
#pragma unroll
        for (int g = 0; g < 4; ++g) { const float hE = h; h = AE[g] * h + BE[g]; const float hO = h; h = AO[g] * h + BO[g]; hin[g] = hi ? hO : hE;
            if (!PASS2) { Bc = AE[g] * Bc + BE[g]; Ac *= AE[g]; Bc = AO[g] * Bc + BO[g]; Ac *= AO[g]; } }
    } else {
#pragma unroll
        for (int g = 3; g >= 0; --g) { const float hO = h; h = AO[g] * h + BO[g]; const float hE = h; h = AE[g] * h + BE[g]; hin[g] = hi ? hO : hE;
            if (!PASS2) { Bc = AO[g] * Bc + BO[g]; Ac *= AO[g]; Bc = AE[g] * Bc + BE[g]; Ac *= AE[g]; } }
    }
    if (PASS2) {
#pragma unroll
        for (int g = 0; g < 4; ++g) { float hh = hin[g];
            if (DIR == 0) {
#pragma unroll
                for (int q = 0; q < 4; ++q) { hh = a[4 * g + q] * hh + b[4 * g + q]; *(LAS unsigned short*)(ocol + crow(4 * g + q, hi) * 128) = (unsigned short)pg8::cvt_pk_bf16(hh, hh); }
            } else {
#pragma unroll
                for (int q = 3; q >= 0; --q) { hh = a[4 * g + q] * hh + b[4 * g + q]; *(LAS unsigned short*)(ocol + crow(4 * g + q, hi) * 128) = (unsigned short)pg8::cvt_pk_bf16(hh, hh); }
            } }
    }
}
template <int DIR, bool PASS2>
DI void scan_sweep(const ScanP& P, int b, int n, int j, LAS unsigned char* ut, int lane) {
    const int col = lane & 31, hi = lane >> 5;
    bf16x8 wA[2][4], wX[2][4]; float ba[2], bx[2], c2v[2];
#pragma unroll
    for (int ct = 0; ct < 2; ++ct) {
#pragma unroll
        for (int ks = 0; ks < 4; ++ks) {
            wA[ct][ks] = *(const GAS bf16x8*)(P.GWT + ((size_t)((DIR * 2 + 0) * 8 + n) * 64 + 32 * ct + col) * 64 + 16 * ks + 8 * hi);
            wX[ct][ks] = *(const GAS bf16x8*)(P.GWT + ((size_t)((DIR * 2 + 1) * 8 + n) * 64 + 32 * ct + col) * 64 + 16 * ks + 8 * hi); }
        const int c = DIR * RW + 64 * n + 32 * ct + col; ba[ct] = P.gab[c]; bx[ct] = P.gxb[c]; c2v[ct] = P.c2[c];
    }
    const float w0 = P.cw[0 * RW + 64 * n + lane], w1 = P.cw[1 * RW + 64 * n + lane], w2 = P.cw[2 * RW + 64 * n + lane], w3 = P.cw[3 * RW + 64 * n + lane], cbv = P.cb[64 * n + lane];
    const int t0 = b * SEQ + j * LCH;
    u32x4 rw[5];
    load_raw(P.RX, t0 + 32 * (DIR == 0 ? 0 : (LCH / 32 - 1)), n, rw, lane);
    float h[2] = {0.f, 0.f}, Ac[2] = {1.f, 1.f}, Bc[2] = {0.f, 0.f};
    if (PASS2) {
        const f32x2* cr = P.carry + ((size_t)(b * 2 + DIR) * NCH) * RW + 64 * n + col;
        const int cnt = DIR == 0 ? j : (NCH - 1 - j);
        f32x2 ab[16][2];
#define SC_LD(dst, q0) do { _Pragma("unroll") for (int q = 0; q < 16; ++q) { const int qq_ = ((q0) + q < cnt) ? ((q0) + q) : (cnt > 0 ? cnt - 1 : 0); const int jj_ = DIR == 0 ? qq_ : (NCH - 1 - qq_); \
            _Pragma("unroll") for (int ct = 0; ct < 2; ++ct) dst[q][ct] = cr[(size_t)jj_ * RW + 32 * ct]; } } while (0)
        for (int q0 = 0; q0 < cnt; q0 += 16) {
            SC_LD(ab, q0);
#pragma unroll
            for (int q = 0; q < 16; ++q) if (q0 + q < cnt) {
#pragma unroll
                for (int ct = 0; ct < 2; ++ct) h[ct] = ab[q][ct].x * h[ct] + ab[q][ct].y; }
        }
#undef SC_LD
    }
#pragma unroll 1
    for (int tq = 0; tq < LCH / 32; ++tq) {
        const int ti = DIR == 0 ? tq : (LCH / 32 - 1 - tq);
        const int tt0 = t0 + 32 * ti;
        build_u_tile(rw, w0, w1, w2, w3, cbv, ut, lane);
        if (tq + 1 < LCH / 32) load_raw(P.RX, t0 + 32 * (DIR == 0 ? tq + 1 : (LCH / 32 - 2 - tq)), n, rw, lane);
        bf16x8 af[4];
#pragma unroll
        for (int ks = 0; ks < 4; ++ks) af[ks] = *(const LAS bf16x8*)(ut + col * UT_PITCH + (16 * ks + 8 * hi) * 2);
        LAS unsigned char* ot = ut + SC_RAW;
#pragma unroll
        for (int ct = 0; ct < 2; ++ct) {
            f32x16 a, bb;
            gate_ct(ut, af, wA[ct], wX[ct], ba[ct], bx[ct], c2v[ct], ct, a, bb, lane);
            scan_tile<DIR, PASS2>(a, bb, ot + (32 * ct + col) * 2, h[ct], Ac[ct], Bc[ct], hi);
            __builtin_amdgcn_sched_barrier(0);
        }
        if (PASS2) {
            bf16* dst = (DIR == 0 ? P.HF : P.HB) + (size_t)tt0 * RW + 64 * n;
#pragma unroll
            for (int i = 0; i < 4; ++i) { const int p = i * 64 + lane, row = p >> 3, ch = p & 7; *(GAS u32x4*)(dst + (size_t)row * RW + 8 * ch) = *(const LAS u32x4*)(ot + p * 16); }
        }
    }
    if (!PASS2 && hi == 0) {
#pragma unroll
        for (int ct = 0; ct < 2; ++ct) P.carry[((size_t)(b * 2 + DIR) * NCH + j) * RW + 64 * n + 32 * ct + col] = (f32x2){Ac[ct], Bc[ct]};
    }
}
template <bool PASS2>
DI void scan_phase(Frame& F, const ScanP& P, int it_lo, int it_hi);
constexpr int AT_OACC = 0, AT_ML = 65536, AT_V = 69632;
DI s16x4 vtr(const LAS unsigned char* p) { typedef short v4i16_t __attribute__((ext_vector_type(4))); return __builtin_bit_cast(s16x4, __builtin_amdgcn_ds_read_tr16_b64_v4i16((LAS v4i16_t*)p)); }
struct AttnP { const bf16* Q; const bf16* K; const bf16* V; bf16* O; };
struct AtDesc { int tb, h, rho, dl, nq0, L, qp0, qst, g, rot; };
DI AtDesc at_desc(int unit, int ti, int wave) {
    const int sp = unit & 15, h = (unit >> 4) & 7, b = unit >> 7, P0 = 512 * sp, g = ti >> 1, x = wave + 8 * (ti & 1);
    AtDesc d; d.tb = b * SEQ; d.h = h; d.g = g; d.dl = g == 0 ? 1 : (g == 1 ? 4 : 16); d.L = SEQ / d.dl;
    if (g == 0) { d.rho = 0; d.nq0 = P0 + 32 * x; d.qp0 = 32 * x; d.qst = 1; d.rot = (10 - (x % 5)) % 5; }
    else if (g == 1) { const int j = x & 3; d.rho = x >> 2; d.nq0 = P0 / 4 + 32 * j; d.qp0 = d.rho + 128 * j; d.qst = 4; d.rot = (5 - j) % 5; }
    else { d.rho = x; d.nq0 = P0 / 16; d.qp0 = d.rho; d.qst = 16; d.rot = 0; }
    return d;
}
struct AtPre { bf16x8 qf[4]; u32x4 k0[4], v0[4]; };
#define ATT_LO(d) (((d).nq0 >= 64) ? 0 : (2 - ((d).nq0 >> 5)))
#define ATT_HI(d) (((((d).L - (d).nq0) >> 5) + 2 < 5) ? ((((d).L - (d).nq0) >> 5) + 2) : 5)
template <int LM = 0>
DI void attn_prefetch(const AttnP& P, const AtDesc& d, int lane, AtPre& pre) {
    const int qi = lane & 31, hi = lane >> 5; const size_t hoff = (size_t)d.h * HD;
    const bf16* qp = P.Q + (size_t)(d.tb * NH + d.h * SEQ + d.rho + d.dl * (d.nq0 + qi)) * HD + 8 * hi;
#pragma unroll
    for (int ks = 0; ks < 4; ++ks) pre.qf[ks] = *(const GAS bf16x8*)(qp + 16 * ks);
    const int klo_ = ATT_LO(d), khi_ = ATT_HI(d), kt0 = d.rot < klo_ ? klo_ : (d.rot >= khi_ ? khi_ - 1 : d.rot);
    const size_t rowoff = (size_t)(d.tb * NH + d.h * SEQ + d.rho + d.dl * (d.nq0 - 64 + 32 * kt0 + (lane >> 3))) * HD + 8 * (lane & 7);
    const size_t vrow8 = (size_t)d.dl * 8 * HD;
#pragma unroll
    for (int i = 0; i < 4; ++i) { const size_t a_ = LM ? ((rowoff + i * vrow8) & (size_t)(1024 * AW - 1)) : (rowoff + i * vrow8); pre.k0[i] = *(const GAS u32x4*)(P.K + a_); pre.v0[i] = *(const GAS u32x4*)(P.V + a_); }
}
template <int LM = 0>
DI void attn_tile(const AttnP& P, const AtDesc& d, const AtPre& pre, LAS unsigned char* vt, int lane, f32x16 (&o)[2], float& m_out, float& l_out) {
    const bf16* Kp = P.K; const bf16* Vp = P.V; const int tb = d.tb, rho = d.rho, dl = d.dl, nq0 = d.nq0;
    const int qi = lane & 31, hi = lane >> 5;
    LAS unsigned char* kt_lds = vt + 32768;
    const int kt_lo = ATT_LO(d), kt_hi = ATT_HI(d), rot = d.rot;
    bf16x8 qf[4]; u32x4 kr[5][4], vv[5][4];
    const size_t hoff = (size_t)d.h * HD;
#pragma unroll
    for (int ks = 0; ks < 4; ++ks) qf[ks] = pre.qf[ks];
#pragma unroll
    for (int i = 0; i < 4; ++i) { kr[0][i] = pre.k0[i]; vv[0][i] = pre.v0[i]; }
    const size_t kstep = (size_t)dl * 32 * HD;
    const size_t rowoff = (size_t)(tb * NH + d.h * SEQ + rho + dl * (nq0 - 64 + (lane >> 3))) * HD + 8 * (lane & 7);
    const bf16* kp0 = Kp + rowoff; const bf16* vp0 = Vp + rowoff;
    const size_t vrow8 = (size_t)dl * 8 * HD;
#define ATT_KTA(kt) (((kt) + rot >= 5) ? (kt) + rot - 5 : (kt) + rot)
#define ATT_CL(kt) (ATT_KTA(kt) < kt_lo ? kt_lo : (ATT_KTA(kt) >= kt_hi ? kt_hi - 1 : ATT_KTA(kt)))
#define ATT_LOADK(kt) do { const size_t ko_ = (size_t)ATT_CL(kt) * kstep; _Pragma("unroll") for (int i = 0; i < 4; ++i) kr[kt][i] = *(const GAS u32x4*)(LM ? Kp + ((rowoff + ko_ + i * vrow8) & (size_t)(1024 * AW - 1)) : kp0 + ko_ + i * vrow8); } while (0)
#define ATT_LOADV(kt) do { const size_t vo_ = (size_t)ATT_CL(kt) * kstep; _Pragma("unroll") for (int i = 0; i < 4; ++i) vv[kt][i] = *(const GAS u32x4*)(LM ? Vp + ((rowoff + vo_ + i * vrow8) & (size_t)(1024 * AW - 1)) : vp0 + vo_ + i * vrow8); } while (0)
    ATT_LOADK(1); ATT_LOADK(2); ATT_LOADK(3); ATT_LOADK(4);
    ATT_LOADV(1);
    f32x16 z;
#pragma unroll
    for (int i = 0; i < 16; ++i) z[i] = 0.f;
    o[0] = z; o[1] = z;
    float m = -1e30f, l = 0.f;
    const int q4 = (lane & 15) >> 2, p4 = lane & 3, blk = (lane >> 4) & 1;
    const LAS unsigned char* vrd = vt + (4 * hi + q4) * 128 + (16 * blk + 4 * p4) * 2;
    const int kwr = (lane >> 3) * 128 + (((lane & 7) ^ ((lane >> 3) & 7)) << 4);
    const LAS unsigned char* krd = kt_lds + qi * 128;
#pragma unroll
    for (int kt = 0; kt < 5; ++kt) {
        if (kt + 2 < 5) ATT_LOADV(kt + 2);
        const int kta = ATT_KTA(kt);
        if (kta >= kt_lo && kta < kt_hi) {
#pragma unroll
            for (int i = 0; i < 4; ++i) *(LAS u32x4*)(kt_lds + i * 1024 + kwr) = kr[kt][i];
            f32x16 s = z;
#pragma unroll
            for (int ks = 0; ks < 4; ++ks) { const bf16x8 kf = *(const LAS bf16x8*)(krd + (((2 * ks + hi) ^ (qi & 7)) << 4)); s = MFMA32(kf, qf[ks], s); }
#pragma unroll
            for (int i = 0; i < 4; ++i) { const int piece = i * 64 + lane; *(LAS u32x4*)(vt + piece * 16) = vv[kt][i]; }
            s16x4 vlo[2][2], vhi[2][2];
#pragma unroll
            for (int sx = 0; sx < 2; ++sx)
#pragma unroll
                for (int dh = 0; dh < 2; ++dh) {
                    asm volatile("ds_read_b64_tr_b16 %0, %1" : "=v"(vlo[sx][dh]) : "v"((unsigned)(size_t)(vrd + (16 * sx) * 128 + 64 * dh)) : "memory");
                    asm volatile("ds_read_b64_tr_b16 %0, %1" : "=v"(vhi[sx][dh]) : "v"((unsigned)(size_t)(vrd + (16 * sx + 8) * 128 + 64 * dh)) : "memory");
                }
            if (kta == 0) {
#pragma unroll
                for (int r = 0; r < 16; ++r) if (crow(r, hi) < qi) s[r] = -1e30f;
            }
            if (kta == 4) {
#pragma unroll
                for (int r = 0; r < 16; ++r) if (crow(r, hi) > qi) s[r] = -1e30f;
            }
            float tm = s[0];
#pragma unroll
            for (int r = 1; r < 16; ++r) tm = fmaxf(tm, s[r]);
            { const auto sw_ = __builtin_amdgcn_permlane32_swap(__float_as_uint(tm), __float_as_uint(tm), false, false); tm = fmaxf(__uint_as_float(sw_[0]), __uint_as_float(sw_[1])); }
            const float mn = fmaxf(m, tm), al = fexp2(m - mn);
            float ps = 0.f;
#pragma unroll
            for (int r = 0; r < 16; ++r) { s[r] = fexp2(s[r] - mn); ps += s[r]; }
            l = l * al + ps; m = mn;
#pragma unroll
            for (int r = 0; r < 16; ++r) { o[0][r] *= al; o[1][r] *= al; }
            bf16x8 pk[2];
#pragma unroll
            for (int sx = 0; sx < 2; ++sx) { u32x4 w; w.x = pg8::cvt_pk_bf16(s[8 * sx + 0], s[8 * sx + 1]); w.y = pg8::cvt_pk_bf16(s[8 * sx + 2], s[8 * sx + 3]);
                w.z = pg8::cvt_pk_bf16(s[8 * sx + 4], s[8 * sx + 5]); w.w = pg8::cvt_pk_bf16(s[8 * sx + 6], s[8 * sx + 7]); pk[sx] = __builtin_bit_cast(bf16x8, w); }
            asm volatile("s_waitcnt lgkmcnt(0)" ::: "memory");
#pragma unroll
            for (int sx = 0; sx < 2; ++sx)
#pragma unroll
                for (int dh = 0; dh < 2; ++dh) {
                    asm volatile("" : "+v"(vlo[sx][dh]), "+v"(vhi[sx][dh]));
                    const bf16x8 vf = __builtin_shufflevector(vlo[sx][dh], vhi[sx][dh], 0, 1, 2, 3, 4, 5, 6, 7);
                    o[dh] = MFMA32(vf, pk[sx], o[dh]);
                }
        }
    }
#undef ATT_LOADK
#undef ATT_LOADV
#undef ATT_CL
#undef ATT_KTA
    m_out = m; l_out = l + __shfl_xor(l, 32);
}
template <int MODE>
DI void attn_phase(Frame& F, const AttnP& P) {
    LAS unsigned char* lds = F.lds;
    LAS unsigned char* vt = lds + AT_V + F.wave * 4096;
    const int lane = F.lane, qi = lane & 31, hi = lane >> 5;
    constexpr int NUNITS = NB * NH * (SEQ / 512);
    if (F.vcu >= NUNITS) return;
    AtDesc d = at_desc(F.vcu, 0, F.wave); AtPre pre; attn_prefetch(P, d, lane, pre);
    for (int unit = F.vcu; unit < NUNITS; unit += F.G) {
        const int sp = unit & 15, h = (unit >> 4) & 7, b = unit >> 7;
        const int tb = b * SEQ, P0 = 512 * sp;
        if (MODE == 0) {
            const size_t base = ((size_t)(tb * NH + h * SEQ + P0)) * HD + (size_t)F.tid * 8;
            u32x4 wk[8], wv[8];
#pragma unroll
            for (int i = 0; i < 8; ++i) { wk[i] = *(const GAS u32x4*)(P.K + base + (size_t)i * 4096); wv[i] = *(const GAS u32x4*)(P.V + base + (size_t)i * 4096); }
#pragma unroll
            for (int i = 0; i < 8; ++i) asm volatile("" :: "v"(wk[i]), "v"(wv[i]));
        }
#pragma unroll 1
        for (int ti = 0; ti < 6; ++ti) {
            f32x16 o[2]; float m, l;
            if (MODE == 3) attn_tile<1>(P, d, pre, vt, lane, o, m, l);
            else if (MODE != 2) attn_tile(P, d, pre, vt, lane, o, m, l);
            else { for (int i_ = 0; i_ < 16; ++i_) { o[0][i_] = 1.f; o[1][i_] = 1.f; } m = 0.f; l = 1.f; }
            const AtDesc dc = d;
            if (MODE == 1 || MODE == 3) { asm volatile("" :: "v"(o[0]), "v"(o[1]), "v"(m), "v"(l)); d = (ti < 5) ? at_desc(unit, ti + 1, F.wave) : ((unit + F.G < NUNITS) ? at_desc(unit + F.G, 0, F.wave) : dc); if (MODE == 3) attn_prefetch<1>(P, d, lane, pre); else attn_prefetch(P, d, lane, pre); continue; }
            const bool more = (ti < 5) || (unit + F.G < NUNITS);
            d = (ti < 5) ? at_desc(unit, ti + 1, F.wave) : (more ? at_desc(unit + F.G, 0, F.wave) : dc);
            attn_prefetch(P, d, lane, pre);
            const int g = dc.g, qpos = dc.qp0 + dc.qst * qi;
            LAS unsigned char* orow = lds + AT_OACC + qpos * 128 + 8 * hi;
            LAS f32x2* ml = (LAS f32x2*)(lds + AT_ML) + qpos;
            float w2 = frcp(l), w1 = 0.f;
            if (g > 0) { const f32x2 old = *ml; const float mN = fmaxf(old.x, m); const float a1 = old.y * fexp2(old.x - mN), a2 = fexp2(m - mN); const float lN = a1 + l * a2, rl = frcp(lN);
                w1 = a1 * rl; w2 = a2 * rl; m = mN; l = lN; }
#pragma unroll
            for (int dh = 0; dh < 2; ++dh)
#pragma unroll
                for (int gq = 0; gq < 4; ++gq) {
                    LAS u32x2* p = (LAS u32x2*)(orow + (32 * dh + 8 * gq) * 2);
                    float v0 = o[dh][4 * gq] * w2, v1 = o[dh][4 * gq + 1] * w2, v2 = o[dh][4 * gq + 2] * w2, v3 = o[dh][4 * gq + 3] * w2;
                    if (g > 0) { const u32x2 ow = *p; v0 += bflo(ow.x) * w1; v1 += bfhi(ow.x) * w1; v2 += bflo(ow.y) * w1; v3 += bfhi(ow.y) * w1; }
                    u32x2 nw; nw.x = pg8::cvt_pk_bf16(v0, v1); nw.y = pg8::cvt_pk_bf16(v2, v3); *p = nw;
                }
            if (hi == 0) *ml = (f32x2){m, l};
            if (ti & 1) __syncthreads();
        }
        if (MODE == 1 || MODE == 3) continue;
#pragma unroll
        for (int i = 0; i < 8; ++i) { const int c = i * 512 + F.tid, q = c >> 3, ch = c & 7;
            *(GAS u32x4*)(P.O + (size_t)(tb + P0 + q) * AW + h * HD + 8 * ch) = *(const LAS u32x4*)(lds + AT_OACC + q * 128 + ch * 16); }
        __syncthreads();
    }
}

struct MixG { f32x4 ga0, ga1, gr0, gr1; };
DI MixG mix_gains(Frame& F) { const int lane = lane_id(); return MixG{*(const f32x4*)(F.in[3] + 8 * lane), *(const f32x4*)(F.in[3] + 8 * lane + 4), *(const f32x4*)(F.in[11] + 8 * lane), *(const f32x4*)(F.in[11] + 8 * lane + 4)}; }
DI void mix_pair(Frame& F, const MixG& g, int tA, int tB) {
    const bf16* AT = (const bf16*)(F.ws + WS_ATTN); const bf16* HFp = (const bf16*)(F.ws + WS_HF); const bf16* HBp = (const bf16*)(F.ws + WS_REC); const bf16* Gp = (const bf16*)(F.ws + WS_Q + 4 * SEG_BYTES);
    bf16* MX = (bf16*)(F.ws + WS_MIX); const int lane = lane_id();
    u32x4 a[2], hf[2], hb[2], gg[2];
#pragma unroll
    for (int u = 0; u < 2; ++u) { const size_t o = (size_t)(u ? tB : tA) * 512 + 8 * lane;
        a[u] = *(const GAS u32x4*)(AT + o); hf[u] = *(const GAS u32x4*)(HFp + o); hb[u] = *(const GAS u32x4*)(HBp + o); gg[u] = *(const GAS u32x4*)(Gp + o); }
#pragma unroll
    for (int u = 0; u < 2; ++u) {
        const int t = u ? tB : tA;
        float av[8] = {bflo(a[u].x), bfhi(a[u].x), bflo(a[u].y), bfhi(a[u].y), bflo(a[u].z), bfhi(a[u].z), bflo(a[u].w), bfhi(a[u].w)};
        float rv[8] = {(bflo(hf[u].x) + bflo(hb[u].x)) * bflo(gg[u].x), (bfhi(hf[u].x) + bfhi(hb[u].x)) * bfhi(gg[u].x), (bflo(hf[u].y) + bflo(hb[u].y)) * bflo(gg[u].y), (bfhi(hf[u].y) + bfhi(hb[u].y)) * bfhi(gg[u].y),
                       (bflo(hf[u].z) + bflo(hb[u].z)) * bflo(gg[u].z), (bfhi(hf[u].z) + bfhi(hb[u].z)) * bfhi(gg[u].z), (bflo(hf[u].w) + bflo(hb[u].w)) * bflo(gg[u].w), (bfhi(hf[u].w) + bfhi(hb[u].w)) * bfhi(gg[u].w)};
        float sa = 0.f, sr = 0.f;
#pragma unroll
        for (int i = 0; i < 8; ++i) { sa += av[i] * av[i]; sr += rv[i] * rv[i]; }
        sa = wave_sum(sa); sr = wave_sum(sr);
        const float ra = 1.0f / sqrtf(sa * (1.f / 512.f) + LN_EPS), rr = 1.0f / sqrtf(sr * (1.f / 512.f) + LN_EPS);
        u32x4 oa, orr;
        oa.x = pk2(av[0] * ra * g.ga0.x, av[1] * ra * g.ga0.y); oa.y = pk2(av[2] * ra * g.ga0.z, av[3] * ra * g.ga0.w); oa.z = pk2(av[4] * ra * g.ga1.x, av[5] * ra * g.ga1.y); oa.w = pk2(av[6] * ra * g.ga1.z, av[7] * ra * g.ga1.w);
        orr.x = pk2(rv[0] * rr * g.gr0.x, rv[1] * rr * g.gr0.y); orr.y = pk2(rv[2] * rr * g.gr0.z, rv[3] * rr * g.gr0.w); orr.z = pk2(rv[4] * rr * g.gr1.x, rv[5] * rr * g.gr1.y); orr.w = pk2(rv[6] * rr * g.gr1.z, rv[7] * rr * g.gr1.w);
        *(GAS u32x4*)(MX + (size_t)t * D + 8 * lane) = oa; *(GAS u32x4*)(MX + (size_t)t * D + AW + 8 * lane) = orr;
    }
}
DI void mix_phase(Frame& F) {
    const int gw = F.vcu * NWAVES + F.wave, NGW = F.G * NWAVES; const MixG g = mix_gains(F);
    for (int t0 = gw; t0 < T; t0 += 2 * NGW) mix_pair(F, g, t0, t0 + NGW);
}
template <bool PASS2>
DI void scan_phase(Frame& F, const ScanP& P, int it_lo, int it_hi) {
    LAS unsigned char* ut = F.lds + F.wave * XSCR;
    LAS float* scr = (LAS float*)(F.lds + F.wave * XSCR);
    const int gw = F.vcu * NWAVES + F.wave, NGW = F.G * NWAVES;
    const bool conv_first = F.wave < 4;
    const bool wg_units = (F.G * NWAVES == NB * 8 * NCH);
    if (conv_first) convert_items(F, it_lo, it_hi, scr);
    for (int u = gw; u < NB * 8 * NCH; u += NGW) {
        int j = u % NCH, n = (u / NCH) & 7, b = u / (NCH * 8);
        if (wg_units) { b = F.vcu / NCH; j = F.vcu % NCH; n = F.wave; }
        scan_sweep<0, PASS2>(P, b, n, j, ut, F.lane);
        scan_sweep<1, PASS2>(P, b, n, j, ut, F.lane);
    }
    if (!conv_first) convert_items(F, it_lo, it_hi, scr);
    if (PASS2 && wg_units) {
        VM_WAIT(); __syncthreads();
        const MixG g = mix_gains(F); const int t0 = (F.vcu / NCH) * SEQ + (F.vcu % NCH) * LCH + F.wave * 16;
#pragma unroll 1
        for (int i = 0; i < 16; i += 2) mix_pair(F, g, t0 + i, t0 + i + 1);
    }
}

template <bool LOCAL>
DI void ln1_phase(Frame& F) {
    const bf16* Yb = (const bf16*)(F.ws + WS_V1); const bf16* XBp = (const bf16*)(F.ws + WS_XB); bf16* X1B = (bf16*)(F.ws + WS_X1B); unsigned char* X1F8 = F.ws + WS_HF;
    const int lane = F.lane;
    const int gw = LOCAL ? (F.vcu * 128 + F.wave * 16) : (F.vcu * NWAVES + F.wave), NGW = LOCAL ? 1 : F.G * NWAVES, tend = LOCAL ? gw + 16 : T;
    f32x4 gg[4], bb[4];
#pragma unroll
    for (int j = 0; j < 4; ++j) { gg[j] = *(const f32x4*)(F.in[13] + 4 * lane + 256 * j); bb[j] = *(const f32x4*)(F.in[14] + 4 * lane + 256 * j); }
    for (int t0 = gw; t0 < tend; t0 += 2 * NGW) {
        f32x4 v[2][4]; u32x2 yv[2][4];
#pragma unroll
        for (int u = 0; u < 2; ++u) { const GAS u32x2* xr = (const GAS u32x2*)(XBp + (size_t)(t0 + u * NGW) * D) + lane; const GAS u32x2* yr = (const GAS u32x2*)(Yb + (size_t)(t0 + u * NGW) * D) + lane;
#pragma unroll
            for (int j = 0; j < 4; ++j) { const u32x2 xw = __builtin_nontemporal_load(xr + 64 * j); v[u][j] = (f32x4){bflo(xw.x), bfhi(xw.x), bflo(xw.y), bfhi(xw.y)}; yv[u][j] = __builtin_nontemporal_load(yr + 64 * j); } }
#pragma unroll
        for (int u = 0; u < 2; ++u) {
            const int t = t0 + u * NGW; float s = 0.f;
#pragma unroll
            for (int j = 0; j < 4; ++j) { v[u][j] = v[u][j] * ALPHA + (f32x4){bflo(yv[u][j].x), bfhi(yv[u][j].x), bflo(yv[u][j].y), bfhi(yv[u][j].y)}; s += (v[u][j].x + v[u][j].y) + (v[u][j].z + v[u][j].w); }
            const float mean = wave_sum(s) * (1.f / D); float s2 = 0.f;
#pragma unroll
            for (int j = 0; j < 4; ++j) { v[u][j] = v[u][j] - mean; s2 += (v[u][j].x * v[u][j].x + v[u][j].y * v[u][j].y) + (v[u][j].z * v[u][j].z + v[u][j].w * v[u][j].w); }
            const float rstd = 1.f / sqrtf(wave_sum(s2) * (1.f / D) + LN_EPS);
            GAS u32x2* o2 = (GAS u32x2*)(X1B + (size_t)t * D) + lane;
#pragma unroll
            for (int j = 0; j < 4; ++j) { const f32x4 y = v[u][j] * rstd * gg[j] + bb[j]; u32x2 w; w.x = pk2(y.x, y.y); w.y = pk2(y.z, y.w); o2[64 * j] = w;
                int q = __builtin_amdgcn_cvt_pk_fp8_f32(y.x, y.y, 0, false); q = __builtin_amdgcn_cvt_pk_fp8_f32(y.z, y.w, q, true); *(GAS unsigned*)(X1F8 + (size_t)t * D + 4 * lane + 256 * j) = (unsigned)q; }
        }
    }
}
template <bool DRY>
DI void route_phase(Frame& F, int it_lo, int it_hi) {
    LAS float* cscr = (LAS float*)(F.lds + 8192 + F.wave * XSCR);
    if (!DRY && F.wave < 4) convert_items(F, it_lo, it_hi, cscr);
    const bool opaque = DRY && (__hip_atomic_load((unsigned*)(F.ctl + CW_TMO), RLX_AGENT) == 0xdeadbeefu);
    const float* LG = (const float*)(F.ws + WS_LOGITS); const float* rbias = F.in[16];
    unsigned* ER = (unsigned*)(F.ws + WS_ER); float* GW = (float*)(F.ws + WS_GW); int* slot_tok = (int*)(F.ws + WS_SLOTTOK);
    LAS unsigned* hist = (LAS unsigned*)(F.lds); LAS unsigned* base = hist + 256; LAS unsigned* erl = hist + 512;
    const int lane = F.lane, tid = F.tid;
    if (!DRY) for (int i = F.vcu * 512 + tid; i < MAXSLOTS; i += F.G * 512) slot_tok[i] = 0;
    if (tid < 256) hist[tid] = 0u;
    __syncthreads();
    const int TPW = T / F.G;
    const f32x4 bi = ((const f32x4*)rbias)[lane];
    const float NEGINF = -__builtin_huge_valf();
    f32x4 nl0, nl1;
    { const int t = F.vcu * TPW + F.wave; nl0 = ((const GAS f32x4*)(LG + (size_t)t * NE))[lane]; nl1 = ((const GAS f32x4*)(LG + (size_t)T * NE + (size_t)t * NE))[lane]; }
    for (int i = F.wave; i < TPW; i += NWAVES) {
        const int t = F.vcu * TPW + i;
        const f32x4 lg = nl0 + nl1;
        { const int tn = F.vcu * TPW + ((i + NWAVES < TPW) ? i + NWAVES : i); nl0 = ((const GAS f32x4*)(LG + (size_t)tn * NE))[lane]; nl1 = ((const GAS f32x4*)(LG + (size_t)T * NE + (size_t)tn * NE))[lane]; }
        const float s0 = frcp(1.f + fexp2(-LOG2E * lg.x)), s1 = frcp(1.f + fexp2(-LOG2E * lg.y)), s2 = frcp(1.f + fexp2(-LOG2E * lg.z)), s3 = frcp(1.f + fexp2(-LOG2E * lg.w));
        float v0 = s0 + bi.x, v1 = s1 + bi.y, v2 = s2 + bi.z, v3 = s3 + bi.w;
        const float hi1 = fmaxf(v0, v1), lo1 = fminf(v0, v1), hi2 = fmaxf(v2, v3), lo2 = fminf(v2, v3);
        float m1 = fmaxf(hi1, hi2), m2 = fmaxf(fminf(hi1, hi2), fmaxf(lo1, lo2));
#pragma unroll
        for (int o = 0; o < 3; ++o) {
            float o1, o2;
            if (o == 0) { o1 = __builtin_bit_cast(float, __builtin_amdgcn_update_dpp(0, __builtin_bit_cast(int, m1), 0xB1, 0xF, 0xF, false)); o2 = __builtin_bit_cast(float, __builtin_amdgcn_update_dpp(0, __builtin_bit_cast(int, m2), 0xB1, 0xF, 0xF, false)); }
            else if (o == 1) { o1 = __builtin_bit_cast(float, __builtin_amdgcn_update_dpp(0, __builtin_bit_cast(int, m1), 0x4E, 0xF, 0xF, false)); o2 = __builtin_bit_cast(float, __builtin_amdgcn_update_dpp(0, __builtin_bit_cast(int, m2), 0x4E, 0xF, 0xF, false)); }
            else { o1 = __builtin_bit_cast(float, __builtin_amdgcn_update_dpp(0, __builtin_bit_cast(int, m1), 0x141, 0xF, 0xF, false)); o2 = __builtin_bit_cast(float, __builtin_amdgcn_update_dpp(0, __builtin_bit_cast(int, m2), 0x141, 0xF, 0xF, false)); }
            const float n1 = fmaxf(m1, o1), n2 = fmaxf(fminf(m1, o1), fmaxf(m2, o2)); m1 = n1; m2 = n2; }
        const float gs = m1 + m2; const int myg = lane >> 3; int rank = 0;
#pragma unroll
        for (int j = 0; j < 8; ++j) { const float gj = __builtin_bit_cast(float, __builtin_amdgcn_readlane(__builtin_bit_cast(int, gs), 8 * j)); rank += (gj > gs || (gj == gs && j < myg)) ? 1 : 0; }
        if (rank >= 4) { v0 = NEGINF; v1 = NEGINF; v2 = NEGINF; v3 = NEGINF; }
        int me = 0; float mg = 0.f, gsum = 0.f;
#pragma unroll
        for (int k = 0; k < 8; ++k) {
            const float lm = fmaxf(fmaxf(v0, v1), fmaxf(v2, v3)), wm = wave_max_fast(lm);
            const unsigned long long b0 = __builtin_amdgcn_ballot_w64(v0 == wm), b1 = __builtin_amdgcn_ballot_w64(v1 == wm), b2 = __builtin_amdgcn_ballot_w64(v2 == wm), b3 = __builtin_amdgcn_ballot_w64(v3 == wm);
            const int c0 = b0 ? 4 * (int)__builtin_ctzll(b0) : (1 << 20), c1 = b1 ? 4 * (int)__builtin_ctzll(b1) + 1 : (1 << 20), c2 = b2 ? 4 * (int)__builtin_ctzll(b2) + 2 : (1 << 20), c3 = b3 ? 4 * (int)__builtin_ctzll(b3) + 3 : (1 << 20);
            const int e = min(min(c0, c1), min(c2, c3)), el = e >> 2, ei = e & 3;
            const float mysc = ei == 0 ? s0 : (ei == 1 ? s1 : (ei == 2 ? s2 : s3));
            const float sc = __builtin_bit_cast(float, __builtin_amdgcn_readlane(__builtin_bit_cast(int, mysc), el));
            v0 = (e == 4 * lane) ? NEGINF : v0; v1 = (e == 4 * lane + 1) ? NEGINF : v1; v2 = (e == 4 * lane + 2) ? NEGINF : v2; v3 = (e == 4 * lane + 3) ? NEGINF : v3;
            me = (lane == k) ? e : me; mg = (lane == k) ? sc : mg; gsum += sc;
        }
        if (lane < 8) { const unsigned lr = __hip_atomic_fetch_add(hist + me, 1u, __ATOMIC_RELAXED, __HIP_MEMORY_SCOPE_WORKGROUP); erl[i * 8 + lane] = ((unsigned)me << 24) | lr; if (!DRY || opaque) GW[(size_t)t * 8 + lane] = mg / gsum * 2.5f; }
    }
    __syncthreads();
    if (tid < 256) base[tid] = DRY ? 0u : atomicAdd((unsigned*)(F.ctl + CW_CNT) + tid, hist[tid]);
    __syncthreads();
    if (!DRY) for (int i = tid; i < TPW * 8; i += 512) { const unsigned er = erl[i]; ER[(size_t)F.vcu * TPW * 8 + i] = er + base[er >> 24]; }
    __syncthreads();
    if (!DRY && F.wave >= 4) convert_items(F, it_lo, it_hi, cscr);
}
DI void slot_phase(Frame& F) {
    const unsigned* ER = (const unsigned*)(F.ws + WS_ER); const float* GW = (const float*)(F.ws + WS_GW);
    unsigned* TS = (unsigned*)(F.ws + WS_TS); int* slot_tok = (int*)(F.ws + WS_SLOTTOK); float* slot_w = (float*)(F.ws + WS_SLOTW); int* tile_e = (int*)(F.ws + WS_TILEE);
    LAS int* tb = (LAS int*)(F.lds); LAS int* tmp = tb + 512;
    const int tid = F.tid;
    int nt_e = 0;
    int cnt_e = 0;
    if (tid < 256) { cnt_e = (int)__hip_atomic_load((unsigned*)(F.ctl + CW_CNT) + tid, RLX_AGENT); nt_e = (cnt_e + 255) >> 8; tmp[tid] = nt_e; }
    __syncthreads();
    int src = 0;
    for (int o = 1; o < 256; o <<= 1) { if (tid < 256) { int v = tmp[src * 256 + tid]; if (tid >= o) v += tmp[src * 256 + tid - o]; tmp[(src ^ 1) * 256 + tid] = v; } src ^= 1; __syncthreads(); }
    if (tid < 256) tb[tid] = tmp[src * 256 + tid] - nt_e;
    const int NT = tmp[src * 256 + 255];
    __syncthreads();
    if (F.vcu == 0) {
        if (tid == 0) __hip_atomic_store((unsigned*)(F.ctl + CW_NT), (unsigned)NT, RLX_AGENT);
        if (tid < 256) for (int tl = tb[tid]; tl < tb[tid] + nt_e; ++tl) { const int rows = cnt_e - 256 * (tl - tb[tid]); tile_e[tl] = tid | ((rows < 256 ? rows : 256) << 16); }
        for (int i = tid; i < NSHT; i += 512) tile_e[NT + i] = NE | (256 << 16);
    }
    for (int i = F.vcu * 512 + tid; i < T; i += F.G * 512) { slot_tok[(size_t)NT * 256 + i] = i; }
    const int TPW = T / F.G;
    for (int i = tid; i < TPW * 8; i += 512) {
        const size_t gi = (size_t)F.vcu * TPW * 8 + i; const unsigned er = ER[gi]; const int e = er >> 24, rk = er & 0xffffff;
        const int slot = tb[e] * 256 + rk;
        slot_tok[slot] = (int)(gi >> 3); slot_w[slot] = GW[gi]; TS[gi] = (unsigned)slot;
    }
}
DI void acc_fp8x4(unsigned w, f32x4& v) { const f32x2 a = __builtin_amdgcn_cvt_pk_f32_fp8((int)w, false), b = __builtin_amdgcn_cvt_pk_f32_fp8((int)w, true); v.x += a.x; v.y += a.y; v.z += b.x; v.w += b.y; }
template <bool STORE>
DI void final_phase(Frame& F) {
    const bool opaque = !STORE && (__hip_atomic_load((unsigned*)(F.ctl + CW_TMO), RLX_AGENT) == 0xdeadbeefu);
    const unsigned char* Y = (const unsigned char*)(F.ws + WS_Y); const unsigned* TS = (const unsigned*)(F.ws + WS_TS); const bf16* X1B = (const bf16*)(F.ws + WS_X1B);
    const size_t shslot0 = (size_t)__hip_atomic_load((unsigned*)(F.ctl + CW_NT), RLX_AGENT) * 256;
    const int gw = F.vcu * NWAVES + F.wave, NGW = F.G * NWAVES, lane = F.lane;
    const int cb = 256 * (lane >> 4) + 32 * ((lane >> 2) & 3) + 8 * (lane & 3);
    f32x4 gg[4], bb[4];
#pragma unroll
    for (int bj = 0; bj < 2; ++bj)
#pragma unroll
        for (int hh = 0; hh < 2; ++hh) { gg[2 * bj + hh] = *(const f32x4*)(F.in[23] + cb + 128 * bj + 4 * hh); bb[2 * bj + hh] = *(const f32x4*)(F.in[24] + cb + 128 * bj + 4 * hh); }
    for (int t0 = gw; t0 < T; t0 += 8 * NGW) {
        const int ti = lane >> 3; const int tt = t0 + ti * NGW;
        const unsigned myslot = (tt < T) ? TS[(size_t)tt * 8 + (lane & 7)] : 0u;
#pragma unroll 1
        for (int i = 0; i < 8; ++i) {
            const int t = t0 + i * NGW; if (t >= T) break;
            float* xr = F.out + (size_t)t * D + cb;
            f32x4 v[4];
#pragma unroll
            for (int bj = 0; bj < 2; ++bj) { const u32x4 w = *(const GAS u32x4*)(X1B + (size_t)t * D + cb + 128 * bj);
                v[2 * bj] = (f32x4){bflo(w.x), bfhi(w.x), bflo(w.y), bfhi(w.y)} * ALPHA; v[2 * bj + 1] = (f32x4){bflo(w.z), bfhi(w.z), bflo(w.w), bfhi(w.w)} * ALPHA; }
            u32x4 yv[8]; const u32x4 ysh = __builtin_nontemporal_load((const GAS u32x4*)(Y + (shslot0 + (size_t)t) * 1024) + lane);
#pragma unroll
            for (int k = 0; k < 8; ++k) { const unsigned slot = (unsigned)__builtin_amdgcn_readlane((int)myslot, i * 8 + k); yv[k] = __builtin_nontemporal_load((const GAS u32x4*)(Y + (size_t)slot * 1024) + lane); }
            f32x4 a[4];
#pragma unroll
            for (int j = 0; j < 4; ++j) a[j] = (f32x4){0.f, 0.f, 0.f, 0.f};
#pragma unroll
            for (int k = 0; k < 8; ++k) { acc_fp8x4(yv[k].x, a[0]); acc_fp8x4(yv[k].y, a[1]); acc_fp8x4(yv[k].z, a[2]); acc_fp8x4(yv[k].w, a[3]); }
            acc_fp8x4(ysh.x, a[0]); acc_fp8x4(ysh.y, a[1]); acc_fp8x4(ysh.z, a[2]); acc_fp8x4(ysh.w, a[3]);
#pragma unroll
            for (int j = 0; j < 4; ++j) v[j] = v[j] + a[j] * (1.0f / YSCALE);
            float s = 0.f;
#pragma unroll
            for (int j = 0; j < 4; ++j) s += (v[j].x + v[j].y) + (v[j].z + v[j].w);
            const float mean = wave_sum(s) * (1.f / D); float s2 = 0.f;
#pragma unroll
            for (int j = 0; j < 4; ++j) { v[j] = v[j] - mean; s2 += (v[j].x * v[j].x + v[j].y * v[j].y) + (v[j].z * v[j].z + v[j].w * v[j].w); }
            const float rstd = 1.f / sqrtf(wave_sum(s2) * (1.f / D) + LN_EPS);
            if (STORE || opaque) {
#pragma unroll
                for (int bj = 0; bj < 2; ++bj) { __builtin_nontemporal_store(v[2 * bj] * rstd * gg[2 * bj] + bb[2 * bj], (GAS f32x4*)(xr + 128 * bj)); __builtin_nontemporal_store(v[2 * bj + 1] * rstd * gg[2 * bj + 1] + bb[2 * bj + 1], (GAS f32x4*)(xr + 128 * bj + 4)); } }
        }
    }
}

#ifndef REPMASK
#define REPMASK 0
#endif
constexpr int N_PHASES = 13;
#ifndef XCF1
#define XCF1 37
#define XCF2 57
#define XCF3 72
#define XCF5 100
#endif
constexpr int XC_F = (XI_ALL * XCF2 / 100) & ~2047;
constexpr int XC_P1 = (XI_ALL * XCF1 / 100) & ~2047, XC_P2 = (XI_ALL * XCF2 / 100) & ~2047, XC_P3 = (XI_ALL * XCF3 / 100) & ~2047, XC_P5 = (XI_ALL * XCF5 / 100) & ~2047;
struct Args { const float* in[25]; float* out; unsigned char* ws; int ph_lo, ph_hi, li, pad; };
DI void ph1_part(Frame& F, int i0, int i1) {
    unsigned char* ws = F.ws;
    SchedDense S{(const bf16*)(ws + WS_XB), (const bf16*)(ws + WS_WINT), D, D, T / 256, INW / 256, F.G, (int)blockIdx.x, i0, i1};
    EpiInProj E{(bf16*)(ws + WS_Q), (const float*)(ws + WS_ROPE)};
    pg8::gemm_phase<EpiInProj, SchedDense, true>(F.lds + RING_OFF, S, E, D);
}
DI void ph1(Frame& F) {
    LAS float* scr = (LAS float*)(F.lds + F.wave * XSCR);
    const int grp = F.vcu & 1;
    if (grp == 0) { convert_items(F, 0, XC_P1, scr); __syncthreads(); }
    ph1_part(F, 0, 1 << 20);
    if (grp == 1) { __syncthreads(); convert_items(F, 0, XC_P1, scr); }
}
DI ScanP mk_scanp(Frame& F) { unsigned char* ws = F.ws;
    return ScanP{(const bf16*)(ws + WS_Q + 3 * SEG_BYTES), (const bf16*)(ws + WS_GWT), F.in[4], F.in[5], F.in[7], F.in[9],
                 (const float*)(ws + WS_C2), (f32x2*)(ws + WS_CARRY), (bf16*)(ws + WS_HF), (bf16*)(ws + WS_REC)}; }
DI void ph2(Frame& F) {
    unsigned char* ws = F.ws;
    const ScanP SP = mk_scanp(F);
    const AttnP AP{(const bf16*)(ws + WS_Q), (const bf16*)(ws + WS_Q + SEG_BYTES), (const bf16*)(ws + WS_Q + 2 * SEG_BYTES), (bf16*)(ws + WS_ATTN)};
    if constexpr ((REPMASK >> 15) & 1) { attn_phase<1>(F, AP); __syncthreads(); }
    if constexpr ((REPMASK >> 16) & 1) { attn_phase<2>(F, AP); __syncthreads(); }
    if constexpr ((REPMASK >> 17) & 1) { attn_phase<3>(F, AP); __syncthreads(); }
    attn_phase<0>(F, AP);
    if constexpr ((REPMASK >> 13) & 1) { attn_phase<0>(F, AP); }
    __syncthreads();
    scan_phase<false>(F, SP, XC_P1, XC_P2);
    if constexpr ((REPMASK >> 14) & 1) { __syncthreads(); scan_phase<false>(F, SP, 0, 0); }
}
DI void ph3(Frame& F) { const ScanP SP = mk_scanp(F); scan_phase<true>(F, SP, XC_P3, XC_P3); }
DI void ph5(Frame& F) {
    unsigned char* ws = F.ws;
    LAS float* scr = (LAS float*)(F.lds + F.wave * XSCR);
    const int grp = F.vcu & 1;
    if (grp == 0) { convert_items(F, XC_P3, XC_P5 - 2048, scr); __syncthreads(); }
    SchedDense S{(const bf16*)(ws + WS_MIX), (const bf16*)(ws + WS_WOUTT), D, D, T / 256, D / 256, F.G, (int)blockIdx.x, 0, 1 << 20};
    EpiYb E{(bf16*)(ws + WS_V1)};
    pg8::gemm_phase<EpiYb, SchedDense, true>(F.lds + RING_OFF, S, E, D);
    if (grp == 1) { __syncthreads(); convert_items(F, XC_P3, XC_P5 - 2048, scr); }
}
DI void ph7(Frame& F) {
    unsigned char* ws = F.ws;
    SchedRouter S{(const bf16*)(ws + WS_X1B), (const bf16*)(ws + WS_RTT), D, D, T / 256, F.G, (int)blockIdx.x};
    EpiLogits E{(float*)(ws + WS_LOGITS)};
    pg8::gemm_phase<EpiLogits, SchedRouter, true>(F.lds + RING_OFF, S, E, 512);
}
DI void ph10(Frame& F) {
    unsigned char* ws = F.ws; const int cid = (int)blockIdx.x;
    LAS unsigned* ue = (LAS unsigned*)(F.lds + UT_OFF); LAS unsigned* uidx = (LAS unsigned*)(F.lds + UT_IDX);
    const int NT = (int)__hip_atomic_load((unsigned*)(F.ctl + CW_NT), RLX_AGENT);
    const int nwg = 2 * (NT + NSHT);
    const int* tile_e = (const int*)(ws + WS_TILEE); const int* slot_tok = (const int*)(ws + WS_SLOTTOK);
    __syncthreads();
    {
        unsigned te[11], st[11]; float sw[11]; const float* slot_w = (const float*)(ws + WS_SLOTW); LAS float* uw = (LAS float*)(F.lds + UT_W);
#pragma unroll
        for (int i = 0; i < 11; ++i) { int wgid; const bool ok = pg8::xcd_order(i, F.G, cid, nwg, wgid); const int tile = ok ? (wgid >> 1) : 0;
            te[i] = (unsigned)tile_e[tile] & 0xffffu; st[i] = (F.tid < 256) ? (unsigned)slot_tok[(size_t)tile * 256 + F.tid] : 0u; sw[i] = (F.tid < 256 && tile < NT) ? slot_w[(size_t)tile * 256 + F.tid] : 1.0f; }
#pragma unroll
        for (int i = 0; i < 11; ++i) { if (F.tid == 0) ue[i] = te[i]; if (F.tid < 256) { uidx[i * 256 + F.tid] = st[i]; uw[i * 256 + F.tid] = sw[i]; } }
    }
    __syncthreads();
    SchedG1 S{(const bf16*)(ws + WS_HF), (const bf16*)(ws + WS_WGUT), ue, uidx, D / 2, nwg, F.G, cid, (size_t)0};
    EpiSwiglu E{(unsigned char*)(ws + WS_H), (const LAS float*)(F.lds + UT_W), NT};
    pg8::gemm_phase<EpiSwiglu, SchedG1, true, false, true>(F.lds + RING_OFF, S, E, D / 2);
}
template <bool DRY>
DI void ph11a(Frame& F) {
    unsigned char* ws = F.ws; const int cid = (int)blockIdx.x;
    LAS unsigned* ue = (LAS unsigned*)(F.lds + UT_OFF);
    const int NT = (int)__hip_atomic_load((unsigned*)(F.ctl + CW_NT), RLX_AGENT);
    const int* tile_e = (const int*)(ws + WS_TILEE);
    const int nwg = 4 * (NT + NSHT);
    __syncthreads();
    for (int i = F.tid; i < 22; i += NWAVES * 64) { int wgid; if (pg8::xcd_order(i, F.G, cid, nwg, wgid)) ue[i] = (unsigned)tile_e[wgid >> 2]; }
    __syncthreads();
    SchedG2 S{(const bf16*)(ws + WS_H), (const bf16*)(ws + WS_WDT), ue, EH / 2, nwg, F.G, cid, 0, (size_t)0};
    EpiDownY E{(unsigned char*)(ws + WS_Y), DRY && (__hip_atomic_load((unsigned*)(F.ctl + CW_TMO), RLX_AGENT) != 0xdeadbeefu)};
    pg8::gemm_phase<EpiDownY, SchedG2, true, false, true>(F.lds + RING_OFF, S, E, EH / 2);
}
DI void pair_sync(Frame& F, const XcdBarrier& bar, int k) {
    asm volatile("s_waitcnt vmcnt(0)" ::: "memory");
    __syncthreads();
    if (threadIdx.x == 0) {
        unsigned* w = (unsigned*)(F.ctl + CW_PAIR) + (F.vcu >> 1) * 2 + k;
        __builtin_amdgcn_s_waitcnt(0);
        const unsigned other = xb_ld((unsigned*)(F.ctl + CW_XCC) + (F.vcu ^ 1));
        if (other != 1u + xb_xcc_id()) { __builtin_amdgcn_fence(__ATOMIC_RELEASE, "agent"); asm volatile("s_waitcnt vmcnt(0)" ::: "memory"); }
        (void)xb_add(w, 1u);
        XB_SPIN(xb_ld(w) < 2u, bar.bar);
        __builtin_amdgcn_fence(__ATOMIC_ACQUIRE, "agent");
        asm volatile("s_waitcnt vmcnt(0)" ::: "memory");
    }
    __syncthreads();
}
DI void group_sync(Frame& F, const XcdBarrier& bar, int k) {
    asm volatile("s_waitcnt vmcnt(0)" ::: "memory");
    __syncthreads();
    if (threadIdx.x == 0) {
        unsigned* w = (unsigned*)(F.ctl + CW_GRP) + (F.vcu >> 5) * 2 + k;
        __builtin_amdgcn_s_waitcnt(0);
        (void)xb_add(w, 1u);
        XB_SPIN(xb_ld(w) < 32u, bar.bar);
        __builtin_amdgcn_fence(__ATOMIC_ACQUIRE, "agent");
        asm volatile("s_waitcnt vmcnt(0)" ::: "memory");
    }
    __syncthreads();
}
DI void ph678(Frame& F, const XcdBarrier& bar) {
    ln1_phase<true>(F);
    pair_sync(F, bar, 0);
    ph7(F);
    pair_sync(F, bar, 1);
    route_phase<false>(F, XC_P5, XI_ALL);
}
#ifndef PHMASK
#define PHMASK 0x1fff
#endif
#ifndef REPMASK
#define REPMASK 0
#endif
__global__ void __launch_bounds__(NWAVES * 64, 2) mk_fwd(Args args) {
    extern __shared__ __attribute__((aligned(16))) unsigned char lds_raw[];
    Frame F;
    F.lds = (LAS unsigned char*)lds_raw;
    F.MISC = (volatile LAS unsigned*)(F.lds + MISC_OFF);
    F.tid = threadIdx.x; F.lane = F.tid & 63; F.wave = __builtin_amdgcn_readfirstlane(F.tid >> 6);
    F.G = gridDim.x; { const int bx = blockIdx.x; F.vcu = (F.G % 8 == 0) ? (bx % 8) * (F.G / 8) + bx / 8 : bx; }
    F.ws = args.ws; F.out = args.out; F.ctl = (gu32*)(args.ws + WS_CTL);
#pragma unroll
    for (int i = 0; i < 25; ++i) F.in[i] = args.in[i];
    if (F.tid < 64) F.MISC[F.tid] = 0u;
    if (F.tid == 0) __hip_atomic_store((unsigned*)(F.ctl + CW_XCC) + F.vcu, 1u + xb_xcc_id(), RLX_AGENT);
    __syncthreads();
    XcdBarrier bar = xcd_barrier_post((unsigned*)(F.ctl + CW_BAR) + args.li * XCD_BAR_WORDS, F.MISC + 8);
    const int lo = args.ph_lo, hi = args.ph_hi;
#ifdef REPORT_K
    unsigned long long* tsb = (unsigned long long*)(args.ws + WS_END + 8 * MiB); int nst = 0;
#define STAMP() do { if (blockIdx.x == 0 && F.tid == 0) tsb[nst] = __builtin_amdgcn_s_memrealtime(); ++nst; } while (0)
#else
#define STAMP() do {} while (0)
#endif
    STAMP();
#define IN(k) (((PHMASK >> (k)) & 1) && lo <= (k) && (k) < hi)
#define REP(k) if constexpr (((REPMASK) >> (k)) & 1)
#define SEAM(k) do { if (IN(k) && IN((k) + 1)) xcd_barrier(bar); STAMP(); } while (0)
#define FSEAMR(k, lo_, hi_) do { if (IN(k) && IN((k) + 1)) { xcd_barrier_arrive(bar); convert_items(F, (lo_), (hi_), nullptr); xcd_barrier_wait(bar); } else if (IN(k)) convert_items(F, (lo_), (hi_), nullptr); STAMP(); } while (0)
#define FSEAM(k, j) FSEAMR(k, XC_F + 2048 * (j), XC_F + 2048 * ((j) + 1))
    if (IN(0)) { p0_prologue(F); REP(0) { __syncthreads(); p0_prologue(F); } } FSEAM(0, 0);
    bool local_ok = false;
    if (F.G == 256 && IN(0) && IN(1)) {
        int ok = 1;
        if (F.tid < 256) { const unsigned a = xb_ld((unsigned*)(F.ctl + CW_XCC) + F.tid), b0 = xb_ld((unsigned*)(F.ctl + CW_XCC) + (F.tid & ~31)); ok = (a == b0) && (a != 0u); }
        if (!ok) F.MISC[20] = 1u;
        __syncthreads();
        local_ok = (F.MISC[20] == 0u);
    }
#define LSEAM(k, idx) do { if (IN(k) && IN((k) + 1)) { if (local_ok) group_sync(F, bar, (idx)); else xcd_barrier(bar); } STAMP(); } while (0)
    if (IN(1)) { ph1(F); REP(1) { __syncthreads(); ph1(F); } } FSEAM(1, 1);
    if (IN(2)) { ph2(F); REP(2) ph2(F); } FSEAM(2, 2);
    const bool fused_mix = (F.G * NWAVES == NB * 8 * NCH);
    if (IN(3)) { ph3(F); REP(3) ph3(F); } if (fused_mix) LSEAM(3, 0); else SEAM(3);
    if (IN(4) && !fused_mix) { mix_phase(F); } if (!fused_mix) SEAM(4);
    if (IN(5)) { ph5(F); REP(5) { __syncthreads(); ph5(F); } } LSEAM(5, 1);
    const bool fuse678 = (F.G == 256) && IN(6) && IN(7) && IN(8);
    if (fuse678) { ph678(F, bar); STAMP(); STAMP(); }
    else {
        if (IN(6)) { ln1_phase<false>(F); REP(6) ln1_phase<false>(F); } SEAM(6);
        if (IN(7)) { ph7(F); REP(7) ph7(F); } SEAM(7);
        if (IN(8)) { REP(8) { route_phase<true>(F, 0, 0); } route_phase<false>(F, XC_P5, XI_ALL); }
    }
    FSEAM(8, 3);
    if (IN(9)) { slot_phase(F); REP(9) { __syncthreads(); slot_phase(F); } } FSEAMR(9, XC_P5 - 2048, XC_P5);
    if (IN(10)) { ph10(F); REP(10) ph10(F); } SEAM(10);
    if (IN(11)) { REP(11) ph11a<true>(F); ph11a<false>(F); } SEAM(11);
    if (IN(12)) { REP(12) { final_phase<false>(F); } final_phase<true>(F); }
    STAMP();
#undef IN
#undef REP
#undef SEAM
#undef FSEAM
#undef FSEAMR
#undef LSEAM
}

#if defined(SELFCHECK) && SELFCHECK
namespace chk {
constexpr int NS = 64;
struct InP { const float* p[25]; };
DI float f8dec(unsigned b) { const int e = (b >> 3) & 15, m = b & 7; const float mag = e == 0 ? (float)m * 0.001953125f : (1.f + (float)m * 0.125f) * exp2f((float)(e - 7)); return (b & 128) ? -mag : mag; }
DI float h_at(const unsigned char* ws, size_t slot, int c) { return f8dec(ws[WS_H + slot * EH + c]) * (1.0f / HSCALE); }

__host__ __device__ inline int samp_tok(int i) { return i == 0 ? 0 : i == 1 ? 8191 : i == 2 ? 8192 : i == 3 ? T - 1 : i == 4 ? 63 : i == 5 ? 64 : i == 6 ? 8127 : i == 7 ? 16384 + 4095 : (int)(((long)i * 2039 + 17 * (i % 5)) % T); }
DI void put_err(unsigned* CHK, int stage, float num, float den) { float e = sqrtf(num / (den + 1e-30f)); if (!(e == e)) e = 1e30f; atomicMax(CHK + stage, __float_as_uint(e)); }
DI float blk_sum(float v, float* red) {
    v = wave_sum(v); __syncthreads(); if ((threadIdx.x & 63) == 0) red[threadIdx.x >> 6] = v; __syncthreads(); return red[0] + red[1] + red[2] + red[3]; }
__global__ void __launch_bounds__(256) c1(const float* x, const int* pos, const float* w_in, const unsigned char* ws, unsigned* CHK) {
    __shared__ float hrow[INW]; __shared__ float red[4];
    const int t = samp_tok(blockIdx.x), tid = threadIdx.x;
    for (int c = tid; c < INW; c += 256) { float a = 0.f; for (int k = 0; k < D; ++k) a = fmaf(x[(size_t)t * D + k], w_in[(size_t)k * INW + c], a); hrow[c] = a; }
    __syncthreads();
    if (tid < 128) { const int i = tid & 7, head = (tid >> 3) & 7, which = tid >> 6;
        const float invf[8] = {1.0f, 0x1.8d275ep-3f, 0x1.341190p-5f, 0x1.ddee9cp-8f, 0x1.72ba44p-10f, 0x1.1f91f0p-12f, 0x1.be218ap-15f, 0x1.5a0f50p-17f};
        float inv = invf[0];
#pragma unroll
        for (int j = 1; j < 8; ++j) inv = (i == j) ? invf[j] : inv;
        float c, s; sincos_acc((float)pos[t] * inv, c, s);
        float* p = hrow + which * AW + head * HD; const float t1 = p[i], t2 = p[i + 8]; p[i] = t1 * c - t2 * s; p[i + 8] = t2 * c + t1 * s; }
    __syncthreads();
    float num = 0.f, den = 0.f;
    for (int c = tid; c < INW; c += 256) { const int seg = c >> 9; float r = hrow[c]; if (seg == 0) r *= QSCALE; if (seg == 4) r = gelu_tanh(r);
        const float f = bf2f(((const bf16*)(ws + WS_Q + (size_t)seg * SEG_BYTES))[(size_t)t * 512 + (c & 511)]); num += (f - r) * (f - r); den += r * r; }
    num = blk_sum(num, red); den = blk_sum(den, red);
    if (tid == 0) put_err(CHK, 1, num, den);
}
__global__ void __launch_bounds__(64) c2(const unsigned char* ws, unsigned* CHK) {
    const bf16* Q = (const bf16*)(ws + WS_Q); const bf16* K = (const bf16*)(ws + WS_Q + SEG_BYTES); const bf16* V = (const bf16*)(ws + WS_Q + 2 * SEG_BYTES); const bf16* O = (const bf16*)(ws + WS_ATTN);
    const int lane = threadIdx.x, head = blockIdx.x & 7, t = samp_tok(blockIdx.x >> 3), b = t / SEQ, s = t % SEQ;
    const float q = bf2f(Q[(size_t)t * AW + head * HD + lane]);
    float m = -1e30f, den = 0.f, o = 0.f;
    for (int g = 0; g < 3; ++g) { const int d = g == 0 ? 1 : (g == 1 ? 4 : 16);
        for (int mm = -64; mm <= 64; ++mm) { const int j = s + d * mm; if (j < 0 || j >= SEQ) continue;
            const size_t row = (size_t)(b * SEQ + j) * AW + head * HD + lane;
            const float sc = wave_sum(q * bf2f(K[row])); const float mn = fmaxf(m, sc), al = exp2f(m - mn), p = exp2f(sc - mn);
            den = den * al + p; o = o * al + p * bf2f(V[row]); m = mn; } }
    const float r = o / den, f = bf2f(O[(size_t)t * AW + head * HD + lane]);
    const float num = wave_sum((f - r) * (f - r)), dn = wave_sum(r * r);
    if (lane == 0) put_err(CHK, 2, num, dn);
}
__global__ void __launch_bounds__(64) c3(InP ip, const unsigned char* ws, float* scratch, unsigned* CHK) {
    const float* cw = ip.p[4]; const float* cb = ip.p[5]; const float* gaw = ip.p[6]; const float* gab = ip.p[7]; const float* gxw = ip.p[8]; const float* gxb = ip.p[9]; const float* lam = ip.p[10];
    const bf16* RX = (const bf16*)(ws + WS_Q + 3 * SEG_BYTES); const bf16* G = (const bf16*)(ws + WS_Q + 4 * SEG_BYTES); const bf16* HFp = (const bf16*)(ws + WS_HF); const bf16* HBp = (const bf16*)(ws + WS_REC);
    const int lane = threadIdx.x, smp = blockIdx.x, b = smp & 3, c = (smp * 37 + 5) % RW, n = c >> 6, j = c & 63;
    float* sc = scratch + (size_t)smp * SEQ * 4;
    for (int s = lane; s < SEQ; s += 64) {
        float pa0 = 0.f, pa1 = 0.f, px0 = 0.f, px1 = 0.f, uc = 0.f;
        for (int i = 0; i < 64; ++i) { const int ci = 64 * n + i; float u = cb[ci];
            for (int k = 0; k < 4; ++k) { const int ss = s + k - 2; if (ss >= 0 && ss < SEQ) u = fmaf(cw[k * RW + ci], bf2f(RX[(size_t)(b * SEQ + ss) * RW + ci]), u); }
            if (i == j) uc = u;
            pa0 = fmaf(u, gaw[(((size_t)0 * 8 + n) * 64 + i) * 64 + j], pa0); px0 = fmaf(u, gxw[(((size_t)0 * 8 + n) * 64 + i) * 64 + j], px0);
            pa1 = fmaf(u, gaw[(((size_t)1 * 8 + n) * 64 + i) * 64 + j], pa1); px1 = fmaf(u, gxw[(((size_t)1 * 8 + n) * 64 + i) * 64 + j], px1); }
        { const float r = 1.f / (1.f + expf(-(pa0 + gab[c]))), ig = 1.f / (1.f + expf(-(px0 + gxb[c])));
          const float l = lam[c], sp = log1pf(expf(-l)), log_a = -8.0f * r * sp, a = expf(log_a);
          sc[(size_t)s * 4 + 0] = a; sc[(size_t)s * 4 + 1] = sqrtf(-expm1f(2.0f * log_a)) * ig * uc; }
        { const float r = 1.f / (1.f + expf(-(pa1 + gab[RW + c]))), ig = 1.f / (1.f + expf(-(px1 + gxb[RW + c])));
          const float l = lam[RW + c], sp = log1pf(expf(-l)), log_a = -8.0f * r * sp, a = expf(log_a);
          sc[(size_t)s * 4 + 2] = a; sc[(size_t)s * 4 + 3] = sqrtf(-expm1f(2.0f * log_a)) * ig * uc; }
    }
    __syncthreads();
    if (lane == 0) { float h = 0.f; for (int s = 0; s < SEQ; ++s) { h = fmaf(sc[(size_t)s * 4], h, sc[(size_t)s * 4 + 1]); sc[(size_t)s * 4 + 1] = h; } }
    if (lane == 1) { float h = 0.f; for (int s = SEQ - 1; s >= 0; --s) { h = fmaf(sc[(size_t)s * 4 + 2], h, sc[(size_t)s * 4 + 3]); sc[(size_t)s * 4 + 3] = h; } }
    __syncthreads();
    float num = 0.f, den = 0.f;
    for (int s = lane; s < SEQ; s += 64) { const size_t o = (size_t)(b * SEQ + s) * RW + c; const float r = (sc[(size_t)s * 4 + 1] + sc[(size_t)s * 4 + 3]) * bf2f(G[o]), f = (bf2f(HFp[o]) + bf2f(HBp[o])) * bf2f(G[o]); num += (f - r) * (f - r); den += r * r; }
    num = wave_sum(num); den = wave_sum(den);
    if (lane == 0) put_err(CHK, 3, num, den);
}
__global__ void __launch_bounds__(256) c4(const float* ga, const float* gr, const unsigned char* ws, unsigned* CHK) {
    __shared__ float red[4];
    const bf16* AT = (const bf16*)(ws + WS_ATTN); const bf16* HFp = (const bf16*)(ws + WS_HF); const bf16* HBp = (const bf16*)(ws + WS_REC); const bf16* Gp = (const bf16*)(ws + WS_Q + 4 * SEG_BYTES); const bf16* MX = (const bf16*)(ws + WS_MIX);
    const int t = samp_tok(blockIdx.x), tid = threadIdx.x;
    float av[2], rv[2], sa = 0.f, sr = 0.f;
    for (int i = 0; i < 2; ++i) { const int c = tid + 256 * i; av[i] = bf2f(AT[(size_t)t * AW + c]); rv[i] = (bf2f(HFp[(size_t)t * RW + c]) + bf2f(HBp[(size_t)t * RW + c])) * bf2f(Gp[(size_t)t * RW + c]); sa += av[i] * av[i]; sr += rv[i] * rv[i]; }
    sa = blk_sum(sa, red); sr = blk_sum(sr, red);
    const float ra = rsqrtf(sa / 512.f + LN_EPS), rr = rsqrtf(sr / 512.f + LN_EPS);
    float num = 0.f, den = 0.f;
    for (int i = 0; i < 2; ++i) { const int c = tid + 256 * i; const float r1 = av[i] * ra * ga[c], r2 = rv[i] * rr * gr[c], f1 = bf2f(MX[(size_t)t * D + c]), f2 = bf2f(MX[(size_t)t * D + AW + c]);
        num += (f1 - r1) * (f1 - r1) + (f2 - r2) * (f2 - r2); den += r1 * r1 + r2 * r2; }
    num = blk_sum(num, red); den = blk_sum(den, red);
    if (tid == 0) put_err(CHK, 4, num, den);
}
__global__ void __launch_bounds__(256) c5(const float* x, const float* w_out, const unsigned char* ws, unsigned* CHK) {
    __shared__ float red[4];
    const bf16* MX = (const bf16*)(ws + WS_MIX); const bf16* Yb = (const bf16*)(ws + WS_V1);
    const int t = samp_tok(blockIdx.x), tid = threadIdx.x; float num = 0.f, den = 0.f;
    for (int c = tid; c < D; c += 256) { float a = 0.f; for (int k = 0; k < D; ++k) a = fmaf(bf2f(MX[(size_t)t * D + k]), w_out[(size_t)k * D + c], a);
        const float r = a, f = bf2f(Yb[(size_t)t * D + c]); num += (f - r) * (f - r); den += r * r; }
    num = blk_sum(num, red); den = blk_sum(den, red);
    if (tid == 0) put_err(CHK, 5, num, den);
}
__global__ void __launch_bounds__(256) c6(const float* g, const float* bb, const float* x, const unsigned char* ws, unsigned* CHK) {
    __shared__ float red[4];
    const bf16* Yb = (const bf16*)(ws + WS_V1); const bf16* X1B = (const bf16*)(ws + WS_X1B);
    const int t = samp_tok(blockIdx.x), tid = threadIdx.x; float v[4], s = 0.f;
    for (int i = 0; i < 4; ++i) { v[i] = ALPHA * x[(size_t)t * D + tid + 256 * i] + bf2f(Yb[(size_t)t * D + tid + 256 * i]); s += v[i]; }
    const float mu = blk_sum(s, red) / D; float q = 0.f;
    for (int i = 0; i < 4; ++i) { const float d = v[i] - mu; q += d * d; }
    const float rs = rsqrtf(blk_sum(q, red) / D + LN_EPS); float num = 0.f, den = 0.f;
    for (int i = 0; i < 4; ++i) { const int c = tid + 256 * i; const float r = (v[i] - mu) * rs * g[c] + bb[c], f2 = bf2f(X1B[(size_t)t * D + c]);
        num += (f2 - r) * (f2 - r); den += r * r; }
    num = blk_sum(num, red); den = blk_sum(den, red);
    if (tid == 0) put_err(CHK, 6, num, den);
}
__global__ void __launch_bounds__(256) c7(const float* router_w, const unsigned char* ws, unsigned* CHK) {
    __shared__ float red[4];
    const bf16* X1B = (const bf16*)(ws + WS_X1B); const float* LG = (const float*)(ws + WS_LOGITS);
    const int t = samp_tok(blockIdx.x), c = threadIdx.x; float a = 0.f;
    for (int k = 0; k < D; ++k) a = fmaf(bf2f(X1B[(size_t)t * D + k]), router_w[(size_t)k * NE + c], a);
    const float f = LG[(size_t)t * NE + c] + LG[(size_t)T * NE + (size_t)t * NE + c];
    const float num = blk_sum((f - a) * (f - a), red), den = blk_sum(a * a, red);
    if (c == 0) put_err(CHK, 7, num, den);
}
__global__ void __launch_bounds__(64) c8(const float* rbias, const unsigned char* ws, const unsigned* ctl, unsigned* CHK) {
    __shared__ float sc[NE], bs[NE]; __shared__ int sel[8]; __shared__ float gate[8]; __shared__ float gsc[8]; __shared__ int gm[8];
    const float* LG = (const float*)(ws + WS_LOGITS); const unsigned* TS = (const unsigned*)(ws + WS_TS); const int* slot_tok = (const int*)(ws + WS_SLOTTOK);
    const float* slot_w = (const float*)(ws + WS_SLOTW); const int* tile_e = (const int*)(ws + WS_TILEE);
    const int t = samp_tok(blockIdx.x), lane = threadIdx.x;
    for (int e = lane; e < NE; e += 64) { const float l = LG[(size_t)t * NE + e] + LG[(size_t)T * NE + (size_t)t * NE + e]; sc[e] = 1.f / (1.f + expf(-l)); bs[e] = sc[e] + rbias[e]; }
    __syncthreads();
    if (lane == 0) {
        for (int g = 0; g < 8; ++g) { float a = -1e30f, b2 = -1e30f; for (int i = 0; i < 32; ++i) { const float v = bs[32 * g + i]; if (v > a) { b2 = a; a = v; } else if (v > b2) b2 = v; } gsc[g] = a + b2; gm[g] = 0; }
        for (int k = 0; k < 4; ++k) { int best = -1; for (int g = 0; g < 8; ++g) if (!gm[g] && (best < 0 || gsc[g] > gsc[best])) best = g; gm[best] = 1; }
        float sum = 0.f;
        for (int k = 0; k < 8; ++k) { int best = -1; for (int e = 0; e < NE; ++e) { if (!gm[e >> 5]) continue; bool used = false; for (int q = 0; q < k; ++q) used |= (sel[q] == e); if (used) continue; if (best < 0 || bs[e] > bs[best]) best = e; } sel[k] = best; sum += sc[best]; }
        for (int k = 0; k < 8; ++k) gate[k] = sc[sel[k]] / sum * 2.5f;
        int bad = 0; const int NT = (int)ctl[CW_NT];
        for (int k = 0; k < 8; ++k) { const unsigned slot = TS[(size_t)t * 8 + k]; const int e = tile_e[slot >> 8];
            if (slot >= (unsigned)NT * 256) { ++bad; continue; }
            if (slot_tok[slot] != t) ++bad;
            int q = -1; for (int k2 = 0; k2 < 8; ++k2) if (sel[k2] == e) q = k2;
            if (q < 0) ++bad; else if (fabsf(slot_w[slot] - gate[q]) > 1e-5f) ++bad; }
        atomicMax(CHK + 8, __float_as_uint((float)bad));
    }
}
DI void samp_slot(int i, const unsigned char* ws, const unsigned* ctl, int& slot, int& e, int& tok) {
    const unsigned* TS = (const unsigned*)(ws + WS_TS); const int* tile_e = (const int*)(ws + WS_TILEE); const int NT = (int)ctl[CW_NT];
    tok = samp_tok(i); if (i >= 32 && (i & 1)) { slot = NT * 256 + tok; e = NE; } else { slot = (int)TS[(size_t)tok * 8 + (i & 7)]; e = tile_e[slot >> 8]; } }
__global__ void __launch_bounds__(256) c9(InP ip, const unsigned char* ws, const unsigned* ctl, unsigned* CHK) {
    __shared__ float red[4];
    int slot, e, tok; samp_slot(blockIdx.x, ws, ctl, slot, e, tok);
    const float* wg = e < NE ? ip.p[17] + (size_t)e * D * EH : ip.p[20]; const float* wu = e < NE ? ip.p[18] + (size_t)e * D * EH : ip.p[21];
    const bf16* X1B = (const bf16*)(ws + WS_X1B); const bf16* Hh = (const bf16*)(ws + WS_H);
    const int c = threadIdx.x; float g = 0.f, u = 0.f;
    for (int k = 0; k < D; ++k) { const float xv = bf2f(X1B[(size_t)tok * D + k]); g = fmaf(xv, wg[(size_t)k * EH + c], g); u = fmaf(xv, wu[(size_t)k * EH + c], u); }
    const float wgt = e < NE ? ((const float*)(ws + WS_SLOTW))[slot] : 1.f; const float r = g / (1.f + expf(-g)) * u * wgt, f = h_at(ws, (size_t)slot, c);
    const float num = blk_sum((f - r) * (f - r), red), den = blk_sum(r * r, red);
    if (c == 0) put_err(CHK, 9, num, den);
}
DI float y_at(const unsigned char* Yb, size_t slot, int c) {
    const int pn = c >> 8, bj = (c >> 7) & 1, wc = (c >> 5) & 3, fq = (c >> 3) & 3, i = c & 7; const unsigned b = Yb[slot * 1024 + ((pn * 4 + wc) * 4 + fq) * 16 + bj * 8 + i];
    const int e = (b >> 3) & 15, m = b & 7; const float mag = e == 0 ? (float)m * 0.001953125f : (1.f + (float)m * 0.125f) * exp2f((float)(e - 7)); return ((b & 128) ? -mag : mag) * (1.0f / YSCALE); }
__global__ void __launch_bounds__(256) c10(InP ip, const unsigned char* ws, const unsigned* ctl, unsigned* CHK) {
    __shared__ float red[4];
    int slot, e, tok; samp_slot(blockIdx.x & 31, ws, ctl, slot, e, tok);
    const float* wd = ip.p[19] + (size_t)e * EH * D; const bf16* Hh = (const bf16*)(ws + WS_H); const unsigned char* Y = (const unsigned char*)(ws + WS_Y);
    float num = 0.f, den = 0.f;
    for (int c = threadIdx.x; c < D; c += 256) { float a = 0.f; for (int k = 0; k < EH; ++k) a = fmaf(h_at(ws, (size_t)slot, k), wd[(size_t)k * D + c], a);
        const float r = a, f = y_at(Y, (size_t)slot, c); num += (f - r) * (f - r); den += r * r; }
    num = blk_sum(num, red); den = blk_sum(den, red);
    if (threadIdx.x == 0) put_err(CHK, 10, num, den);
}
__global__ void __launch_bounds__(256) save_x1b(const unsigned char* ws, bf16* dst) { const bf16* X1B = (const bf16*)(ws + WS_X1B); const int t = samp_tok(blockIdx.x); for (int c = threadIdx.x; c < D; c += 256) dst[(size_t)blockIdx.x * D + c] = X1B[(size_t)t * D + c]; }
__global__ void __launch_bounds__(256) c11(InP ip, const float* out, const unsigned char* ws, const unsigned* ctl, unsigned* CHK, const bf16* x1s) {
    __shared__ float red[4];
    const bf16* Hh = (const bf16*)(ws + WS_H); const unsigned char* Y = (const unsigned char*)(ws + WS_Y); const unsigned* TS = (const unsigned*)(ws + WS_TS);
    const int t = samp_tok(blockIdx.x), tid = threadIdx.x, NT = (int)ctl[CW_NT]; const float* sd = ip.p[22];
    float v[4], s = 0.f;
    for (int i = 0; i < 4; ++i) { const int c = tid + 256 * i; float a = 0.f; for (int k = 0; k < EH; ++k) a = fmaf(h_at(ws, (size_t)NT * 256 + t, k), sd[(size_t)k * D + c], a);
        a += ALPHA * bf2f(x1s[(size_t)blockIdx.x * D + c]); for (int k = 0; k < 8; ++k) a += y_at(Y, (size_t)TS[(size_t)t * 8 + k], c); v[i] = a; s += a; }
    const float mu = blk_sum(s, red) / D; float q = 0.f;
    for (int i = 0; i < 4; ++i) { const float d = v[i] - mu; q += d * d; }
    const float rs = rsqrtf(blk_sum(q, red) / D + LN_EPS); float num = 0.f, den = 0.f;
    for (int i = 0; i < 4; ++i) { const int c = tid + 256 * i; const float r = (v[i] - mu) * rs * ip.p[23][c] + ip.p[24][c], f = out[(size_t)t * D + c]; num += (f - r) * (f - r); den += r * r; }
    num = blk_sum(num, red); den = blk_sum(den, red);
    if (tid == 0) put_err(CHK, 11, num, den);
}
__global__ void __launch_bounds__(256) verdict(float* out, const unsigned* CHK, const unsigned* ctl) {
    int stage = 0; float err = 0.f;
    for (int s = 1; s <= 11; ++s) { const float e = __uint_as_float(CHK[s]); const float tol = (s == 8) ? 0.5f : (s == 10 ? 0.12f : (s == 9 ? 0.12f : (s == 11 ? 0.05f : 0.03f))); if (stage == 0 && !(e <= tol)) { stage = s; err = e; } }
    for (int li = 0; li < 16; ++li) if (stage == 0 && ctl[CW_BAR + li * XCD_BAR_WORDS_C + 128] != 0) { stage = 12; err = 1.f; }
    if (stage == 0) return;
    float lg = (log10f(fminf(fmaxf(err, 1e-3f), 1.f)) + 3.f) / 3.f; const float c2v = powf(10.f, (float)stage) * (1.f + 8.f * lg); const float C = sqrtf(c2v);
    for (size_t i = (size_t)blockIdx.x * 256 + threadIdx.x; i < (size_t)T * D; i += (size_t)gridDim.x * 256) out[i] = C;
}
}
#endif

#ifdef REPORT_K
#ifndef REPORT_B
#define REPORT_B REPORT_K
#endif
__global__ void __launch_bounds__(256) k_report(float* out, const unsigned long long* ts) {
    const float usA = (float)(ts[REPORT_K + 1] - ts[REPORT_K]) * 0.01f, usB = (float)(ts[REPORT_B + 1] - ts[REPORT_B]) * 0.01f;
    const int bA = (int)(usA * (1.0f / 8.0f)), bB = (int)(usB * (1.0f / 16.0f));
    if (blockIdx.x == 0 && threadIdx.x == 0) out[0] += (float)bA;
    const int row = 1 + (int)blockIdx.x;
    if (row <= bB) for (int c = threadIdx.x; c < D; c += 256) out[(size_t)row * D + c] += 2.0f;
}
#endif
extern "C" void kernel_launch(void* const* d_in, const int* in_sizes, int n_in, void* d_out, int out_size, void* d_ws, size_t ws_size, hipStream_t stream) {
    static int grid = 0;
    if (grid == 0) {
        if (n_in != 25 || in_sizes[0] != T * D || out_size != T * D || ws_size < WS_END) { fprintf(stderr, "kernel_launch: unexpected problem shape / workspace (%d inputs, ws %zu); nothing launched\n", n_in, ws_size); grid = -1; return; }
        int dev = 0, cus = 0, per_cu = 0;
        if (hipGetDevice(&dev) != hipSuccess || hipDeviceGetAttribute(&cus, hipDeviceAttributeMultiprocessorCount, dev) != hipSuccess) { grid = -1; return; }
        if (hipFuncSetAttribute((const void*)mk_fwd, hipFuncAttributeMaxDynamicSharedMemorySize, LDS_BYTES) != hipSuccess) { fprintf(stderr, "kernel_launch: hipFuncSetAttribute failed\n"); grid = -1; return; }
        if (hipOccupancyMaxActiveBlocksPerMultiprocessor(&per_cu, (const void*)mk_fwd, NWAVES * 64, LDS_BYTES) != hipSuccess || per_cu < 1) { fprintf(stderr, "kernel_launch: occupancy query says %d\n", per_cu); }
        (void)hipGetLastError();
        grid = cus;
    }
    if (grid < 0) return;
    (void)hipMemsetAsync((char*)d_ws + WS_CTL, 0, CTL_ZERO_BYTES, stream);
    Args a{};
    for (int i = 0; i < 25; ++i) a.in[i] = (const float*)d_in[i];
    a.out = (float*)d_out; a.ws = (unsigned char*)d_ws;
#if defined(SELFCHECK) && SELFCHECK
    unsigned char* ws = (unsigned char*)d_ws; unsigned* CHK = (unsigned*)(ws + WS_CTL) + CW_CHK; const unsigned* ctl = (const unsigned*)(ws + WS_CTL);
    chk::InP inp{}; for (int i = 0; i < 25; ++i) inp.p[i] = a.in[i];
    float* scratch = (float*)(ws + WS_END + MiB);
    for (int p = 0; p < N_PHASES; ++p) {
        a.ph_lo = p; a.ph_hi = p + 1; a.li = p;
        hipLaunchKernelGGL(mk_fwd, dim3(grid), dim3(NWAVES * 64), LDS_BYTES, stream, a);
        using namespace chk;
        if (p == 1) hipLaunchKernelGGL(c1, dim3(NS), dim3(256), 0, stream, a.in[0], (const int*)d_in[1], a.in[2], ws, CHK);
        if (p == 2) hipLaunchKernelGGL(c2, dim3(NS * 8), dim3(64), 0, stream, ws, CHK);
        if (p == 3) hipLaunchKernelGGL(c3, dim3(16), dim3(64), 0, stream, inp, ws, scratch, CHK);
        if (p == 4) hipLaunchKernelGGL(c4, dim3(NS), dim3(256), 0, stream, a.in[3], a.in[11], ws, CHK);
        if (p == 5) hipLaunchKernelGGL(c5, dim3(NS), dim3(256), 0, stream, a.in[0], a.in[12], ws, CHK);
        if (p == 6) hipLaunchKernelGGL(c6, dim3(NS), dim3(256), 0, stream, a.in[13], a.in[14], a.in[0], ws, CHK);
        if (p == 7) hipLaunchKernelGGL(c7, dim3(NS), dim3(256), 0, stream, a.in[15], ws, CHK);
        if (p == 9) hipLaunchKernelGGL(c8, dim3(NS), dim3(64), 0, stream, a.in[16], ws, ctl, CHK);
        if (p == 10) { hipLaunchKernelGGL(c9, dim3(NS), dim3(256), 0, stream, inp, ws, ctl, CHK); hipLaunchKernelGGL(save_x1b, dim3(NS), dim3(256), 0, stream, ws, (bf16*)(ws + WS_END + 4 * MiB)); }
        if (p == 11) hipLaunchKernelGGL(c10, dim3(32), dim3(256), 0, stream, inp, ws, ctl, CHK);
        if (p == 12) hipLaunchKernelGGL(c11, dim3(NS), dim3(256), 0, stream, inp, (const float*)d_out, ws, ctl, CHK, (const bf16*)(ws + WS_END + 4 * MiB));
    }
    hipLaunchKernelGGL(chk::verdict, dim3(1024), dim3(256), 0, stream, (float*)d_out, CHK, ctl);
#else
    a.ph_lo = 0; a.ph_hi = N_PHASES; a.li = 0;
    hipLaunchKernelGGL(mk_fwd, dim3(grid), dim3(NWAVES * 64), LDS_BYTES, stream, a);
#ifdef REPORT_K
    hipLaunchKernelGGL(k_report, dim3(64), dim3(256), 0, stream, (float*)d_out, (const unsigned long long*)((unsigned char*)d_ws + WS_END + 8 * MiB));
#endif
#endif
}
```
